# Optimizing an MI355X kernel written in HIP

```python
import math
import jax, jax.numpy as jnp
from jax import lax
import numpy as np

D_MODEL = 1024
BATCH = 2
SEQ = 8192
DEPTH = 2

N_MIXERS = 2
N_CONV_LAYERS = (DEPTH + N_MIXERS - 1) // N_MIXERS
N_ATTN_LAYERS = DEPTH // N_MIXERS
CONV_WIDTH = 3
N_HEADS = 16
N_KV_HEADS = 4
HEAD_DIM = D_MODEL // N_HEADS
GROUP = N_HEADS // N_KV_HEADS
WINDOW = 128
BLOCK = 128
NEG_INF = -1e30
N_BUCKETS = 32
MAX_DISTANCE = 128
PEER_HEADS = 8
N_KEYS = 128
N_EXPERTS = N_KEYS * N_KEYS
PEER_TOPK = 16
QUERY_DIM = 256
SUB_DIM = QUERY_DIM // 2
PEER_CHUNK = 128
RMS_EPS = 1e-6

kernel_name = "hybrid_conv_swa_peer_encoder"


def _rmsnorm(x, g):
    xf = x.astype(jnp.float32)
    y = xf * lax.rsqrt(jnp.mean(xf * xf, axis=-1, keepdims=True) + RMS_EPS)
    return (y * g.astype(jnp.float32)).astype(x.dtype)


def _short_conv_mixer(x, w_in, w_conv, w_out):
    gate_b, gate_c, h = jnp.split(x @ w_in, 3, axis=-1)
    y = lax.conv_general_dilated(
        gate_c * h, w_conv[:, None, :].astype(h.dtype),
        window_strides=(1,), padding=((CONV_WIDTH // 2, CONV_WIDTH // 2),),
        dimension_numbers=("NWC", "WIO", "NWC"), feature_group_count=D_MODEL)
    return (gate_b * y) @ w_out


def _t5_bucket(rel):
    half = N_BUCKETS // 2
    max_exact = half // 2
    ret = jnp.where(rel > 0, half, 0)
    n = jnp.abs(rel)
    nf = jnp.maximum(n, 1).astype(jnp.float32)
    large = max_exact + (jnp.log(nf / max_exact) / math.log(MAX_DISTANCE / max_exact)
                         * (half - max_exact)).astype(jnp.int32)
    large = jnp.minimum(large, half - 1)
    return ret + jnp.where(n < max_exact, n, large)


def _windowed_gqa(x, w_qkv, sink, w_o, rel_bias):
    bsz, s, _ = x.shape
    nb = s // BLOCK
    qkv = x @ w_qkv
    q = qkv[..., :N_HEADS * HEAD_DIM].reshape(bsz, nb, BLOCK, N_KV_HEADS, GROUP, HEAD_DIM)
    k = qkv[..., N_HEADS * HEAD_DIM:(N_HEADS + N_KV_HEADS) * HEAD_DIM].reshape(bsz, s, N_KV_HEADS, HEAD_DIM)
    v = qkv[..., (N_HEADS + N_KV_HEADS) * HEAD_DIM:].reshape(bsz, s, N_KV_HEADS, HEAD_DIM)

    def band(t):
        tp = jnp.pad(t, ((0, 0), (BLOCK, BLOCK), (0, 0), (0, 0)))
        tb = tp.reshape(bsz, nb + 2, BLOCK, N_KV_HEADS, HEAD_DIM)
        return jnp.concatenate([tb[:, :-2], tb[:, 1:-1], tb[:, 2:]], axis=2)

    kw, vw = band(k), band(v)
    scores = jnp.einsum("bnqhgd,bnkhd->bnhgqk", q, kw).astype(jnp.float32) / math.sqrt(HEAD_DIM)

    qi = jnp.arange(BLOCK)[:, None]
    kj = jnp.arange(3 * BLOCK)[None, :]
    rel = kj - BLOCK - qi
    bias = rel_bias[_t5_bucket(rel)].astype(jnp.float32)
    bias = jnp.transpose(bias, (2, 0, 1)).reshape(N_KV_HEADS, GROUP, BLOCK, 3 * BLOCK)
    kpos = jnp.arange(nb)[:, None] * BLOCK - BLOCK + jnp.arange(3 * BLOCK)[None, :]
    valid = (jnp.abs(rel) <= WINDOW)[None] & ((kpos >= 0) & (kpos < s))[:, None, :]
    logits = jnp.where(valid[None, :, None, None], scores + bias, NEG_INF)

    sink_logit = jnp.broadcast_to(sink.astype(jnp.float32).reshape(N_KV_HEADS, GROUP, 1, 1),
                                  logits.shape[:-1] + (1,))
    probs = jax.nn.softmax(jnp.concatenate([logits, sink_logit], axis=-1), axis=-1)[..., :-1]
    out = jnp.einsum("bnhgqk,bnkhd->bnqhgd", probs.astype(vw.dtype), vw)
    return out.reshape(bsz, s, N_HEADS * HEAD_DIM) @ w_o


def _peer(xn, w_q, subkeys, u_tab, v_tab):
    bsz, s, d = xn.shape
    t = xn.reshape(-1, d)
    n_tok = t.shape[0]
    q = (t @ w_q).reshape(n_tok, PEER_HEADS, 2, SUB_DIM)
    sc = jnp.einsum("thpd,hpnd->thpn", q, subkeys).astype(jnp.float32)
    sv, si = lax.top_k(sc, PEER_TOPK)
    cand = (sv[:, :, 0, :, None] + sv[:, :, 1, None, :]).reshape(n_tok, PEER_HEADS, PEER_TOPK * PEER_TOPK)
    cidx = (si[:, :, 0, :, None] * N_KEYS + si[:, :, 1, None, :]).reshape(n_tok, PEER_HEADS, PEER_TOPK * PEER_TOPK)
    top_v, pos = lax.top_k(cand, PEER_TOPK)
    idx = jnp.take_along_axis(cidx, pos, axis=-1)
    g = jax.nn.softmax(top_v, axis=-1)

    n_chunks = n_tok // PEER_CHUNK
    n_sel = PEER_HEADS * PEER_TOPK

    def expert_block(args):
        xc, ic, gc = args
        u = jnp.take(u_tab, ic, axis=0)
        h = jnp.einsum("cd,ced->ce", xc, u)
        a = gc.astype(xc.dtype) * jax.nn.gelu(h, approximate=False)
        return jnp.einsum("ce,ced->cd", a, jnp.take(v_tab, ic, axis=0))

    out = lax.map(expert_block, (t.reshape(n_chunks, PEER_CHUNK, d),
                                 idx.reshape(n_chunks, PEER_CHUNK, n_sel),
                                 g.reshape(n_chunks, PEER_CHUNK, n_sel)))
    return out.reshape(bsz, s, d)


def setup_inputs(seed: int = 0) -> dict:
    key = jax.random.key(seed)
    ks = jax.random.split(key, 20)
    D = D_MODEL
    nrm = lambda k, shape, scale: jax.random.normal(k, shape, jnp.float32) * scale
    qkv_cols = (N_HEADS + 2 * N_KV_HEADS) * HEAD_DIM
    return {
        "x": nrm(ks[0], (BATCH, SEQ, D), 1.0),
        "conv_norm_g": 1.0 + nrm(ks[1], (N_CONV_LAYERS, D), 0.02),
        "conv_w_in": nrm(ks[2], (N_CONV_LAYERS, D, 3 * D), D ** -0.5),
        "conv_w": nrm(ks[3], (N_CONV_LAYERS, CONV_WIDTH, D), CONV_WIDTH ** -0.5),
        "conv_w_out": nrm(ks[4], (N_CONV_LAYERS, D, D), D ** -0.5),
        "attn_norm_g": 1.0 + nrm(ks[5], (N_ATTN_LAYERS, D), 0.02),
        "attn_w_qkv": nrm(ks[6], (N_ATTN_LAYERS, D, qkv_cols), D ** -0.5),
        "attn_sink": nrm(ks[7], (N_ATTN_LAYERS, N_HEADS), 0.5),
        "attn_w_o": nrm(ks[8], (N_ATTN_LAYERS, N_HEADS * HEAD_DIM, D), (N_HEADS * HEAD_DIM) ** -0.5),
        "rel_bias": nrm(ks[9], (N_BUCKETS, N_HEADS), 0.1),
        "ffn_norm_g": 1.0 + nrm(ks[10], (DEPTH, D), 0.02),
        "peer_w_q": nrm(ks[11], (DEPTH, D, PEER_HEADS * QUERY_DIM), D ** -0.5),
        "peer_subkeys": nrm(ks[12], (DEPTH, PEER_HEADS, 2, N_KEYS, SUB_DIM), SUB_DIM ** -0.5),
        "peer_u": nrm(ks[13], (DEPTH, N_EXPERTS, D), D ** -0.5),
        "peer_v": nrm(ks[14], (DEPTH, N_EXPERTS, D), D ** -0.5),
        "final_norm_g": 1.0 + nrm(ks[15], (D,), 0.02),
    }


def reference(x, conv_norm_g, conv_w_in, conv_w, conv_w_out, attn_norm_g, attn_w_qkv,
              attn_sink, attn_w_o, rel_bias, ffn_norm_g, peer_w_q, peer_subkeys,
              peer_u, peer_v, final_norm_g):
    for i in range(DEPTH):
        j = i // N_MIXERS
        if i % N_MIXERS == 0:
            x = x + _short_conv_mixer(_rmsnorm(x, conv_norm_g[j]), conv_w_in[j], conv_w[j], conv_w_out[j])
        else:
            x = x + _windowed_gqa(_rmsnorm(x, attn_norm_g[j]), attn_w_qkv[j], attn_sink[j],
                                  attn_w_o[j], rel_bias)
        x = x + _peer(_rmsnorm(x, ffn_norm_g[i]), peer_w_q[i], peer_subkeys[i], peer_u[i], peer_v[i])
    return _rmsnorm(x, final_norm_g)
```

```cpp
#include <hip/hip_runtime.h>
#include <cstdio>
#include <cstdint>
namespace pg8 {
#define PG8_LAS __attribute__((address_space(3)))
typedef unsigned short bf16_t;
typedef short bf16x8 __attribute__((ext_vector_type(8)));
typedef float f32x4 __attribute__((ext_vector_type(4)));
typedef unsigned u32x4 __attribute__((ext_vector_type(4)));
constexpr int BM = 256, BK = 64, HALF = 128, HTB = HALF * BK * 2  , STAGE_BYTES = 8 * HTB, NXCD = 8, WGM = 8;

__host__ __device__ __forceinline__ int lds_byte(int r, int c) { const int st = (r >> 4) * 2 + (c >> 5), rr = r & 15, cc = c & 31, ob = rr * 64 + cc * 2; return st * 1024 + (ob ^ (((ob >> 9) & 1) << 5)); }
__host__ __device__ __forceinline__ void stage_rc(int b, int& R, int& C) { const int st = b / 1024, sb = b % 1024, swz = sb ^ (((sb >> 9) & 1) << 5); R = (st >> 1) * 16 + swz / 64; C = (st & 1) * 32 + (swz % 64) / 2; }
__host__ __device__ __forceinline__ int perm32(int rho) { const int n = rho >> 4, i = rho & 15; return 8 * (i >> 2) + 4 * n + (i & 3); }

struct Unit { int pm, pn; };
struct Gemm { const bf16_t* A; const bf16_t* Bt; int M, N, K; };

struct StaticOrder {
    int nM, nN, nwg, G, c;
    __host__ __device__ void init(int M, int N, int G_, int c_) { nM = M / BM; nN = N / BM; nwg = nM * nN; G = G_; c = c_; }
    __host__ __device__ bool next(int i, Unit& u) const {
        const long L = (long)i * G + c; if (L >= nwg) return false;
        int wgid = (int)L; { const int q = nwg / NXCD, r = nwg % NXCD, xcd = wgid % NXCD, off = wgid / NXCD; wgid = (xcd < r ? xcd * (q + 1) : r * (q + 1) + (xcd - r) * q) + off; }
        const int nig = WGM * nN, gid = wgid / nig, fm = gid * WGM, gsz = (nM - fm) < WGM ? (nM - fm) : WGM;
        u.pm = fm + ((wgid % nig) % gsz); u.pn = (wgid % nig) / gsz; return true;
    }
    __device__ __forceinline__ void a_ready(const Unit&) const {}
    __device__ __forceinline__ void done(const Unit&) const {}
};

__device__ __forceinline__ unsigned cvt_pk_bf16(float lo, float hi) { unsigned r; asm volatile("v_cvt_pk_bf16_f32 %0, %1, %2" : "=v"(r) : "v"(lo), "v"(hi)); return r; }
typedef unsigned u32x2 __attribute__((ext_vector_type(2)));
__device__ __forceinline__ float row_rstd(const float* ss, int row) {
    const f32x4* p = (const f32x4*)(ss + (size_t)row * 16);
    const f32x4 a = p[0], b = p[1], c = p[2], d = p[3];
    const float s = (((a[0] + a[1]) + (a[2] + a[3])) + ((b[0] + b[1]) + (b[2] + b[3]))) + (((c[0] + c[1]) + (c[2] + c[3])) + ((d[0] + d[1]) + (d[2] + d[3])));
    return __builtin_amdgcn_rsqf(s * (1.0f / 1024.0f) + 1e-6f);
}
struct EpiBf16RS {
    static constexpr bool PERM = true, AFTER_DRAIN = false;
    bf16_t* O0; int ld0; int nt0; bf16_t* O1; bf16_t* O2; int ld1; const float* ss;
    __device__ __forceinline__ void operator()(const f32x4 (&acc)[2][2][4][2], const Unit& u, int wr, int wc, int fr, int fq) const {
        bf16_t* base; int ld, colt;
        if (u.pn < nt0) { base = O0; ld = ld0; colt = u.pn * BM; } else if (u.pn == nt0) { base = O1; ld = ld1; colt = 0; } else { base = O2; ld = ld1; colt = (u.pn - nt0 - 1) * BM; }
        const int row0 = u.pm * BM + wr * 64 + fr, col0 = colt + wc * 32 + 8 * fq;
#pragma unroll
        for (int ai = 0; ai < 2; ++ai)
#pragma unroll
            for (int m = 0; m < 4; ++m) { const int row = row0 + ai * HALF + m * 16; const float rs = row_rstd(ss, row); bf16_t* rowp = base + (size_t)row * ld + col0;
#pragma unroll
                for (int bj = 0; bj < 2; ++bj) { const f32x4 v0 = acc[ai][bj][m][0] * rs, v1 = acc[ai][bj][m][1] * rs;
                    u32x4 w; w.x = cvt_pk_bf16(v0[0], v0[1]); w.y = cvt_pk_bf16(v0[2], v0[3]); w.z = cvt_pk_bf16(v1[0], v1[1]); w.w = cvt_pk_bf16(v1[2], v1[3]);
                    *(u32x4*)(rowp + bj * HALF) = w; } }
    }
};
struct EpiResid {
    static constexpr bool PERM = false, AFTER_DRAIN = false;
    const float* base; float* out; bf16_t* xb; float* ss;
    __device__ __forceinline__ void operator()(const f32x4 (&acc)[2][2][4][2], const Unit& u, int wr, int wc, int fr, int fq) const {
        const int row0 = u.pm * BM + wr * 64 + fr, col0 = u.pn * BM + wc * 32 + 4 * fq;
#pragma unroll
        for (int ai = 0; ai < 2; ++ai)
#pragma unroll
            for (int m = 0; m < 4; ++m) { const int row = row0 + ai * HALF + m * 16; float sq = 0.f;
#pragma unroll
                for (int bj = 0; bj < 2; ++bj)
#pragma unroll
                    for (int n = 0; n < 2; ++n) { const size_t off = (size_t)row * 1024 + col0 + bj * HALF + n * 16;
                        const f32x4 o = *(const f32x4*)(base + off) + acc[ai][bj][m][n];
                        *(f32x4*)(out + off) = o; sq += (o[0] * o[0] + o[1] * o[1]) + (o[2] * o[2] + o[3] * o[3]);
                        u32x2 w; w.x = cvt_pk_bf16(o[0], o[1]); w.y = cvt_pk_bf16(o[2], o[3]); *(u32x2*)(xb + off) = w; }
                sq += __shfl_xor(sq, 16); sq += __shfl_xor(sq, 32);
                if (fq == 0) ss[(size_t)row * 16 + u.pn * 4 + wc] = sq; }
    }
};

template <class Epi, class Sched, bool ALIGN_EPI = false, bool SP2 = false>
__device__ __forceinline__ void gemm_phase(PG8_LAS unsigned char* lds, const Gemm g, const Sched& S, const Epi& E) {
    const int tid = threadIdx.x, wid = __builtin_amdgcn_readfirstlane(tid >> 6), lane = tid & 63, wr = wid >> 2, wc = wid & 3, fr = lane & 15, fq = lane >> 4;
    const int K = g.K, nt = K / BK;
    unsigned voffA[2], voffB[2];
#pragma unroll
    for (int i = 0; i < 2; ++i) { int R, C; stage_rc(tid * 16 + i * 8192, R, C); const int Rb = Epi::PERM ? ((R & ~31) + perm32(R & 31)) : R;
        voffA[i] = (unsigned)(R * K + C) * 2u; voffB[i] = (unsigned)(Rb * K + C) * 2u; }
    const size_t kstep = (size_t)(BK * 2);
    const size_t hstep = (size_t)HALF * K * 2;
    const size_t tstep = 2 * hstep;
    const unsigned ldsw = (unsigned)wid * 1024u;
    const int aoff = lds_byte(wr * 64 + fr, fq * 8), boff = lds_byte(wc * 32 + fr, fq * 8);
#define PG8_SA(b, h) (((b) * 2 + (h)) * HTB)
#define PG8_SB(b, h) ((4 + (b) * 2 + (h)) * HTB)
#define PG8_STAGE(bufoff, gbase, voff) do { _Pragma("unroll") for (int _i = 0; _i < 2; ++_i) \
        __builtin_amdgcn_global_load_lds((const unsigned*)((const char*)(gbase) + (voff)[_i]), (PG8_LAS unsigned*)(lds + (bufoff) + ldsw + _i * 8192), 16, 0, 0); } while (0)
#define PG8_LDA(dst, b, h) do { _Pragma("unroll") for (int m = 0; m < 4; ++m) _Pragma("unroll") for (int k = 0; k < 2; ++k) dst[m][k] = *(const PG8_LAS bf16x8*)(lds + PG8_SA(b, h) + aoff + m * 2048 + k * 1024); } while (0)
#define PG8_LDB(dst, b, h) do { _Pragma("unroll") for (int n = 0; n < 2; ++n) _Pragma("unroll") for (int k = 0; k < 2; ++k) dst[n][k] = *(const PG8_LAS bf16x8*)(lds + PG8_SB(b, h) + boff + n * 2048 + k * 1024); } while (0)
#define PG8_MMA(ai, bj, At, Bt) do { __builtin_amdgcn_s_setprio(1); _Pragma("unroll") for (int m = 0; m < 4; ++m) _Pragma("unroll") for (int n = 0; n < 2; ++n) _Pragma("unroll") for (int k = 0; k < 2; ++k) \
        acc[ai][bj][m][n] = __builtin_amdgcn_mfma_f32_16x16x32_bf16(Bt[n][k], At[m][k], acc[ai][bj][m][n], 0, 0, 0); __builtin_amdgcn_s_setprio(0); } while (0)
#define PG8_WAIT_V(n) asm volatile("s_waitcnt vmcnt(" #n ")" ::: "memory")
#define PG8_WAIT_L(n) asm volatile("s_waitcnt lgkmcnt(" #n ")" ::: "memory")
#define PG8_BAR __builtin_amdgcn_s_barrier()
#define PG8_SCHED __builtin_amdgcn_sched_barrier(0)
    Unit cur, nxt; int ui = 0;
    if (!S.next(0, cur)) return;
    f32x4 acc[2][2][4][2];
#pragma unroll
    for (int a = 0; a < 2; ++a)
#pragma unroll
        for (int b = 0; b < 2; ++b)
#pragma unroll
            for (int m = 0; m < 4; ++m)
#pragma unroll
                for (int n = 0; n < 2; ++n) acc[a][b][m][n] = (f32x4){0.f, 0.f, 0.f, 0.f};
    bf16x8 At[4][2], B0[2][2], B1[2][2];
    const char* cA = (const char*)g.A + (size_t)cur.pm * tstep; const char* cB = (const char*)g.Bt + (size_t)cur.pn * tstep;
    S.a_ready(cur);
    if constexpr (SP2) {
        PG8_STAGE(PG8_SB(0, 0), cB, voffB); PG8_STAGE(PG8_SB(0, 1), cB + hstep, voffB); PG8_STAGE(PG8_SA(0, 0), cA, voffA); PG8_STAGE(PG8_SA(0, 1), cA + hstep, voffA);
        if (wr == 1) PG8_BAR;
        PG8_WAIT_V(2); PG8_BAR;
        PG8_STAGE(PG8_SB(1, 0), cB + kstep, voffB); PG8_STAGE(PG8_SA(1, 0), cA + kstep, voffA); PG8_STAGE(PG8_SB(1, 1), cB + hstep + kstep, voffB);
        PG8_WAIT_V(6); PG8_BAR;
    } else {
        PG8_STAGE(PG8_SB(0, 0), cB, voffB); PG8_STAGE(PG8_SA(0, 0), cA, voffA); PG8_STAGE(PG8_SB(0, 1), cB + hstep, voffB); PG8_STAGE(PG8_SA(0, 1), cA + hstep, voffA);
        if (wr == 1) PG8_BAR;
        PG8_WAIT_V(4); PG8_BAR;
        PG8_STAGE(PG8_SB(1, 0), cB + kstep, voffB); PG8_STAGE(PG8_SA(1, 0), cA + kstep, voffA); PG8_STAGE(PG8_SB(1, 1), cB + hstep + kstep, voffB);
        PG8_WAIT_V(6); PG8_BAR;
    }
    for (;;) {
        const bool has_next = S.next(ui + 1, nxt);
        const char* nA = has_next ? (const char*)g.A + (size_t)nxt.pm * tstep : cA; const char* nB = has_next ? (const char*)g.Bt + (size_t)nxt.pn * tstep : cB;
        for (int t = 0; t < nt; t += 2) {
            const bool last = (t == nt - 2);
            const char* a1 = cA + (size_t)(t + 1) * kstep;
            const char* a2 = last ? nA : cA + (size_t)(t + 2) * kstep; const char* b2 = last ? nB : cB + (size_t)(t + 2) * kstep;
            const char* a3 = a2 + kstep; const char* b3 = b2 + kstep;
            if (last && has_next) S.a_ready(nxt);
            if constexpr (SP2) {
            PG8_LDB(B0, 0, 0); PG8_LDB(B1, 0, 1); PG8_SCHED; PG8_LDA(At, 0, 0); PG8_STAGE(PG8_SA(1, 1), a1 + hstep, voffA);
            PG8_WAIT_V(8); PG8_WAIT_L(0); PG8_BAR; PG8_MMA(0, 0, At, B0); PG8_MMA(0, 1, At, B1); PG8_BAR; PG8_SCHED;
            PG8_LDA(At, 0, 1); PG8_STAGE(PG8_SB(0, 0), b2, voffB); PG8_STAGE(PG8_SB(0, 1), b2 + hstep, voffB); PG8_STAGE(PG8_SA(0, 0), a2, voffA);
            PG8_WAIT_V(8); PG8_WAIT_L(0); PG8_BAR; PG8_MMA(1, 0, At, B0); PG8_MMA(1, 1, At, B1); PG8_BAR; PG8_SCHED;
            PG8_LDB(B0, 1, 0); PG8_LDB(B1, 1, 1); PG8_SCHED; PG8_LDA(At, 1, 0); PG8_STAGE(PG8_SA(0, 1), a2 + hstep, voffA);
            PG8_WAIT_V(8); PG8_WAIT_L(0); PG8_BAR; PG8_MMA(0, 0, At, B0); PG8_MMA(0, 1, At, B1); PG8_BAR; PG8_SCHED;
            PG8_LDA(At, 1, 1); PG8_STAGE(PG8_SB(1, 0), b3, voffB); PG8_STAGE(PG8_SB(1, 1), b3 + hstep, voffB); PG8_STAGE(PG8_SA(1, 0), a3, voffA);
            PG8_WAIT_V(8); PG8_WAIT_L(0); PG8_BAR; PG8_MMA(1, 0, At, B0); PG8_MMA(1, 1, At, B1); PG8_BAR; PG8_SCHED;
            } else {
            PG8_LDB(B0, 0, 0); PG8_SCHED; PG8_LDA(At, 0, 0); PG8_STAGE(PG8_SA(1, 1), a1 + hstep, voffA);
            PG8_WAIT_L(8); PG8_BAR; PG8_WAIT_L(0); PG8_MMA(0, 0, At, B0); PG8_BAR; PG8_SCHED;
            PG8_LDB(B1, 0, 1); PG8_STAGE(PG8_SB(0, 0), b2, voffB);
            PG8_BAR; PG8_WAIT_L(0); PG8_MMA(0, 1, At, B1); PG8_BAR;
            PG8_LDA(At, 0, 1); PG8_STAGE(PG8_SA(0, 0), a2, voffA);
            PG8_BAR; PG8_WAIT_L(0); PG8_MMA(1, 0, At, B0); PG8_BAR; PG8_SCHED;
            PG8_STAGE(PG8_SB(0, 1), b2 + hstep, voffB);
            PG8_WAIT_V(6); PG8_BAR; PG8_MMA(1, 1, At, B1); PG8_BAR;
            PG8_LDB(B0, 1, 0); PG8_SCHED; PG8_LDA(At, 1, 0); PG8_STAGE(PG8_SA(0, 1), a2 + hstep, voffA);
            PG8_WAIT_L(8); PG8_BAR; PG8_WAIT_L(0); PG8_MMA(0, 0, At, B0); PG8_BAR; PG8_SCHED;
            PG8_LDB(B1, 1, 1); PG8_STAGE(PG8_SB(1, 0), b3, voffB);
            PG8_BAR; PG8_WAIT_L(0); PG8_MMA(0, 1, At, B1); PG8_BAR;
            PG8_LDA(At, 1, 1); PG8_STAGE(PG8_SA(1, 0), a3, voffA);
            PG8_BAR; PG8_WAIT_L(0); PG8_MMA(1, 0, At, B0); PG8_BAR; PG8_SCHED;
            PG8_STAGE(PG8_SB(1, 1), b3 + hstep, voffB);
            PG8_WAIT_V(6); PG8_BAR; PG8_MMA(1, 1, At, B1); PG8_BAR;
            }
        }
        if constexpr (ALIGN_EPI) { if (wr == 0) PG8_BAR; }
        if constexpr (!Epi::AFTER_DRAIN) { E(acc, cur, wr, wc, fr, fq); S.done(cur); }
        if (!has_next) break;
#pragma unroll
        for (int a = 0; a < 2; ++a)
#pragma unroll
            for (int b = 0; b < 2; ++b)
#pragma unroll
                for (int m = 0; m < 4; ++m)
#pragma unroll
                    for (int n = 0; n < 2; ++n) acc[a][b][m][n] = (f32x4){0.f, 0.f, 0.f, 0.f};
        cur = nxt; cA = nA; cB = nB; ++ui;
        if constexpr (ALIGN_EPI) { if (wr == 1) PG8_BAR; }
    }
    PG8_WAIT_V(0);
    if constexpr (!ALIGN_EPI) { if (wr == 0) PG8_BAR; }
    PG8_BAR;
    if constexpr (Epi::AFTER_DRAIN) { E.fused(acc, cur, wr, wc, fr, fq, lds, wid, lane); S.done(cur); }
#undef PG8_SA
#undef PG8_SB
#undef PG8_STAGE
#undef PG8_LDA
#undef PG8_LDB
#undef PG8_MMA
#undef PG8_WAIT_V
#undef PG8_WAIT_L
#undef PG8_BAR
#undef PG8_SCHED
}
}

constexpr int NWAVES = 8;
constexpr int BATCH = 2, SEQ = 8192, D = 1024, T = BATCH * SEQ;
constexpr int NIN = 3072, NQKV = 1536, NPQ = 2048, NEXP = 16384;
constexpr float LOG2E = 1.4426950408889634f;
constexpr float QSCALE = 0.125f * LOG2E;
constexpr float NEGBIG = -1e30f;
#ifndef MK_PER_PHASE
#define MK_PER_PHASE 0
#endif
constexpr int NPH = 13;

constexpr size_t MiB = 1u << 20;
constexpr size_t WS_CTL = 0, CTL_ZERO_BYTES = 65536;
constexpr size_t WS_WIN = 1 * MiB, WS_WOUT = 7 * MiB, WS_WQKV = 9 * MiB, WS_WO = 12 * MiB, WS_WPQ = 14 * MiB, WS_SK = 22 * MiB;
constexpr size_t WS_SS = 23 * MiB;
constexpr size_t WS_IDX = 28 * MiB, WS_GATE = 36 * MiB, WS_XB = 44 * MiB, WS_Y = 76 * MiB, WS_U = 108 * MiB, WS_V = 172 * MiB;
constexpr size_t WS_G1 = 236 * MiB, WS_PQ = 332 * MiB, WS_Q = 396 * MiB, WS_K = 428 * MiB, WS_VV = 436 * MiB, WS_AO = 444 * MiB, WS_END = 476 * MiB;
constexpr int CW_BAR = 4096;

constexpr int RING_BYTES = 131072;
constexpr int LDSCTL_OFF = RING_BYTES, MISC_OFF = LDSCTL_OFF + 320;
constexpr int LDS_BYTES = 147456;

#define LAS __attribute__((address_space(3)))
typedef unsigned short bf16;
typedef unsigned v4u __attribute__((ext_vector_type(4)));
typedef unsigned v2u __attribute__((ext_vector_type(2)));
typedef float f32x4 __attribute__((ext_vector_type(4)));
typedef float f32x2 __attribute__((ext_vector_type(2)));
typedef float f32x16 __attribute__((ext_vector_type(16)));
typedef short bf16x8 __attribute__((ext_vector_type(8)));
typedef __bf16 bf16x2_t __attribute__((ext_vector_type(2)));
#define LDS_WAIT() asm volatile("s_waitcnt lgkmcnt(0)" ::: "memory")
#define DI __device__ __forceinline__

DI unsigned pk2(float lo, float hi) { f32x2 v = {lo, hi}; bf16x2_t b = __builtin_convertvector(v, bf16x2_t); return __builtin_bit_cast(unsigned, b); }
DI float bf_lo(unsigned u) { return __uint_as_float(u << 16); }
DI float bf_hi(unsigned u) { return __uint_as_float(u & 0xffff0000u); }
DI float wave_sum(float v) {
#pragma unroll
    for (int o = 1; o < 64; o <<= 1) v += __shfl_xor(v, o);
    return v;
}
#define XB_TMO      128
#define XB_XCNT(j)  (256  + 64 * (j))
#define XB_XSUB(j)  (1280 + 64 * (j))
#define XB_XGEN(j)  (2304 + 64 * (j))
#define XB_TOP      3328
#define XB_TOPGEN   3392
#define XCD_BAR_WORDS 3456
#define XB_SPIN_CAP (1u << 18)

__device__ __forceinline__ unsigned xb_ld(unsigned* p)              { return __hip_atomic_load(p, __ATOMIC_RELAXED, __HIP_MEMORY_SCOPE_AGENT); }
__device__ __forceinline__ unsigned xb_add(unsigned* p, unsigned v) { return __hip_atomic_fetch_add(p, v, __ATOMIC_RELAXED, __HIP_MEMORY_SCOPE_AGENT); }
__device__ __forceinline__ unsigned xb_xcc_id() { return (unsigned)__builtin_amdgcn_s_getreg((3 << 11) | 20) & 0xFu; }
#define XB_SPIN(cond, bar) do { unsigned _sp = 0; while (cond) { __builtin_amdgcn_s_sleep(1); \
    if ((++_sp & 255u) == 0u) { if (xb_ld(&(bar)[XB_TMO])) break; if (_sp > XB_SPIN_CAP) { atomicAdd(&(bar)[XB_TMO], 1u); break; } } } } while (0)

struct XcdBarrier {
    unsigned* bar; unsigned x;
    volatile LAS unsigned* st;
};

__device__ __forceinline__ XcdBarrier xcd_barrier_post(unsigned* bar, volatile LAS unsigned* st) {
    XcdBarrier b; b.bar = bar; b.x = xb_xcc_id(); b.st = st;
    if (threadIdx.x == 0) (void)xb_add(&bar[XB_XCNT(b.x)], 1u);
    return b;
}
__device__ __forceinline__ void xcd_barrier_complete(unsigned* bar, unsigned x, unsigned& nloc, unsigned& nx) {
    const unsigned G = gridDim.x * gridDim.y * gridDim.z;
    unsigned sum, cnt, mine, sp = 0u;
    for (;;) {
        sum = 0u; cnt = 0u; mine = 0u;
#pragma unroll
        for (unsigned j = 0; j < 16; ++j) { const unsigned c = xb_ld(&bar[XB_XCNT(j)]); sum += c; cnt += (c > 0u) ? 1u : 0u; mine = (j == x) ? c : mine; }
        if (sum == G) break;
        __builtin_amdgcn_s_sleep(1);
        if ((++sp & 255u) == 0u) { if (xb_ld(&bar[XB_TMO])) break; if (sp > XB_SPIN_CAP) { atomicAdd(&bar[XB_TMO], 1u); break; } }
    }
    nloc = mine > 0u ? mine : 1u; nx = cnt > 0u ? cnt : 1u;
}

__device__ __forceinline__ void xcd_barrier(const XcdBarrier& b) {
    asm volatile("s_waitcnt vmcnt(0)" ::: "memory");
    __syncthreads();
    if (threadIdx.x == 0) {
        unsigned* bar = b.bar;
        __builtin_amdgcn_s_waitcnt(0);
        unsigned nloc = b.st[0], nx = b.st[1];
        if (nloc == 0u) { xcd_barrier_complete(bar, b.x, nloc, nx); b.st[0] = nloc; b.st[1] = nx; }
        const unsigned old = xb_add(&bar[XB_XSUB(b.x)], 1u);
        const unsigned gen = old / nloc;
        if (old + 1u == (gen + 1u) * nloc) {
            __builtin_amdgcn_fence(__ATOMIC_RELEASE, "agent");
            asm volatile("s_waitcnt vmcnt(0)" ::: "memory");
            const unsigned og = xb_add(&bar[XB_TOP], 1u);
            const unsigned tg = og / nx;
            if (og + 1u == (tg + 1u) * nx) xb_add(&bar[XB_TOPGEN], 1u);
            else XB_SPIN(xb_ld(&bar[XB_TOPGEN]) == tg, bar);
            __builtin_amdgcn_fence(__ATOMIC_ACQUIRE, "agent");
            xb_add(&bar[XB_XGEN(b.x)], 1u);
            asm volatile("s_waitcnt vmcnt(0)" ::: "memory");
        } else {
            XB_SPIN(xb_ld(&bar[XB_XGEN(b.x)]) == gen, bar);
            __builtin_amdgcn_fence(__ATOMIC_ACQUIRE, "agent");
            asm volatile("s_waitcnt vmcnt(0)" ::: "memory");
        }
    }
    __syncthreads();
}

DI void p0_transpose_item(const float* W, int K, int N, bf16* WT, LAS float* scr, int item, int lane, const float* gain, int nscaled, float cscale) {
    const int nblk = N / 32, kb = item / nblk, nb = item % nblk, k0 = 64 * kb, n0 = 32 * nb;
#pragma unroll 8
    for (int i = 0; i < 32; ++i) { const int kk = 2 * i + (lane >> 5); float v = W[(size_t)(k0 + kk) * N + n0 + (lane & 31)]; if (gain) v *= gain[k0 + kk]; scr[kk * 33 + (lane & 31)] = v; }
    LDS_WAIT();
    const int c = lane & 7;
#pragma unroll
    for (int j = 0; j < 4; ++j) { const int n = (lane >> 3) + 8 * j; const LAS float* s = scr + (8 * c) * 33 + n; const float cs = (n0 + n < nscaled) ? cscale : 1.f;
        v4u o; o.x = pk2(s[0 * 33] * cs, s[1 * 33] * cs); o.y = pk2(s[2 * 33] * cs, s[3 * 33] * cs); o.z = pk2(s[4 * 33] * cs, s[5 * 33] * cs); o.w = pk2(s[6 * 33] * cs, s[7 * 33] * cs);
        *(v4u*)(WT + (size_t)(n0 + n) * K + k0 + 8 * c) = o; }
    LDS_WAIT();
}
struct P0Args { const float *x, *conv_g, *w_in, *w_out, *attn_g, *w_qkv, *w_o, *ffn_g, *w_pq, *subk, *pu, *pv;
                bf16 *WinT, *WoutT, *WqkvT, *WoT, *WpqT, *SKb, *Ub, *Vb, *XB; float* SS0; };
DI void p0_prologue(const P0Args& a, LAS unsigned char* lds, int vcu, int G, int wave, int lane, int tid) {
    LAS float* scr = (LAS float*)(lds + wave * 16384);
    const int gw = vcu * NWAVES + wave, NGW = G * NWAVES;
    constexpr int I_IN = 16 * (NIN / 32), I_OUT = 16 * (D / 32), I_QKV = 16 * (NQKV / 32), I_O = I_OUT, I_PQ = 16 * (NPQ / 32);
    constexpr int NITEMS = I_IN + I_OUT + I_QKV + I_O + 2 * I_PQ;
    for (int it = gw; it < NITEMS; it += NGW) {
        int r = it;
        if (r < I_IN) { p0_transpose_item(a.w_in, D, NIN, a.WinT, scr, r, lane, a.conv_g, 0, 1.f); continue; } r -= I_IN;
        if (r < I_OUT) { p0_transpose_item(a.w_out, D, D, a.WoutT, scr, r, lane, nullptr, 0, 1.f); continue; } r -= I_OUT;
        if (r < I_QKV) { p0_transpose_item(a.w_qkv, D, NQKV, a.WqkvT, scr, r, lane, a.attn_g, 1024, QSCALE); continue; } r -= I_QKV;
        if (r < I_O) { p0_transpose_item(a.w_o, D, D, a.WoT, scr, r, lane, nullptr, 0, 1.f); continue; } r -= I_O;
        if (r < I_PQ) { p0_transpose_item(a.w_pq, D, NPQ, a.WpqT, scr, r, lane, a.ffn_g, 0, 1.f); continue; } r -= I_PQ;
        p0_transpose_item(a.w_pq + (size_t)D * NPQ, D, NPQ, a.WpqT + (size_t)NPQ * D, scr, r, lane, a.ffn_g + D, 0, 1.f);
    }
    const size_t gt = (size_t)vcu * (NWAVES * 64) + tid, NGT = (size_t)G * NWAVES * 64;
    constexpr size_t C_SK = (size_t)2 * 8 * 2 * 128 * 128 / 8, C_TAB = (size_t)2 * NEXP * D / 8;
    for (size_t c = gt; c < C_SK; c += NGT) { const f32x4 v0 = *(const f32x4*)(a.subk + c * 8), v1 = *(const f32x4*)(a.subk + c * 8 + 4);
        v4u o; o.x = pk2(v0[0], v0[1]); o.y = pk2(v0[2], v0[3]); o.z = pk2(v1[0], v1[1]); o.w = pk2(v1[2], v1[3]); *(v4u*)(a.SKb + c * 8) = o; }
    for (size_t c = gt; c < C_TAB; c += NGT) { const int layer = (int)(c / ((size_t)NEXP * D / 8)), d0 = (int)(c % (D / 8)) * 8;
        const f32x4 g0 = *(const f32x4*)(a.ffn_g + layer * D + d0), g1 = *(const f32x4*)(a.ffn_g + layer * D + d0 + 4);
        const f32x4 v0 = __builtin_nontemporal_load((const f32x4*)(a.pu + c * 8)) * g0, v1 = __builtin_nontemporal_load((const f32x4*)(a.pu + c * 8 + 4)) * g1;
        v4u o; o.x = pk2(v0[0], v0[1]); o.y = pk2(v0[2], v0[3]); o.z = pk2(v1[0], v1[1]); o.w = pk2(v1[2], v1[3]); *(v4u*)(a.Ub + c * 8) = o; }
    for (size_t c = gt; c < C_TAB; c += NGT) {
        const f32x4 v0 = __builtin_nontemporal_load((const f32x4*)(a.pv + c * 8)), v1 = __builtin_nontemporal_load((const f32x4*)(a.pv + c * 8 + 4));
        v4u o; o.x = pk2(v0[0], v0[1]); o.y = pk2(v0[2], v0[3]); o.z = pk2(v1[0], v1[1]); o.w = pk2(v1[2], v1[3]); *(v4u*)(a.Vb + c * 8) = o; }
    for (int m = gw; m < T; m += NGW) {
        const f32x4* xr = (const f32x4*)(a.x + (size_t)m * D) + lane; float s = 0.f; f32x4 v[4];
#pragma unroll
        for (int j = 0; j < 4; ++j) { v[j] = xr[64 * j]; s += (v[j][0] * v[j][0] + v[j][1] * v[j][1]) + (v[j][2] * v[j][2] + v[j][3] * v[j][3]); }
        s = wave_sum(s);
        v2u* o8 = (v2u*)(a.XB + (size_t)m * D) + lane;
#pragma unroll
        for (int j = 0; j < 4; ++j) { v2u w; w.x = pk2(v[j][0], v[j][1]); w.y = pk2(v[j][2], v[j][3]); o8[64 * j] = w; }
        if (lane < 4) { f32x4 z = {0.f, 0.f, 0.f, 0.f}; if (lane == 0) z[0] = s; ((f32x4*)(a.SS0 + (size_t)m * 16))[lane] = z; }
    }
}

DI void conv_gate_phase(const bf16* G1, const float* cw, bf16* Y, int vcu, int G, int tid) {
    const size_t gt = (size_t)vcu * (NWAVES * 64) + tid, NGT = (size_t)G * NWAVES * 64;
    for (size_t c = gt; c < (size_t)T * (D / 8); c += NGT) {
        const int t = (int)(c / (D / 8)), d0 = (int)(c % (D / 8)) * 8, ts = t % SEQ;
        const v4u gb = *(const v4u*)(G1 + (size_t)t * NIN + d0);
        float acc[8];
#pragma unroll
        for (int i = 0; i < 8; ++i) acc[i] = 0.f;
#pragma unroll
        for (int w = 0; w < 3; ++w) { const int tt = ts + w - 1;
            if (tt >= 0 && tt < SEQ) {
                const v4u gc = *(const v4u*)(G1 + (size_t)(t + w - 1) * NIN + D + d0), hh = *(const v4u*)(G1 + (size_t)(t + w - 1) * NIN + 2 * D + d0);
                const f32x4 w0 = *(const f32x4*)(cw + w * D + d0), w1 = *(const f32x4*)(cw + w * D + d0 + 4);
                acc[0] += w0[0] * (bf_lo(gc.x) * bf_lo(hh.x)); acc[1] += w0[1] * (bf_hi(gc.x) * bf_hi(hh.x));
                acc[2] += w0[2] * (bf_lo(gc.y) * bf_lo(hh.y)); acc[3] += w0[3] * (bf_hi(gc.y) * bf_hi(hh.y));
                acc[4] += w1[0] * (bf_lo(gc.z) * bf_lo(hh.z)); acc[5] += w1[1] * (bf_hi(gc.z) * bf_hi(hh.z));
                acc[6] += w1[2] * (bf_lo(gc.w) * bf_lo(hh.w)); acc[7] += w1[3] * (bf_hi(gc.w) * bf_hi(hh.w)); } }
        v4u o; o.x = pk2(acc[0] * bf_lo(gb.x), acc[1] * bf_hi(gb.x)); o.y = pk2(acc[2] * bf_lo(gb.y), acc[3] * bf_hi(gb.y));
        o.z = pk2(acc[4] * bf_lo(gb.z), acc[5] * bf_hi(gb.z)); o.w = pk2(acc[6] * bf_lo(gb.w), acc[7] * bf_hi(gb.w));
        *(v4u*)(Y + (size_t)t * D + d0) = o;
    }
}

template <int CTRL> DI unsigned dppu(unsigned v) { return (unsigned)__builtin_amdgcn_update_dpp(0, (int)v, CTRL, 0xf, 0xf, false); }
DI unsigned umax(unsigned a, unsigned b) { return a > b ? a : b; }
DI unsigned umin(unsigned a, unsigned b) { return a < b ? a : b; }
DI unsigned rowmax_u(unsigned v) { v = umax(v, dppu<0x128>(v)); v = umax(v, dppu<0x124>(v)); v = umax(v, dppu<0x122>(v)); v = umax(v, dppu<0x121>(v)); return v; }
DI float rowsum_f(float v) { v += __uint_as_float(dppu<0x128>(__float_as_uint(v))); v += __uint_as_float(dppu<0x124>(__float_as_uint(v))); v += __uint_as_float(dppu<0x122>(__float_as_uint(v))); v += __uint_as_float(dppu<0x121>(__float_as_uint(v))); return v; }
DI unsigned f2key(float f) { const unsigned u = __float_as_uint(f); return u ^ ((unsigned)((int)u >> 31) | 0x80000000u); }
DI float key2f(unsigned k) { const unsigned u = (k & 0x80000000u) ? (k ^ 0x80000000u) : ~k; return __uint_as_float(u); }
DI unsigned cand_ij(int c) {
    unsigned i, j;
    if (c < 16) { i = 0; j = c; } else if (c < 24) { i = 1; j = c - 16; } else if (c < 29) { i = 2; j = c - 24; } else if (c < 33) { i = 3; j = c - 29; }
    else if (c < 36) { i = 4; j = c - 33; } else if (c < 38) { i = 5; j = c - 36; } else if (c < 40) { i = 6; j = c - 38; } else if (c < 42) { i = 7; j = c - 40; }
    else { i = 8 + (c - 42); j = 0; }
    return (i & 15u) | (j << 4);
}
#define CE_DESC(a, b) do { const unsigned _hi = umax(a, b), _lo = umin(a, b); a = _hi; b = _lo; } while (0)
DI void route_phase(const bf16* PQ, const bf16* SK, int* IDX, float* GATE, LAS unsigned char* lds, int vcu, int G, int wave, int lane, int tid) {
    const int fr = lane & 15, fq = lane >> 4;
    LAS unsigned char* TAB = lds;
    if (tid < 64) TAB[tid] = (unsigned char)(tid < 50 ? cand_ij(tid) : 0xff);
    __syncthreads();
    for (int item = vcu; item < (T / 128) * 8; item += G) {
        const int h = item & 7, tile = item >> 3, t0 = tile * 128 + wave * 16;
        unsigned res[2][4];
#pragma unroll
        for (int p = 0; p < 2; ++p) {
            bf16x8 af[4];
#pragma unroll
            for (int ks = 0; ks < 4; ++ks) af[ks] = *(const bf16x8*)(PQ + (size_t)(t0 + fr) * NPQ + h * 256 + p * 128 + ks * 32 + fq * 8);
            f32x4 acc[8];
#pragma unroll
            for (int n = 0; n < 8; ++n) { acc[n] = (f32x4){0.f, 0.f, 0.f, 0.f};
#pragma unroll
                for (int ks = 0; ks < 4; ++ks) { const bf16x8 bfr = *(const bf16x8*)(SK + (size_t)((h * 2 + p) * 128 + n * 16 + fr) * 128 + ks * 32 + fq * 8);
                    acc[n] = __builtin_amdgcn_mfma_f32_16x16x32_bf16(af[ks], bfr, acc[n], 0, 0, 0); } }
#pragma unroll
            for (int r = 0; r < 4; ++r) {
                unsigned L[8];
#pragma unroll
                for (int n = 0; n < 8; ++n) L[n] = (f2key(acc[n][r]) & ~127u) | (unsigned)(127 - (16 * n + fr));
                CE_DESC(L[0], L[1]); CE_DESC(L[2], L[3]); CE_DESC(L[4], L[5]); CE_DESC(L[6], L[7]);
                CE_DESC(L[0], L[2]); CE_DESC(L[1], L[3]); CE_DESC(L[4], L[6]); CE_DESC(L[5], L[7]);
                CE_DESC(L[1], L[2]); CE_DESC(L[5], L[6]); CE_DESC(L[0], L[4]); CE_DESC(L[3], L[7]);
                CE_DESC(L[1], L[5]); CE_DESC(L[2], L[6]);
                CE_DESC(L[1], L[4]); CE_DESC(L[3], L[6]);
                CE_DESC(L[2], L[4]); CE_DESC(L[3], L[5]);
                CE_DESC(L[3], L[4]);
                unsigned rr = 0u;
#pragma unroll
                for (int k = 0; k < 16; ++k) {
                    const unsigned gm = rowmax_u(L[0]);
                    rr = (fr == k) ? gm : rr;
                    const bool pop = (L[0] == gm);
#pragma unroll
                    for (int n = 0; n < 7; ++n) L[n] = pop ? L[n + 1] : L[n];
                    L[7] = pop ? 0u : L[7];
                }
                res[p][r] = rr;
            }
        }
        const int gbase = (lane & 48) * 4;
#pragma unroll
        for (int r = 0; r < 4; ++r) {
            const int t = t0 + 4 * fq + r;
            unsigned ck[4];
#pragma unroll
            for (int s = 0; s < 4; ++s) { const int c = fr + 16 * s; const unsigned tb = TAB[c & 63];
                const unsigned k0 = (unsigned)__builtin_amdgcn_ds_bpermute(gbase + (int)(tb & 15u) * 4, (int)res[0][r]);
                const unsigned k1 = (unsigned)__builtin_amdgcn_ds_bpermute(gbase + (int)((tb >> 4) & 15u) * 4, (int)res[1][r]);
                const float v = key2f((k0 & ~127u) | 64u) + key2f((k1 & ~127u) | 64u);
                ck[s] = (c < 50) ? ((f2key(v) & ~63u) | (unsigned)(63 - c)) : 0u; }
            unsigned sel = 0u;
#pragma unroll
            for (int k = 0; k < 16; ++k) {
                const unsigned gm = rowmax_u(umax(umax(ck[0], ck[1]), umax(ck[2], ck[3])));
                sel = (fr == k) ? gm : sel;
#pragma unroll
                for (int s = 0; s < 4; ++s) ck[s] = (ck[s] == gm) ? 0u : ck[s];
            }
            const int cs = 63 - (int)(sel & 63u); const unsigned tb = TAB[cs & 63];
            const unsigned k0 = (unsigned)__builtin_amdgcn_ds_bpermute(gbase + (int)(tb & 15u) * 4, (int)res[0][r]);
            const unsigned k1 = (unsigned)__builtin_amdgcn_ds_bpermute(gbase + (int)((tb >> 4) & 15u) * 4, (int)res[1][r]);
            const int e = (127 - (int)(k0 & 127u)) * 128 + (127 - (int)(k1 & 127u));
            const float val = key2f((sel & ~63u) | 32u), top = key2f((rowmax_u(sel) & ~63u) | 32u);
            const float ex = __builtin_amdgcn_exp2f((val - top) * LOG2E), sum = rowsum_f(ex);
            IDX[(size_t)t * 128 + h * 16 + fr] = e; GATE[(size_t)t * 128 + h * 16 + fr] = ex / sum;
        }
    }
}

DI float dot8(v4u x, v4u u, float acc) {
    acc += bf_lo(x.x) * bf_lo(u.x); acc += bf_hi(x.x) * bf_hi(u.x); acc += bf_lo(x.y) * bf_lo(u.y); acc += bf_hi(x.y) * bf_hi(u.y);
    acc += bf_lo(x.z) * bf_lo(u.z); acc += bf_hi(x.z) * bf_hi(u.z); acc += bf_lo(x.w) * bf_lo(u.w); acc += bf_hi(x.w) * bf_hi(u.w);
    return acc;
}
DI void fma8(float* acc, float a, v4u v) {
    acc[0] += a * bf_lo(v.x); acc[1] += a * bf_hi(v.x); acc[2] += a * bf_lo(v.y); acc[3] += a * bf_hi(v.y);
    acc[4] += a * bf_lo(v.z); acc[5] += a * bf_hi(v.z); acc[6] += a * bf_lo(v.w); acc[7] += a * bf_hi(v.w);
}
template <bool FINAL>
DI void experts_phase(const bf16* U, const bf16* V, const int* IDX, const float* GATE, const float* ss_in, float* ss_out, float* xf, bf16* XB, const float* fin_g,
                      int vcu, int G, int wave, int lane) {
    for (int t = vcu * NWAVES + wave; t < T; t += G * NWAVES) {
        const v4u* xr = (const v4u*)(XB + (size_t)t * D);
        const v4u xa = xr[lane], xb = xr[64 + lane];
        const float rs = pg8::row_rstd(ss_in, t);
        const int myi0 = IDX[(size_t)t * 128 + lane], myi1 = IDX[(size_t)t * 128 + 64 + lane];
        const int eperm = (lane & 7) * 8 + (lane >> 3);
        const float g0 = GATE[(size_t)t * 128 + eperm], g1 = GATE[(size_t)t * 128 + 64 + eperm];
        float H0 = 0.f, H1 = 0.f;
#pragma unroll 1
        for (int b = 0; b < 16; ++b) {
            const int src = (b < 8) ? myi0 : myi1;
            v4u ua[8], ub[8];
#pragma unroll
            for (int j = 0; j < 8; ++j) { const int idx = __builtin_amdgcn_readlane(src, ((b & 7) * 8 + j));
                const v4u* ur = (const v4u*)(U + (size_t)idx * D); ua[j] = ur[lane]; ub[j] = ur[64 + lane]; }
            float p[8];
#pragma unroll
            for (int j = 0; j < 8; ++j) p[j] = dot8(xb, ub[j], dot8(xa, ua[j], 0.f));
            const bool b5 = lane & 32, b4 = lane & 16, b3 = lane & 8;
            float q[4];
#pragma unroll
            for (int j = 0; j < 4; ++j) { const float keep = b5 ? p[4 + j] : p[j], send = b5 ? p[j] : p[4 + j]; q[j] = keep + __shfl_xor(send, 32); }
            float r2[2];
#pragma unroll
            for (int j = 0; j < 2; ++j) { const float keep = b4 ? q[2 + j] : q[j], send = b4 ? q[j] : q[2 + j]; r2[j] = keep + __shfl_xor(send, 16); }
            float k3; { const float keep = b3 ? r2[1] : r2[0], send = b3 ? r2[0] : r2[1]; k3 = keep + __shfl_xor(send, 8); }
            k3 += __shfl_xor(k3, 4); k3 += __shfl_xor(k3, 2); k3 += __shfl_xor(k3, 1);
            const bool mine = (lane & 7) == (b & 7);
            if (b < 8) H0 = mine ? k3 : H0; else H1 = mine ? k3 : H1;
        }
        const float h0 = H0 * rs, h1 = H1 * rs;
        const float a0 = g0 * (0.5f * h0 * (1.f + erff(h0 * 0.70710678118654752f))), a1 = g1 * (0.5f * h1 * (1.f + erff(h1 * 0.70710678118654752f)));
        float acc[16];
#pragma unroll
        for (int i = 0; i < 16; ++i) acc[i] = 0.f;
#pragma unroll 1
        for (int b = 0; b < 16; ++b) {
            const int src = (b < 8) ? myi0 : myi1; const float asrc = (b < 8) ? a0 : a1;
            v4u va[8], vb[8]; float aj[8];
#pragma unroll
            for (int j = 0; j < 8; ++j) { const int idx = __builtin_amdgcn_readlane(src, ((b & 7) * 8 + j));
                const v4u* vr = (const v4u*)(V + (size_t)idx * D); va[j] = vr[lane]; vb[j] = vr[64 + lane];
                aj[j] = __uint_as_float((unsigned)__builtin_amdgcn_readlane((int)__float_as_uint(asrc), j * 8 + (b & 7))); }
#pragma unroll
            for (int j = 0; j < 8; ++j) { fma8(acc, aj[j], va[j]); fma8(acc + 8, aj[j], vb[j]); }
        }
        float* xo = xf + (size_t)t * D;
        f32x4 o[4]; o[0] = *(const f32x4*)(xo + lane * 8); o[1] = *(const f32x4*)(xo + lane * 8 + 4); o[2] = *(const f32x4*)(xo + 512 + lane * 8); o[3] = *(const f32x4*)(xo + 512 + lane * 8 + 4);
        float sq = 0.f;
#pragma unroll
        for (int i = 0; i < 4; ++i) { o[i] += (f32x4){acc[4 * i], acc[4 * i + 1], acc[4 * i + 2], acc[4 * i + 3]}; sq += (o[i][0] * o[i][0] + o[i][1] * o[i][1]) + (o[i][2] * o[i][2] + o[i][3] * o[i][3]); }
        sq = wave_sum(sq);
        if (FINAL) {
            const float rf = __builtin_amdgcn_rsqf(sq * (1.0f / 1024.0f) + 1e-6f);
            const f32x4 gg0 = *(const f32x4*)(fin_g + lane * 8), gg1 = *(const f32x4*)(fin_g + lane * 8 + 4), gg2 = *(const f32x4*)(fin_g + 512 + lane * 8), gg3 = *(const f32x4*)(fin_g + 512 + lane * 8 + 4);
            *(f32x4*)(xo + lane * 8) = o[0] * rf * gg0; *(f32x4*)(xo + lane * 8 + 4) = o[1] * rf * gg1; *(f32x4*)(xo + 512 + lane * 8) = o[2] * rf * gg2; *(f32x4*)(xo + 512 + lane * 8 + 4) = o[3] * rf * gg3;
        } else {
            *(f32x4*)(xo + lane * 8) = o[0]; *(f32x4*)(xo + lane * 8 + 4) = o[1]; *(f32x4*)(xo + 512 + lane * 8) = o[2]; *(f32x4*)(xo + 512 + lane * 8 + 4) = o[3];
            v4u w0, w1; w0.x = pk2(o[0][0], o[0][1]); w0.y = pk2(o[0][2], o[0][3]); w0.z = pk2(o[1][0], o[1][1]); w0.w = pk2(o[1][2], o[1][3]);
            w1.x = pk2(o[2][0], o[2][1]); w1.y = pk2(o[2][2], o[2][3]); w1.z = pk2(o[3][0], o[3][1]); w1.w = pk2(o[3][2], o[3][3]);
            v4u* xw = (v4u*)(XB + (size_t)t * D); xw[lane] = w0; xw[64 + lane] = w1;
            if (lane < 4) { f32x4 z = {0.f, 0.f, 0.f, 0.f}; if (lane == 0) z[0] = sq; ((f32x4*)(ss_out + (size_t)t * 16))[lane] = z; }
        }
    }
}

DI int t5_bucket(int rel) {
    const int n = rel < 0 ? -rel : rel; int b;
    if (n < 8) b = n; else if (n < 12) b = 8; else if (n < 16) b = 9; else if (n < 23) b = 10; else if (n < 32) b = 11; else if (n < 46) b = 12; else if (n < 64) b = 13; else if (n < 91) b = 14; else b = 15;
    return b + (rel > 0 ? 16 : 0);
}
DI int crow(int reg, int h) { return (reg & 3) + 8 * (reg >> 2) + 4 * h; }
constexpr int AT_KL = 0, AT_KSTR = 144, AT_VT = 384 * AT_KSTR  , AT_VSTR = 776, AT_BT = AT_VT + 64 * AT_VSTR  , AT_END = AT_BT + 4 * 512 * 4;
static_assert(AT_END <= RING_BYTES, "attention LDS");
DI void attn_phase(const bf16* Qg, const bf16* Kg, const bf16* Vg, bf16* AO, const float* rel_bias, const float* sink, LAS unsigned char* lds, int vcu, int G, int wave, int lane, int tid) {
    const int r = lane & 31, h = lane >> 5;
    for (int unit = vcu; unit < BATCH * 4 * (SEQ / 128); unit += G) {
        const int b = unit / 256, kvh = (unit % 256) / 64, blk = unit % 64;
        __syncthreads();
        for (int c = tid; c < 384 * 8; c += NWAVES * 64) { const int row = c >> 3, c8 = c & 7, ts = blk * 128 - 128 + row;
            v4u kv = {0u, 0u, 0u, 0u}, vv = {0u, 0u, 0u, 0u};
            if (ts >= 0 && ts < SEQ) { const size_t g = (size_t)(b * SEQ + ts) * 256 + kvh * 64 + c8 * 8; kv = *(const v4u*)(Kg + g); vv = *(const v4u*)(Vg + g); }
            *(LAS v4u*)(lds + AT_KL + row * AT_KSTR + c8 * 16) = kv;
            LAS unsigned short* vt = (LAS unsigned short*)(lds + AT_VT) + (c8 * 8) * (AT_VSTR / 2) + row;
            vt[0 * (AT_VSTR / 2)] = (unsigned short)(vv.x & 0xffffu); vt[1 * (AT_VSTR / 2)] = (unsigned short)(vv.x >> 16);
            vt[2 * (AT_VSTR / 2)] = (unsigned short)(vv.y & 0xffffu); vt[3 * (AT_VSTR / 2)] = (unsigned short)(vv.y >> 16);
            vt[4 * (AT_VSTR / 2)] = (unsigned short)(vv.z & 0xffffu); vt[5 * (AT_VSTR / 2)] = (unsigned short)(vv.z >> 16);
            vt[6 * (AT_VSTR / 2)] = (unsigned short)(vv.w & 0xffffu); vt[7 * (AT_VSTR / 2)] = (unsigned short)(vv.w >> 16); }
        for (int c = tid; c < 4 * 512; c += NWAVES * 64) { const int g = c >> 9, i = c & 511, rel = i - 255;
            float v = NEGBIG; if (rel >= -128 && rel <= 128) v = rel_bias[t5_bucket(rel) * 16 + kvh * 4 + g] * LOG2E;
            *(LAS float*)(lds + AT_BT + c * 4) = v; }
        __syncthreads();
        const int g = wave >> 1, qh = wave & 1, head = kvh * 4 + g;
        const float sinkl = sink[head] * LOG2E;
        bf16x8 qf[2][4];
#pragma unroll
        for (int qt = 0; qt < 2; ++qt)
#pragma unroll
            for (int s = 0; s < 4; ++s) qf[qt][s] = *(const bf16x8*)(Qg + (size_t)(b * SEQ + blk * 128 + qh * 64 + qt * 32 + r) * D + head * 64 + s * 16 + h * 8);
        float m[2] = {sinkl, sinkl}, l[2] = {0.f, 0.f};
        f32x16 o[2][2];
#pragma unroll
        for (int qt = 0; qt < 2; ++qt)
#pragma unroll
            for (int dt = 0; dt < 2; ++dt)
#pragma unroll
                for (int i = 0; i < 16; ++i) o[qt][dt][i] = 0.f;
        int kt_lo = 2 * qh, kt_hi = 2 * qh + 9;
        if (blk == 0 && kt_lo < 4) kt_lo = 4;
        if (blk == SEQ / 128 - 1 && kt_hi > 7) kt_hi = 7;
#pragma unroll 1
        for (int kt = kt_lo; kt <= kt_hi; ++kt) {
            bf16x8 kf[4];
#pragma unroll
            for (int s = 0; s < 4; ++s) kf[s] = *(const LAS bf16x8*)(lds + AT_KL + (32 * kt + r) * AT_KSTR + s * 32 + h * 16);
            bf16x8 vf[2][2];
#pragma unroll
            for (int dt = 0; dt < 2; ++dt)
#pragma unroll
                for (int s2 = 0; s2 < 2; ++s2) { const LAS unsigned char* vp = lds + AT_VT + (32 * dt + r) * AT_VSTR + (32 * kt + 16 * s2 + 4 * h) * 2;
                    const v2u lo = *(const LAS v2u*)vp, hi2 = *(const LAS v2u*)(vp + 16); v4u w = {lo.x, lo.y, hi2.x, hi2.y}; vf[dt][s2] = __builtin_bit_cast(bf16x8, w); }
#pragma unroll
            for (int qt = 0; qt < 2; ++qt) {
                f32x16 s;
                const LAS float* bt = (const LAS float*)(lds + AT_BT) + g * 512 + 127 + 32 * kt + 4 * h - (64 * qh + 32 * qt + r);
#pragma unroll
                for (int i = 0; i < 16; ++i) s[i] = bt[(i & 3) + 8 * (i >> 2)];
#pragma unroll
                for (int k4 = 0; k4 < 4; ++k4) s = __builtin_amdgcn_mfma_f32_32x32x16_bf16(kf[k4], qf[qt][k4], s, 0, 0, 0);
                float mx = s[0];
#pragma unroll
                for (int i = 1; i < 16; ++i) mx = fmaxf(mx, s[i]);
                mx = fmaxf(mx, __shfl_xor(mx, 32));
                const float mn = fmaxf(m[qt], mx), al = __builtin_amdgcn_exp2f(m[qt] - mn); m[qt] = mn;
                float ps = 0.f;
#pragma unroll
                for (int i = 0; i < 16; ++i) { s[i] = __builtin_amdgcn_exp2f(s[i] - mn); ps += s[i]; }
                l[qt] = l[qt] * al + ps;
#pragma unroll
                for (int dt = 0; dt < 2; ++dt)
#pragma unroll
                    for (int i = 0; i < 16; ++i) o[qt][dt][i] *= al;
                bf16x8 pf[2];
#pragma unroll
                for (int s2 = 0; s2 < 2; ++s2) { v4u w; w.x = pk2(s[8 * s2 + 0], s[8 * s2 + 1]); w.y = pk2(s[8 * s2 + 2], s[8 * s2 + 3]); w.z = pk2(s[8 * s2 + 4], s[8 * s2 + 5]); w.w = pk2(s[8 * s2 + 6], s[8 * s2 + 7]); pf[s2] = __builtin_bit_cast(bf16x8, w); }
#pragma unroll
                for (int dt = 0; dt < 2; ++dt)
#pragma unroll
                    for (int s2 = 0; s2 < 2; ++s2) o[qt][dt] = __builtin_amdgcn_mfma_f32_32x32x16_bf16(vf[dt][s2], pf[s2], o[qt][dt], 0, 0, 0);
            }
        }
#pragma unroll
        for (int qt = 0; qt < 2; ++qt) {
            const float lt = l[qt] + __shfl_xor(l[qt], 32) + __builtin_amdgcn_exp2f(sinkl - m[qt]), inv = 1.0f / lt;
            bf16* op = AO + (size_t)(b * SEQ + blk * 128 + qh * 64 + qt * 32 + r) * D + head * 64 + 4 * h;
#pragma unroll
            for (int dt = 0; dt < 2; ++dt)
#pragma unroll
                for (int gq = 0; gq < 4; ++gq) { v2u w; w.x = pk2(o[qt][dt][4 * gq] * inv, o[qt][dt][4 * gq + 1] * inv); w.y = pk2(o[qt][dt][4 * gq + 2] * inv, o[qt][dt][4 * gq + 3] * inv);
                    *(v2u*)(op + 32 * dt + 8 * gq) = w; }
        }
    }
}

struct Args { const float* in[16]; float* out; unsigned char* ws; int ph_lo, ph_hi; };
__global__ void __launch_bounds__(NWAVES * 64, 2) fwd_kernel(Args args) {
    extern __shared__ __attribute__((aligned(16))) unsigned char lds_raw[];
    LAS unsigned char* lds = (LAS unsigned char*)lds_raw;
    volatile LAS unsigned* MISC = (volatile LAS unsigned*)(lds + MISC_OFF);
    const int tid = threadIdx.x, lane = tid & 63, wave = __builtin_amdgcn_readfirstlane(tid >> 6);
    const int G = gridDim.x; const int bx = blockIdx.x; const int vcu = (G % 8 == 0) ? (bx % 8) * (G / 8) + bx / 8 : bx;
    unsigned char* ws = args.ws;
    unsigned* ctl = (unsigned*)(ws + WS_CTL);
    const float* x = args.in[0]; const float* conv_g = args.in[1]; const float* w_in = args.in[2]; const float* conv_w = args.in[3]; const float* w_out = args.in[4];
    const float* attn_g = args.in[5]; const float* w_qkv = args.in[6]; const float* sink = args.in[7]; const float* w_o = args.in[8]; const float* rel_bias = args.in[9];
    const float* ffn_g = args.in[10]; const float* w_pq = args.in[11]; const float* subk = args.in[12]; const float* pu = args.in[13]; const float* pv = args.in[14]; const float* fin_g = args.in[15];
    float* out = args.out;
    bf16* WinT = (bf16*)(ws + WS_WIN); bf16* WoutT = (bf16*)(ws + WS_WOUT); bf16* WqkvT = (bf16*)(ws + WS_WQKV); bf16* WoT = (bf16*)(ws + WS_WO); bf16* WpqT = (bf16*)(ws + WS_WPQ); bf16* SKb = (bf16*)(ws + WS_SK);
    float* SS = (float*)(ws + WS_SS); int* IDX = (int*)(ws + WS_IDX); float* GATE = (float*)(ws + WS_GATE);
    bf16* XB = (bf16*)(ws + WS_XB); bf16* Y = (bf16*)(ws + WS_Y); bf16* Ub = (bf16*)(ws + WS_U); bf16* Vb = (bf16*)(ws + WS_V);
    bf16* G1 = (bf16*)(ws + WS_G1); bf16* PQ = (bf16*)(ws + WS_PQ); bf16* Qb = (bf16*)(ws + WS_Q); bf16* Kb = (bf16*)(ws + WS_K); bf16* VVb = (bf16*)(ws + WS_VV); bf16* AO = (bf16*)(ws + WS_AO);
    float* SS0 = SS; float* SS1 = SS + (size_t)T * 16; float* SS2 = SS + (size_t)2 * T * 16; float* SS3 = SS + (size_t)3 * T * 16;

    for (int u = tid; u < (LDS_BYTES - LDSCTL_OFF) / 4; u += NWAVES * 64) ((LAS unsigned*)(lds + LDSCTL_OFF))[u] = 0u;
    __syncthreads();
    XcdBarrier bar; bar.bar = ctl + CW_BAR; bar.x = 0; bar.st = nullptr;
    if (!MK_PER_PHASE) bar = xcd_barrier_post(ctl + CW_BAR, MISC + 8);
    const int lo = args.ph_lo, hi = args.ph_hi;
#define IN(k) (lo <= (k) && (k) < hi)
#define SEAM(k) do { if (IN(k) && IN((k) + 1)) xcd_barrier(bar); } while (0)

    if (IN(0)) {
        P0Args a{x, conv_g, w_in, w_out, attn_g, w_qkv, w_o, ffn_g, w_pq, subk, pu, pv, WinT, WoutT, WqkvT, WoT, WpqT, SKb, Ub, Vb, XB, SS0};
        p0_prologue(a, lds, vcu, G, wave, lane, tid);
    }
    SEAM(0);
    if (IN(1)) {
        pg8::Gemm g{XB, WinT, T, NIN, D}; pg8::StaticOrder S; S.init(T, NIN, G, bx);
        pg8::EpiBf16RS E{G1, NIN, NIN / 256, nullptr, nullptr, 0, SS0};
        pg8::gemm_phase<pg8::EpiBf16RS, pg8::StaticOrder, true, true>(lds, g, S, E);
    }
    SEAM(1);
    if (IN(2)) conv_gate_phase(G1, conv_w, Y, vcu, G, tid);
    SEAM(2);
    if (IN(3)) {
        pg8::Gemm g{Y, WoutT, T, D, D}; pg8::StaticOrder S; S.init(T, D, G, bx);
        pg8::EpiResid E{x, out, XB, SS1};
        pg8::gemm_phase<pg8::EpiResid, pg8::StaticOrder, true, true>(lds, g, S, E);
    }
    SEAM(3);
    if (IN(4)) {
        pg8::Gemm g{XB, WpqT, T, NPQ, D}; pg8::StaticOrder S; S.init(T, NPQ, G, bx);
        pg8::EpiBf16RS E{PQ, NPQ, NPQ / 256, nullptr, nullptr, 0, SS1};
        pg8::gemm_phase<pg8::EpiBf16RS, pg8::StaticOrder, true, true>(lds, g, S, E);
    }
    SEAM(4);
    if (IN(5)) route_phase(PQ, SKb, IDX, GATE, lds, vcu, G, wave, lane, tid);
    SEAM(5);
    if (IN(6)) experts_phase<false>(Ub, Vb, IDX, GATE, SS1, SS2, out, XB, fin_g, vcu, G, wave, lane);
    SEAM(6);
    if (IN(7)) {
        pg8::Gemm g{XB, WqkvT, T, NQKV, D}; pg8::StaticOrder S; S.init(T, NQKV, G, bx);
        pg8::EpiBf16RS E{Qb, D, 4, Kb, VVb, 256, SS2};
        pg8::gemm_phase<pg8::EpiBf16RS, pg8::StaticOrder, true, true>(lds, g, S, E);
    }
    SEAM(7);
    if (IN(8)) attn_phase(Qb, Kb, VVb, AO, rel_bias, sink, lds, vcu, G, wave, lane, tid);
    SEAM(8);
    if (IN(9)) {
        pg8::Gemm g{AO, WoT, T, D, D}; pg8::StaticOrder S; S.init(T, D, G, bx);
        pg8::EpiResid E{out, out, XB, SS3};
        pg8::gemm_phase<pg8::EpiResid, pg8::StaticOrder, true, true>(lds, g, S, E);
    }
    SEAM(9);
    if (IN(10)) {
        pg8::Gemm g{XB, WpqT + (size_t)NPQ * D, T, NPQ, D}; pg8::StaticOrder S; S.init(T, NPQ, G, bx);
        pg8::EpiBf16RS E{PQ, NPQ, NPQ / 256, nullptr, nullptr, 0, SS3};
        pg8::gemm_phase<pg8::EpiBf16RS, pg8::StaticOrder, true, true>(lds, g, S, E);
    }
    SEAM(10);
    if (IN(11)) route_phase(PQ, SKb + (size_t)8 * 2 * 128 * 128, IDX, GATE, lds, vcu, G, wave, lane, tid);
    SEAM(11);
    if (IN(12)) experts_phase<true>(Ub + (size_t)NEXP * D, Vb + (size_t)NEXP * D, IDX, GATE, SS3, nullptr, out, XB, fin_g, vcu, G, wave, lane);
#undef IN
#undef SEAM
}

extern "C" void kernel_launch(void* const* d_in, const int* in_sizes, int n_in, void* d_out, int out_size, void* d_ws, size_t ws_size, hipStream_t stream) {
    static int grid = 0;
    if (grid == 0) {
        if (n_in != 16 || in_sizes[0] != T * D || out_size != T * D || ws_size < WS_END) { fprintf(stderr, "kernel_launch: unexpected shapes (n_in %d, in0 %d, out %d, ws %zu)\n", n_in, n_in > 0 ? in_sizes[0] : -1, out_size, ws_size); grid = -1; return; }
        int dev = 0, cus = 0, per_cu = 0;
        if (hipGetDevice(&dev) != hipSuccess || hipDeviceGetAttribute(&cus, hipDeviceAttributeMultiprocessorCount, dev) != hipSuccess) { grid = -1; return; }
        if (hipFuncSetAttribute((const void*)fwd_kernel, hipFuncAttributeMaxDynamicSharedMemorySize, LDS_BYTES) != hipSuccess) { fprintf(stderr, "kernel_launch: hipFuncSetAttribute failed\n"); grid = -1; return; }
        if (hipOccupancyMaxActiveBlocksPerMultiprocessor(&per_cu, (const void*)fwd_kernel, NWAVES * 64, LDS_BYTES) != hipSuccess || per_cu < 1) { fprintf(stderr, "kernel_launch: occupancy query says %d blocks per CU\n", per_cu); (void)hipGetLastError(); grid = -1; return; }
        grid = cus;
    }
    if (grid < 0) return;
    (void)hipMemsetAsync((char*)d_ws + WS_CTL, 0, CTL_ZERO_BYTES, stream);
    Args a{};
    for (int i = 0; i < 16; ++i) a.in[i] = (const float*)d_in[i];
    a.out = (float*)d_out; a.ws = (unsigned char*)d_ws;
#if MK_PER_PHASE
    for (int p = 0; p < NPH; ++p) { a.ph_lo = p; a.ph_hi = p + 1; hipLaunchKernelGGL(fwd_kernel, dim3(grid), dim3(NWAVES * 64), LDS_BYTES, stream, a); }
#else
    a.ph_lo = 0; a.ph_hi = NPH;
    hipLaunchKernelGGL(fwd_kernel, dim3(grid), dim3(NWAVES * 64), LDS_BYTES, stream, a);
#endif
}
```

```cpp
#include <hip/hip_runtime.h>
#include <cstdio>
#include <cstdint>
namespace pg8 {
#define PG8_LAS __attribute__((address_space(3)))
typedef unsigned short bf16_t;
typedef short bf16x8 __attribute__((ext_vector_type(8)));
typedef float f32x4 __attribute__((ext_vector_type(4)));
typedef unsigned u32x4 __attribute__((ext_vector_type(4)));
constexpr int BM = 256, BK = 64, HALF = 128, HTB = HALF * BK * 2  , STAGE_BYTES = 8 * HTB, NXCD = 8, WGM = 8;

__host__ __device__ __forceinline__ int lds_byte(int r, int c) { const int st = (r >> 4) * 2 + (c >> 5), rr = r & 15, cc = c & 31, ob = rr * 64 + cc * 2; return st * 1024 + (ob ^ (((ob >> 9) & 1) << 5)); }
__host__ __device__ __forceinline__ void stage_rc(int b, int& R, int& C) { const int st = b / 1024, sb = b % 1024, swz = sb ^ (((sb >> 9) & 1) << 5); R = (st >> 1) * 16 + swz / 64; C = (st & 1) * 32 + (swz % 64) / 2; }
__host__ __device__ __forceinline__ int perm32(int rho) { const int n = rho >> 4, i = rho & 15; return 8 * (i >> 2) + 4 * n + (i & 3); }

struct Unit { int pm, pn; };
struct Gemm { const bf16_t* A; const bf16_t* Bt; int M, N, K; };

struct StaticOrder {
    int nM, nN, nwg, G, c;
    __host__ __device__ void init(int M, int N, int G_, int c_) { nM = M / BM; nN = N / BM; nwg = nM * nN; G = G_; c = c_; }
    __host__ __device__ bool next(int i, Unit& u) const {
        const long L = (long)i * G + c; if (L >= nwg) return false;
        int wgid = (int)L; { const int q = nwg / NXCD, r = nwg % NXCD, xcd = wgid % NXCD, off = wgid / NXCD; wgid = (xcd < r ? xcd * (q + 1) : r * (q + 1) + (xcd - r) * q) + off; }
        const int nig = WGM * nN, gid = wgid / nig, fm = gid * WGM, gsz = (nM - fm) < WGM ? (nM - fm) : WGM;
        u.pm = fm + ((wgid % nig) % gsz); u.pn = (wgid % nig) / gsz; return true;
    }
    __device__ __forceinline__ void a_ready(const Unit&) const {}
    __device__ __forceinline__ void done(const Unit&) const {}
};

__device__ __forceinline__ unsigned cvt_pk_bf16(float lo, float hi) { unsigned r; asm volatile("v_cvt_pk_bf16_f32 %0, %1, %2" : "=v"(r) : "v"(lo), "v"(hi)); return r; }
typedef unsigned u32x2 __attribute__((ext_vector_type(2)));
__device__ __forceinline__ float row_rstd(const float* ss, int row) {
    const f32x4* p = (const f32x4*)(ss + (size_t)row * 16);
    const f32x4 a = p[0], b = p[1], c = p[2], d = p[3];
    const float s = (((a[0] + a[1]) + (a[2] + a[3])) + ((b[0] + b[1]) + (b[2] + b[3]))) + (((c[0] + c[1]) + (c[2] + c[3])) + ((d[0] + d[1]) + (d[2] + d[3])));
    return __builtin_amdgcn_rsqf(s * (1.0f / 1024.0f) + 1e-6f);
}
struct EpiBf16RS {
    static constexpr bool PERM = true, AFTER_DRAIN = false;
    bf16_t* O0; int ld0; int nt0; bf16_t* O1; bf16_t* O2; int ld1; const float* ss;
    __device__ __forceinline__ void operator()(const f32x4 (&acc)[2][2][4][2], const Unit& u, int wr, int wc, int fr, int fq) const {
        bf16_t* base; int ld, colt;
        if (u.pn < nt0) { base = O0; ld = ld0; colt = u.pn * BM; } else if (u.pn == nt0) { base = O1; ld = ld1; colt = 0; } else { base = O2; ld = ld1; colt = (u.pn - nt0 - 1) * BM; }
        const int row0 = u.pm * BM + wr * 64 + fr, col0 = colt + wc * 32 + 8 * fq;
#pragma unroll
        for (int ai = 0; ai < 2; ++ai)
#pragma unroll
            for (int m = 0; m < 4; ++m) { const int row = row0 + ai * HALF + m * 16; const float rs = row_rstd(ss, row); bf16_t* rowp = base + (size_t)row * ld + col0;
#pragma unroll
                for (int bj = 0; bj < 2; ++bj) { const f32x4 v0 = acc[ai][bj][m][0] * rs, v1 = acc[ai][bj][m][1] * rs;
                    u32x4 w; w.x = cvt_pk_bf16(v0[0], v0[1]); w.y = cvt_pk_bf16(v0[2], v0[3]); w.z = cvt_pk_bf16(v1[0], v1[1]); w.w = cvt_pk_bf16(v1[2], v1[3]);
                    *(u32x4*)(rowp + bj * HALF) = w; } }
    }
};
struct EpiResid {
    static constexpr bool PERM = false, AFTER_DRAIN = false;
    const float* base; float* out; bf16_t* xb; float* ss;
    __device__ __forceinline__ void operator()(const f32x4 (&acc)[2][2][4][2], const Unit& u, int wr, int wc, int fr, int fq) const {
        const int row0 = u.pm * BM + wr * 64 + fr, col0 = u.pn * BM + wc * 32 + 4 * fq;
#pragma unroll
        for (int ai = 0; ai < 2; ++ai)
#pragma unroll
            for (int m = 0; m < 4; ++m) { const int row = row0 + ai * HALF + m * 16; float sq = 0.f;
#pragma unroll
                for (int bj = 0; bj < 2; ++bj)
#pragma unroll
                    for (int n = 0; n < 2; ++n) { const size_t off = (size_t)row * 1024 + col0 + bj * HALF + n * 16;
                        const f32x4 o = *(const f32x4*)(base + off) + acc[ai][bj][m][n];
                        *(f32x4*)(out + off) = o; sq += (o[0] * o[0] + o[1] * o[1]) + (o[2] * o[2] + o[3] * o[3]);
                        u32x2 w; w.x = cvt_pk_bf16(o[0], o[1]); w.y = cvt_pk_bf16(o[2], o[3]); *(u32x2*)(xb + off) = w; }
                sq += __shfl_xor(sq, 16); sq += __shfl_xor(sq, 32);
                if (fq == 0) ss[(size_t)row * 16 + u.pn * 4 + wc] = sq; }
    }
};

template <class Epi, class Sched, bool ALIGN_EPI = false, bool SP2 = false>
__device__ __forceinline__ void gemm_phase(PG8_LAS unsigned char* lds, const Gemm g, const Sched& S, const Epi& E) {
    const int tid = threadIdx.x, wid = __builtin_amdgcn_readfirstlane(tid >> 6), lane = tid & 63, wr = wid >> 2, wc = wid & 3, fr = lane & 15, fq = lane >> 4;
    const int K = g.K, nt = K / BK;
    unsigned voffA[2], voffB[2];
#pragma unroll
    for (int i = 0; i < 2; ++i) { int R, C; stage_rc(tid * 16 + i * 8192, R, C); const int Rb = Epi::PERM ? ((R & ~31) + perm32(R & 31)) : R;
        voffA[i] = (unsigned)(R * K + C) * 2u; voffB[i] = (unsigned)(Rb * K + C) * 2u; }
    const size_t kstep = (size_t)(BK * 2);
    const size_t hstep = (size_t)HALF * K * 2;
    const size_t tstep = 2 * hstep;
    const unsigned ldsw = (unsigned)wid * 1024u;
    const int aoff = lds_byte(wr * 64 + fr, fq * 8), boff = lds_byte(wc * 32 + fr, fq * 8);
#define PG8_SA(b, h) (((b) * 2 + (h)) * HTB)
#define PG8_SB(b, h) ((4 + (b) * 2 + (h)) * HTB)
#define PG8_STAGE(bufoff, gbase, voff) do { _Pragma("unroll") for (int _i = 0; _i < 2; ++_i) \
        __builtin_amdgcn_global_load_lds((const unsigned*)((const char*)(gbase) + (voff)[_i]), (PG8_LAS unsigned*)(lds + (bufoff) + ldsw + _i * 8192), 16, 0, 0); } while (0)
#define PG8_LDA(dst, b, h) do { _Pragma("unroll") for (int m = 0; m < 4; ++m) _Pragma("unroll") for (int k = 0; k < 2; ++k) dst[m][k] = *(const PG8_LAS bf16x8*)(lds + PG8_SA(b, h) + aoff + m * 2048 + k * 1024); } while (0)
#define PG8_LDB(dst, b, h) do { _Pragma("unroll") for (int n = 0; n < 2; ++n) _Pragma("unroll") for (int k = 0; k < 2; ++k) dst[n][k] = *(const PG8_LAS bf16x8*)(lds + PG8_SB(b, h) + boff + n * 2048 + k * 1024); } while (0)
#define PG8_MMA(ai, bj, At, Bt) do { __builtin_amdgcn_s_setprio(1); _Pragma("unroll") for (int m = 0; m < 4; ++m) _Pragma("unroll") for (int n = 0; n < 2; ++n) _Pragma("unroll") for (int k = 0; k < 2; ++k) \
        acc[ai][bj][m][n] = __builtin_amdgcn_mfma_f32_16x16x32_bf16(Bt[n][k], At[m][k], acc[ai][bj][m][n], 0, 0, 0); __builtin_amdgcn_s_setprio(0); } while (0)
#define PG8_WAIT_V(n) asm volatile("s_waitcnt vmcnt(" #n ")" ::: "memory")
#define PG8_WAIT_L(n) asm volatile("s_waitcnt lgkmcnt(" #n ")" ::: "memory")
#define PG8_BAR __builtin_amdgcn_s_barrier()
#define PG8_SCHED __builtin_amdgcn_sched_barrier(0)
    Unit cur, nxt; int ui = 0;
    if (!S.next(0, cur)) return;
    f32x4 acc[2][2][4][2];
#pragma unroll
    for (int a = 0; a < 2; ++a)
#pragma unroll
        for (int b = 0; b < 2; ++b)
#pragma unroll
            for (int m = 0; m < 4; ++m)
#pragma unroll
                for (int n = 0; n < 2; ++n) acc[a][b][m][n] = (f32x4){0.f, 0.f, 0.f, 0.f};
    bf16x8 At[4][2], B0[2][2], B1[2][2];
    const char* cA = (const char*)g.A + (size_t)cur.pm * tstep; const char* cB = (const char*)g.Bt + (size_t)cur.pn * tstep;
    S.a_ready(cur);
    if constexpr (SP2) {
        PG8_STAGE(PG8_SB(0, 0), cB, voffB); PG8_STAGE(PG8_SB(0, 1), cB + hstep, voffB); PG8_STAGE(PG8_SA(0, 0), cA, voffA); PG8_STAGE(PG8_SA(0, 1), cA + hstep, voffA);
        if (wr == 1) PG8_BAR;
        PG8_WAIT_V(2); PG8_BAR;
        PG8_STAGE(PG8_SB(1, 0), cB + kstep, voffB); PG8_STAGE(PG8_SA(1, 0), cA + kstep, voffA); PG8_STAGE(PG8_SB(1, 1), cB + hstep + kstep, voffB);
        PG8_WAIT_V(6); PG8_BAR;
    } else {
        PG8_STAGE(PG8_SB(0, 0), cB, voffB); PG8_STAGE(PG8_SA(0, 0), cA, voffA); PG8_STAGE(PG8_SB(0, 1), cB + hstep, voffB); PG8_STAGE(PG8_SA(0, 1), cA + hstep, voffA);
        if (wr == 1) PG8_BAR;
        PG8_WAIT_V(4); PG8_BAR;
        PG8_STAGE(PG8_SB(1, 0), cB + kstep, voffB); PG8_STAGE(PG8_SA(1, 0), cA + kstep, voffA); PG8_STAGE(PG8_SB(1, 1), cB + hstep + kstep, voffB);
        PG8_WAIT_V(6); PG8_BAR;
    }
    for (;;) {
        const bool has_next = S.next(ui + 1, nxt);
        const char* nA = has_next ? (const char*)g.A + (size_t)nxt.pm * tstep : cA; const char* nB = has_next ? (const char*)g.Bt + (size_t)nxt.pn * tstep : cB;
        for (int t = 0; t < nt; t += 2) {
            const bool last = (t == nt - 2);
            const char* a1 = cA + (size_t)(t + 1) * kstep;
            const char* a2 = last ? nA : cA + (size_t)(t + 2) * kstep; const char* b2 = last ? nB : cB + (size_t)(t + 2) * kstep;
            const char* a3 = a2 + kstep; const char* b3 = b2 + kstep;
            if (last && has_next) S.a_ready(nxt);
            if constexpr (SP2) {
            PG8_LDB(B0, 0, 0); PG8_LDB(B1, 0, 1); PG8_SCHED; PG8_LDA(At, 0, 0); PG8_STAGE(PG8_SA(1, 1), a1 + hstep, voffA);
            PG8_WAIT_V(8); PG8_WAIT_L(0); PG8_BAR; PG8_MMA(0, 0, At, B0); PG8_MMA(0, 1, At, B1); PG8_BAR; PG8_SCHED;
            PG8_LDA(At, 0, 1); PG8_STAGE(PG8_SB(0, 0), b2, voffB); PG8_STAGE(PG8_SB(0, 1), b2 + hstep, voffB); PG8_STAGE(PG8_SA(0, 0), a2, voffA);
            PG8_WAIT_V(8); PG8_WAIT_L(0); PG8_BAR; PG8_MMA(1, 0, At, B0); PG8_MMA(1, 1, At, B1); PG8_BAR; PG8_SCHED;
            PG8_LDB(B0, 1, 0); PG8_LDB(B1, 1, 1); PG8_SCHED; PG8_LDA(At, 1, 0); PG8_STAGE(PG8_SA(0, 1), a2 + hstep, voffA);
            PG8_WAIT_V(8); PG8_WAIT_L(0); PG8_BAR; PG8_MMA(0, 0, At, B0); PG8_MMA(0, 1, At, B1); PG8_BAR; PG8_SCHED;
            PG8_LDA(At, 1, 1); PG8_STAGE(PG8_SB(1, 0), b3, voffB); PG8_STAGE(PG8_SB(1, 1), b3 + hstep, voffB); PG8_STAGE(PG8_SA(1, 0), a3, voffA);
            PG8_WAIT_V(8); PG8_WAIT_L(0); PG8_BAR; PG8_MMA(1, 0, At, B0); PG8_MMA(1, 1, At, B1); PG8_BAR; PG8_SCHED;
            } else {
            PG8_LDB(B0, 0, 0); PG8_SCHED; PG8_LDA(At, 0, 0); PG8_STAGE(PG8_SA(1, 1), a1 + hstep, voffA);
            PG8_WAIT_L(8); PG8_BAR; PG8_WAIT_L(0); PG8_MMA(0, 0, At, B0); PG8_BAR; PG8_SCHED;
            PG8_LDB(B1, 0, 1); PG8_STAGE(PG8_SB(0, 0), b2, voffB);
            PG8_BAR; PG8_WAIT_L(0); PG8_MMA(0, 1, At, B1); PG8_BAR;
            PG8_LDA(At, 0, 1); PG8_STAGE(PG8_SA(0, 0), a2, voffA);
            PG8_BAR; PG8_WAIT_L(0); PG8_MMA(1, 0, At, B0); PG8_BAR; PG8_SCHED;
            PG8_STAGE(PG8_SB(0, 1), b2 + hstep, voffB);
            PG8_WAIT_V(6); PG8_BAR; PG8_MMA(1, 1, At, B1); PG8_BAR;
            PG8_LDB(B0, 1, 0); PG8_SCHED; PG8_LDA(At, 1, 0); PG8_STAGE(PG8_SA(0, 1), a2 + hstep, voffA);
            PG8_WAIT_L(8); PG8_BAR; PG8_WAIT_L(0); PG8_MMA(0, 0, At, B0); PG8_BAR; PG8_SCHED;
            PG8_LDB(B1, 1, 1); PG8_STAGE(PG8_SB(1, 0), b3, voffB);
            PG8_BAR; PG8_WAIT_L(0); PG8_MMA(0, 1, At, B1); PG8_BAR;
            PG8_LDA(At, 1, 1); PG8_STAGE(PG8_SA(1, 0), a3, voffA);
            PG8_BAR; PG8_WAIT_L(0); PG8_MMA(1, 0, At, B0); PG8_BAR; PG8_SCHED;
            PG8_STAGE(PG8_SB(1, 1), b3 + hstep, voffB);
            PG8_WAIT_V(6); PG8_BAR; PG8_MMA(1, 1, At, B1); PG8_BAR;
            }
        }
        if constexpr (ALIGN_EPI) { if (wr == 0) PG8_BAR; }
        if constexpr (!Epi::AFTER_DRAIN) { E(acc, cur, wr, wc, fr, fq); S.done(cur); }
        if (!has_next) break;
#pragma unroll
        for (int a = 0; a < 2; ++a)
#pragma unroll
            for (int b = 0; b < 2; ++b)
#pragma unroll
                for (int m = 0; m < 4; ++m)
#pragma unroll
                    for (int n = 0; n < 2; ++n) acc[a][b][m][n] = (f32x4){0.f, 0.f, 0.f, 0.f};
        cur = nxt; cA = nA; cB = nB; ++ui;
        if constexpr (ALIGN_EPI) { if (wr == 1) PG8_BAR; }
    }
    PG8_WAIT_V(0);
    if constexpr (!ALIGN_EPI) { if (wr == 0) PG8_BAR; }
    PG8_BAR;
    if constexpr (Epi::AFTER_DRAIN) { E.fused(acc, cur, wr, wc, fr, fq, lds, wid, lane); S.done(cur); }
#undef PG8_SA
#undef PG8_SB
#undef PG8_STAGE
#undef PG8_LDA
#undef PG8_LDB
#undef PG8_MMA
#undef PG8_WAIT_V
#undef PG8_WAIT_L
#undef PG8_BAR
#undef PG8_SCHED
}
}

constexpr int NWAVES = 8;
constexpr int BATCH = 2, SEQ = 8192, D = 1024, T = BATCH * SEQ;
constexpr int NIN = 3072, NQKV = 1536, NPQ = 2048, NEXP = 16384;
constexpr float LOG2E = 1.4426950408889634f;
constexpr float QSCALE = 0.125f * LOG2E;
constexpr float NEGBIG = -1e30f;
#ifndef MK_PER_PHASE
#define MK_PER_PHASE 0
#endif
constexpr int NPH = 13;
#ifndef REP_MASK
#define REP_MASK 0
#endif
#define REPS(k) for (int rep_ = 0; rep_ < (((REP_MASK) >> (k)) & 1) + 1; ++rep_)

constexpr size_t MiB = 1u << 20;
constexpr size_t WS_CTL = 0, CTL_ZERO_BYTES = 65536;
constexpr size_t WS_WIN = 1 * MiB, WS_WOUT = 7 * MiB, WS_WQKV = 9 * MiB, WS_WO = 12 * MiB, WS_WPQ = 14 * MiB, WS_SK = 22 * MiB;
constexpr size_t WS_SS = 23 * MiB;
constexpr size_t WS_IDX = 28 * MiB, WS_GATE = 36 * MiB, WS_XB = 44 * MiB, WS_Y = 76 * MiB, WS_U = 108 * MiB, WS_V = 172 * MiB;
constexpr size_t WS_G1 = 236 * MiB, WS_PQ = 332 * MiB, WS_Q = 396 * MiB, WS_K = 428 * MiB, WS_VV = 436 * MiB, WS_AO = 444 * MiB, WS_END = 476 * MiB;
constexpr int CW_BAR = 4096;

constexpr int RING_BYTES = 131072;
constexpr int LDSCTL_OFF = RING_BYTES, MISC_OFF = LDSCTL_OFF + 320;
constexpr int LDS_BYTES = 147456;

#define LAS __attribute__((address_space(3)))
typedef unsigned short bf16;
typedef unsigned v4u __attribute__((ext_vector_type(4)));
typedef unsigned v2u __attribute__((ext_vector_type(2)));
typedef float f32x4 __attribute__((ext_vector_type(4)));
typedef float f32x2 __attribute__((ext_vector_type(2)));
typedef float f32x16 __attribute__((ext_vector_type(16)));
typedef short bf16x8 __attribute__((ext_vector_type(8)));
typedef __bf16 bf16x2_t __attribute__((ext_vector_type(2)));
#define LDS_WAIT() asm volatile("s_waitcnt lgkmcnt(0)" ::: "memory")
#define DI __device__ __forceinline__

DI unsigned pk2(float lo, float hi) { f32x2 v = {lo, hi}; bf16x2_t b = __builtin_convertvector(v, bf16x2_t); return __builtin_bit_cast(unsigned, b); }
DI float bf_lo(unsigned u) { return __uint_as_float(u << 16); }
DI float bf_hi(unsigned u) { return __uint_as_float(u & 0xffff0000u); }
DI float wave_sum(float v) {
#pragma unroll
    for (int o = 1; o < 64; o <<= 1) v += __shfl_xor(v, o);
    return v;
}
#define XB_TMO      128
#define XB_XCNT(j)  (256  + 64 * (j))
#define XB_XSUB(j)  (1280 + 64 * (j))
#define XB_XGEN(j)  (2304 + 64 * (j))
#define XB_TOP      3328
#define XB_TOPGEN   3392
#define XCD_BAR_WORDS 3456
#define XB_SPIN_CAP (1u << 18)

__device__ __forceinline__ unsigned xb_ld(unsigned* p)              { return __hip_atomic_load(p, __ATOMIC_RELAXED, __HIP_MEMORY_SCOPE_AGENT); }
__device__ __forceinline__ unsigned xb_add(unsigned* p, unsigned v) { return __hip_atomic_fetch_add(p, v, __ATOMIC_RELAXED, __HIP_MEMORY_SCOPE_AGENT); }
__device__ __forceinline__ unsigned xb_xcc_id() { return (unsigned)__builtin_amdgcn_s_getreg((3 << 11) | 20) & 0xFu; }
#define XB_SPIN(cond, bar) do { unsigned _sp = 0; while (cond) { __builtin_amdgcn_s_sleep(1); \
    if ((++_sp & 255u) == 0u) { if (xb_ld(&(bar)[XB_TMO])) break; if (_sp > XB_SPIN_CAP) { atomicAdd(&(bar)[XB_TMO], 1u); break; } } } } while (0)

struct XcdBarrier {
    unsigned* bar; unsigned x;
    volatile LAS unsigned* st;
};

__device__ __forceinline__ XcdBarrier xcd_barrier_post(unsigned* bar, volatile LAS unsigned* st) {
    XcdBarrier b; b.bar = bar; b.x = xb_xcc_id(); b.st = st;
    if (threadIdx.x == 0) (void)xb_add(&bar[XB_XCNT(b.x)], 1u);
    return b;
}
__device__ __forceinline__ void xcd_barrier_complete(unsigned* bar, unsigned x, unsigned& nloc, unsigned& nx) {
    const unsigned G = gridDim.x * gridDim.y * gridDim.z;
    unsigned sum, cnt, mine, sp = 0u;
    for (;;) {
        sum = 0u; cnt = 0u; mine = 0u;
#pragma unroll
        for (unsigned j = 0; j < 16; ++j) { const unsigned c = xb_ld(&bar[XB_XCNT(j)]); sum += c; cnt += (c > 0u) ? 1u : 0u; mine = (j == x) ? c : mine; }
        if (sum == G) break;
        __builtin_amdgcn_s_sleep(1);
        if ((++sp & 255u) == 0u) { if (xb_ld(&bar[XB_TMO])) break; if (sp > XB_SPIN_CAP) { atomicAdd(&bar[XB_TMO], 1u); break; } }
    }
    nloc = mine > 0u ? mine : 1u; nx = cnt > 0u ? cnt : 1u;
}

__device__ __forceinline__ void xcd_barrier(const XcdBarrier& b) {
    asm volatile("s_waitcnt vmcnt(0)" ::: "memory");
    __syncthreads();
    if (threadIdx.x == 0) {
        unsigned* bar = b.bar;
        __builtin_amdgcn_s_waitcnt(0);
        unsigned nloc = b.st[0], nx = b.st[1];
        if (nloc == 0u) { xcd_barrier_complete(bar, b.x, nloc, nx); b.st[0] = nloc; b.st[1] = nx; }
        const unsigned old = xb_add(&bar[XB_XSUB(b.x)], 1u);
        const unsigned gen = old / nloc;
        if (old + 1u == (gen + 1u) * nloc) {
            __builtin_amdgcn_fence(__ATOMIC_RELEASE, "agent");
            asm volatile("s_waitcnt vmcnt(0)" ::: "memory");
            const unsigned og = xb_add(&bar[XB_TOP], 1u);
            const unsigned tg = og / nx;
            if (og + 1u == (tg + 1u) * nx) xb_add(&bar[XB_TOPGEN], 1u);
            else XB_SPIN(xb_ld(&bar[XB_TOPGEN]) == tg, bar);
            __builtin_amdgcn_fence(__ATOMIC_ACQUIRE, "agent");
            xb_add(&bar[XB_XGEN(b.x)], 1u);
            asm volatile("s_waitcnt vmcnt(0)" ::: "memory");
        } else {
            XB_SPIN(xb_ld(&bar[XB_XGEN(b.x)]) == gen, bar);
            __builtin_amdgcn_fence(__ATOMIC_ACQUIRE, "agent");
            asm volatile("s_waitcnt vmcnt(0)" ::: "memory");
        }
    }
    __syncthreads();
}

DI void p0_transpose_item(const float* W, int K, int N, bf16* WT, LAS float* scr, int item, int lane, const float* gain, int nscaled, float cscale) {
    const int nblk = N / 32, kb = item / nblk, nb = item % nblk, k0 = 64 * kb, n0 = 32 * nb;
#pragma unroll 8
    for (int i = 0; i < 32; ++i) { const int kk = 2 * i + (lane >> 5); float v = W[(size_t)(k0 + kk) * N + n0 + (lane & 31)]; if (gain) v *= gain[k0 + kk]; scr[kk * 33 + (lane & 31)] = v; }
    LDS_WAIT();
    const int c = lane & 7;
#pragma unroll
    for (int j = 0; j < 4; ++j) { const int n = (lane >> 3) + 8 * j; const LAS float* s = scr + (8 * c) * 33 + n; const float cs = (n0 + n < nscaled) ? cscale : 1.f;
        v4u o; o.x = pk2(s[0 * 33] * cs, s[1 * 33] * cs); o.y = pk2(s[2 * 33] * cs, s[3 * 33] * cs); o.z = pk2(s[4 * 33] * cs, s[5 * 33] * cs); o.w = pk2(s[6 * 33] * cs, s[7 * 33] * cs);
        *(v4u*)(WT + (size_t)(n0 + n) * K + k0 + 8 * c) = o; }
    LDS_WAIT();
}
struct P0Args { const float *x, *conv_g, *w_in, *w_out, *attn_g, *w_qkv, *w_o, *ffn_g, *w_pq, *subk, *pu, *pv;
                bf16 *WinT, *WoutT, *WqkvT, *WoT, *WpqT, *SKb; unsigned char *U8, *V8; bf16* XB; float* SS0; };
DI void p0_prologue(const P0Args& a, LAS unsigned char* lds, int vcu, int G, int wave, int lane, int tid) {
    LAS float* scr = (LAS float*)(lds + wave * 16384);
    const int gw = vcu * NWAVES + wave, NGW = G * NWAVES;
    constexpr int I_IN = 16 * (NIN / 32), I_OUT = 16 * (D / 32), I_QKV = 16 * (NQKV / 32), I_O = I_OUT, I_PQ = 16 * (NPQ / 32);
    constexpr int NITEMS = I_IN + I_OUT + I_QKV + I_O + 2 * I_PQ;
    for (int it = gw; it < NITEMS; it += NGW) {
        int r = it;
        if (r < I_IN) { p0_transpose_item(a.w_in, D, NIN, a.WinT, scr, r, lane, a.conv_g, 0, 1.f); continue; } r -= I_IN;
        if (r < I_OUT) { p0_transpose_item(a.w_out, D, D, a.WoutT, scr, r, lane, nullptr, 0, 1.f); continue; } r -= I_OUT;
        if (r < I_QKV) { p0_transpose_item(a.w_qkv, D, NQKV, a.WqkvT, scr, r, lane, a.attn_g, 1024, QSCALE); continue; } r -= I_QKV;
        if (r < I_O) { p0_transpose_item(a.w_o, D, D, a.WoT, scr, r, lane, nullptr, 0, 1.f); continue; } r -= I_O;
        if (r < I_PQ) { p0_transpose_item(a.w_pq, D, NPQ, a.WpqT, scr, r, lane, a.ffn_g, 0, 1.f); continue; } r -= I_PQ;
        p0_transpose_item(a.w_pq + (size_t)D * NPQ, D, NPQ, a.WpqT + (size_t)NPQ * D, scr, r, lane, a.ffn_g + D, 0, 1.f);
    }
    const size_t gt = (size_t)vcu * (NWAVES * 64) + tid, NGT = (size_t)G * NWAVES * 64;
    constexpr size_t C_SK = (size_t)2 * 8 * 2 * 128 * 128 / 8;
    for (size_t c = gt; c < C_SK; c += NGT) { const f32x4 v0 = *(const f32x4*)(a.subk + c * 8), v1 = *(const f32x4*)(a.subk + c * 8 + 4);
        v4u o; o.x = pk2(v0[0], v0[1]); o.y = pk2(v0[2], v0[3]); o.z = pk2(v1[0], v1[1]); o.w = pk2(v1[2], v1[3]); *(v4u*)(a.SKb + c * 8) = o; }
    constexpr size_t C_T16 = (size_t)2 * NEXP * D / 16;
    for (size_t c = gt; c < C_T16; c += NGT) { const int layer = (int)(c / ((size_t)NEXP * D / 16)), d0 = (int)(c % (D / 16)) * 16;
        v4u o;
#pragma unroll
        for (int q = 0; q < 4; ++q) { const f32x4 g = *(const f32x4*)(a.ffn_g + layer * D + d0 + 4 * q);
            const f32x4 v = __builtin_nontemporal_load((const f32x4*)(a.pu + c * 16 + 4 * q)) * g * 1024.0f;
            int w = __builtin_amdgcn_cvt_pk_fp8_f32(v[0], v[1], 0, false); w = __builtin_amdgcn_cvt_pk_fp8_f32(v[2], v[3], w, true); o[q] = (unsigned)w; }
        *(v4u*)(a.U8 + c * 16) = o; }
    for (size_t c = gt; c < C_T16; c += NGT) {
        v4u o;
#pragma unroll
        for (int q = 0; q < 4; ++q) { const f32x4 v = __builtin_nontemporal_load((const f32x4*)(a.pv + c * 16 + 4 * q)) * 1024.0f;
            int w = __builtin_amdgcn_cvt_pk_fp8_f32(v[0], v[1], 0, false); w = __builtin_amdgcn_cvt_pk_fp8_f32(v[2], v[3], w, true); o[q] = (unsigned)w; }
        *(v4u*)(a.V8 + c * 16) = o; }
    for (int m = gw; m < T; m += NGW) {
        const f32x4* xr = (const f32x4*)(a.x + (size_t)m * D) + lane; float s = 0.f; f32x4 v[4];
#pragma unroll
        for (int j = 0; j < 4; ++j) { v[j] = xr[64 * j]; s += (v[j][0] * v[j][0] + v[j][1] * v[j][1]) + (v[j][2] * v[j][2] + v[j][3] * v[j][3]); }
        s = wave_sum(s);
        v2u* o8 = (v2u*)(a.XB + (size_t)m * D) + lane;
#pragma unroll
        for (int j = 0; j < 4; ++j) { v2u w; w.x = pk2(v[j][0], v[j][1]); w.y = pk2(v[j][2], v[j][3]); o8[64 * j] = w; }
        if (lane < 4) { f32x4 z = {0.f, 0.f, 0.f, 0.f}; if (lane == 0) z[0] = s; ((f32x4*)(a.SS0 + (size_t)m * 16))[lane] = z; }
    }
}

DI void conv_gate_phase(const bf16* G1, const float* cw, bf16* Y, int vcu, int G, int tid) {
    const size_t gt = (size_t)vcu * (NWAVES * 64) + tid, NGT = (size_t)G * NWAVES * 64;
    for (size_t c = gt; c < (size_t)T * (D / 8); c += NGT) {
        const int t = (int)(c / (D / 8)), d0 = (int)(c % (D / 8)) * 8, ts = t % SEQ;
        const v4u gb = *(const v4u*)(G1 + (size_t)t * NIN + d0);
        float acc[8];
#pragma unroll
        for (int i = 0; i < 8; ++i) acc[i] = 0.f;
#pragma unroll
        for (int w = 0; w < 3; ++w) { const int tt = ts + w - 1;
            if (tt >= 0 && tt < SEQ) {
                const v4u gc = *(const v4u*)(G1 + (size_t)(t + w - 1) * NIN + D + d0), hh = *(const v4u*)(G1 + (size_t)(t + w - 1) * NIN + 2 * D + d0);
                const f32x4 w0 = *(const f32x4*)(cw + w * D + d0), w1 = *(const f32x4*)(cw + w * D + d0 + 4);
                acc[0] += w0[0] * (bf_lo(gc.x) * bf_lo(hh.x)); acc[1] += w0[1] * (bf_hi(gc.x) * bf_hi(hh.x));
                acc[2] += w0[2] * (bf_lo(gc.y) * bf_lo(hh.y)); acc[3] += w0[3] * (bf_hi(gc.y) * bf_hi(hh.y));
                acc[4] += w1[0] * (bf_lo(gc.z) * bf_lo(hh.z)); acc[5] += w1[1] * (bf_hi(gc.z) * bf_hi(hh.z));
                acc[6] += w1[2] * (bf_lo(gc.w) * bf_lo(hh.w)); acc[7] += w1[3] * (bf_hi(gc.w) * bf_hi(hh.w)); } }
        v4u o; o.x = pk2(acc[0] * bf_lo(gb.x), acc[1] * bf_hi(gb.x)); o.y = pk2(acc[2] * bf_lo(gb.y), acc[3] * bf_hi(gb.y));
        o.z = pk2(acc[4] * bf_lo(gb.z), acc[5] * bf_hi(gb.z)); o.w = pk2(acc[6] * bf_lo(gb.w), acc[7] * bf_hi(gb.w));
        *(v4u*)(Y + (size_t)t * D + d0) = o;
    }
}

template <int CTRL> DI unsigned dppu(unsigned v) { return (unsigned)__builtin_amdgcn_update_dpp(0, (int)v, CTRL, 0xf, 0xf, false); }
DI unsigned umax(unsigned a, unsigned b) { return a > b ? a : b; }
DI unsigned umin(unsigned a, unsigned b) { return a < b ? a : b; }
DI unsigned rowmax_u(unsigned v) { v = umax(v, dppu<0x128>(v)); v = umax(v, dppu<0x124>(v)); v = umax(v, dppu<0x122>(v)); v = umax(v, dppu<0x121>(v)); return v; }
DI float rowsum_f(float v) { v += __uint_as_float(dppu<0x128>(__float_as_uint(v))); v += __uint_as_float(dppu<0x124>(__float_as_uint(v))); v += __uint_as_float(dppu<0x122>(__float_as_uint(v))); v += __uint_as_float(dppu<0x121>(__float_as_uint(v))); return v; }
DI unsigned f2key(float f) { const unsigned u = __float_as_uint(f); return u ^ ((unsigned)((int)u >> 31) | 0x80000000u); }
DI float key2f(unsigned k) { const unsigned u = (k & 0x80000000u) ? (k ^ 0x80000000u) : ~k; return __uint_as_float(u); }
DI unsigned cand_ij(int c) {
    unsigned i, j;
    if (c < 16) { i = 0; j = c; } else if (c < 24) { i = 1; j = c - 16; } else if (c < 29) { i = 2; j = c - 24; } else if (c < 33) { i = 3; j = c - 29; }
    else if (c < 36) { i = 4; j = c - 33; } else if (c < 38) { i = 5; j = c - 36; } else if (c < 40) { i = 6; j = c - 38; } else if (c < 42) { i = 7; j = c - 40; }
    else { i = 8 + (c - 42); j = 0; }
    return (i & 15u) | (j << 4);
}
#define CE_DESC(a, b) do { const unsigned _hi = umax(a, b), _lo = umin(a, b); a = _hi; b = _lo; } while (0)
DI void route_phase(const bf16* PQ, const bf16* SK, int* IDX, float* GATE, LAS unsigned char* lds, int vcu, int G, int wave, int lane, int tid) {
    const int fr = lane & 15, fq = lane >> 4;
    LAS unsigned char* TAB = lds;
    if (tid < 64) TAB[tid] = (unsigned char)(tid < 50 ? cand_ij(tid) : 0xff);
    __syncthreads();
    for (int item = vcu; item < (T / 128) * 8; item += G) {
        const int h = item & 7, tile = item >> 3, t0 = tile * 128 + wave * 16;
        unsigned res[2][4];
#pragma unroll
        for (int p = 0; p < 2; ++p) {
            bf16x8 af[4];
#pragma unroll
            for (int ks = 0; ks < 4; ++ks) af[ks] = *(const bf16x8*)(PQ + (size_t)(t0 + fr) * NPQ + h * 256 + p * 128 + ks * 32 + fq * 8);
            f32x4 acc[8];
#pragma unroll
            for (int n = 0; n < 8; ++n) { acc[n] = (f32x4){0.f, 0.f, 0.f, 0.f};
#pragma unroll
                for (int ks = 0; ks < 4; ++ks) { const bf16x8 bfr = *(const bf16x8*)(SK + (size_t)((h * 2 + p) * 128 + n * 16 + fr) * 128 + ks * 32 + fq * 8);
                    acc[n] = __builtin_amdgcn_mfma_f32_16x16x32_bf16(af[ks], bfr, acc[n], 0, 0, 0); } }
#pragma unroll
            for (int r = 0; r < 4; ++r) {
                unsigned L[8];
#pragma unroll
                for (int n = 0; n < 8; ++n) L[n] = (f2key(acc[n][r]) & ~127u) | (unsigned)(127 - (16 * n + fr));
                CE_DESC(L[0], L[1]); CE_DESC(L[2], L[3]); CE_DESC(L[4], L[5]); CE_DESC(L[6], L[7]);
                CE_DESC(L[0], L[2]); CE_DESC(L[1], L[3]); CE_DESC(L[4], L[6]); CE_DESC(L[5], L[7]);
                CE_DESC(L[1], L[2]); CE_DESC(L[5], L[6]); CE_DESC(L[0], L[4]); CE_DESC(L[3], L[7]);
                CE_DESC(L[1], L[5]); CE_DESC(L[2], L[6]);
                CE_DESC(L[1], L[4]); CE_DESC(L[3], L[6]);
                CE_DESC(L[2], L[4]); CE_DESC(L[3], L[5]);
                CE_DESC(L[3], L[4]);
                unsigned rr = 0u;
#pragma unroll
                for (int k = 0; k < 16; ++k) {
                    const unsigned gm = rowmax_u(L[0]);
                    rr = (fr == k) ? gm : rr;
                    const bool pop = (L[0] == gm);
#pragma unroll
                    for (int n = 0; n < 7; ++n) L[n] = pop ? L[n + 1] : L[n];
                    L[7] = pop ? 0u : L[7];
                }
                res[p][r] = rr;
            }
        }
        const int gbase = (lane & 48) * 4;
#pragma unroll
        for (int r = 0; r < 4; ++r) {
            const int t = t0 + 4 * fq + r;
            unsigned ck[4];
#pragma unroll
            for (int s = 0; s < 4; ++s) { const int c = fr + 16 * s; const unsigned tb = TAB[c & 63];
                const unsigned k0 = (unsigned)__builtin_amdgcn_ds_bpermute(gbase + (int)(tb & 15u) * 4, (int)res[0][r]);
                const unsigned k1 = (unsigned)__builtin_amdgcn_ds_bpermute(gbase + (int)((tb >> 4) & 15u) * 4, (int)res[1][r]);
                const float v = key2f((k0 & ~127u) | 64u) + key2f((k1 & ~127u) | 64u);
                ck[s] = (c < 50) ? ((f2key(v) & ~63u) | (unsigned)(63 - c)) : 0u; }
            unsigned sel = 0u;
#pragma unroll
            for (int k = 0; k < 16; ++k) {
                const unsigned gm = rowmax_u(umax(umax(ck[0], ck[1]), umax(ck[2], ck[3])));
                sel = (fr == k) ? gm : sel;
#pragma unroll
                for (int s = 0; s < 4; ++s) ck[s] = (ck[s] == gm) ? 0u : ck[s];
            }
            const int cs = 63 - (int)(sel & 63u); const unsigned tb = TAB[cs & 63];
            const unsigned k0 = (unsigned)__builtin_amdgcn_ds_bpermute(gbase + (int)(tb & 15u) * 4, (int)res[0][r]);
            const unsigned k1 = (unsigned)__builtin_amdgcn_ds_bpermute(gbase + (int)((tb >> 4) & 15u) * 4, (int)res[1][r]);
            const int e = (127 - (int)(k0 & 127u)) * 128 + (127 - (int)(k1 & 127u));
            const float val = key2f((sel & ~63u) | 32u), top = key2f((rowmax_u(sel) & ~63u) | 32u);
            const float ex = __builtin_amdgcn_exp2f((val - top) * LOG2E), sum = rowsum_f(ex);
            IDX[(size_t)t * 128 + h * 16 + fr] = e; GATE[(size_t)t * 128 + h * 16 + fr] = ex / sum;
        }
    }
}

DI float dot8(v4u x, v4u u, float acc) {
    acc += bf_lo(x.x) * bf_lo(u.x); acc += bf_hi(x.x) * bf_hi(u.x); acc += bf_lo(x.y) * bf_lo(u.y); acc += bf_hi(x.y) * bf_hi(u.y);
    acc += bf_lo(x.z) * bf_lo(u.z); acc += bf_hi(x.z) * bf_hi(u.z); acc += bf_lo(x.w) * bf_lo(u.w); acc += bf_hi(x.w) * bf_hi(u.w);
    return acc;
}
DI void fma8(float* acc, float a, v4u v) {
    acc[0] += a * bf_lo(v.x); acc[1] += a * bf_hi(v.x); acc[2] += a * bf_lo(v.y); acc[3] += a * bf_hi(v.y);
    acc[4] += a * bf_lo(v.z); acc[5] += a * bf_hi(v.z); acc[6] += a * bf_lo(v.w); acc[7] += a * bf_hi(v.w);
}
DI f32x2 fp8lo(unsigned w) { return __builtin_amdgcn_cvt_pk_f32_fp8((int)w, false); }
DI f32x2 fp8hi(unsigned w) { return __builtin_amdgcn_cvt_pk_f32_fp8((int)w, true); }
template <bool FINAL>
DI void experts_phase(const unsigned char* U8, const unsigned char* V8, const int* IDX, const float* GATE, const float* ss_in, float* ss_out, float* xf, bf16* XB, const float* fin_g,
                      int vcu, int G, int wave, int lane) {
    for (int t = vcu * NWAVES + wave; t < T; t += G * NWAVES) {
        const v4u* xr = (const v4u*)(XB + (size_t)t * D) + 2 * lane;
        const v4u xa = xr[0], xb = xr[1];
        f32x2 xp[8];
        xp[0] = (f32x2){bf_lo(xa.x), bf_hi(xa.x)}; xp[1] = (f32x2){bf_lo(xa.y), bf_hi(xa.y)}; xp[2] = (f32x2){bf_lo(xa.z), bf_hi(xa.z)}; xp[3] = (f32x2){bf_lo(xa.w), bf_hi(xa.w)};
        xp[4] = (f32x2){bf_lo(xb.x), bf_hi(xb.x)}; xp[5] = (f32x2){bf_lo(xb.y), bf_hi(xb.y)}; xp[6] = (f32x2){bf_lo(xb.z), bf_hi(xb.z)}; xp[7] = (f32x2){bf_lo(xb.w), bf_hi(xb.w)};
        const float rs = pg8::row_rstd(ss_in, t) * (1.0f / 1024.0f);
        const int myi0 = IDX[(size_t)t * 128 + lane], myi1 = IDX[(size_t)t * 128 + 64 + lane];
        const int eperm = (lane & 3) * 16 + (lane >> 2);
        const float g0 = GATE[(size_t)t * 128 + eperm], g1 = GATE[(size_t)t * 128 + 64 + eperm];
        float H0 = 0.f, H1 = 0.f;
#pragma unroll 1
        for (int b = 0; b < 8; ++b) {
            const int src = (b < 4) ? myi0 : myi1;
            v4u uw[16];
#pragma unroll
            for (int j = 0; j < 16; ++j) { const int idx = __builtin_amdgcn_readlane(src, ((b & 3) * 16 + j)); uw[j] = *((const v4u*)(U8 + (size_t)idx * D) + lane); }
            float p[16];
#pragma unroll
            for (int j = 0; j < 16; ++j) { f32x2 a2 = {0.f, 0.f};
#pragma unroll
                for (int q = 0; q < 4; ++q) { a2 = __builtin_elementwise_fma(xp[2 * q], fp8lo(uw[j][q]), a2); a2 = __builtin_elementwise_fma(xp[2 * q + 1], fp8hi(uw[j][q]), a2); }
                p[j] = a2.x + a2.y; }
            const bool b5 = lane & 32, b4 = lane & 16, b3 = lane & 8, b2 = lane & 4;
            float q8[8];
#pragma unroll
            for (int j = 0; j < 8; ++j) { const float keep = b5 ? p[8 + j] : p[j], send = b5 ? p[j] : p[8 + j]; q8[j] = keep + __shfl_xor(send, 32); }
            float q4[4];
#pragma unroll
            for (int j = 0; j < 4; ++j) { const float keep = b4 ? q8[4 + j] : q8[j], send = b4 ? q8[j] : q8[4 + j]; q4[j] = keep + __shfl_xor(send, 16); }
            float q2[2];
#pragma unroll
            for (int j = 0; j < 2; ++j) { const float keep = b3 ? q4[2 + j] : q4[j], send = b3 ? q4[j] : q4[2 + j]; q2[j] = keep + __shfl_xor(send, 8); }
            float k1; { const float keep = b2 ? q2[1] : q2[0], send = b2 ? q2[0] : q2[1]; k1 = keep + __shfl_xor(send, 4); }
            k1 += __shfl_xor(k1, 2); k1 += __shfl_xor(k1, 1);
            const bool mine = (lane & 3) == (b & 3);
            if (b < 4) H0 = mine ? k1 : H0; else H1 = mine ? k1 : H1;
        }
        const float h0 = H0 * rs, h1 = H1 * rs;
        const float a0 = (1.0f / 1024.0f) * g0 * (0.5f * h0 * (1.f + erff(h0 * 0.70710678118654752f))), a1 = (1.0f / 1024.0f) * g1 * (0.5f * h1 * (1.f + erff(h1 * 0.70710678118654752f)));
        f32x2 acc[8];
#pragma unroll
        for (int i = 0; i < 8; ++i) acc[i] = (f32x2){0.f, 0.f};
#pragma unroll 1
        for (int b = 0; b < 8; ++b) {
            const int src = (b < 4) ? myi0 : myi1; const float asrc = (b < 4) ? a0 : a1;
            v4u vw[16]; float aj[16];
#pragma unroll
            for (int j = 0; j < 16; ++j) { const int idx = __builtin_amdgcn_readlane(src, ((b & 3) * 16 + j)); vw[j] = *((const v4u*)(V8 + (size_t)idx * D) + lane);
                aj[j] = __uint_as_float((unsigned)__builtin_amdgcn_readlane((int)__float_as_uint(asrc), j * 4 + (b & 3))); }
#pragma unroll
            for (int j = 0; j < 16; ++j) { const f32x2 a2 = {aj[j], aj[j]};
#pragma unroll
                for (int q = 0; q < 4; ++q) { acc[2 * q] = __builtin_elementwise_fma(a2, fp8lo(vw[j][q]), acc[2 * q]); acc[2 * q + 1] = __builtin_elementwise_fma(a2, fp8hi(vw[j][q]), acc[2 * q + 1]); } }
        }
        float* xo = xf + (size_t)t * D + 16 * lane;
        f32x4 o[4]; float sq = 0.f;
#pragma unroll
        for (int i = 0; i < 4; ++i) { o[i] = *(const f32x4*)(xo + 4 * i) + (f32x4){acc[2 * i].x, acc[2 * i].y, acc[2 * i + 1].x, acc[2 * i + 1].y}; sq += (o[i][0] * o[i][0] + o[i][1] * o[i][1]) + (o[i][2] * o[i][2] + o[i][3] * o[i][3]); }
        sq = wave_sum(sq);
        if (FINAL) {
            const float rf = __builtin_amdgcn_rsqf(sq * (1.0f / 1024.0f) + 1e-6f);
#pragma unroll
            for (int i = 0; i < 4; ++i) *(f32x4*)(xo + 4 * i) = o[i] * rf * *(const f32x4*)(fin_g + 16 * lane + 4 * i);
        } else {
#pragma unroll
            for (int i = 0; i < 4; ++i) *(f32x4*)(xo + 4 * i) = o[i];
            v4u w0, w1; w0.x = pk2(o[0][0], o[0][1]); w0.y = pk2(o[0][2], o[0][3]); w0.z = pk2(o[1][0], o[1][1]); w0.w = pk2(o[1][2], o[1][3]);
            w1.x = pk2(o[2][0], o[2][1]); w1.y = pk2(o[2][2], o[2][3]); w1.z = pk2(o[3][0], o[3][1]); w1.w = pk2(o[3][2], o[3][3]);
            v4u* xw = (v4u*)(XB + (size_t)t * D) + 2 * lane; xw[0] = w0; xw[1] = w1;
            if (lane < 4) { f32x4 z = {0.f, 0.f, 0.f, 0.f}; if (lane == 0) z[0] = sq; ((f32x4*)(ss_out + (size_t)t * 16))[lane] = z; }
        }
    }
}

DI int t5_bucket(int rel) {
    const int n = rel < 0 ? -rel : rel; int b;
    if (n < 8) b = n; else if (n < 12) b = 8; else if (n < 16) b = 9; else if (n < 23) b = 10; else if (n < 32) b = 11; else if (n < 46) b = 12; else if (n < 64) b = 13; else if (n < 91) b = 14; else b = 15;
    return b + (rel > 0 ? 16 : 0);
}
DI int crow(int reg, int h) { return (reg & 3) + 8 * (reg >> 2) + 4 * h; }
constexpr int AT_KL = 0, AT_KSTR = 144, AT_VT = 384 * AT_KSTR  , AT_VSTR = 776, AT_BT = AT_VT + 64 * AT_VSTR  , AT_END = AT_BT + 4 * 512 * 4;
static_assert(AT_END <= RING_BYTES, "attention LDS");
DI void attn_phase(const bf16* Qg, const bf16* Kg, const bf16* Vg, bf16* AO, const float* rel_bias, const float* sink, LAS unsigned char* lds, int vcu, int G, int wave, int lane, int tid) {
    const int r = lane & 31, h = lane >> 5;
    for (int unit = vcu; unit < BATCH * 4 * (SEQ / 128); unit += G) {
        const int b = unit / 256, kvh = (unit % 256) / 64, blk = unit % 64;
        __syncthreads();
        for (int c = tid; c < 384 * 8; c += NWAVES * 64) { const int row = c >> 3, c8 = c & 7, ts = blk * 128 - 128 + row;
            v4u kv = {0u, 0u, 0u, 0u}, vv = {0u, 0u, 0u, 0u};
            if (ts >= 0 && ts < SEQ) { const size_t g = (size_t)(b * SEQ + ts) * 256 + kvh * 64 + c8 * 8; kv = *(const v4u*)(Kg + g); vv = *(const v4u*)(Vg + g); }
            *(LAS v4u*)(lds + AT_KL + row * AT_KSTR + c8 * 16) = kv;
            LAS unsigned short* vt = (LAS unsigned short*)(lds + AT_VT) + (c8 * 8) * (AT_VSTR / 2) + row;
            vt[0 * (AT_VSTR / 2)] = (unsigned short)(vv.x & 0xffffu); vt[1 * (AT_VSTR / 2)] = (unsigned short)(vv.x >> 16);
            vt[2 * (AT_VSTR / 2)] = (unsigned short)(vv.y & 0xffffu); vt[3 * (AT_VSTR / 2)] = (unsigned short)(vv.y >> 16);
            vt[4 * (AT_VSTR / 2)] = (unsigned short)(vv.z & 0xffffu); vt[5 * (AT_VSTR / 2)] = (unsigned short)(vv.z >> 16);
            vt[6 * (AT_VSTR / 2)] = (unsigned short)(vv.w & 0xffffu); vt[7 * (AT_VSTR / 2)] = (unsigned short)(vv.w >> 16); }
        for (int c = tid; c < 4 * 512; c += NWAVES * 64) { const int g = c >> 9, i = c & 511, rel = i - 255;
            float v = NEGBIG; if (rel >= -128 && rel <= 128) v = rel_bias[t5_bucket(rel) * 16 + kvh * 4 + g] * LOG2E;
            *(LAS float*)(lds + AT_BT + c * 4) = v; }
        __syncthreads();
        const int g = wave >> 1, qh = wave & 1, head = kvh * 4 + g;
        const float sinkl = sink[head] * LOG2E;
        bf16x8 qf[2][4];
#pragma unroll
        for (int qt = 0; qt < 2; ++qt)
#pragma unroll
            for (int s = 0; s < 4; ++s) qf[qt][s] = *(const bf16x8*)(Qg + (size_t)(b * SEQ + blk * 128 + qh * 64 + qt * 32 + r) * D + head * 64 + s * 16 + h * 8);
        float m[2] = {sinkl, sinkl}, l[2] = {0.f, 0.f};
        f32x16 o[2][2];
#pragma unroll
        for (int qt = 0; qt < 2; ++qt)
#pragma unroll
            for (int dt = 0; dt < 2; ++dt)
#pragma unroll
                for (int i = 0; i < 16; ++i) o[qt][dt][i] = 0.f;
        int kt_lo = 2 * qh, kt_hi = 2 * qh + 9;
        if (blk == 0 && kt_lo < 4) kt_lo = 4;
        if (blk == SEQ / 128 - 1 && kt_hi > 7) kt_hi = 7;
#pragma unroll 1
        for (int kt = kt_lo; kt <= kt_hi; ++kt) {
            bf16x8 kf[4];
#pragma unroll
            for (int s = 0; s < 4; ++s) kf[s] = *(const LAS bf16x8*)(lds + AT_KL + (32 * kt + r) * AT_KSTR + s * 32 + h * 16);
            bf16x8 vf[2][2];
#pragma unroll
            for (int dt = 0; dt < 2; ++dt)
#pragma unroll
                for (int s2 = 0; s2 < 2; ++s2) { const LAS unsigned char* vp = lds + AT_VT + (32 * dt + r) * AT_VSTR + (32 * kt + 16 * s2 + 4 * h) * 2;
                    const v2u lo = *(const LAS v2u*)vp, hi2 = *(const LAS v2u*)(vp + 16); v4u w = {lo.x, lo.y, hi2.x, hi2.y}; vf[dt][s2] = __builtin_bit_cast(bf16x8, w); }
#pragma unroll
            for (int qt = 0; qt < 2; ++qt) {
                f32x16 s;
                const LAS float* bt = (const LAS float*)(lds + AT_BT) + g * 512 + 127 + 32 * kt + 4 * h - (64 * qh + 32 * qt + r);
#pragma unroll
                for (int i = 0; i < 16; ++i) s[i] = bt[(i & 3) + 8 * (i >> 2)];
#pragma unroll
                for (int k4 = 0; k4 < 4; ++k4) s = __builtin_amdgcn_mfma_f32_32x32x16_bf16(kf[k4], qf[qt][k4], s, 0, 0, 0);
                float mx = s[0];
#pragma unroll
                for (int i = 1; i < 16; ++i) mx = fmaxf(mx, s[i]);
                mx = fmaxf(mx, __shfl_xor(mx, 32));
                const float mn = fmaxf(m[qt], mx), al = __builtin_amdgcn_exp2f(m[qt] - mn); m[qt] = mn;
                float ps = 0.f;
#pragma unroll
                for (int i = 0; i < 16; ++i) { s[i] = __builtin_amdgcn_exp2f(s[i] - mn); ps += s[i]; }
                l[qt] = l[qt] * al + ps;
#pragma unroll
                for (int dt = 0; dt < 2; ++dt)
#pragma unroll
                    for (int i = 0; i < 16; ++i) o[qt][dt][i] *= al;
                bf16x8 pf[2];
#pragma unroll
                for (int s2 = 0; s2 < 2; ++s2) { v4u w; w.x = pk2(s[8 * s2 + 0], s[8 * s2 + 1]); w.y = pk2(s[8 * s2 + 2], s[8 * s2 + 3]); w.z = pk2(s[8 * s2 + 4], s[8 * s2 + 5]); w.w = pk2(s[8 * s2 + 6], s[8 * s2 + 7]); pf[s2] = __builtin_bit_cast(bf16x8, w); }
#pragma unroll
                for (int dt = 0; dt < 2; ++dt)
#pragma unroll
                    for (int s2 = 0; s2 < 2; ++s2) o[qt][dt] = __builtin_amdgcn_mfma_f32_32x32x16_bf16(vf[dt][s2], pf[s2], o[qt][dt], 0, 0, 0);
            }
        }
#pragma unroll
        for (int qt = 0; qt < 2; ++qt) {
            const float lt = l[qt] + __shfl_xor(l[qt], 32) + __builtin_amdgcn_exp2f(sinkl - m[qt]), inv = 1.0f / lt;
            bf16* op = AO + (size_t)(b * SEQ + blk * 128 + qh * 64 + qt * 32 + r) * D + head * 64 + 4 * h;
#pragma unroll
            for (int dt = 0; dt < 2; ++dt)
#pragma unroll
                for (int gq = 0; gq < 4; ++gq) { v2u w; w.x = pk2(o[qt][dt][4 * gq] * inv, o[qt][dt][4 * gq + 1] * inv); w.y = pk2(o[qt][dt][4 * gq + 2] * inv, o[qt][dt][4 * gq + 3] * inv);
                    *(v2u*)(op + 32 * dt + 8 * gq) = w; }
        }
    }
}

struct Args { const float* in[16]; float* out; unsigned char* ws; int ph_lo, ph_hi; };
__global__ void __launch_bounds__(NWAVES * 64, 2) fwd_kernel(Args args) {
    extern __shared__ __attribute__((aligned(16))) unsigned char lds_raw[];
    LAS unsigned char* lds = (LAS unsigned char*)lds_raw;
    volatile LAS unsigned* MISC = (volatile LAS unsigned*)(lds + MISC_OFF);
    const int tid = threadIdx.x, lane = tid & 63, wave = __builtin_amdgcn_readfirstlane(tid >> 6);
    const int G = gridDim.x; const int bx = blockIdx.x; const int vcu = (G % 8 == 0) ? (bx % 8) * (G / 8) + bx / 8 : bx;
    unsigned char* ws = args.ws;
    unsigned* ctl = (unsigned*)(ws + WS_CTL);
    const float* x = args.in[0]; const float* conv_g = args.in[1]; const float* w_in = args.in[2]; const float* conv_w = args.in[3]; const float* w_out = args.in[4];
    const float* attn_g = args.in[5]; const float* w_qkv = args.in[6]; const float* sink = args.in[7]; const float* w_o = args.in[8]; const float* rel_bias = args.in[9];
    const float* ffn_g = args.in[10]; const float* w_pq = args.in[11]; const float* subk = args.in[12]; const float* pu = args.in[13]; const float* pv = args.in[14]; const float* fin_g = args.in[15];
    float* out = args.out;
    bf16* WinT = (bf16*)(ws + WS_WIN); bf16* WoutT = (bf16*)(ws + WS_WOUT); bf16* WqkvT = (bf16*)(ws + WS_WQKV); bf16* WoT = (bf16*)(ws + WS_WO); bf16* WpqT = (bf16*)(ws + WS_WPQ); bf16* SKb = (bf16*)(ws + WS_SK);
    float* SS = (float*)(ws + WS_SS); int* IDX = (int*)(ws + WS_IDX); float* GATE = (float*)(ws + WS_GATE);
    bf16* XB = (bf16*)(ws + WS_XB); bf16* Y = (bf16*)(ws + WS_Y); unsigned char* U8 = ws + WS_U; unsigned char* V8 = ws + WS_V;
    bf16* G1 = (bf16*)(ws + WS_G1); bf16* PQ = (bf16*)(ws + WS_PQ); bf16* Qb = (bf16*)(ws + WS_Q); bf16* Kb = (bf16*)(ws + WS_K); bf16* VVb = (bf16*)(ws + WS_VV); bf16* AO = (bf16*)(ws + WS_AO);
    float* SS0 = SS; float* SS1 = SS + (size_t)T * 16; float* SS2 = SS + (size_t)2 * T * 16; float* SS3 = SS + (size_t)3 * T * 16;

    for (int u = tid; u < (LDS_BYTES - LDSCTL_OFF) / 4; u += NWAVES * 64) ((LAS unsigned*)(lds + LDSCTL_OFF))[u] = 0u;
    __syncthreads();
    XcdBarrier bar; bar.bar = ctl + CW_BAR; bar.x = 0; bar.st = nullptr;
    if (!MK_PER_PHASE) bar = xcd_barrier_post(ctl + CW_BAR, MISC + 8);
    const int lo = args.ph_lo, hi = args.ph_hi;
#define IN(k) (lo <= (k) && (k) < hi)
#define SEAM(k) do { if (IN(k) && IN((k) + 1)) xcd_barrier(bar); } while (0)

    if (IN(0)) REPS(0) {
        P0Args a{x, conv_g, w_in, w_out, attn_g, w_qkv, w_o, ffn_g, w_pq, subk, pu, pv, WinT, WoutT, WqkvT, WoT, WpqT, SKb, U8, V8, XB, SS0};
        p0_prologue(a, lds, vcu, G, wave, lane, tid);
    }
    SEAM(0);
    if (IN(1)) REPS(1) {
        pg8::Gemm g{XB, WinT, T, NIN, D}; pg8::StaticOrder S; S.init(T, NIN, G, bx);
        pg8::EpiBf16RS E{G1, NIN, NIN / 256, nullptr, nullptr, 0, SS0};
        pg8::gemm_phase<pg8::EpiBf16RS, pg8::StaticOrder, true, true>(lds, g, S, E);
    }
    SEAM(1);
    if (IN(2)) REPS(2) conv_gate_phase(G1, conv_w, Y, vcu, G, tid);
    SEAM(2);
    if (IN(3)) REPS(3) {
        pg8::Gemm g{Y, WoutT, T, D, D}; pg8::StaticOrder S; S.init(T, D, G, bx);
        pg8::EpiResid E{x, out, XB, SS1};
        pg8::gemm_phase<pg8::EpiResid, pg8::StaticOrder, true, true>(lds, g, S, E);
    }
    SEAM(3);
    if (IN(4)) REPS(4) {
        pg8::Gemm g{XB, WpqT, T, NPQ, D}; pg8::StaticOrder S; S.init(T, NPQ, G, bx);
        pg8::EpiBf16RS E{PQ, NPQ, NPQ / 256, nullptr, nullptr, 0, SS1};
        pg8::gemm_phase<pg8::EpiBf16RS, pg8::StaticOrder, true, true>(lds, g, S, E);
    }
    SEAM(4);
    if (IN(5)) REPS(5) route_phase(PQ, SKb, IDX, GATE, lds, vcu, G, wave, lane, tid);
    SEAM(5);
    if (IN(6)) experts_phase<false>(U8, V8, IDX, GATE, SS1, SS2, out, XB, fin_g, vcu, G, wave, lane);
    SEAM(6);
    if (IN(7)) REPS(7) {
        pg8::Gemm g{XB, WqkvT, T, NQKV, D}; pg8::StaticOrder S; S.init(T, NQKV, G, bx);
        pg8::EpiBf16RS E{Qb, D, 4, Kb, VVb, 256, SS2};
        pg8::gemm_phase<pg8::EpiBf16RS, pg8::StaticOrder, true, true>(lds, g, S, E);
    }
    SEAM(7);
    if (IN(8)) REPS(8) attn_phase(Qb, Kb, VVb, AO, rel_bias, sink, lds, vcu, G, wave, lane, tid);
    SEAM(8);
    if (IN(9)) {
        pg8::Gemm g{AO, WoT, T, D, D}; pg8::StaticOrder S; S.init(T, D, G, bx);
        pg8::EpiResid E{out, out, XB, SS3};
        pg8::gemm_phase<pg8::EpiResid, pg8::StaticOrder, true, true>(lds, g, S, E);
    }
    SEAM(9);
    if (IN(10)) REPS(10) {
        pg8::Gemm g{XB, WpqT + (size_t)NPQ * D, T, NPQ, D}; pg8::StaticOrder S; S.init(T, NPQ, G, bx);
        pg8::EpiBf16RS E{PQ, NPQ, NPQ / 256, nullptr, nullptr, 0, SS3};
        pg8::gemm_phase<pg8::EpiBf16RS, pg8::StaticOrder, true, true>(lds, g, S, E);
    }
    SEAM(10);
    if (IN(11)) REPS(11) route_phase(PQ, SKb + (size_t)8 * 2 * 128 * 128, IDX, GATE, lds, vcu, G, wave, lane, tid);
    SEAM(11);
    if (IN(12)) experts_phase<true>(U8 + (size_t)NEXP * D, V8 + (size_t)NEXP * D, IDX, GATE, SS3, nullptr, out, XB, fin_g, vcu, G, wave, lane);
#undef IN
#undef SEAM
}

extern "C" void kernel_launch(void* const* d_in, const int* in_sizes, int n_in, void* d_out, int out_size, void* d_ws, size_t ws_size, hipStream_t stream) {
    static int grid = 0;
    if (grid == 0) {
        if (n_in != 16 || in_sizes[0] != T * D || out_size != T * D || ws_size < WS_END) { fprintf(stderr, "kernel_launch: unexpected shapes (n_in %d, in0 %d, out %d, ws %zu)\n", n_in, n_in > 0 ? in_sizes[0] : -1, out_size, ws_size); grid = -1; return; }
        int dev = 0, cus = 0, per_cu = 0;
        if (hipGetDevice(&dev) != hipSuccess || hipDeviceGetAttribute(&cus, hipDeviceAttributeMultiprocessorCount, dev) != hipSuccess) { grid = -1; return; }
        if (hipFuncSetAttribute((const void*)fwd_kernel, hipFuncAttributeMaxDynamicSharedMemorySize, LDS_BYTES) != hipSuccess) { fprintf(stderr, "kernel_launch: hipFuncSetAttribute failed\n"); grid = -1; return; }
        if (hipOccupancyMaxActiveBlocksPerMultiprocessor(&per_cu, (const void*)fwd_kernel, NWAVES * 64, LDS_BYTES) != hipSuccess || per_cu < 1) { fprintf(stderr, "kernel_launch: occupancy query says %d blocks per CU\n", per_cu); (void)hipGetLastError(); grid = -1; return; }
        grid = cus;
    }
    if (grid < 0) return;
    (void)hipMemsetAsync((char*)d_ws + WS_CTL, 0, CTL_ZERO_BYTES, stream);
    Args a{};
    for (int i = 0; i < 16; ++i) a.in[i] = (const float*)d_in[i];
    a.out = (float*)d_out; a.ws = (unsigned char*)d_ws;
#if MK_PER_PHASE
    for (int p = 0; p < NPH; ++p) { a.ph_lo = p; a.ph_hi = p + 1; hipLaunchKernelGGL(fwd_kernel, dim3(grid), dim3(NWAVES * 64), LDS_BYTES, stream, a); }
#else
    a.ph_lo = 0; a.ph_hi = NPH;
    hipLaunchKernelGGL(fwd_kernel, dim3(grid), dim3(NWAVES * 64), LDS_BYTES, stream, a);
#endif
}
```

```cpp
#include <hip/hip_runtime.h>
#include <cstdio>
#include <cstdint>
namespace pg8 {
#define PG8_LAS __attribute__((address_space(3)))
typedef unsigned short bf16_t;
typedef short bf16x8 __attribute__((ext_vector_type(8)));
typedef float f32x4 __attribute__((ext_vector_type(4)));
typedef unsigned u32x4 __attribute__((ext_vector_type(4)));
constexpr int BM = 256, BK = 64, HALF = 128, HTB = HALF * BK * 2  , STAGE_BYTES = 8 * HTB, NXCD = 8, WGM = 8;

__host__ __device__ __forceinline__ int lds_byte(int r, int c) { const int st = (r >> 4) * 2 + (c >> 5), rr = r & 15, cc = c & 31, ob = rr * 64 + cc * 2; return st * 1024 + (ob ^ (((ob >> 9) & 1) << 5)); }
__host__ __device__ __forceinline__ void stage_rc(int b, int& R, int& C) { const int st = b / 1024, sb = b % 1024, swz = sb ^ (((sb >> 9) & 1) << 5); R = (st >> 1) * 16 + swz / 64; C = (st & 1) * 32 + (swz % 64) / 2; }
__host__ __device__ __forceinline__ int perm32(int rho) { const int n = rho >> 4, i = rho & 15; return 8 * (i >> 2) + 4 * n + (i & 3); }

struct Unit { int pm, pn; };
struct Gemm { const bf16_t* A; const bf16_t* Bt; int M, N, K; };

struct StaticOrder {
    int nM, nN, nwg, G, c;
    __host__ __device__ void init(int M, int N, int G_, int c_) { nM = M / BM; nN = N / BM; nwg = nM * nN; G = G_; c = c_; }
    __host__ __device__ bool next(int i, Unit& u) const {
        const long L = (long)i * G + c; if (L >= nwg) return false;
        int wgid = (int)L; { const int q = nwg / NXCD, r = nwg % NXCD, xcd = wgid % NXCD, off = wgid / NXCD; wgid = (xcd < r ? xcd * (q + 1) : r * (q + 1) + (xcd - r) * q) + off; }
        const int nig = WGM * nN, gid = wgid / nig, fm = gid * WGM, gsz = (nM - fm) < WGM ? (nM - fm) : WGM;
        u.pm = fm + ((wgid % nig) % gsz); u.pn = (wgid % nig) / gsz; return true;
    }
    __device__ __forceinline__ void a_ready(const Unit&) const {}
    __device__ __forceinline__ void done(const Unit&) const {}
};

__device__ __forceinline__ unsigned cvt_pk_bf16(float lo, float hi) { unsigned r; asm volatile("v_cvt_pk_bf16_f32 %0, %1, %2" : "=v"(r) : "v"(lo), "v"(hi)); return r; }
typedef unsigned u32x2 __attribute__((ext_vector_type(2)));
__device__ __forceinline__ float row_rstd(const float* ss, int row) {
    const f32x4* p = (const f32x4*)(ss + (size_t)row * 16);
    const f32x4 a = p[0], b = p[1], c = p[2], d = p[3];
    const float s = (((a[0] + a[1]) + (a[2] + a[3])) + ((b[0] + b[1]) + (b[2] + b[3]))) + (((c[0] + c[1]) + (c[2] + c[3])) + ((d[0] + d[1]) + (d[2] + d[3])));
    return __builtin_amdgcn_rsqf(s * (1.0f / 1024.0f) + 1e-6f);
}
struct EpiBf16RS {
    static constexpr bool PERM = true, AFTER_DRAIN = false;
    bf16_t* O0; int ld0; int nt0; bf16_t* O1; bf16_t* O2; int ld1; const float* ss;
    __device__ __forceinline__ void operator()(const f32x4 (&acc)[2][2][4][2], const Unit& u, int wr, int wc, int fr, int fq) const {
        bf16_t* base; int ld, colt;
        if (u.pn < nt0) { base = O0; ld = ld0; colt = u.pn * BM; } else if (u.pn == nt0) { base = O1; ld = ld1; colt = 0; } else { base = O2; ld = ld1; colt = (u.pn - nt0 - 1) * BM; }
        const int row0 = u.pm * BM + wr * 64 + fr, col0 = colt + wc * 32 + 8 * fq;
#pragma unroll
        for (int ai = 0; ai < 2; ++ai)
#pragma unroll
            for (int m = 0; m < 4; ++m) { const int row = row0 + ai * HALF + m * 16; const float rs = row_rstd(ss, row); bf16_t* rowp = base + (size_t)row * ld + col0;
#pragma unroll
                for (int bj = 0; bj < 2; ++bj) { const f32x4 v0 = acc[ai][bj][m][0] * rs, v1 = acc[ai][bj][m][1] * rs;
                    u32x4 w; w.x = cvt_pk_bf16(v0[0], v0[1]); w.y = cvt_pk_bf16(v0[2], v0[3]); w.z = cvt_pk_bf16(v1[0], v1[1]); w.w = cvt_pk_bf16(v1[2], v1[3]);
                    *(u32x4*)(rowp + bj * HALF) = w; } }
    }
};
struct EpiResid {
    static constexpr bool PERM = false, AFTER_DRAIN = false;
    const float* base; float* out; bf16_t* xb; float* ss;
    __device__ __forceinline__ void operator()(const f32x4 (&acc)[2][2][4][2], const Unit& u, int wr, int wc, int fr, int fq) const {
        const int row0 = u.pm * BM + wr * 64 + fr, col0 = u.pn * BM + wc * 32 + 4 * fq;
#pragma unroll
        for (int ai = 0; ai < 2; ++ai)
#pragma unroll
            for (int m = 0; m < 4; ++m) { const int row = row0 + ai * HALF + m * 16; float sq = 0.f;
#pragma unroll
                for (int bj = 0; bj < 2; ++bj)
#pragma unroll
                    for (int n = 0; n < 2; ++n) { const size_t off = (size_t)row * 1024 + col0 + bj * HALF + n * 16;
                        const f32x4 o = *(const f32x4*)(base + off) + acc[ai][bj][m][n];
                        *(f32x4*)(out + off) = o; sq += (o[0] * o[0] + o[1] * o[1]) + (o[2] * o[2] + o[3] * o[3]);
                        u32x2 w; w.x = cvt_pk_bf16(o[0], o[1]); w.y = cvt_pk_bf16(o[2], o[3]); *(u32x2*)(xb + off) = w; }
                sq += __shfl_xor(sq, 16); sq += __shfl_xor(sq, 32);
                if (fq == 0) ss[(size_t)row * 16 + u.pn * 4 + wc] = sq; }
    }
};

template <class Epi, class Sched, bool ALIGN_EPI = false, bool SP2 = false>
__device__ __forceinline__ void gemm_phase(PG8_LAS unsigned char* lds, const Gemm g, const Sched& S, const Epi& E) {
    const int tid = threadIdx.x, wid = __builtin_amdgcn_readfirstlane(tid >> 6), lane = tid & 63, wr = wid >> 2, wc = wid & 3, fr = lane & 15, fq = lane >> 4;
    const int K = g.K, nt = K / BK;
    unsigned voffA[2], voffB[2];
#pragma unroll
    for (int i = 0; i < 2; ++i) { int R, C; stage_rc(tid * 16 + i * 8192, R, C); const int Rb = Epi::PERM ? ((R & ~31) + perm32(R & 31)) : R;
        voffA[i] = (unsigned)(R * K + C) * 2u; voffB[i] = (unsigned)(Rb * K + C) * 2u; }
    const size_t kstep = (size_t)(BK * 2);
    const size_t hstep = (size_t)HALF * K * 2;
    const size_t tstep = 2 * hstep;
    const unsigned ldsw = (unsigned)wid * 1024u;
    const int aoff = lds_byte(wr * 64 + fr, fq * 8), boff = lds_byte(wc * 32 + fr, fq * 8);
#define PG8_SA(b, h) (((b) * 2 + (h)) * HTB)
#define PG8_SB(b, h) ((4 + (b) * 2 + (h)) * HTB)
#define PG8_STAGE(bufoff, gbase, voff) do { _Pragma("unroll") for (int _i = 0; _i < 2; ++_i) \
        __builtin_amdgcn_global_load_lds((const unsigned*)((const char*)(gbase) + (voff)[_i]), (PG8_LAS unsigned*)(lds + (bufoff) + ldsw + _i * 8192), 16, 0, 0); } while (0)
#define PG8_LDA(dst, b, h) do { _Pragma("unroll") for (int m = 0; m < 4; ++m) _Pragma("unroll") for (int k = 0; k < 2; ++k) dst[m][k] = *(const PG8_LAS bf16x8*)(lds + PG8_SA(b, h) + aoff + m * 2048 + k * 1024); } while (0)
#define PG8_LDB(dst, b, h) do { _Pragma("unroll") for (int n = 0; n < 2; ++n) _Pragma("unroll") for (int k = 0; k < 2; ++k) dst[n][k] = *(const PG8_LAS bf16x8*)(lds + PG8_SB(b, h) + boff + n * 2048 + k * 1024); } while (0)
#define PG8_MMA(ai, bj, At, Bt) do { __builtin_amdgcn_s_setprio(1); _Pragma("unroll") for (int m = 0; m < 4; ++m) _Pragma("unroll") for (int n = 0; n < 2; ++n) _Pragma("unroll") for (int k = 0; k < 2; ++k) \
        acc[ai][bj][m][n] = __builtin_amdgcn_mfma_f32_16x16x32_bf16(Bt[n][k], At[m][k], acc[ai][bj][m][n], 0, 0, 0); __builtin_amdgcn_s_setprio(0); } while (0)
#define PG8_WAIT_V(n) asm volatile("s_waitcnt vmcnt(" #n ")" ::: "memory")
#define PG8_WAIT_L(n) asm volatile("s_waitcnt lgkmcnt(" #n ")" ::: "memory")
#define PG8_BAR __builtin_amdgcn_s_barrier()
#define PG8_SCHED __builtin_amdgcn_sched_barrier(0)
    Unit cur, nxt; int ui = 0;
    if (!S.next(0, cur)) return;
    f32x4 acc[2][2][4][2];
#pragma unroll
    for (int a = 0; a < 2; ++a)
#pragma unroll
        for (int b = 0; b < 2; ++b)
#pragma unroll
            for (int m = 0; m < 4; ++m)
#pragma unroll
                for (int n = 0; n < 2; ++n) acc[a][b][m][n] = (f32x4){0.f, 0.f, 0.f, 0.f};
    bf16x8 At[4][2], B0[2][2], B1[2][2];
    const char* cA = (const char*)g.A + (size_t)cur.pm * tstep; const char* cB = (const char*)g.Bt + (size_t)cur.pn * tstep;
    S.a_ready(cur);
    if constexpr (SP2) {
        PG8_STAGE(PG8_SB(0, 0), cB, voffB); PG8_STAGE(PG8_SB(0, 1), cB + hstep, voffB); PG8_STAGE(PG8_SA(0, 0), cA, voffA); PG8_STAGE(PG8_SA(0, 1), cA + hstep, voffA);
        if (wr == 1) PG8_BAR;
        PG8_WAIT_V(2); PG8_BAR;
        PG8_STAGE(PG8_SB(1, 0), cB + kstep, voffB); PG8_STAGE(PG8_SA(1, 0), cA + kstep, voffA); PG8_STAGE(PG8_SB(1, 1), cB + hstep + kstep, voffB);
        PG8_WAIT_V(6); PG8_BAR;
    } else {
        PG8_STAGE(PG8_SB(0, 0), cB, voffB); PG8_STAGE(PG8_SA(0, 0), cA, voffA); PG8_STAGE(PG8_SB(0, 1), cB + hstep, voffB); PG8_STAGE(PG8_SA(0, 1), cA + hstep, voffA);
        if (wr == 1) PG8_BAR;
        PG8_WAIT_V(4); PG8_BAR;
        PG8_STAGE(PG8_SB(1, 0), cB + kstep, voffB); PG8_STAGE(PG8_SA(1, 0), cA + kstep, voffA); PG8_STAGE(PG8_SB(1, 1), cB + hstep + kstep, voffB);
        PG8_WAIT_V(6); PG8_BAR;
    }
    for (;;) {
        const bool has_next = S.next(ui + 1, nxt);
        const char* nA = has_next ? (const char*)g.A + (size_t)nxt.pm * tstep : cA; const char* nB = has_next ? (const char*)g.Bt + (size_t)nxt.pn * tstep : cB;
        for (int t = 0; t < nt; t += 2) {
            const bool last = (t == nt - 2);
            const char* a1 = cA + (size_t)(t + 1) * kstep;
            const char* a2 = last ? nA : cA + (size_t)(t + 2) * kstep; const char* b2 = last ? nB : cB + (size_t)(t + 2) * kstep;
            const char* a3 = a2 + kstep; const char* b3 = b2 + kstep;
            if (last && has_next) S.a_ready(nxt);
            if constexpr (SP2) {
            PG8_LDB(B0, 0, 0); PG8_LDB(B1, 0, 1); PG8_SCHED; PG8_LDA(At, 0, 0); PG8_STAGE(PG8_SA(1, 1), a1 + hstep, voffA);
            PG8_WAIT_V(8); PG8_WAIT_L(0); PG8_BAR; PG8_MMA(0, 0, At, B0); PG8_MMA(0, 1, At, B1); PG8_BAR; PG8_SCHED;
            PG8_LDA(At, 0, 1); PG8_STAGE(PG8_SB(0, 0), b2, voffB); PG8_STAGE(PG8_SB(0, 1), b2 + hstep, voffB); PG8_STAGE(PG8_SA(0, 0), a2, voffA);
            PG8_WAIT_V(8); PG8_WAIT_L(0); PG8_BAR; PG8_MMA(1, 0, At, B0); PG8_MMA(1, 1, At, B1); PG8_BAR; PG8_SCHED;
            PG8_LDB(B0, 1, 0); PG8_LDB(B1, 1, 1); PG8_SCHED; PG8_LDA(At, 1, 0); PG8_STAGE(PG8_SA(0, 1), a2 + hstep, voffA);
            PG8_WAIT_V(8); PG8_WAIT_L(0); PG8_BAR; PG8_MMA(0, 0, At, B0); PG8_MMA(0, 1, At, B1); PG8_BAR; PG8_SCHED;
            PG8_LDA(At, 1, 1); PG8_STAGE(PG8_SB(1, 0), b3, voffB); PG8_STAGE(PG8_SB(1, 1), b3 + hstep, voffB); PG8_STAGE(PG8_SA(1, 0), a3, voffA);
            PG8_WAIT_V(8); PG8_WAIT_L(0); PG8_BAR; PG8_MMA(1, 0, At, B0); PG8_MMA(1, 1, At, B1); PG8_BAR; PG8_SCHED;
            } else {
            PG8_LDB(B0, 0, 0); PG8_SCHED; PG8_LDA(At, 0, 0); PG8_STAGE(PG8_SA(1, 1), a1 + hstep, voffA);
            PG8_WAIT_L(8); PG8_BAR; PG8_WAIT_L(0); PG8_MMA(0, 0, At, B0); PG8_BAR; PG8_SCHED;
            PG8_LDB(B1, 0, 1); PG8_STAGE(PG8_SB(0, 0), b2, voffB);
            PG8_BAR; PG8_WAIT_L(0); PG8_MMA(0, 1, At, B1); PG8_BAR;
            PG8_LDA(At, 0, 1); PG8_STAGE(PG8_SA(0, 0), a2, voffA);
            PG8_BAR; PG8_WAIT_L(0); PG8_MMA(1, 0, At, B0); PG8_BAR; PG8_SCHED;
            PG8_STAGE(PG8_SB(0, 1), b2 + hstep, voffB);
            PG8_WAIT_V(6); PG8_BAR; PG8_MMA(1, 1, At, B1); PG8_BAR;
            PG8_LDB(B0, 1, 0); PG8_SCHED; PG8_LDA(At, 1, 0); PG8_STAGE(PG8_SA(0, 1), a2 + hstep, voffA);
            PG8_WAIT_L(8); PG8_BAR; PG8_WAIT_L(0); PG8_MMA(0, 0, At, B0); PG8_BAR; PG8_SCHED;
            PG8_LDB(B1, 1, 1); PG8_STAGE(PG8_SB(1, 0), b3, voffB);
            PG8_BAR; PG8_WAIT_L(0); PG8_MMA(0, 1, At, B1); PG8_BAR;
            PG8_LDA(At, 1, 1); PG8_STAGE(PG8_SA(1, 0), a3, voffA);
            PG8_BAR; PG8_WAIT_L(0); PG8_MMA(1, 0, At, B0); PG8_BAR; PG8_SCHED;
            PG8_STAGE(PG8_SB(1, 1), b3 + hstep, voffB);
            PG8_WAIT_V(6); PG8_BAR; PG8_MMA(1, 1, At, B1); PG8_BAR;
            }
        }
        if constexpr (ALIGN_EPI) { if (wr == 0) PG8_BAR; }
        if constexpr (!Epi::AFTER_DRAIN) { E(acc, cur, wr, wc, fr, fq); S.done(cur); }
        if (!has_next) break;
#pragma unroll
        for (int a = 0; a < 2; ++a)
#pragma unroll
            for (int b = 0; b < 2; ++b)
#pragma unroll
                for (int m = 0; m < 4; ++m)
#pragma unroll
                    for (int n = 0; n < 2; ++n) acc[a][b][m][n] = (f32x4){0.f, 0.f, 0.f, 0.f};
        cur = nxt; cA = nA; cB = nB; ++ui;
        if constexpr (ALIGN_EPI) { if (wr == 1) PG8_BAR; }
    }
    PG8_WAIT_V(0);
    if constexpr (!ALIGN_EPI) { if (wr == 0) PG8_BAR; }
    PG8_BAR;
    if constexpr (Epi::AFTER_DRAIN) { E.fused(acc, cur, wr, wc, fr, fq, lds, wid, lane); S.done(cur); }
#undef PG8_SA
#undef PG8_SB
#undef PG8_STAGE
#undef PG8_LDA
#undef PG8_LDB
#undef PG8_MMA
#undef PG8_WAIT_V
#undef PG8_WAIT_L
#undef PG8_BAR
#undef PG8_SCHED
}
}

constexpr int NWAVES = 8;
constexpr int BATCH = 2, SEQ = 8192, D = 1024, T = BATCH * SEQ;
constexpr int NIN = 3072, NQKV = 1536, NPQ = 2048, NEXP = 16384;
constexpr float LOG2E = 1.4426950408889634f;
constexpr float QSCALE = 0.125f * LOG2E;
constexpr float NEGBIG = -1e30f;
#ifndef MK_PER_PHASE
#define MK_PER_PHASE 0
#endif
constexpr int NPH = 18;
#ifndef REP_MASK
#define REP_MASK 0
#endif
#define REPS(k) for (int rep_ = 0; rep_ < (((REP_MASK) >> (k)) & 1) + 1; ++rep_)

constexpr size_t MiB = 1u << 20;
constexpr size_t WS_CTL = 0, CTL_ZERO_BYTES = 65536;
constexpr size_t WS_WIN = 1 * MiB, WS_WOUT = 7 * MiB, WS_WQKV = 9 * MiB, WS_WO = 12 * MiB, WS_WPQ = 14 * MiB, WS_SK = 22 * MiB;
constexpr size_t WS_SS = 23 * MiB;
constexpr size_t WS_IDX = 28 * MiB, WS_GATE = 36 * MiB, WS_XB = 44 * MiB, WS_Y = 76 * MiB, WS_U = 108 * MiB, WS_V = 172 * MiB;
constexpr size_t WS_G1 = 236 * MiB, WS_PQ = 332 * MiB, WS_Q = 396 * MiB, WS_K = 428 * MiB, WS_VV = 436 * MiB, WS_AO = 444 * MiB, WS_END = 476 * MiB;
constexpr size_t WS_HP = WS_G1, WS_A = WS_G1 + 64 * MiB;
constexpr int CW_BAR = 4096;
constexpr int CW_WQ = 8192;

constexpr int RING_BYTES = 131072;
constexpr int LDSCTL_OFF = RING_BYTES, MISC_OFF = LDSCTL_OFF + 320;
constexpr int LDS_BYTES = 147456;

#define LAS __attribute__((address_space(3)))
typedef unsigned short bf16;
typedef unsigned v4u __attribute__((ext_vector_type(4)));
typedef unsigned v2u __attribute__((ext_vector_type(2)));
typedef float f32x4 __attribute__((ext_vector_type(4)));
typedef float f32x2 __attribute__((ext_vector_type(2)));
typedef float f32x16 __attribute__((ext_vector_type(16)));
typedef short bf16x8 __attribute__((ext_vector_type(8)));
typedef __bf16 bf16x2_t __attribute__((ext_vector_type(2)));
#define LDS_WAIT() asm volatile("s_waitcnt lgkmcnt(0)" ::: "memory")
#define DI __device__ __forceinline__

DI unsigned pk2(float lo, float hi) { f32x2 v = {lo, hi}; bf16x2_t b = __builtin_convertvector(v, bf16x2_t); return __builtin_bit_cast(unsigned, b); }
DI float bf_lo(unsigned u) { return __uint_as_float(u << 16); }
DI float bf_hi(unsigned u) { return __uint_as_float(u & 0xffff0000u); }
DI float wave_sum(float v) {
#pragma unroll
    for (int o = 1; o < 64; o <<= 1) v += __shfl_xor(v, o);
    return v;
}
#define XB_TMO      128
#define XB_XCNT(j)  (256  + 64 * (j))
#define XB_XSUB(j)  (1280 + 64 * (j))
#define XB_XGEN(j)  (2304 + 64 * (j))
#define XB_TOP      3328
#define XB_TOPGEN   3392
#define XCD_BAR_WORDS 3456
#define XB_SPIN_CAP (1u << 18)

__device__ __forceinline__ unsigned xb_ld(unsigned* p)              { return __hip_atomic_load(p, __ATOMIC_RELAXED, __HIP_MEMORY_SCOPE_AGENT); }
__device__ __forceinline__ unsigned xb_add(unsigned* p, unsigned v) { return __hip_atomic_fetch_add(p, v, __ATOMIC_RELAXED, __HIP_MEMORY_SCOPE_AGENT); }
__device__ __forceinline__ unsigned xb_xcc_id() { return (unsigned)__builtin_amdgcn_s_getreg((3 << 11) | 20) & 0xFu; }
#define XB_SPIN(cond, bar) do { unsigned _sp = 0; while (cond) { __builtin_amdgcn_s_sleep(1); \
    if ((++_sp & 255u) == 0u) { if (xb_ld(&(bar)[XB_TMO])) break; if (_sp > XB_SPIN_CAP) { atomicAdd(&(bar)[XB_TMO], 1u); break; } } } } while (0)

struct XcdBarrier {
    unsigned* bar; unsigned x;
    volatile LAS unsigned* st;
};

__device__ __forceinline__ XcdBarrier xcd_barrier_post(unsigned* bar, volatile LAS unsigned* st) {
    XcdBarrier b; b.bar = bar; b.x = xb_xcc_id(); b.st = st;
    if (threadIdx.x == 0) (void)xb_add(&bar[XB_XCNT(b.x)], 1u);
    return b;
}
__device__ __forceinline__ void xcd_barrier_complete(unsigned* bar, unsigned x, unsigned& nloc, unsigned& nx) {
    const unsigned G = gridDim.x * gridDim.y * gridDim.z;
    unsigned sum, cnt, mine, sp = 0u;
    for (;;) {
        sum = 0u; cnt = 0u; mine = 0u;
#pragma unroll
        for (unsigned j = 0; j < 16; ++j) { const unsigned c = xb_ld(&bar[XB_XCNT(j)]); sum += c; cnt += (c > 0u) ? 1u : 0u; mine = (j == x) ? c : mine; }
        if (sum == G) break;
        __builtin_amdgcn_s_sleep(1);
        if ((++sp & 255u) == 0u) { if (xb_ld(&bar[XB_TMO])) break; if (sp > XB_SPIN_CAP) { atomicAdd(&bar[XB_TMO], 1u); break; } }
    }
    nloc = mine > 0u ? mine : 1u; nx = cnt > 0u ? cnt : 1u;
}

__device__ __forceinline__ void xcd_barrier(const XcdBarrier& b) {
    asm volatile("s_waitcnt vmcnt(0)" ::: "memory");
    __syncthreads();
    if (threadIdx.x == 0) {
        unsigned* bar = b.bar;
        __builtin_amdgcn_s_waitcnt(0);
        unsigned nloc = b.st[0], nx = b.st[1];
        if (nloc == 0u) { xcd_barrier_complete(bar, b.x, nloc, nx); b.st[0] = nloc; b.st[1] = nx; }
        const unsigned old = xb_add(&bar[XB_XSUB(b.x)], 1u);
        const unsigned gen = old / nloc;
        if (old + 1u == (gen + 1u) * nloc) {
            __builtin_amdgcn_fence(__ATOMIC_RELEASE, "agent");
            asm volatile("s_waitcnt vmcnt(0)" ::: "memory");
            const unsigned og = xb_add(&bar[XB_TOP], 1u);
            const unsigned tg = og / nx;
            if (og + 1u == (tg + 1u) * nx) xb_add(&bar[XB_TOPGEN], 1u);
            else XB_SPIN(xb_ld(&bar[XB_TOPGEN]) == tg, bar);
            __builtin_amdgcn_fence(__ATOMIC_ACQUIRE, "agent");
            xb_add(&bar[XB_XGEN(b.x)], 1u);
            asm volatile("s_waitcnt vmcnt(0)" ::: "memory");
        } else {
            XB_SPIN(xb_ld(&bar[XB_XGEN(b.x)]) == gen, bar);
            __builtin_amdgcn_fence(__ATOMIC_ACQUIRE, "agent");
            asm volatile("s_waitcnt vmcnt(0)" ::: "memory");
        }
    }
    __syncthreads();
}

DI void p0_transpose_item(const float* W, int K, int N, bf16* WT, LAS float* scr, int item, int lane, const float* gain, int nscaled, float cscale) {
    const int nblk = N / 32, kb = item / nblk, nb = item % nblk, k0 = 64 * kb, n0 = 32 * nb;
#pragma unroll 8
    for (int i = 0; i < 32; ++i) { const int kk = 2 * i + (lane >> 5); float v = W[(size_t)(k0 + kk) * N + n0 + (lane & 31)]; if (gain) v *= gain[k0 + kk]; scr[kk * 33 + (lane & 31)] = v; }
    LDS_WAIT();
    const int c = lane & 7;
#pragma unroll
    for (int j = 0; j < 4; ++j) { const int n = (lane >> 3) + 8 * j; const LAS float* s = scr + (8 * c) * 33 + n; const float cs = (n0 + n < nscaled) ? cscale : 1.f;
        v4u o; o.x = pk2(s[0 * 33] * cs, s[1 * 33] * cs); o.y = pk2(s[2 * 33] * cs, s[3 * 33] * cs); o.z = pk2(s[4 * 33] * cs, s[5 * 33] * cs); o.w = pk2(s[6 * 33] * cs, s[7 * 33] * cs);
        *(v4u*)(WT + (size_t)(n0 + n) * K + k0 + 8 * c) = o; }
    LDS_WAIT();
}
struct P0Args { const float *x, *conv_g, *w_in, *w_out, *attn_g, *w_qkv, *w_o, *ffn_g, *w_pq, *subk, *pu, *pv;
                bf16 *WinT, *WoutT, *WqkvT, *WoT, *WpqT, *SKb; unsigned char *U8, *V8; bf16* XB; float* SS0; };
DI void p0_prologue(const P0Args& a, LAS unsigned char* lds, int vcu, int G, int wave, int lane, int tid) {
    LAS float* scr = (LAS float*)(lds + wave * 16384);
    const int gw = vcu * NWAVES + wave, NGW = G * NWAVES;
    constexpr int I_IN = 16 * (NIN / 32), I_OUT = 16 * (D / 32), I_QKV = 16 * (NQKV / 32), I_O = I_OUT, I_PQ = 16 * (NPQ / 32);
    constexpr int NITEMS = I_IN + I_OUT + I_QKV + I_O + 2 * I_PQ;
    for (int it = gw; it < NITEMS; it += NGW) {
        int r = it;
        if (r < I_IN) { p0_transpose_item(a.w_in, D, NIN, a.WinT, scr, r, lane, a.conv_g, 0, 1.f); continue; } r -= I_IN;
        if (r < I_OUT) { p0_transpose_item(a.w_out, D, D, a.WoutT, scr, r, lane, nullptr, 0, 1.f); continue; } r -= I_OUT;
        if (r < I_QKV) { p0_transpose_item(a.w_qkv, D, NQKV, a.WqkvT, scr, r, lane, a.attn_g, 1024, QSCALE); continue; } r -= I_QKV;
        if (r < I_O) { p0_transpose_item(a.w_o, D, D, a.WoT, scr, r, lane, nullptr, 0, 1.f); continue; } r -= I_O;
        if (r < I_PQ) { p0_transpose_item(a.w_pq, D, NPQ, a.WpqT, scr, r, lane, a.ffn_g, 0, 1.f); continue; } r -= I_PQ;
        p0_transpose_item(a.w_pq + (size_t)D * NPQ, D, NPQ, a.WpqT + (size_t)NPQ * D, scr, r, lane, a.ffn_g + D, 0, 1.f);
    }
    const size_t gt = (size_t)vcu * (NWAVES * 64) + tid, NGT = (size_t)G * NWAVES * 64;
    constexpr size_t C_SK = (size_t)2 * 8 * 2 * 128 * 128 / 8;
    for (size_t c = gt; c < C_SK; c += NGT) { const f32x4 v0 = *(const f32x4*)(a.subk + c * 8), v1 = *(const f32x4*)(a.subk + c * 8 + 4);
        v4u o; o.x = pk2(v0[0], v0[1]); o.y = pk2(v0[2], v0[3]); o.z = pk2(v1[0], v1[1]); o.w = pk2(v1[2], v1[3]); *(v4u*)(a.SKb + c * 8) = o; }
    constexpr size_t C_T16 = (size_t)2 * NEXP * D / 16;
    for (size_t c = gt; c < C_T16; c += NGT) { const int layer = (int)(c / ((size_t)NEXP * D / 16)), d0 = (int)(c % (D / 16)) * 16;
        v4u o;
#pragma unroll
        for (int q = 0; q < 4; ++q) { const f32x4 g = *(const f32x4*)(a.ffn_g + layer * D + d0 + 4 * q);
            const f32x4 v = __builtin_nontemporal_load((const f32x4*)(a.pu + c * 16 + 4 * q)) * g * 1024.0f;
            int w = __builtin_amdgcn_cvt_pk_fp8_f32(v[0], v[1], 0, false); w = __builtin_amdgcn_cvt_pk_fp8_f32(v[2], v[3], w, true); o[q] = (unsigned)w; }
        *(v4u*)(a.U8 + c * 16) = o; }
    for (size_t c = gt; c < C_T16; c += NGT) {
        v4u o;
#pragma unroll
        for (int q = 0; q < 4; ++q) { const f32x4 v = __builtin_nontemporal_load((const f32x4*)(a.pv + c * 16 + 4 * q)) * 1024.0f;
            int w = __builtin_amdgcn_cvt_pk_fp8_f32(v[0], v[1], 0, false); w = __builtin_amdgcn_cvt_pk_fp8_f32(v[2], v[3], w, true); o[q] = (unsigned)w; }
        *(v4u*)(a.V8 + c * 16) = o; }
    for (int m = gw; m < T; m += NGW) {
        const f32x4* xr = (const f32x4*)(a.x + (size_t)m * D) + lane; float s = 0.f; f32x4 v[4];
#pragma unroll
        for (int j = 0; j < 4; ++j) { v[j] = xr[64 * j]; s += (v[j][0] * v[j][0] + v[j][1] * v[j][1]) + (v[j][2] * v[j][2] + v[j][3] * v[j][3]); }
        s = wave_sum(s);
        v2u* o8 = (v2u*)(a.XB + (size_t)m * D) + lane;
#pragma unroll
        for (int j = 0; j < 4; ++j) { v2u w; w.x = pk2(v[j][0], v[j][1]); w.y = pk2(v[j][2], v[j][3]); o8[64 * j] = w; }
        if (lane < 4) { f32x4 z = {0.f, 0.f, 0.f, 0.f}; ((f32x4*)(a.SS0 + (size_t)(2 * T + m) * 16))[lane] = z; ((f32x4*)(a.SS0 + (size_t)(4 * T + m) * 16))[lane] = z;
            if (lane == 0) z[0] = s; ((f32x4*)(a.SS0 + (size_t)m * 16))[lane] = z; }
    }
}

DI void conv_gate_phase(const bf16* G1, const float* cw, bf16* Y, int vcu, int G, int tid) {
    const size_t gt = (size_t)vcu * (NWAVES * 64) + tid, NGT = (size_t)G * NWAVES * 64;
    for (size_t c = gt; c < (size_t)T * (D / 8); c += NGT) {
        const int t = (int)(c / (D / 8)), d0 = (int)(c % (D / 8)) * 8, ts = t % SEQ;
        const v4u gb = *(const v4u*)(G1 + (size_t)t * NIN + d0);
        float acc[8];
#pragma unroll
        for (int i = 0; i < 8; ++i) acc[i] = 0.f;
#pragma unroll
        for (int w = 0; w < 3; ++w) { const int tt = ts + w - 1;
            if (tt >= 0 && tt < SEQ) {
                const v4u gc = *(const v4u*)(G1 + (size_t)(t + w - 1) * NIN + D + d0), hh = *(const v4u*)(G1 + (size_t)(t + w - 1) * NIN + 2 * D + d0);
                const f32x4 w0 = *(const f32x4*)(cw + w * D + d0), w1 = *(const f32x4*)(cw + w * D + d0 + 4);
                acc[0] += w0[0] * (bf_lo(gc.x) * bf_lo(hh.x)); acc[1] += w0[1] * (bf_hi(gc.x) * bf_hi(hh.x));
                acc[2] += w0[2] * (bf_lo(gc.y) * bf_lo(hh.y)); acc[3] += w0[3] * (bf_hi(gc.y) * bf_hi(hh.y));
                acc[4] += w1[0] * (bf_lo(gc.z) * bf_lo(hh.z)); acc[5] += w1[1] * (bf_hi(gc.z) * bf_hi(hh.z));
                acc[6] += w1[2] * (bf_lo(gc.w) * bf_lo(hh.w)); acc[7] += w1[3] * (bf_hi(gc.w) * bf_hi(hh.w)); } }
        v4u o; o.x = pk2(acc[0] * bf_lo(gb.x), acc[1] * bf_hi(gb.x)); o.y = pk2(acc[2] * bf_lo(gb.y), acc[3] * bf_hi(gb.y));
        o.z = pk2(acc[4] * bf_lo(gb.z), acc[5] * bf_hi(gb.z)); o.w = pk2(acc[6] * bf_lo(gb.w), acc[7] * bf_hi(gb.w));
        *(v4u*)(Y + (size_t)t * D + d0) = o;
    }
}

template <int CTRL> DI unsigned dppu(unsigned v) { return (unsigned)__builtin_amdgcn_update_dpp(0, (int)v, CTRL, 0xf, 0xf, false); }
DI unsigned umax(unsigned a, unsigned b) { return a > b ? a : b; }
DI unsigned umin(unsigned a, unsigned b) { return a < b ? a : b; }
DI unsigned rowmax_u(unsigned v) { v = umax(v, dppu<0x128>(v)); v = umax(v, dppu<0x124>(v)); v = umax(v, dppu<0x122>(v)); v = umax(v, dppu<0x121>(v)); return v; }
DI float rowsum_f(float v) { v += __uint_as_float(dppu<0x128>(__float_as_uint(v))); v += __uint_as_float(dppu<0x124>(__float_as_uint(v))); v += __uint_as_float(dppu<0x122>(__float_as_uint(v))); v += __uint_as_float(dppu<0x121>(__float_as_uint(v))); return v; }
DI unsigned f2key(float f) { const unsigned u = __float_as_uint(f); return u ^ ((unsigned)((int)u >> 31) | 0x80000000u); }
DI float key2f(unsigned k) { const unsigned u = (k & 0x80000000u) ? (k ^ 0x80000000u) : ~k; return __uint_as_float(u); }
DI unsigned cand_ij(int c) {
    unsigned i, j;
    if (c < 16) { i = 0; j = c; } else if (c < 24) { i = 1; j = c - 16; } else if (c < 29) { i = 2; j = c - 24; } else if (c < 33) { i = 3; j = c - 29; }
    else if (c < 36) { i = 4; j = c - 33; } else if (c < 38) { i = 5; j = c - 36; } else if (c < 40) { i = 6; j = c - 38; } else if (c < 42) { i = 7; j = c - 40; }
    else { i = 8 + (c - 42); j = 0; }
    return (i & 15u) | (j << 4);
}
#define CE_DESC(a, b) do { const unsigned _hi = umax(a, b), _lo = umin(a, b); a = _hi; b = _lo; } while (0)
DI void route_phase(const bf16* PQ, const bf16* SK, unsigned short* IDX, float* GATE, LAS unsigned char* lds, int vcu, int G, int wave, int lane, int tid) {
    const int fr = lane & 15, fq = lane >> 4;
    LAS unsigned char* TAB = lds;
    LAS unsigned char* SKL = lds + 256;
    if (tid < 64) TAB[tid] = (unsigned char)(tid < 50 ? cand_ij(tid) : 0xff);
    int cur_h = -1;
    for (int item = vcu; item < (T / 128) * 8; item += G) {
        const int h = item & 7, tile = item >> 3, t0 = tile * 128 + wave * 16;
        if (h != cur_h) { __syncthreads();
            for (int c = tid; c < 2 * 128 * 16; c += NWAVES * 64) { const int row = c >> 4, c16 = c & 15;
                *(LAS v4u*)(SKL + row * 272 + c16 * 16) = *(const v4u*)(SK + (size_t)(h * 256 + row) * 128 + c16 * 8); }
            cur_h = h; __syncthreads(); }
        unsigned res[2][4];
#pragma unroll
        for (int p = 0; p < 2; ++p) {
            bf16x8 af[4];
#pragma unroll
            for (int ks = 0; ks < 4; ++ks) af[ks] = *(const bf16x8*)(PQ + (size_t)(t0 + fr) * NPQ + h * 256 + p * 128 + ks * 32 + fq * 8);
            f32x4 acc[8];
#pragma unroll
            for (int n = 0; n < 8; ++n) { acc[n] = (f32x4){0.f, 0.f, 0.f, 0.f};
#pragma unroll
                for (int ks = 0; ks < 4; ++ks) { const bf16x8 bfr = *(const LAS bf16x8*)(SKL + (p * 128 + n * 16 + fr) * 272 + ks * 64 + fq * 16);
                    acc[n] = __builtin_amdgcn_mfma_f32_16x16x32_bf16(af[ks], bfr, acc[n], 0, 0, 0); } }
            unsigned L[4][8];
#pragma unroll
            for (int r = 0; r < 4; ++r)
#pragma unroll
                for (int n = 0; n < 8; ++n) L[r][n] = (f2key(acc[n][r]) & ~127u) | (unsigned)(127 - (16 * n + fr));
#define CE4(i, j) do { _Pragma("unroll") for (int r = 0; r < 4; ++r) CE_DESC(L[r][i], L[r][j]); } while (0)
            CE4(0, 1); CE4(2, 3); CE4(4, 5); CE4(6, 7);
            CE4(0, 2); CE4(1, 3); CE4(4, 6); CE4(5, 7);
            CE4(1, 2); CE4(5, 6); CE4(0, 4); CE4(3, 7);
            CE4(1, 5); CE4(2, 6);
            CE4(1, 4); CE4(3, 6);
            CE4(2, 4); CE4(3, 5);
            CE4(3, 4);
#undef CE4
            unsigned rr[4] = {0u, 0u, 0u, 0u};
#pragma unroll
            for (int k = 0; k < 16; ++k) {
                unsigned gm[4];
#pragma unroll
                for (int r = 0; r < 4; ++r) gm[r] = umax(L[r][0], dppu<0x128>(L[r][0]));
#pragma unroll
                for (int r = 0; r < 4; ++r) gm[r] = umax(gm[r], dppu<0x124>(gm[r]));
#pragma unroll
                for (int r = 0; r < 4; ++r) gm[r] = umax(gm[r], dppu<0x122>(gm[r]));
#pragma unroll
                for (int r = 0; r < 4; ++r) gm[r] = umax(gm[r], dppu<0x121>(gm[r]));
#pragma unroll
                for (int r = 0; r < 4; ++r) { rr[r] = (fr == k) ? gm[r] : rr[r]; const bool pop = (L[r][0] == gm[r]);
#pragma unroll
                    for (int n = 0; n < 7; ++n) L[r][n] = pop ? L[r][n + 1] : L[r][n];
                    L[r][7] = pop ? 0u : L[r][7]; }
            }
#pragma unroll
            for (int r = 0; r < 4; ++r) res[p][r] = rr[r];
        }
        const int gbase = (lane & 48) * 4;
        unsigned ck[4][4];
#pragma unroll
        for (int r = 0; r < 4; ++r)
#pragma unroll
            for (int s = 0; s < 4; ++s) { const int c = fr + 16 * s; const unsigned tb = TAB[c & 63];
                const unsigned k0 = (unsigned)__builtin_amdgcn_ds_bpermute(gbase + (int)(tb & 15u) * 4, (int)res[0][r]);
                const unsigned k1 = (unsigned)__builtin_amdgcn_ds_bpermute(gbase + (int)((tb >> 4) & 15u) * 4, (int)res[1][r]);
                const float v = key2f((k0 & ~127u) | 64u) + key2f((k1 & ~127u) | 64u);
                ck[r][s] = (c < 50) ? ((f2key(v) & ~63u) | (unsigned)(63 - c)) : 0u; }
        unsigned sel[4] = {0u, 0u, 0u, 0u};
#pragma unroll
        for (int k = 0; k < 16; ++k) {
            unsigned gm[4];
#pragma unroll
            for (int r = 0; r < 4; ++r) { const unsigned lm = umax(umax(ck[r][0], ck[r][1]), umax(ck[r][2], ck[r][3])); gm[r] = umax(lm, dppu<0x128>(lm)); }
#pragma unroll
            for (int r = 0; r < 4; ++r) gm[r] = umax(gm[r], dppu<0x124>(gm[r]));
#pragma unroll
            for (int r = 0; r < 4; ++r) gm[r] = umax(gm[r], dppu<0x122>(gm[r]));
#pragma unroll
            for (int r = 0; r < 4; ++r) gm[r] = umax(gm[r], dppu<0x121>(gm[r]));
#pragma unroll
            for (int r = 0; r < 4; ++r) { sel[r] = (fr == k) ? gm[r] : sel[r];
#pragma unroll
                for (int s = 0; s < 4; ++s) ck[r][s] = (ck[r][s] == gm[r]) ? 0u : ck[r][s]; }
        }
#pragma unroll
        for (int r = 0; r < 4; ++r) {
            const int t = t0 + 4 * fq + r;
            const int cs = 63 - (int)(sel[r] & 63u); const unsigned tb = TAB[cs & 63];
            const unsigned k0 = (unsigned)__builtin_amdgcn_ds_bpermute(gbase + (int)(tb & 15u) * 4, (int)res[0][r]);
            const unsigned k1 = (unsigned)__builtin_amdgcn_ds_bpermute(gbase + (int)((tb >> 4) & 15u) * 4, (int)res[1][r]);
            const int e = (127 - (int)(k0 & 127u)) * 128 + (127 - (int)(k1 & 127u));
            const float val = key2f((sel[r] & ~63u) | 32u), top = key2f((rowmax_u(sel[r]) & ~63u) | 32u);
            const float ex = __builtin_amdgcn_exp2f((val - top) * LOG2E), sum = rowsum_f(ex);
            IDX[(size_t)t * 128 + h * 16 + fr] = (unsigned short)e; GATE[(size_t)t * 128 + h * 16 + fr] = ex / sum;
        }
    }
}

DI float dot8(v4u x, v4u u, float acc) {
    acc += bf_lo(x.x) * bf_lo(u.x); acc += bf_hi(x.x) * bf_hi(u.x); acc += bf_lo(x.y) * bf_lo(u.y); acc += bf_hi(x.y) * bf_hi(u.y);
    acc += bf_lo(x.z) * bf_lo(u.z); acc += bf_hi(x.z) * bf_hi(u.z); acc += bf_lo(x.w) * bf_lo(u.w); acc += bf_hi(x.w) * bf_hi(u.w);
    return acc;
}
DI void fma8(float* acc, float a, v4u v) {
    acc[0] += a * bf_lo(v.x); acc[1] += a * bf_hi(v.x); acc[2] += a * bf_lo(v.y); acc[3] += a * bf_hi(v.y);
    acc[4] += a * bf_lo(v.z); acc[5] += a * bf_hi(v.z); acc[6] += a * bf_lo(v.w); acc[7] += a * bf_hi(v.w);
}
DI f32x2 fp8lo(unsigned w) { return __builtin_amdgcn_cvt_pk_f32_fp8((int)w, false); }
DI f32x2 fp8hi(unsigned w) { return __builtin_amdgcn_cvt_pk_f32_fp8((int)w, true); }

constexpr int XCHUNK = 128, XNCHUNK = T / XCHUNK, XTPW = XCHUNK / NWAVES;
template <int CTRL> DI float dppf(float v) { return __uint_as_float(dppu<CTRL>(__float_as_uint(v))); }
struct UTok { v4u xa, xb; v4u uw[16]; };
DI void u_issue(UTok& S, const unsigned char* U8s, const unsigned short* IDX, const bf16* XB, int t, int s, int lane) {
    const int g = lane >> 3, k = lane & 7;
    const int i0 = IDX[(size_t)t * 128 + lane], i1 = IDX[(size_t)t * 128 + 64 + lane];
    const v4u* xr = (const v4u*)(XB + (size_t)t * D + 128 * s + 16 * k);
    S.xa = xr[0]; S.xb = xr[1];
#pragma unroll
    for (int i = 0; i < 16; ++i) { const int idx = __builtin_amdgcn_ds_bpermute((8 * (i & 7) + g) * 4, i < 8 ? i0 : i1);
        S.uw[i] = *(const v4u*)(U8s + (size_t)idx * D + 16 * k); }
}
DI void u_compute(const UTok& S, float* HPs, int t, int lane) {
    const int g = lane >> 3, k = lane & 7;
    const v4u xa = S.xa, xb = S.xb;
    f32x2 xp[8];
    xp[0] = (f32x2){bf_lo(xa.x), bf_hi(xa.x)}; xp[1] = (f32x2){bf_lo(xa.y), bf_hi(xa.y)}; xp[2] = (f32x2){bf_lo(xa.z), bf_hi(xa.z)}; xp[3] = (f32x2){bf_lo(xa.w), bf_hi(xa.w)};
    xp[4] = (f32x2){bf_lo(xb.x), bf_hi(xb.x)}; xp[5] = (f32x2){bf_lo(xb.y), bf_hi(xb.y)}; xp[6] = (f32x2){bf_lo(xb.z), bf_hi(xb.z)}; xp[7] = (f32x2){bf_lo(xb.w), bf_hi(xb.w)};
    float r0 = 0.f, r1 = 0.f;
#pragma unroll
    for (int i = 0; i < 16; ++i) { f32x2 a2 = {0.f, 0.f};
#pragma unroll
        for (int q = 0; q < 4; ++q) { a2 = __builtin_elementwise_fma(xp[2 * q], fp8lo(S.uw[i][q]), a2); a2 = __builtin_elementwise_fma(xp[2 * q + 1], fp8hi(S.uw[i][q]), a2); }
        float p = a2.x + a2.y;
        p += dppf<0xB1>(p); p += dppf<0x4E>(p); p += dppf<0x141>(p);
        if (i < 8) r0 = ((i & 7) == k) ? p : r0; else r1 = ((i & 7) == k) ? p : r1; }
    HPs[(size_t)t * 128 + 8 * k + g] = r0; HPs[(size_t)t * 128 + 64 + 8 * k + g] = r1;
}
struct VTok { v4u vw[16]; float av[16]; };
DI void v_issue(VTok& S, const unsigned char* V8s, const unsigned short* IDX, const float* A, int t, int lane) {
    const int g = lane >> 3, k = lane & 7;
    const int i0 = IDX[(size_t)t * 128 + lane], i1 = IDX[(size_t)t * 128 + 64 + lane];
    const float a0 = A[(size_t)t * 128 + lane], a1 = A[(size_t)t * 128 + 64 + lane];
#pragma unroll
    for (int i = 0; i < 16; ++i) { const int ad = (8 * (i & 7) + g) * 4; const int idx = __builtin_amdgcn_ds_bpermute(ad, i < 8 ? i0 : i1);
        S.av[i] = __uint_as_float((unsigned)__builtin_amdgcn_ds_bpermute(ad, (int)__float_as_uint(i < 8 ? a0 : a1)));
        S.vw[i] = *(const v4u*)(V8s + (size_t)idx * D + 16 * k); }
}
template <bool FINAL>
DI void v_compute(const VTok& S, float* xf, bf16* XB, float* ss_out, int t, int s, int lane) {
    const int k = lane & 7;
    const bool b3 = lane & 8, b4 = lane & 16, b5 = lane & 32;
    const int col = 128 * s + 16 * k + (b3 ? 8 : 0) + (b4 ? 4 : 0) + (b5 ? 2 : 0);
    float* xo = xf + (size_t)t * D + col;
    f32x2 o = *(const f32x2*)xo;
    f32x2 acc[8];
#pragma unroll
    for (int i = 0; i < 8; ++i) acc[i] = (f32x2){0.f, 0.f};
#pragma unroll
    for (int i = 0; i < 16; ++i) { const f32x2 a2 = {S.av[i], S.av[i]};
#pragma unroll
        for (int q = 0; q < 4; ++q) { acc[2 * q] = __builtin_elementwise_fma(a2, fp8lo(S.vw[i][q]), acc[2 * q]); acc[2 * q + 1] = __builtin_elementwise_fma(a2, fp8hi(S.vw[i][q]), acc[2 * q + 1]); } }
    float v[16];
#pragma unroll
    for (int i = 0; i < 8; ++i) { v[2 * i] = acc[i].x; v[2 * i + 1] = acc[i].y; }
    float v8[8], v4[4], v2[2];
#pragma unroll
    for (int j = 0; j < 8; ++j) { const float keep = b3 ? v[8 + j] : v[j], send = b3 ? v[j] : v[8 + j]; v8[j] = keep + __shfl_xor(send, 8); }
#pragma unroll
    for (int j = 0; j < 4; ++j) { const float keep = b4 ? v8[4 + j] : v8[j], send = b4 ? v8[j] : v8[4 + j]; v4[j] = keep + __shfl_xor(send, 16); }
#pragma unroll
    for (int j = 0; j < 2; ++j) { const float keep = b5 ? v4[2 + j] : v4[j], send = b5 ? v4[j] : v4[2 + j]; v2[j] = keep + __shfl_xor(send, 32); }
    o.x += v2[0]; o.y += v2[1];
    *(f32x2*)xo = o;
    if (!FINAL) *(unsigned*)(XB + (size_t)t * D + col) = pk2(o.x, o.y);
    const float sq = wave_sum(o.x * o.x + o.y * o.y);
    if (lane == 0) ss_out[(size_t)t * 16 + s] = sq;
}
template <int PASS, bool FINAL>
DI void sliced_pass(const unsigned char* TAB, const unsigned short* IDX, const bf16* XBc, bf16* XBw, float* HP, const float* A, float* xf, float* ss_out,
                    unsigned* heads, volatile LAS unsigned* slot, int wave, int lane, int tid) {
    const int own = (int)(xb_xcc_id() & 7u);
#pragma unroll 1
    for (int ds = 0; ds < 8; ++ds) { const int s = (own + ds) & 7;
        unsigned* head = heads + 64 * s; unsigned tk = 0u;
        if (tid == 0) tk = __hip_atomic_fetch_add(head, 1u, __ATOMIC_RELAXED, __HIP_MEMORY_SCOPE_AGENT);
        for (;;) {
            __syncthreads(); if (tid == 0) *slot = tk; __syncthreads();
            const unsigned c = *slot; if (c >= (unsigned)XNCHUNK) break;
            if (tid == 0) tk = __hip_atomic_fetch_add(head, 1u, __ATOMIC_RELAXED, __HIP_MEMORY_SCOPE_AGENT);
            const int t0 = (int)c * XCHUNK + wave * XTPW;
            if (PASS == 0) { const unsigned char* Ts = TAB + 128 * s; float* HPs = HP + (size_t)s * T * 128;
                UTok P, Q; u_issue(P, Ts, IDX, XBc, t0, s, lane);
#pragma unroll 1
                for (int j = 0; j < XTPW; j += 2) { u_issue(Q, Ts, IDX, XBc, t0 + j + 1, s, lane); u_compute(P, HPs, t0 + j, lane);
                    if (j + 2 < XTPW) u_issue(P, Ts, IDX, XBc, t0 + j + 2, s, lane); u_compute(Q, HPs, t0 + j + 1, lane); }
            } else { const unsigned char* Ts = TAB + 128 * s;
                VTok P, Q; v_issue(P, Ts, IDX, A, t0, lane);
#pragma unroll 1
                for (int j = 0; j < XTPW; j += 2) { v_issue(Q, Ts, IDX, A, t0 + j + 1, lane); v_compute<FINAL>(P, xf, XBw, ss_out, t0 + j, s, lane);
                    if (j + 2 < XTPW) v_issue(P, Ts, IDX, A, t0 + j + 2, lane); v_compute<FINAL>(Q, xf, XBw, ss_out, t0 + j + 1, s, lane); }
            }
        } }
}
DI void reduce_phase(const float* HP, const float* GATE, const float* ss_in, float* A, int vcu, int G, int tid) {
    const size_t gt = (size_t)vcu * (NWAVES * 64) + tid, NGT = (size_t)G * NWAVES * 64;
    for (size_t c = gt; c < (size_t)T * 128; c += NGT) { float h = 0.f;
#pragma unroll
        for (int s = 0; s < 8; ++s) h += HP[(size_t)s * T * 128 + c];
        h *= pg8::row_rstd(ss_in, (int)(c >> 7)) * (1.0f / 1024.0f);
        A[c] = (1.0f / 1024.0f) * GATE[c] * (0.5f * h * (1.f + erff(h * 0.70710678118654752f))); }
}
DI void final_phase(const float* ss, float* xf, const float* fin_g, int vcu, int G, int wave, int lane) {
    for (int m = vcu * NWAVES + wave; m < T; m += G * NWAVES) { const float rf = pg8::row_rstd(ss, m);
        f32x4* xr = (f32x4*)(xf + (size_t)m * D) + lane;
#pragma unroll
        for (int j = 0; j < 4; ++j) xr[64 * j] = xr[64 * j] * rf * *((const f32x4*)fin_g + lane + 64 * j); }
}

DI int t5_bucket(int rel) {
    const int n = rel < 0 ? -rel : rel; int b;
    if (n < 8) b = n; else if (n < 12) b = 8; else if (n < 16) b = 9; else if (n < 23) b = 10; else if (n < 32) b = 11; else if (n < 46) b = 12; else if (n < 64) b = 13; else if (n < 91) b = 14; else b = 15;
    return b + (rel > 0 ? 16 : 0);
}
DI int crow(int reg, int h) { return (reg & 3) + 8 * (reg >> 2) + 4 * h; }
constexpr int AT_KL = 0, AT_KSTR = 144, AT_VT = 384 * AT_KSTR  , AT_VSTR = 776, AT_BT = AT_VT + 64 * AT_VSTR  , AT_END = AT_BT + 4 * 512 * 4;
static_assert(AT_END <= RING_BYTES, "attention LDS");
DI void attn_phase(const bf16* Qg, const bf16* Kg, const bf16* Vg, bf16* AO, const float* rel_bias, const float* sink, LAS unsigned char* lds, int vcu, int G, int wave, int lane, int tid) {
    const int r = lane & 31, h = lane >> 5;
    for (int unit = vcu; unit < BATCH * 4 * (SEQ / 128); unit += G) {
        const int b = unit / 256, kvh = (unit % 256) / 64, blk = unit % 64;
        __syncthreads();
        for (int c = tid; c < 384 * 8; c += NWAVES * 64) { const int row = c >> 3, c8 = c & 7, ts = blk * 128 - 128 + row;
            v4u kv = {0u, 0u, 0u, 0u}, vv = {0u, 0u, 0u, 0u};
            if (ts >= 0 && ts < SEQ) { const size_t g = (size_t)(b * SEQ + ts) * 256 + kvh * 64 + c8 * 8; kv = *(const v4u*)(Kg + g); vv = *(const v4u*)(Vg + g); }
            *(LAS v4u*)(lds + AT_KL + row * AT_KSTR + c8 * 16) = kv;
            LAS unsigned short* vt = (LAS unsigned short*)(lds + AT_VT) + (c8 * 8) * (AT_VSTR / 2) + row;
            vt[0 * (AT_VSTR / 2)] = (unsigned short)(vv.x & 0xffffu); vt[1 * (AT_VSTR / 2)] = (unsigned short)(vv.x >> 16);
            vt[2 * (AT_VSTR / 2)] = (unsigned short)(vv.y & 0xffffu); vt[3 * (AT_VSTR / 2)] = (unsigned short)(vv.y >> 16);
            vt[4 * (AT_VSTR / 2)] = (unsigned short)(vv.z & 0xffffu); vt[5 * (AT_VSTR / 2)] = (unsigned short)(vv.z >> 16);
            vt[6 * (AT_VSTR / 2)] = (unsigned short)(vv.w & 0xffffu); vt[7 * (AT_VSTR / 2)] = (unsigned short)(vv.w >> 16); }
        for (int c = tid; c < 4 * 512; c += NWAVES * 64) { const int g = c >> 9, i = c & 511, rel = i - 255;
            float v = NEGBIG; if (rel >= -128 && rel <= 128) v = rel_bias[t5_bucket(rel) * 16 + kvh * 4 + g] * LOG2E;
            *(LAS float*)(lds + AT_BT + c * 4) = v; }
        __syncthreads();
        const int g = wave >> 1, qh = wave & 1, head = kvh * 4 + g;
        const float sinkl = sink[head] * LOG2E;
        bf16x8 qf[2][4];
#pragma unroll
        for (int qt = 0; qt < 2; ++qt)
#pragma unroll
            for (int s = 0; s < 4; ++s) qf[qt][s] = *(const bf16x8*)(Qg + (size_t)(b * SEQ + blk * 128 + qh * 64 + qt * 32 + r) * D + head * 64 + s * 16 + h * 8);
        float m[2] = {sinkl, sinkl}, l[2] = {0.f, 0.f};
        f32x16 o[2][2];
#pragma unroll
        for (int qt = 0; qt < 2; ++qt)
#pragma unroll
            for (int dt = 0; dt < 2; ++dt)
#pragma unroll
                for (int i = 0; i < 16; ++i) o[qt][dt][i] = 0.f;
        int kt_lo = 2 * qh, kt_hi = 2 * qh + 9;
        if (blk == 0 && kt_lo < 4) kt_lo = 4;
        if (blk == SEQ / 128 - 1 && kt_hi > 7) kt_hi = 7;
#pragma unroll 1
        for (int kt = kt_lo; kt <= kt_hi; ++kt) {
            bf16x8 kf[4];
#pragma unroll
            for (int s = 0; s < 4; ++s) kf[s] = *(const LAS bf16x8*)(lds + AT_KL + (32 * kt + r) * AT_KSTR + s * 32 + h * 16);
            bf16x8 vf[2][2];
#pragma unroll
            for (int dt = 0; dt < 2; ++dt)
#pragma unroll
                for (int s2 = 0; s2 < 2; ++s2) { const LAS unsigned char* vp = lds + AT_VT + (32 * dt + r) * AT_VSTR + (32 * kt + 16 * s2 + 4 * h) * 2;
                    const v2u lo = *(const LAS v2u*)vp, hi2 = *(const LAS v2u*)(vp + 16); v4u w = {lo.x, lo.y, hi2.x, hi2.y}; vf[dt][s2] = __builtin_bit_cast(bf16x8, w); }
#pragma unroll
            for (int qt = 0; qt < 2; ++qt) {
                f32x16 s;
                const LAS float* bt = (const LAS float*)(lds + AT_BT) + g * 512 + 127 + 32 * kt + 4 * h - (64 * qh + 32 * qt + r);
#pragma unroll
                for (int i = 0; i < 16; ++i) s[i] = bt[(i & 3) + 8 * (i >> 2)];
#pragma unroll
                for (int k4 = 0; k4 < 4; ++k4) s = __builtin_amdgcn_mfma_f32_32x32x16_bf16(kf[k4], qf[qt][k4], s, 0, 0, 0);
                float mx = s[0];
#pragma unroll
                for (int i = 1; i < 16; ++i) mx = fmaxf(mx, s[i]);
                mx = fmaxf(mx, __shfl_xor(mx, 32));
                const float mn = fmaxf(m[qt], mx), al = __builtin_amdgcn_exp2f(m[qt] - mn); m[qt] = mn;
                float ps = 0.f;
#pragma unroll
                for (int i = 0; i < 16; ++i) { s[i] = __builtin_amdgcn_exp2f(s[i] - mn); ps += s[i]; }
                l[qt] = l[qt] * al + ps;
#pragma unroll
                for (int dt = 0; dt < 2; ++dt)
#pragma unroll
                    for (int i = 0; i < 16; ++i) o[qt][dt][i] *= al;
                bf16x8 pf[2];
#pragma unroll
                for (int s2 = 0; s2 < 2; ++s2) { v4u w; w.x = pk2(s[8 * s2 + 0], s[8 * s2 + 1]); w.y = pk2(s[8 * s2 + 2], s[8 * s2 + 3]); w.z = pk2(s[8 * s2 + 4], s[8 * s2 + 5]); w.w = pk2(s[8 * s2 + 6], s[8 * s2 + 7]); pf[s2] = __builtin_bit_cast(bf16x8, w); }
#pragma unroll
                for (int dt = 0; dt < 2; ++dt)
#pragma unroll
                    for (int s2 = 0; s2 < 2; ++s2) o[qt][dt] = __builtin_amdgcn_mfma_f32_32x32x16_bf16(vf[dt][s2], pf[s2], o[qt][dt], 0, 0, 0);
            }
        }
#pragma unroll
        for (int qt = 0; qt < 2; ++qt) {
            const float lt = l[qt] + __shfl_xor(l[qt], 32) + __builtin_amdgcn_exp2f(sinkl - m[qt]), inv = 1.0f / lt;
            bf16* op = AO + (size_t)(b * SEQ + blk * 128 + qh * 64 + qt * 32 + r) * D + head * 64 + 4 * h;
#pragma unroll
            for (int dt = 0; dt < 2; ++dt)
#pragma unroll
                for (int gq = 0; gq < 4; ++gq) { v2u w; w.x = pk2(o[qt][dt][4 * gq] * inv, o[qt][dt][4 * gq + 1] * inv); w.y = pk2(o[qt][dt][4 * gq + 2] * inv, o[qt][dt][4 * gq + 3] * inv);
                    *(v2u*)(op + 32 * dt + 8 * gq) = w; }
        }
    }
}

struct Args { const float* in[16]; float* out; unsigned char* ws; int ph_lo, ph_hi; };
__global__ void __launch_bounds__(NWAVES * 64, 2) fwd_kernel(Args args) {
    extern __shared__ __attribute__((aligned(16))) unsigned char lds_raw[];
    LAS unsigned char* lds = (LAS unsigned char*)lds_raw;
    volatile LAS unsigned* MISC = (volatile LAS unsigned*)(lds + MISC_OFF);
    const int tid = threadIdx.x, lane = tid & 63, wave = __builtin_amdgcn_readfirstlane(tid >> 6);
    const int G = gridDim.x; const int bx = blockIdx.x; const int vcu = (G % 8 == 0) ? (bx % 8) * (G / 8) + bx / 8 : bx;
    unsigned char* ws = args.ws;
    unsigned* ctl = (unsigned*)(ws + WS_CTL);
    const float* x = args.in[0]; const float* conv_g = args.in[1]; const float* w_in = args.in[2]; const float* conv_w = args.in[3]; const float* w_out = args.in[4];
    const float* attn_g = args.in[5]; const float* w_qkv = args.in[6]; const float* sink = args.in[7]; const float* w_o = args.in[8]; const float* rel_bias = args.in[9];
    const float* ffn_g = args.in[10]; const float* w_pq = args.in[11]; const float* subk = args.in[12]; const float* pu = args.in[13]; const float* pv = args.in[14]; const float* fin_g = args.in[15];
    float* out = args.out;
    bf16* WinT = (bf16*)(ws + WS_WIN); bf16* WoutT = (bf16*)(ws + WS_WOUT); bf16* WqkvT = (bf16*)(ws + WS_WQKV); bf16* WoT = (bf16*)(ws + WS_WO); bf16* WpqT = (bf16*)(ws + WS_WPQ); bf16* SKb = (bf16*)(ws + WS_SK);
    float* SS = (float*)(ws + WS_SS); unsigned short* IDX = (unsigned short*)(ws + WS_IDX); float* HP = (float*)(ws + WS_HP); float* AA = (float*)(ws + WS_A); float* GATE = (float*)(ws + WS_GATE);
    bf16* XB = (bf16*)(ws + WS_XB); bf16* Y = (bf16*)(ws + WS_Y); unsigned char* U8 = ws + WS_U; unsigned char* V8 = ws + WS_V;
    bf16* G1 = (bf16*)(ws + WS_G1); bf16* PQ = (bf16*)(ws + WS_PQ); bf16* Qb = (bf16*)(ws + WS_Q); bf16* Kb = (bf16*)(ws + WS_K); bf16* VVb = (bf16*)(ws + WS_VV); bf16* AO = (bf16*)(ws + WS_AO);
    float* SS0 = SS; float* SS1 = SS + (size_t)T * 16; float* SS2 = SS + (size_t)2 * T * 16; float* SS3 = SS + (size_t)3 * T * 16; float* SS4 = SS + (size_t)4 * T * 16;

    for (int u = tid; u < (LDS_BYTES - LDSCTL_OFF) / 4; u += NWAVES * 64) ((LAS unsigned*)(lds + LDSCTL_OFF))[u] = 0u;
    __syncthreads();
    XcdBarrier bar; bar.bar = ctl + CW_BAR; bar.x = 0; bar.st = nullptr;
    if (!MK_PER_PHASE) bar = xcd_barrier_post(ctl + CW_BAR, MISC + 8);
    const int lo = args.ph_lo, hi = args.ph_hi;
#define IN(k) (lo <= (k) && (k) < hi)
#define SEAM(k) do { if (IN(k) && IN((k) + 1)) xcd_barrier(bar); } while (0)

    if (IN(0)) REPS(0) {
        P0Args a{x, conv_g, w_in, w_out, attn_g, w_qkv, w_o, ffn_g, w_pq, subk, pu, pv, WinT, WoutT, WqkvT, WoT, WpqT, SKb, U8, V8, XB, SS0};
        p0_prologue(a, lds, vcu, G, wave, lane, tid);
    }
    SEAM(0);
    if (IN(1)) REPS(1) {
        pg8::Gemm g{XB, WinT, T, NIN, D}; pg8::StaticOrder S; S.init(T, NIN, G, bx);
        pg8::EpiBf16RS E{G1, NIN, NIN / 256, nullptr, nullptr, 0, SS0};
        pg8::gemm_phase<pg8::EpiBf16RS, pg8::StaticOrder, true, true>(lds, g, S, E);
    }
    SEAM(1);
    if (IN(2)) REPS(2) conv_gate_phase(G1, conv_w, Y, vcu, G, tid);
    SEAM(2);
    if (IN(3)) REPS(3) {
        pg8::Gemm g{Y, WoutT, T, D, D}; pg8::StaticOrder S; S.init(T, D, G, bx);
        pg8::EpiResid E{x, out, XB, SS1};
        pg8::gemm_phase<pg8::EpiResid, pg8::StaticOrder, true, true>(lds, g, S, E);
    }
    SEAM(3);
    if (IN(4)) REPS(4) {
        pg8::Gemm g{XB, WpqT, T, NPQ, D}; pg8::StaticOrder S; S.init(T, NPQ, G, bx);
        pg8::EpiBf16RS E{PQ, NPQ, NPQ / 256, nullptr, nullptr, 0, SS1};
        pg8::gemm_phase<pg8::EpiBf16RS, pg8::StaticOrder, true, true>(lds, g, S, E);
    }
    SEAM(4);
    if (IN(5)) REPS(5) route_phase(PQ, SKb, IDX, GATE, lds, vcu, G, wave, lane, tid);
    SEAM(5);
    if (IN(6)) sliced_pass<0, false>(U8, IDX, XB, XB, HP, AA, out, SS2, ctl + CW_WQ + 64 * 0, MISC + 12, wave, lane, tid);
    SEAM(6);
    if (IN(7)) reduce_phase(HP, GATE, SS1, AA, vcu, G, tid);
    SEAM(7);
    if (IN(8)) sliced_pass<1, false>(V8, IDX, XB, XB, HP, AA, out, SS2, ctl + CW_WQ + 64 * 8, MISC + 12, wave, lane, tid);
    SEAM(8);
    if (IN(9)) REPS(9) {
        pg8::Gemm g{XB, WqkvT, T, NQKV, D}; pg8::StaticOrder S; S.init(T, NQKV, G, bx);
        pg8::EpiBf16RS E{Qb, D, 4, Kb, VVb, 256, SS2};
        pg8::gemm_phase<pg8::EpiBf16RS, pg8::StaticOrder, true, true>(lds, g, S, E);
    }
    SEAM(9);
    if (IN(10)) REPS(10) attn_phase(Qb, Kb, VVb, AO, rel_bias, sink, lds, vcu, G, wave, lane, tid);
    SEAM(10);
    if (IN(11)) {
        pg8::Gemm g{AO, WoT, T, D, D}; pg8::StaticOrder S; S.init(T, D, G, bx);
        pg8::EpiResid E{out, out, XB, SS3};
        pg8::gemm_phase<pg8::EpiResid, pg8::StaticOrder, true, true>(lds, g, S, E);
    }
    SEAM(11);
    if (IN(12)) REPS(12) {
        pg8::Gemm g{XB, WpqT + (size_t)NPQ * D, T, NPQ, D}; pg8::StaticOrder S; S.init(T, NPQ, G, bx);
        pg8::EpiBf16RS E{PQ, NPQ, NPQ / 256, nullptr, nullptr, 0, SS3};
        pg8::gemm_phase<pg8::EpiBf16RS, pg8::StaticOrder, true, true>(lds, g, S, E);
    }
    SEAM(12);
    if (IN(13)) REPS(13) route_phase(PQ, SKb + (size_t)8 * 2 * 128 * 128, IDX, GATE, lds, vcu, G, wave, lane, tid);
    SEAM(13);
    if (IN(14)) sliced_pass<0, true>(U8 + (size_t)NEXP * D, IDX, XB, XB, HP, AA, out, SS4, ctl + CW_WQ + 64 * 16, MISC + 12, wave, lane, tid);
    SEAM(14);
    if (IN(15)) reduce_phase(HP, GATE, SS3, AA, vcu, G, tid);
    SEAM(15);
    if (IN(16)) sliced_pass<1, true>(V8 + (size_t)NEXP * D, IDX, XB, XB, HP, AA, out, SS4, ctl + CW_WQ + 64 * 24, MISC + 12, wave, lane, tid);
    SEAM(16);
    if (IN(17)) final_phase(SS4, out, fin_g, vcu, G, wave, lane);
#undef IN
#undef SEAM
}

extern "C" void kernel_launch(void* const* d_in, const int* in_sizes, int n_in, void* d_out, int out_size, void* d_ws, size_t ws_size, hipStream_t stream) {
    static int grid = 0;
    if (grid == 0) {
        if (n_in != 16 || in_sizes[0] != T * D || out_size != T * D || ws_size < WS_END) { fprintf(stderr, "kernel_launch: unexpected shapes (n_in %d, in0 %d, out %d, ws %zu)\n", n_in, n_in > 0 ? in_sizes[0] : -1, out_size, ws_size); grid = -1; return; }
        int dev = 0, cus = 0, per_cu = 0;
        if (hipGetDevice(&dev) != hipSuccess || hipDeviceGetAttribute(&cus, hipDeviceAttributeMultiprocessorCount, dev) != hipSuccess) { grid = -1; return; }
        if (hipFuncSetAttribute((const void*)fwd_kernel, hipFuncAttributeMaxDynamicSharedMemorySize, LDS_BYTES) != hipSuccess) { fprintf(stderr, "kernel_launch: hipFuncSetAttribute failed\n"); grid = -1; return; }
        if (hipOccupancyMaxActiveBlocksPerMultiprocessor(&per_cu, (const void*)fwd_kernel, NWAVES * 64, LDS_BYTES) != hipSuccess || per_cu < 1) { fprintf(stderr, "kernel_launch: occupancy query says %d blocks per CU\n", per_cu); (void)hipGetLastError(); grid = -1; return; }
        grid = cus;
    }
    if (grid < 0) return;
    (void)hipMemsetAsync((char*)d_ws + WS_CTL, 0, CTL_ZERO_BYTES, stream);
    Args a{};
    for (int i = 0; i < 16; ++i) a.in[i] = (const float*)d_in[i];
    a.out = (float*)d_out; a.ws = (unsigned char*)d_ws;
#if MK_PER_PHASE
    for (int p = 0; p < NPH; ++p) { a.ph_lo = p; a.ph_hi = p + 1; hipLaunchKernelGGL(fwd_kernel, dim3(grid), dim3(NWAVES * 64), LDS_BYTES, stream, a); }
#else
    a.ph_lo = 0; a.ph_hi = NPH;
    hipLaunchKernelGGL(fwd_kernel, dim3(grid), dim3(NWAVES * 64), LDS_BYTES, stream, a);
#endif
}
```

```cpp
#include <hip/hip_runtime.h>
#include <cstdio>
#include <cstdint>
namespace pg8 {
#define PG8_LAS __attribute__((address_space(3)))
typedef unsigned short bf16_t;
typedef short bf16x8 __attribute__((ext_vector_type(8)));
typedef float f32x4 __attribute__((ext_vector_type(4)));
typedef unsigned u32x4 __attribute__((ext_vector_type(4)));
constexpr int BM = 256, BK = 64, HALF = 128, HTB = HALF * BK * 2  , STAGE_BYTES = 8 * HTB, NXCD = 8, WGM = 8;

__host__ __device__ __forceinline__ int lds_byte(int r, int c) { const int st = (r >> 4) * 2 + (c >> 5), rr = r & 15, cc = c & 31, ob = rr * 64 + cc * 2; return st * 1024 + (ob ^ (((ob >> 9) & 1) << 5)); }
__host__ __device__ __forceinline__ void stage_rc(int b, int& R, int& C) { const int st = b / 1024, sb = b % 1024, swz = sb ^ (((sb >> 9) & 1) << 5); R = (st >> 1) * 16 + swz / 64; C = (st & 1) * 32 + (swz % 64) / 2; }
__host__ __device__ __forceinline__ int perm32(int rho) { const int n = rho >> 4, i = rho & 15; return 8 * (i >> 2) + 4 * n + (i & 3); }

struct Unit { int pm, pn; };
struct Gemm { const bf16_t* A; const bf16_t* Bt; int M, N, K; };

struct StaticOrder {
    int nM, nN, nwg, G, c;
    __host__ __device__ void init(int M, int N, int G_, int c_) { nM = M / BM; nN = N / BM; nwg = nM * nN; G = G_; c = c_; }
    __host__ __device__ bool next(int i, Unit& u) const {
        const long L = (long)i * G + c; if (L >= nwg) return false;
        int wgid = (int)L; { const int q = nwg / NXCD, r = nwg % NXCD, xcd = wgid % NXCD, off = wgid / NXCD; wgid = (xcd < r ? xcd * (q + 1) : r * (q + 1) + (xcd - r) * q) + off; }
        const int nig = WGM * nN, gid = wgid / nig, fm = gid * WGM, gsz = (nM - fm) < WGM ? (nM - fm) : WGM;
        u.pm = fm + ((wgid % nig) % gsz); u.pn = (wgid % nig) / gsz; return true;
    }
    __device__ __forceinline__ void a_ready(const Unit&) const {}
    __device__ __forceinline__ void done(const Unit&) const {}
};

__device__ __forceinline__ unsigned cvt_pk_bf16(float lo, float hi) { unsigned r; asm volatile("v_cvt_pk_bf16_f32 %0, %1, %2" : "=v"(r) : "v"(lo), "v"(hi)); return r; }
typedef unsigned u32x2 __attribute__((ext_vector_type(2)));
__device__ __forceinline__ float row_rstd(const float* ss, int row) {
    const f32x4* p = (const f32x4*)(ss + (size_t)row * 16);
    const f32x4 a = p[0], b = p[1], c = p[2], d = p[3];
    const float s = (((a[0] + a[1]) + (a[2] + a[3])) + ((b[0] + b[1]) + (b[2] + b[3]))) + (((c[0] + c[1]) + (c[2] + c[3])) + ((d[0] + d[1]) + (d[2] + d[3])));
    return __builtin_amdgcn_rsqf(s * (1.0f / 1024.0f) + 1e-6f);
}
struct EpiBf16RS {
    static constexpr bool PERM = true, AFTER_DRAIN = false;
    bf16_t* O0; int ld0; int nt0; bf16_t* O1; bf16_t* O2; int ld1; const float* ss;
    __device__ __forceinline__ void operator()(const f32x4 (&acc)[2][2][4][2], const Unit& u, int wr, int wc, int fr, int fq) const {
        bf16_t* base; int ld, colt;
        if (u.pn < nt0) { base = O0; ld = ld0; colt = u.pn * BM; } else if (u.pn == nt0) { base = O1; ld = ld1; colt = 0; } else { base = O2; ld = ld1; colt = (u.pn - nt0 - 1) * BM; }
        const int row0 = u.pm * BM + wr * 64 + fr, col0 = colt + wc * 32 + 8 * fq;
#pragma unroll
        for (int ai = 0; ai < 2; ++ai)
#pragma unroll
            for (int m = 0; m < 4; ++m) { const int row = row0 + ai * HALF + m * 16; const float rs = row_rstd(ss, row); bf16_t* rowp = base + (size_t)row * ld + col0;
#pragma unroll
                for (int bj = 0; bj < 2; ++bj) { const f32x4 v0 = acc[ai][bj][m][0] * rs, v1 = acc[ai][bj][m][1] * rs;
                    u32x4 w; w.x = cvt_pk_bf16(v0[0], v0[1]); w.y = cvt_pk_bf16(v0[2], v0[3]); w.z = cvt_pk_bf16(v1[0], v1[1]); w.w = cvt_pk_bf16(v1[2], v1[3]);
                    *(u32x4*)(rowp + bj * HALF) = w; } }
    }
};
struct EpiResid {
    static constexpr bool PERM = false, AFTER_DRAIN = false;
    const float* base; float* out; bf16_t* xb; float* ss;
    __device__ __forceinline__ void operator()(const f32x4 (&acc)[2][2][4][2], const Unit& u, int wr, int wc, int fr, int fq) const {
        const int row0 = u.pm * BM + wr * 64 + fr, col0 = u.pn * BM + wc * 32 + 4 * fq;
#pragma unroll
        for (int ai = 0; ai < 2; ++ai)
#pragma unroll
            for (int m = 0; m < 4; ++m) { const int row = row0 + ai * HALF + m * 16; float sq = 0.f;
#pragma unroll
                for (int bj = 0; bj < 2; ++bj)
#pragma unroll
                    for (int n = 0; n < 2; ++n) { const size_t off = (size_t)row * 1024 + col0 + bj * HALF + n * 16;
                        const f32x4 o = *(const f32x4*)(base + off) + acc[ai][bj][m][n];
                        *(f32x4*)(out + off) = o; sq += (o[0] * o[0] + o[1] * o[1]) + (o[2] * o[2] + o[3] * o[3]);
                        u32x2 w; w.x = cvt_pk_bf16(o[0], o[1]); w.y = cvt_pk_bf16(o[2], o[3]); *(u32x2*)(xb + off) = w; }
                sq += __shfl_xor(sq, 16); sq += __shfl_xor(sq, 32);
                if (fq == 0) ss[(size_t)row * 16 + u.pn * 4 + wc] = sq; }
    }
};

template <class Epi, class Sched, bool ALIGN_EPI = false, bool SP2 = false>
__device__ __forceinline__ void gemm_phase(PG8_LAS unsigned char* lds, const Gemm g, const Sched& S, const Epi& E) {
    const int tid = threadIdx.x, wid = __builtin_amdgcn_readfirstlane(tid >> 6), lane = tid & 63, wr = wid >> 2, wc = wid & 3, fr = lane & 15, fq = lane >> 4;
    const int K = g.K, nt = K / BK;
    unsigned voffA[2], voffB[2];
#pragma unroll
    for (int i = 0; i < 2; ++i) { int R, C; stage_rc(tid * 16 + i * 8192, R, C); const int Rb = Epi::PERM ? ((R & ~31) + perm32(R & 31)) : R;
        voffA[i] = (unsigned)(R * K + C) * 2u; voffB[i] = (unsigned)(Rb * K + C) * 2u; }
    const size_t kstep = (size_t)(BK * 2);
    const size_t hstep = (size_t)HALF * K * 2;
    const size_t tstep = 2 * hstep;
    const unsigned ldsw = (unsigned)wid * 1024u;
    const int aoff = lds_byte(wr * 64 + fr, fq * 8), boff = lds_byte(wc * 32 + fr, fq * 8);
#define PG8_SA(b, h) (((b) * 2 + (h)) * HTB)
#define PG8_SB(b, h) ((4 + (b) * 2 + (h)) * HTB)
#define PG8_STAGE(bufoff, gbase, voff) do { _Pragma("unroll") for (int _i = 0; _i < 2; ++_i) \
        __builtin_amdgcn_global_load_lds((const unsigned*)((const char*)(gbase) + (voff)[_i]), (PG8_LAS unsigned*)(lds + (bufoff) + ldsw + _i * 8192), 16, 0, 0); } while (0)
#define PG8_LDA(dst, b, h) do { _Pragma("unroll") for (int m = 0; m < 4; ++m) _Pragma("unroll") for (int k = 0; k < 2; ++k) dst[m][k] = *(const PG8_LAS bf16x8*)(lds + PG8_SA(b, h) + aoff + m * 2048 + k * 1024); } while (0)
#define PG8_LDB(dst, b, h) do { _Pragma("unroll") for (int n = 0; n < 2; ++n) _Pragma("unroll") for (int k = 0; k < 2; ++k) dst[n][k] = *(const PG8_LAS bf16x8*)(lds + PG8_SB(b, h) + boff + n * 2048 + k * 1024); } while (0)
#define PG8_MMA(ai, bj, At, Bt) do { __builtin_amdgcn_s_setprio(1); _Pragma("unroll") for (int m = 0; m < 4; ++m) _Pragma("unroll") for (int n = 0; n < 2; ++n) _Pragma("unroll") for (int k = 0; k < 2; ++k) \
        acc[ai][bj][m][n] = __builtin_amdgcn_mfma_f32_16x16x32_bf16(Bt[n][k], At[m][k], acc[ai][bj][m][n], 0, 0, 0); __builtin_amdgcn_s_setprio(0); } while (0)
#define PG8_WAIT_V(n) asm volatile("s_waitcnt vmcnt(" #n ")" ::: "memory")
#define PG8_WAIT_L(n) asm volatile("s_waitcnt lgkmcnt(" #n ")" ::: "memory")
#define PG8_BAR __builtin_amdgcn_s_barrier()
#define PG8_SCHED __builtin_amdgcn_sched_barrier(0)
    Unit cur, nxt; int ui = 0;
    if (!S.next(0, cur)) return;
    f32x4 acc[2][2][4][2];
#pragma unroll
    for (int a = 0; a < 2; ++a)
#pragma unroll
        for (int b = 0; b < 2; ++b)
#pragma unroll
            for (int m = 0; m < 4; ++m)
#pragma unroll
                for (int n = 0; n < 2; ++n) acc[a][b][m][n] = (f32x4){0.f, 0.f, 0.f, 0.f};
    bf16x8 At[4][2], B0[2][2], B1[2][2];
    const char* cA = (const char*)g.A + (size_t)cur.pm * tstep; const char* cB = (const char*)g.Bt + (size_t)cur.pn * tstep;
    S.a_ready(cur);
    if constexpr (SP2) {
        PG8_STAGE(PG8_SB(0, 0), cB, voffB); PG8_STAGE(PG8_SB(0, 1), cB + hstep, voffB); PG8_STAGE(PG8_SA(0, 0), cA, voffA); PG8_STAGE(PG8_SA(0, 1), cA + hstep, voffA);
        if (wr == 1) PG8_BAR;
        PG8_WAIT_V(2); PG8_BAR;
        PG8_STAGE(PG8_SB(1, 0), cB + kstep, voffB); PG8_STAGE(PG8_SA(1, 0), cA + kstep, voffA); PG8_STAGE(PG8_SB(1, 1), cB + hstep + kstep, voffB);
        PG8_WAIT_V(6); PG8_BAR;
    } else {
        PG8_STAGE(PG8_SB(0, 0), cB, voffB); PG8_STAGE(PG8_SA(0, 0), cA, voffA); PG8_STAGE(PG8_SB(0, 1), cB + hstep, voffB); PG8_STAGE(PG8_SA(0, 1), cA + hstep, voffA);
        if (wr == 1) PG8_BAR;
        PG8_WAIT_V(4); PG8_BAR;
        PG8_STAGE(PG8_SB(1, 0), cB + kstep, voffB); PG8_STAGE(PG8_SA(1, 0), cA + kstep, voffA); PG8_STAGE(PG8_SB(1, 1), cB + hstep + kstep, voffB);
        PG8_WAIT_V(6); PG8_BAR;
    }
    for (;;) {
        const bool has_next = S.next(ui + 1, nxt);
        const char* nA = has_next ? (const char*)g.A + (size_t)nxt.pm * tstep : cA; const char* nB = has_next ? (const char*)g.Bt + (size_t)nxt.pn * tstep : cB;
        for (int t = 0; t < nt; t += 2) {
            const bool last = (t == nt - 2);
            const char* a1 = cA + (size_t)(t + 1) * kstep;
            const char* a2 = last ? nA : cA + (size_t)(t + 2) * kstep; const char* b2 = last ? nB : cB + (size_t)(t + 2) * kstep;
            const char* a3 = a2 + kstep; const char* b3 = b2 + kstep;
            if (last && has_next) S.a_ready(nxt);
            if constexpr (SP2) {
            PG8_LDB(B0, 0, 0); PG8_LDB(B1, 0, 1); PG8_SCHED; PG8_LDA(At, 0, 0); PG8_STAGE(PG8_SA(1, 1), a1 + hstep, voffA);
            PG8_WAIT_V(8); PG8_WAIT_L(0); PG8_BAR; PG8_MMA(0, 0, At, B0); PG8_MMA(0, 1, At, B1); PG8_BAR; PG8_SCHED;
            PG8_LDA(At, 0, 1); PG8_STAGE(PG8_SB(0, 0), b2, voffB); PG8_STAGE(PG8_SB(0, 1), b2 + hstep, voffB); PG8_STAGE(PG8_SA(0, 0), a2, voffA);
            PG8_WAIT_V(8); PG8_WAIT_L(0); PG8_BAR; PG8_MMA(1, 0, At, B0); PG8_MMA(1, 1, At, B1); PG8_BAR; PG8_SCHED;
            PG8_LDB(B0, 1, 0); PG8_LDB(B1, 1, 1); PG8_SCHED; PG8_LDA(At, 1, 0); PG8_STAGE(PG8_SA(0, 1), a2 + hstep, voffA);
            PG8_WAIT_V(8); PG8_WAIT_L(0); PG8_BAR; PG8_MMA(0, 0, At, B0); PG8_MMA(0, 1, At, B1); PG8_BAR; PG8_SCHED;
            PG8_LDA(At, 1, 1); PG8_STAGE(PG8_SB(1, 0), b3, voffB); PG8_STAGE(PG8_SB(1, 1), b3 + hstep, voffB); PG8_STAGE(PG8_SA(1, 0), a3, voffA);
            PG8_WAIT_V(8); PG8_WAIT_L(0); PG8_BAR; PG8_MMA(1, 0, At, B0); PG8_MMA(1, 1, At, B1); PG8_BAR; PG8_SCHED;
            } else {
            PG8_LDB(B0, 0, 0); PG8_SCHED; PG8_LDA(At, 0, 0); PG8_STAGE(PG8_SA(1, 1), a1 + hstep, voffA);
            PG8_WAIT_L(8); PG8_BAR; PG8_WAIT_L(0); PG8_MMA(0, 0, At, B0); PG8_BAR; PG8_SCHED;
            PG8_LDB(B1, 0, 1); PG8_STAGE(PG8_SB(0, 0), b2, voffB);
            PG8_BAR; PG8_WAIT_L(0); PG8_MMA(0, 1, At, B1); PG8_BAR;
            PG8_LDA(At, 0, 1); PG8_STAGE(PG8_SA(0, 0), a2, voffA);
            PG8_BAR; PG8_WAIT_L(0); PG8_MMA(1, 0, At, B0); PG8_BAR; PG8_SCHED;
            PG8_STAGE(PG8_SB(0, 1), b2 + hstep, voffB);
            PG8_WAIT_V(6); PG8_BAR; PG8_MMA(1, 1, At, B1); PG8_BAR;
            PG8_LDB(B0, 1, 0); PG8_SCHED; PG8_LDA(At, 1, 0); PG8_STAGE(PG8_SA(0, 1), a2 + hstep, voffA);
            PG8_WAIT_L(8); PG8_BAR; PG8_WAIT_L(0); PG8_MMA(0, 0, At, B0); PG8_BAR; PG8_SCHED;
            PG8_LDB(B1, 1, 1); PG8_STAGE(PG8_SB(1, 0), b3, voffB);
            PG8_BAR; PG8_WAIT_L(0); PG8_MMA(0, 1, At, B1); PG8_BAR;
            PG8_LDA(At, 1, 1); PG8_STAGE(PG8_SA(1, 0), a3, voffA);
            PG8_BAR; PG8_WAIT_L(0); PG8_MMA(1, 0, At, B0); PG8_BAR; PG8_SCHED;
            PG8_STAGE(PG8_SB(1, 1), b3 + hstep, voffB);
            PG8_WAIT_V(6); PG8_BAR; PG8_MMA(1, 1, At, B1); PG8_BAR;
            }
        }
        if constexpr (ALIGN_EPI) { if (wr == 0) PG8_BAR; }
        if constexpr (!Epi::AFTER_DRAIN) { E(acc, cur, wr, wc, fr, fq); S.done(cur); }
        if (!has_next) break;
#pragma unroll
        for (int a = 0; a < 2; ++a)
#pragma unroll
            for (int b = 0; b < 2; ++b)
#pragma unroll
                for (int m = 0; m < 4; ++m)
#pragma unroll
                    for (int n = 0; n < 2; ++n) acc[a][b][m][n] = (f32x4){0.f, 0.f, 0.f, 0.f};
        cur = nxt; cA = nA; cB = nB; ++ui;
        if constexpr (ALIGN_EPI) { if (wr == 1) PG8_BAR; }
    }
    PG8_WAIT_V(0);
    if constexpr (!ALIGN_EPI) { if (wr == 0) PG8_BAR; }
    PG8_BAR;
    if constexpr (Epi::AFTER_DRAIN) { E.fused(acc, cur, wr, wc, fr, fq, lds, wid, lane); S.done(cur); }
#undef PG8_SA
#undef PG8_SB
#undef PG8_STAGE
#undef PG8_LDA
#undef PG8_LDB
#undef PG8_MMA
#undef PG8_WAIT_V
#undef PG8_WAIT_L
#undef PG8_BAR
#undef PG8_SCHED
}
}

constexpr int NWAVES = 8;
constexpr int BATCH = 2, SEQ = 8192, D = 1024, T = BATCH * SEQ;
constexpr int NIN = 3072, NQKV = 1536, NPQ = 2048, NEXP = 16384;
constexpr float LOG2E = 1.4426950408889634f;
constexpr float QSCALE = 0.125f * LOG2E;
constexpr float NEGBIG = -1e30f;
#ifndef MK_PER_PHASE
#define MK_PER_PHASE 0
#endif
constexpr int NPH = 18;
#ifndef REP_MASK
#define REP_MASK 0
#endif
#define REPS(k) for (int rep_ = 0; rep_ < (((REP_MASK) >> (k)) & 1) + 1; ++rep_)

constexpr size_t MiB = 1u << 20;
constexpr size_t WS_CTL = 0, CTL_ZERO_BYTES = 65536;
constexpr size_t WS_WIN = 1 * MiB, WS_WOUT = 7 * MiB, WS_WQKV = 9 * MiB, WS_WO = 12 * MiB, WS_WPQ = 14 * MiB, WS_SK = 22 * MiB;
constexpr size_t WS_SS = 23 * MiB;
constexpr size_t WS_IDX = 28 * MiB, WS_GATE = 36 * MiB, WS_XB = 44 * MiB, WS_Y = 76 * MiB, WS_U = 108 * MiB, WS_V = 172 * MiB;
constexpr size_t WS_G1 = 236 * MiB, WS_PQ = 332 * MiB, WS_Q = 396 * MiB, WS_K = 428 * MiB, WS_VV = 436 * MiB, WS_AO = 444 * MiB, WS_END = 476 * MiB;
constexpr size_t WS_HP = WS_G1, WS_A = WS_G1 + 64 * MiB;
constexpr int CW_BAR = 4096;
constexpr int CW_WQ = 8192;

constexpr int RING_BYTES = 131072;
constexpr int LDSCTL_OFF = RING_BYTES, MISC_OFF = LDSCTL_OFF + 320;
constexpr int LDS_BYTES = 147456;

#define LAS __attribute__((address_space(3)))
typedef unsigned short bf16;
typedef unsigned v4u __attribute__((ext_vector_type(4)));
typedef unsigned v2u __attribute__((ext_vector_type(2)));
typedef float f32x4 __attribute__((ext_vector_type(4)));
typedef float f32x2 __attribute__((ext_vector_type(2)));
typedef float f32x16 __attribute__((ext_vector_type(16)));
typedef short bf16x8 __attribute__((ext_vector_type(8)));
typedef __bf16 bf16x2_t __attribute__((ext_vector_type(2)));
#define LDS_WAIT() asm volatile("s_waitcnt lgkmcnt(0)" ::: "memory")
#define DI __device__ __forceinline__

DI unsigned pk2(float lo, float hi) { f32x2 v = {lo, hi}; bf16x2_t b = __builtin_convertvector(v, bf16x2_t); return __builtin_bit_cast(unsigned, b); }
DI float bf_lo(unsigned u) { return __uint_as_float(u << 16); }
DI float bf_hi(unsigned u) { return __uint_as_float(u & 0xffff0000u); }
DI float wave_sum(float v) {
#pragma unroll
    for (int o = 1; o < 64; o <<= 1) v += __shfl_xor(v, o);
    return v;
}
#define XB_TMO      128
#define XB_XCNT(j)  (256  + 64 * (j))
#define XB_XSUB(j)  (1280 + 64 * (j))
#define XB_XGEN(j)  (2304 + 64 * (j))
#define XB_TOP      3328
#define XB_TOPGEN   3392
#define XCD_BAR_WORDS 3456
#define XB_SPIN_CAP (1u << 18)

__device__ __forceinline__ unsigned xb_ld(unsigned* p)              { return __hip_atomic_load(p, __ATOMIC_RELAXED, __HIP_MEMORY_SCOPE_AGENT); }
__device__ __forceinline__ unsigned xb_add(unsigned* p, unsigned v) { return __hip_atomic_fetch_add(p, v, __ATOMIC_RELAXED, __HIP_MEMORY_SCOPE_AGENT); }
__device__ __forceinline__ unsigned xb_xcc_id() { return (unsigned)__builtin_amdgcn_s_getreg((3 << 11) | 20) & 0xFu; }
#define XB_SPIN(cond, bar) do { unsigned _sp = 0; while (cond) { __builtin_amdgcn_s_sleep(1); \
    if ((++_sp & 255u) == 0u) { if (xb_ld(&(bar)[XB_TMO])) break; if (_sp > XB_SPIN_CAP) { atomicAdd(&(bar)[XB_TMO], 1u); break; } } } } while (0)

struct XcdBarrier {
    unsigned* bar; unsigned x;
    volatile LAS unsigned* st;
};

__device__ __forceinline__ XcdBarrier xcd_barrier_post(unsigned* bar, volatile LAS unsigned* st) {
    XcdBarrier b; b.bar = bar; b.x = xb_xcc_id(); b.st = st;
    if (threadIdx.x == 0) (void)xb_add(&bar[XB_XCNT(b.x)], 1u);
    return b;
}
__device__ __forceinline__ void xcd_barrier_complete(unsigned* bar, unsigned x, unsigned& nloc, unsigned& nx) {
    const unsigned G = gridDim.x * gridDim.y * gridDim.z;
    unsigned sum, cnt, mine, sp = 0u;
    for (;;) {
        sum = 0u; cnt = 0u; mine = 0u;
#pragma unroll
        for (unsigned j = 0; j < 16; ++j) { const unsigned c = xb_ld(&bar[XB_XCNT(j)]); sum += c; cnt += (c > 0u) ? 1u : 0u; mine = (j == x) ? c : mine; }
        if (sum == G) break;
        __builtin_amdgcn_s_sleep(1);
        if ((++sp & 255u) == 0u) { if (xb_ld(&bar[XB_TMO])) break; if (sp > XB_SPIN_CAP) { atomicAdd(&bar[XB_TMO], 1u); break; } }
    }
    nloc = mine > 0u ? mine : 1u; nx = cnt > 0u ? cnt : 1u;
}

__device__ __forceinline__ void xcd_barrier(const XcdBarrier& b) {
    asm volatile("s_waitcnt vmcnt(0)" ::: "memory");
    __syncthreads();
    if (threadIdx.x == 0) {
        unsigned* bar = b.bar;
        __builtin_amdgcn_s_waitcnt(0);
        unsigned nloc = b.st[0], nx = b.st[1];
        if (nloc == 0u) { xcd_barrier_complete(bar, b.x, nloc, nx); b.st[0] = nloc; b.st[1] = nx; }
        const unsigned old = xb_add(&bar[XB_XSUB(b.x)], 1u);
        const unsigned gen = old / nloc;
        if (old + 1u == (gen + 1u) * nloc) {
            __builtin_amdgcn_fence(__ATOMIC_RELEASE, "agent");
            asm volatile("s_waitcnt vmcnt(0)" ::: "memory");
            const unsigned og = xb_add(&bar[XB_TOP], 1u);
            const unsigned tg = og / nx;
            if (og + 1u == (tg + 1u) * nx) xb_add(&bar[XB_TOPGEN], 1u);
            else XB_SPIN(xb_ld(&bar[XB_TOPGEN]) == tg, bar);
            __builtin_amdgcn_fence(__ATOMIC_ACQUIRE, "agent");
            xb_add(&bar[XB_XGEN(b.x)], 1u);
            asm volatile("s_waitcnt vmcnt(0)" ::: "memory");
        } else {
            XB_SPIN(xb_ld(&bar[XB_XGEN(b.x)]) == gen, bar);
            __builtin_amdgcn_fence(__ATOMIC_ACQUIRE, "agent");
            asm volatile("s_waitcnt vmcnt(0)" ::: "memory");
        }
    }
    __syncthreads();
}

DI void p0_transpose_item(const float* W, int K, int N, bf16* WT, LAS float* scr, int item, int lane, const float* gain, int nscaled, float cscale) {
    const int nblk = N / 32, kb = item / nblk, nb = item % nblk, k0 = 64 * kb, n0 = 32 * nb;
#pragma unroll 8
    for (int i = 0; i < 32; ++i) { const int kk = 2 * i + (lane >> 5); float v = W[(size_t)(k0 + kk) * N + n0 + (lane & 31)]; if (gain) v *= gain[k0 + kk]; scr[kk * 33 + (lane & 31)] = v; }
    LDS_WAIT();
    const int c = lane & 7;
#pragma unroll
    for (int j = 0; j < 4; ++j) { const int n = (lane >> 3) + 8 * j; const LAS float* s = scr + (8 * c) * 33 + n; const float cs = (n0 + n < nscaled) ? cscale : 1.f;
        v4u o; o.x = pk2(s[0 * 33] * cs, s[1 * 33] * cs); o.y = pk2(s[2 * 33] * cs, s[3 * 33] * cs); o.z = pk2(s[4 * 33] * cs, s[5 * 33] * cs); o.w = pk2(s[6 * 33] * cs, s[7 * 33] * cs);
        *(v4u*)(WT + (size_t)(n0 + n) * K + k0 + 8 * c) = o; }
    LDS_WAIT();
}
struct P0Args { const float *x, *conv_g, *w_in, *w_out, *attn_g, *w_qkv, *w_o, *ffn_g, *w_pq, *subk, *pu, *pv;
                bf16 *WinT, *WoutT, *WqkvT, *WoT, *WpqT, *SKb; unsigned char *U8, *V8; bf16* XB; float* SS0; };
DI void p0_prologue(const P0Args& a, LAS unsigned char* lds, int vcu, int G, int wave, int lane, int tid) {
    LAS float* scr = (LAS float*)(lds + wave * 16384);
    const int gw = vcu * NWAVES + wave, NGW = G * NWAVES;
    constexpr int I_IN = 16 * (NIN / 32), I_OUT = 16 * (D / 32), I_QKV = 16 * (NQKV / 32), I_O = I_OUT, I_PQ = 16 * (NPQ / 32);
    constexpr int NITEMS = I_IN + I_OUT + I_QKV + I_O + 2 * I_PQ;
    for (int it = gw; it < NITEMS; it += NGW) {
        int r = it;
        if (r < I_IN) { p0_transpose_item(a.w_in, D, NIN, a.WinT, scr, r, lane, a.conv_g, 0, 1.f); continue; } r -= I_IN;
        if (r < I_OUT) { p0_transpose_item(a.w_out, D, D, a.WoutT, scr, r, lane, nullptr, 0, 1.f); continue; } r -= I_OUT;
        if (r < I_QKV) { p0_transpose_item(a.w_qkv, D, NQKV, a.WqkvT, scr, r, lane, a.attn_g, 1024, QSCALE); continue; } r -= I_QKV;
        if (r < I_O) { p0_transpose_item(a.w_o, D, D, a.WoT, scr, r, lane, nullptr, 0, 1.f); continue; } r -= I_O;
        if (r < I_PQ) { p0_transpose_item(a.w_pq, D, NPQ, a.WpqT, scr, r, lane, a.ffn_g, 0, 1.f); continue; } r -= I_PQ;
        p0_transpose_item(a.w_pq + (size_t)D * NPQ, D, NPQ, a.WpqT + (size_t)NPQ * D, scr, r, lane, a.ffn_g + D, 0, 1.f);
    }
    const size_t gt = (size_t)vcu * (NWAVES * 64) + tid, NGT = (size_t)G * NWAVES * 64;
    constexpr size_t C_SK = (size_t)2 * 8 * 2 * 128 * 128 / 8;
    for (size_t c = gt; c < C_SK; c += NGT) { const f32x4 v0 = *(const f32x4*)(a.subk + c * 8), v1 = *(const f32x4*)(a.subk + c * 8 + 4);
        v4u o; o.x = pk2(v0[0], v0[1]); o.y = pk2(v0[2], v0[3]); o.z = pk2(v1[0], v1[1]); o.w = pk2(v1[2], v1[3]); *(v4u*)(a.SKb + c * 8) = o; }
    constexpr size_t C_T16 = (size_t)2 * NEXP * D / 16;
    for (size_t c = gt; c < C_T16; c += NGT) { const int layer = (int)(c / ((size_t)NEXP * D / 16)), d0 = (int)(c % (D / 16)) * 16;
        v4u o;
#pragma unroll
        for (int q = 0; q < 4; ++q) { const f32x4 g = *(const f32x4*)(a.ffn_g + layer * D + d0 + 4 * q);
            const f32x4 v = __builtin_nontemporal_load((const f32x4*)(a.pu + c * 16 + 4 * q)) * g * 1024.0f;
            int w = __builtin_amdgcn_cvt_pk_fp8_f32(v[0], v[1], 0, false); w = __builtin_amdgcn_cvt_pk_fp8_f32(v[2], v[3], w, true); o[q] = (unsigned)w; }
        *(v4u*)(a.U8 + c * 16) = o; }
    for (size_t c = gt; c < C_T16; c += NGT) {
        v4u o;
#pragma unroll
        for (int q = 0; q < 4; ++q) { const f32x4 v = __builtin_nontemporal_load((const f32x4*)(a.pv + c * 16 + 4 * q)) * 1024.0f;
            int w = __builtin_amdgcn_cvt_pk_fp8_f32(v[0], v[1], 0, false); w = __builtin_amdgcn_cvt_pk_fp8_f32(v[2], v[3], w, true); o[q] = (unsigned)w; }
        *(v4u*)(a.V8 + c * 16) = o; }
    for (int m = gw; m < T; m += NGW) {
        const f32x4* xr = (const f32x4*)(a.x + (size_t)m * D) + lane; float s = 0.f; f32x4 v[4];
#pragma unroll
        for (int j = 0; j < 4; ++j) { v[j] = xr[64 * j]; s += (v[j][0] * v[j][0] + v[j][1] * v[j][1]) + (v[j][2] * v[j][2] + v[j][3] * v[j][3]); }
        s = wave_sum(s);
        v2u* o8 = (v2u*)(a.XB + (size_t)m * D) + lane;
#pragma unroll
        for (int j = 0; j < 4; ++j) { v2u w; w.x = pk2(v[j][0], v[j][1]); w.y = pk2(v[j][2], v[j][3]); o8[64 * j] = w; }
        if (lane < 4) { f32x4 z = {0.f, 0.f, 0.f, 0.f}; ((f32x4*)(a.SS0 + (size_t)(2 * T + m) * 16))[lane] = z; ((f32x4*)(a.SS0 + (size_t)(4 * T + m) * 16))[lane] = z;
            if (lane == 0) z[0] = s; ((f32x4*)(a.SS0 + (size_t)m * 16))[lane] = z; }
    }
}

DI void conv_gate_phase(const bf16* G1, const float* cw, bf16* Y, int vcu, int G, int tid) {
    const size_t gt = (size_t)vcu * (NWAVES * 64) + tid, NGT = (size_t)G * NWAVES * 64;
    for (size_t c = gt; c < (size_t)T * (D / 8); c += NGT) {
        const int t = (int)(c / (D / 8)), d0 = (int)(c % (D / 8)) * 8, ts = t % SEQ;
        const v4u gb = *(const v4u*)(G1 + (size_t)t * NIN + d0);
        float acc[8];
#pragma unroll
        for (int i = 0; i < 8; ++i) acc[i] = 0.f;
#pragma unroll
        for (int w = 0; w < 3; ++w) { const int tt = ts + w - 1;
            if (tt >= 0 && tt < SEQ) {
                const v4u gc = *(const v4u*)(G1 + (size_t)(t + w - 1) * NIN + D + d0), hh = *(const v4u*)(G1 + (size_t)(t + w - 1) * NIN + 2 * D + d0);
                const f32x4 w0 = *(const f32x4*)(cw + w * D + d0), w1 = *(const f32x4*)(cw + w * D + d0 + 4);
                acc[0] += w0[0] * (bf_lo(gc.x) * bf_lo(hh.x)); acc[1] += w0[1] * (bf_hi(gc.x) * bf_hi(hh.x));
                acc[2] += w0[2] * (bf_lo(gc.y) * bf_lo(hh.y)); acc[3] += w0[3] * (bf_hi(gc.y) * bf_hi(hh.y));
                acc[4] += w1[0] * (bf_lo(gc.z) * bf_lo(hh.z)); acc[5] += w1[1] * (bf_hi(gc.z) * bf_hi(hh.z));
                acc[6] += w1[2] * (bf_lo(gc.w) * bf_lo(hh.w)); acc[7] += w1[3] * (bf_hi(gc.w) * bf_hi(hh.w)); } }
        v4u o; o.x = pk2(acc[0] * bf_lo(gb.x), acc[1] * bf_hi(gb.x)); o.y = pk2(acc[2] * bf_lo(gb.y), acc[3] * bf_hi(gb.y));
        o.z = pk2(acc[4] * bf_lo(gb.z), acc[5] * bf_hi(gb.z)); o.w = pk2(acc[6] * bf_lo(gb.w), acc[7] * bf_hi(gb.w));
        *(v4u*)(Y + (size_t)t * D + d0) = o;
    }
}

template <int CTRL> DI unsigned dppu(unsigned v) { return (unsigned)__builtin_amdgcn_update_dpp(0, (int)v, CTRL, 0xf, 0xf, false); }
DI unsigned umax(unsigned a, unsigned b) { return a > b ? a : b; }
DI unsigned umin(unsigned a, unsigned b) { return a < b ? a : b; }
DI unsigned rowmax_u(unsigned v) { v = umax(v, dppu<0x128>(v)); v = umax(v, dppu<0x124>(v)); v = umax(v, dppu<0x122>(v)); v = umax(v, dppu<0x121>(v)); return v; }
DI float rowsum_f(float v) { v += __uint_as_float(dppu<0x128>(__float_as_uint(v))); v += __uint_as_float(dppu<0x124>(__float_as_uint(v))); v += __uint_as_float(dppu<0x122>(__float_as_uint(v))); v += __uint_as_float(dppu<0x121>(__float_as_uint(v))); return v; }
DI unsigned f2key(float f) { const unsigned u = __float_as_uint(f); return u ^ ((unsigned)((int)u >> 31) | 0x80000000u); }
DI float key2f(unsigned k) { const unsigned u = (k & 0x80000000u) ? (k ^ 0x80000000u) : ~k; return __uint_as_float(u); }
DI unsigned cand_ij(int c) {
    unsigned i, j;
    if (c < 16) { i = 0; j = c; } else if (c < 24) { i = 1; j = c - 16; } else if (c < 29) { i = 2; j = c - 24; } else if (c < 33) { i = 3; j = c - 29; }
    else if (c < 36) { i = 4; j = c - 33; } else if (c < 38) { i = 5; j = c - 36; } else if (c < 40) { i = 6; j = c - 38; } else if (c < 42) { i = 7; j = c - 40; }
    else { i = 8 + (c - 42); j = 0; }
    return (i & 15u) | (j << 4);
}
#define CE_DESC(a, b) do { const unsigned _hi = umax(a, b), _lo = umin(a, b); a = _hi; b = _lo; } while (0)
DI void route_phase(const bf16* PQ, const bf16* SK, unsigned short* IDX, float* GATE, LAS unsigned char* lds, int vcu, int G, int wave, int lane, int tid) {
    const int fr = lane & 15, fq = lane >> 4;
    LAS unsigned char* TAB = lds;
    LAS unsigned char* SKL = lds + 256;
    if (tid < 64) TAB[tid] = (unsigned char)(tid < 50 ? cand_ij(tid) : 0xff);
    int cur_h = -1;
    for (int item = vcu; item < (T / 128) * 8; item += G) {
        const int h = item & 7, tile = item >> 3, t0 = tile * 128 + wave * 16;
        if (h != cur_h) { __syncthreads();
            for (int c = tid; c < 2 * 128 * 16; c += NWAVES * 64) { const int row = c >> 4, c16 = c & 15;
                *(LAS v4u*)(SKL + row * 272 + c16 * 16) = *(const v4u*)(SK + (size_t)(h * 256 + row) * 128 + c16 * 8); }
            cur_h = h; __syncthreads(); }
        unsigned res[2][4];
#pragma unroll
        for (int p = 0; p < 2; ++p) {
            bf16x8 af[4];
#pragma unroll
            for (int ks = 0; ks < 4; ++ks) af[ks] = *(const bf16x8*)(PQ + (size_t)(t0 + fr) * NPQ + h * 256 + p * 128 + ks * 32 + fq * 8);
            f32x4 acc[8];
#pragma unroll
            for (int n = 0; n < 8; ++n) { acc[n] = (f32x4){0.f, 0.f, 0.f, 0.f};
#pragma unroll
                for (int ks = 0; ks < 4; ++ks) { const bf16x8 bfr = *(const LAS bf16x8*)(SKL + (p * 128 + n * 16 + fr) * 272 + ks * 64 + fq * 16);
                    acc[n] = __builtin_amdgcn_mfma_f32_16x16x32_bf16(af[ks], bfr, acc[n], 0, 0, 0); } }
            unsigned L[4][8];
#pragma unroll
            for (int r = 0; r < 4; ++r)
#pragma unroll
                for (int n = 0; n < 8; ++n) L[r][n] = (f2key(acc[n][r]) & ~127u) | (unsigned)(127 - (16 * n + fr));
#define CE4(i, j) do { _Pragma("unroll") for (int r = 0; r < 4; ++r) CE_DESC(L[r][i], L[r][j]); } while (0)
            CE4(0, 1); CE4(2, 3); CE4(4, 5); CE4(6, 7);
            CE4(0, 2); CE4(1, 3); CE4(4, 6); CE4(5, 7);
            CE4(1, 2); CE4(5, 6); CE4(0, 4); CE4(3, 7);
            CE4(1, 5); CE4(2, 6);
            CE4(1, 4); CE4(3, 6);
            CE4(2, 4); CE4(3, 5);
            CE4(3, 4);
#undef CE4
            unsigned rr[4] = {0u, 0u, 0u, 0u};
#pragma unroll
            for (int k = 0; k < 16; ++k) {
                unsigned gm[4];
#pragma unroll
                for (int r = 0; r < 4; ++r) gm[r] = umax(L[r][0], dppu<0x128>(L[r][0]));
#pragma unroll
                for (int r = 0; r < 4; ++r) gm[r] = umax(gm[r], dppu<0x124>(gm[r]));
#pragma unroll
                for (int r = 0; r < 4; ++r) gm[r] = umax(gm[r], dppu<0x122>(gm[r]));
#pragma unroll
                for (int r = 0; r < 4; ++r) gm[r] = umax(gm[r], dppu<0x121>(gm[r]));
#pragma unroll
                for (int r = 0; r < 4; ++r) { rr[r] = (fr == k) ? gm[r] : rr[r]; const bool pop = (L[r][0] == gm[r]);
#pragma unroll
                    for (int n = 0; n < 7; ++n) L[r][n] = pop ? L[r][n + 1] : L[r][n];
                    L[r][7] = pop ? 0u : L[r][7]; }
            }
#pragma unroll
            for (int r = 0; r < 4; ++r) res[p][r] = rr[r];
        }
        const int gbase = (lane & 48) * 4;
        unsigned ck[4][4];
#pragma unroll
        for (int r = 0; r < 4; ++r)
#pragma unroll
            for (int s = 0; s < 4; ++s) { const int c = fr + 16 * s; const unsigned tb = TAB[c & 63];
                const unsigned k0 = (unsigned)__builtin_amdgcn_ds_bpermute(gbase + (int)(tb & 15u) * 4, (int)res[0][r]);
                const unsigned k1 = (unsigned)__builtin_amdgcn_ds_bpermute(gbase + (int)((tb >> 4) & 15u) * 4, (int)res[1][r]);
                const float v = key2f((k0 & ~127u) | 64u) + key2f((k1 & ~127u) | 64u);
                ck[r][s] = (c < 50) ? ((f2key(v) & ~63u) | (unsigned)(63 - c)) : 0u; }
        unsigned sel[4] = {0u, 0u, 0u, 0u};
#pragma unroll
        for (int k = 0; k < 16; ++k) {
            unsigned gm[4];
#pragma unroll
            for (int r = 0; r < 4; ++r) { const unsigned lm = umax(umax(ck[r][0], ck[r][1]), umax(ck[r][2], ck[r][3])); gm[r] = umax(lm, dppu<0x128>(lm)); }
#pragma unroll
            for (int r = 0; r < 4; ++r) gm[r] = umax(gm[r], dppu<0x124>(gm[r]));
#pragma unroll
            for (int r = 0; r < 4; ++r) gm[r] = umax(gm[r], dppu<0x122>(gm[r]));
#pragma unroll
            for (int r = 0; r < 4; ++r) gm[r] = umax(gm[r], dppu<0x121>(gm[r]));
#pragma unroll
            for (int r = 0; r < 4; ++r) { sel[r] = (fr == k) ? gm[r] : sel[r];
#pragma unroll
                for (int s = 0; s < 4; ++s) ck[r][s] = (ck[r][s] == gm[r]) ? 0u : ck[r][s]; }
        }
#pragma unroll
        for (int r = 0; r < 4; ++r) {
            const int t = t0 + 4 * fq + r;
            const int cs = 63 - (int)(sel[r] & 63u); const unsigned tb = TAB[cs & 63];
            const unsigned k0 = (unsigned)__builtin_amdgcn_ds_bpermute(gbase + (int)(tb & 15u) * 4, (int)res[0][r]);
            const unsigned k1 = (unsigned)__builtin_amdgcn_ds_bpermute(gbase + (int)((tb >> 4) & 15u) * 4, (int)res[1][r]);
            const int e = (127 - (int)(k0 & 127u)) * 128 + (127 - (int)(k1 & 127u));
            const float val = key2f((sel[r] & ~63u) | 32u), top = key2f((rowmax_u(sel[r]) & ~63u) | 32u);
            const float ex = __builtin_amdgcn_exp2f((val - top) * LOG2E), sum = rowsum_f(ex);
            IDX[(size_t)t * 128 + h * 16 + fr] = (unsigned short)e; GATE[(size_t)t * 128 + h * 16 + fr] = ex / sum;
        }
    }
}

DI float dot8(v4u x, v4u u, float acc) {
    acc += bf_lo(x.x) * bf_lo(u.x); acc += bf_hi(x.x) * bf_hi(u.x); acc += bf_lo(x.y) * bf_lo(u.y); acc += bf_hi(x.y) * bf_hi(u.y);
    acc += bf_lo(x.z) * bf_lo(u.z); acc += bf_hi(x.z) * bf_hi(u.z); acc += bf_lo(x.w) * bf_lo(u.w); acc += bf_hi(x.w) * bf_hi(u.w);
    return acc;
}
DI void fma8(float* acc, float a, v4u v) {
    acc[0] += a * bf_lo(v.x); acc[1] += a * bf_hi(v.x); acc[2] += a * bf_lo(v.y); acc[3] += a * bf_hi(v.y);
    acc[4] += a * bf_lo(v.z); acc[5] += a * bf_hi(v.z); acc[6] += a * bf_lo(v.w); acc[7] += a * bf_hi(v.w);
}
DI f32x2 fp8lo(unsigned w) { return __builtin_amdgcn_cvt_pk_f32_fp8((int)w, false); }
DI f32x2 fp8hi(unsigned w) { return __builtin_amdgcn_cvt_pk_f32_fp8((int)w, true); }

constexpr int XCHUNK = 128, XNCHUNK = T / XCHUNK, XTPW = XCHUNK / NWAVES;
template <int CTRL> DI float dppf(float v) { return __uint_as_float(dppu<CTRL>(__float_as_uint(v))); }
struct UTok { v4u xa, xb; v4u uw[16]; };
DI void u_issue(UTok& S, const unsigned char* U8s, const unsigned short* IDX, const bf16* XB, int t, int s, int lane) {
    const int g = lane >> 3, k = lane & 7;
    const int i0 = IDX[(size_t)t * 128 + lane], i1 = IDX[(size_t)t * 128 + 64 + lane];
    const v4u* xr = (const v4u*)(XB + (size_t)t * D + 128 * s + 16 * k);
    S.xa = xr[0]; S.xb = xr[1];
#pragma unroll
    for (int i = 0; i < 16; ++i) { const unsigned idx = (unsigned)__builtin_amdgcn_ds_bpermute((8 * (i & 7) + g) * 4, i < 8 ? i0 : i1);
        S.uw[i] = *(const v4u*)(U8s + (idx * 1024u + 16u * (unsigned)k)); }
}
DI void u_compute(const UTok& S, float* HPs, int t, int lane) {
    const int g = lane >> 3, k = lane & 7;
    const v4u xa = S.xa, xb = S.xb;
    f32x2 xp[8];
    xp[0] = (f32x2){bf_lo(xa.x), bf_hi(xa.x)}; xp[1] = (f32x2){bf_lo(xa.y), bf_hi(xa.y)}; xp[2] = (f32x2){bf_lo(xa.z), bf_hi(xa.z)}; xp[3] = (f32x2){bf_lo(xa.w), bf_hi(xa.w)};
    xp[4] = (f32x2){bf_lo(xb.x), bf_hi(xb.x)}; xp[5] = (f32x2){bf_lo(xb.y), bf_hi(xb.y)}; xp[6] = (f32x2){bf_lo(xb.z), bf_hi(xb.z)}; xp[7] = (f32x2){bf_lo(xb.w), bf_hi(xb.w)};
    float p[16];
#pragma unroll
    for (int i = 0; i < 16; ++i) { f32x2 a2 = {0.f, 0.f};
#pragma unroll
        for (int q = 0; q < 4; ++q) { a2 = __builtin_elementwise_fma(xp[2 * q], fp8lo(S.uw[i][q]), a2); a2 = __builtin_elementwise_fma(xp[2 * q + 1], fp8hi(S.uw[i][q]), a2); }
        p[i] = a2.x + a2.y; }
    const bool h4 = k >= 4, h1 = k & 1, h2 = k & 2;
    float q8[8], q4[4], q2[2];
#pragma unroll
    for (int j = 0; j < 8; ++j) { const float keep = h4 ? p[8 + j] : p[j], send = h4 ? p[j] : p[8 + j]; q8[j] = keep + dppf<0x141>(send); }
#pragma unroll
    for (int j = 0; j < 4; ++j) { const float keep = h1 ? q8[4 + j] : q8[j], send = h1 ? q8[j] : q8[4 + j]; q4[j] = keep + dppf<0xB1>(send); }
#pragma unroll
    for (int j = 0; j < 2; ++j) { const float keep = h2 ? q4[2 + j] : q4[j], send = h2 ? q4[j] : q4[2 + j]; q2[j] = keep + dppf<0x4E>(send); }
    const int ib = (h4 ? 8 : 0) + (h1 ? 4 : 0) + (h2 ? 2 : 0);
    HPs[(size_t)t * 128 + 8 * ib + g] = q2[0]; HPs[(size_t)t * 128 + 8 * ib + 8 + g] = q2[1];
}
struct VTok { v4u vw[16]; float av[16]; };
DI void v_issue(VTok& S, const unsigned char* V8s, const unsigned short* IDX, const float* A, int t, int lane) {
    const int g = lane >> 3, k = lane & 7;
    const int i0 = IDX[(size_t)t * 128 + lane], i1 = IDX[(size_t)t * 128 + 64 + lane];
    const float a0 = A[(size_t)t * 128 + lane], a1 = A[(size_t)t * 128 + 64 + lane];
#pragma unroll
    for (int i = 0; i < 16; ++i) { const int ad = (8 * (i & 7) + g) * 4; const int idx = __builtin_amdgcn_ds_bpermute(ad, i < 8 ? i0 : i1);
        S.av[i] = __uint_as_float((unsigned)__builtin_amdgcn_ds_bpermute(ad, (int)__float_as_uint(i < 8 ? a0 : a1)));
        S.vw[i] = *(const v4u*)(V8s + ((unsigned)idx * 1024u + 16u * (unsigned)k)); }
}
template <bool FINAL>
DI void v_compute(const VTok& S, float* xf, bf16* XB, float* ss_out, int t, int s, int lane) {
    const int k = lane & 7;
    const bool b3 = lane & 8, b4 = lane & 16, b5 = lane & 32;
    const int col = 128 * s + 16 * k + (b3 ? 8 : 0) + (b4 ? 4 : 0) + (b5 ? 2 : 0);
    float* xo = xf + (size_t)t * D + col;
    f32x2 o = *(const f32x2*)xo;
    f32x2 acc[8];
#pragma unroll
    for (int i = 0; i < 8; ++i) acc[i] = (f32x2){0.f, 0.f};
#pragma unroll
    for (int i = 0; i < 16; ++i) { const f32x2 a2 = {S.av[i], S.av[i]};
#pragma unroll
        for (int q = 0; q < 4; ++q) { acc[2 * q] = __builtin_elementwise_fma(a2, fp8lo(S.vw[i][q]), acc[2 * q]); acc[2 * q + 1] = __builtin_elementwise_fma(a2, fp8hi(S.vw[i][q]), acc[2 * q + 1]); } }
    float v[16];
#pragma unroll
    for (int i = 0; i < 8; ++i) { v[2 * i] = acc[i].x; v[2 * i + 1] = acc[i].y; }
    float v8[8], v4[4], v2[2];
#pragma unroll
    for (int j = 0; j < 8; ++j) { const float keep = b3 ? v[8 + j] : v[j], send = b3 ? v[j] : v[8 + j]; v8[j] = keep + __shfl_xor(send, 8); }
#pragma unroll
    for (int j = 0; j < 4; ++j) { const float keep = b4 ? v8[4 + j] : v8[j], send = b4 ? v8[j] : v8[4 + j]; v4[j] = keep + __shfl_xor(send, 16); }
#pragma unroll
    for (int j = 0; j < 2; ++j) { const float keep = b5 ? v4[2 + j] : v4[j], send = b5 ? v4[j] : v4[2 + j]; v2[j] = keep + __shfl_xor(send, 32); }
    o.x += v2[0]; o.y += v2[1];
    *(f32x2*)xo = o;
    if (!FINAL) *(unsigned*)(XB + (size_t)t * D + col) = pk2(o.x, o.y);
    const float sq = wave_sum(o.x * o.x + o.y * o.y);
    if (lane == 0) ss_out[(size_t)t * 16 + s] = sq;
}
template <int PASS, bool FINAL>
DI void sliced_pass(const unsigned char* TAB, const unsigned short* IDX, const bf16* XBc, bf16* XBw, float* HP, const float* A, float* xf, float* ss_out,
                    unsigned* heads, volatile LAS unsigned* slot, int wave, int lane, int tid) {
    const int own = (int)(xb_xcc_id() & 7u);
#pragma unroll 1
    for (int ds = 0; ds < 8; ++ds) { const int s = (own + ds) & 7;
        unsigned* head = heads + 64 * s; unsigned tk = 0u;
        if (tid == 0) tk = __hip_atomic_fetch_add(head, 1u, __ATOMIC_RELAXED, __HIP_MEMORY_SCOPE_AGENT);
        for (;;) {
            __syncthreads(); if (tid == 0) *slot = tk; __syncthreads();
            const unsigned c = *slot; if (c >= (unsigned)XNCHUNK) break;
            if (tid == 0) tk = __hip_atomic_fetch_add(head, 1u, __ATOMIC_RELAXED, __HIP_MEMORY_SCOPE_AGENT);
            const int t0 = (int)c * XCHUNK + wave * XTPW;
            if (PASS == 0) { const unsigned char* Ts = TAB + 128 * s; float* HPs = HP + (size_t)s * T * 128;
                UTok P, Q; u_issue(P, Ts, IDX, XBc, t0, s, lane);
#pragma unroll 1
                for (int j = 0; j < XTPW; j += 2) { u_issue(Q, Ts, IDX, XBc, t0 + j + 1, s, lane); u_compute(P, HPs, t0 + j, lane);
                    if (j + 2 < XTPW) u_issue(P, Ts, IDX, XBc, t0 + j + 2, s, lane); u_compute(Q, HPs, t0 + j + 1, lane); }
            } else { const unsigned char* Ts = TAB + 128 * s;
                VTok P, Q; v_issue(P, Ts, IDX, A, t0, lane);
#pragma unroll 1
                for (int j = 0; j < XTPW; j += 2) { v_issue(Q, Ts, IDX, A, t0 + j + 1, lane); v_compute<FINAL>(P, xf, XBw, ss_out, t0 + j, s, lane);
                    if (j + 2 < XTPW) v_issue(P, Ts, IDX, A, t0 + j + 2, lane); v_compute<FINAL>(Q, xf, XBw, ss_out, t0 + j + 1, s, lane); }
            }
        } }
}
DI void reduce_phase(const float* HP, const float* GATE, const float* ss_in, float* A, int vcu, int G, int tid) {
    const size_t gt = (size_t)vcu * (NWAVES * 64) + tid, NGT = (size_t)G * NWAVES * 64;
    for (size_t c = gt; c < (size_t)T * 128; c += NGT) { float h = 0.f;
#pragma unroll
        for (int s = 0; s < 8; ++s) h += HP[(size_t)s * T * 128 + c];
        h *= pg8::row_rstd(ss_in, (int)(c >> 7)) * (1.0f / 1024.0f);
        A[c] = (1.0f / 1024.0f) * GATE[c] * (0.5f * h * (1.f + erff(h * 0.70710678118654752f))); }
}
DI void final_phase(const float* ss, float* xf, const float* fin_g, int vcu, int G, int wave, int lane) {
    for (int m = vcu * NWAVES + wave; m < T; m += G * NWAVES) { const float rf = pg8::row_rstd(ss, m);
        f32x4* xr = (f32x4*)(xf + (size_t)m * D) + lane;
#pragma unroll
        for (int j = 0; j < 4; ++j) xr[64 * j] = xr[64 * j] * rf * *((const f32x4*)fin_g + lane + 64 * j); }
}

DI int t5_bucket(int rel) {
    const int n = rel < 0 ? -rel : rel; int b;
    if (n < 8) b = n; else if (n < 12) b = 8; else if (n < 16) b = 9; else if (n < 23) b = 10; else if (n < 32) b = 11; else if (n < 46) b = 12; else if (n < 64) b = 13; else if (n < 91) b = 14; else b = 15;
    return b + (rel > 0 ? 16 : 0);
}
DI int crow(int reg, int h) { return (reg & 3) + 8 * (reg >> 2) + 4 * h; }
constexpr int AT_KL = 0, AT_KSTR = 144, AT_VT = 384 * AT_KSTR  , AT_VSTR = 776, AT_BT = AT_VT + 64 * AT_VSTR  , AT_END = AT_BT + 4 * 512 * 4;
static_assert(AT_END <= RING_BYTES, "attention LDS");
DI void attn_phase(const bf16* Qg, const bf16* Kg, const bf16* Vg, bf16* AO, const float* rel_bias, const float* sink, LAS unsigned char* lds, int vcu, int G, int wave, int lane, int tid) {
    const int r = lane & 31, h = lane >> 5;
    for (int unit = vcu; unit < BATCH * 4 * (SEQ / 128); unit += G) {
        const int b = unit / 256, kvh = (unit % 256) / 64, blk = unit % 64;
        __syncthreads();
        for (int c = tid; c < 384 * 8; c += NWAVES * 64) { const int row = c >> 3, c8 = c & 7, ts = blk * 128 - 128 + row;
            v4u kv = {0u, 0u, 0u, 0u}, vv = {0u, 0u, 0u, 0u};
            if (ts >= 0 && ts < SEQ) { const size_t g = (size_t)(b * SEQ + ts) * 256 + kvh * 64 + c8 * 8; kv = *(const v4u*)(Kg + g); vv = *(const v4u*)(Vg + g); }
            *(LAS v4u*)(lds + AT_KL + row * AT_KSTR + c8 * 16) = kv;
            LAS unsigned short* vt = (LAS unsigned short*)(lds + AT_VT) + (c8 * 8) * (AT_VSTR / 2) + row;
            vt[0 * (AT_VSTR / 2)] = (unsigned short)(vv.x & 0xffffu); vt[1 * (AT_VSTR / 2)] = (unsigned short)(vv.x >> 16);
            vt[2 * (AT_VSTR / 2)] = (unsigned short)(vv.y & 0xffffu); vt[3 * (AT_VSTR / 2)] = (unsigned short)(vv.y >> 16);
            vt[4 * (AT_VSTR / 2)] = (unsigned short)(vv.z & 0xffffu); vt[5 * (AT_VSTR / 2)] = (unsigned short)(vv.z >> 16);
            vt[6 * (AT_VSTR / 2)] = (unsigned short)(vv.w & 0xffffu); vt[7 * (AT_VSTR / 2)] = (unsigned short)(vv.w >> 16); }
        for (int c = tid; c < 4 * 512; c += NWAVES * 64) { const int g = c >> 9, i = c & 511, rel = i - 255;
            float v = NEGBIG; if (rel >= -128 && rel <= 128) v = rel_bias[t5_bucket(rel) * 16 + kvh * 4 + g] * LOG2E;
            *(LAS float*)(lds + AT_BT + c * 4) = v; }
        __syncthreads();
        const int g = wave >> 1, qh = wave & 1, head = kvh * 4 + g;
        const float sinkl = sink[head] * LOG2E;
        bf16x8 qf[2][4];
#pragma unroll
        for (int qt = 0; qt < 2; ++qt)
#pragma unroll
            for (int s = 0; s < 4; ++s) qf[qt][s] = *(const bf16x8*)(Qg + (size_t)(b * SEQ + blk * 128 + qh * 64 + qt * 32 + r) * D + head * 64 + s * 16 + h * 8);
        float m[2] = {sinkl, sinkl}, l[2] = {0.f, 0.f};
        f32x16 o[2][2];
#pragma unroll
        for (int qt = 0; qt < 2; ++qt)
#pragma unroll
            for (int dt = 0; dt < 2; ++dt)
#pragma unroll
                for (int i = 0; i < 16; ++i) o[qt][dt][i] = 0.f;
        int kt_lo = 2 * qh, kt_hi = 2 * qh + 9;
        if (blk == 0 && kt_lo < 4) kt_lo = 4;
        if (blk == SEQ / 128 - 1 && kt_hi > 7) kt_hi = 7;
#pragma unroll 1
        for (int kt = kt_lo; kt <= kt_hi; ++kt) {
            bf16x8 kf[4];
#pragma unroll
            for (int s = 0; s < 4; ++s) kf[s] = *(const LAS bf16x8*)(lds + AT_KL + (32 * kt + r) * AT_KSTR + s * 32 + h * 16);
            bf16x8 vf[2][2];
#pragma unroll
            for (int dt = 0; dt < 2; ++dt)
#pragma unroll
                for (int s2 = 0; s2 < 2; ++s2) { const LAS unsigned char* vp = lds + AT_VT + (32 * dt + r) * AT_VSTR + (32 * kt + 16 * s2 + 4 * h) * 2;
                    const v2u lo = *(const LAS v2u*)vp, hi2 = *(const LAS v2u*)(vp + 16); v4u w = {lo.x, lo.y, hi2.x, hi2.y}; vf[dt][s2] = __builtin_bit_cast(bf16x8, w); }
#pragma unroll
            for (int qt = 0; qt < 2; ++qt) {
                f32x16 s;
                const LAS float* bt = (const LAS float*)(lds + AT_BT) + g * 512 + 127 + 32 * kt + 4 * h - (64 * qh + 32 * qt + r);
#pragma unroll
                for (int i = 0; i < 16; ++i) s[i] = bt[(i & 3) + 8 * (i >> 2)];
#pragma unroll
                for (int k4 = 0; k4 < 4; ++k4) s = __builtin_amdgcn_mfma_f32_32x32x16_bf16(kf[k4], qf[qt][k4], s, 0, 0, 0);
                float mx = s[0];
#pragma unroll
                for (int i = 1; i < 16; ++i) mx = fmaxf(mx, s[i]);
                mx = fmaxf(mx, __shfl_xor(mx, 32));
                const float mn = fmaxf(m[qt], mx), al = __builtin_amdgcn_exp2f(m[qt] - mn); m[qt] = mn;
                float ps = 0.f;
#pragma unroll
                for (int i = 0; i < 16; ++i) { s[i] = __builtin_amdgcn_exp2f(s[i] - mn); ps += s[i]; }
                l[qt] = l[qt] * al + ps;
#pragma unroll
                for (int dt = 0; dt < 2; ++dt)
#pragma unroll
                    for (int i = 0; i < 16; ++i) o[qt][dt][i] *= al;
                bf16x8 pf[2];
#pragma unroll
                for (int s2 = 0; s2 < 2; ++s2) { v4u w; w.x = pk2(s[8 * s2 + 0], s[8 * s2 + 1]); w.y = pk2(s[8 * s2 + 2], s[8 * s2 + 3]); w.z = pk2(s[8 * s2 + 4], s[8 * s2 + 5]); w.w = pk2(s[8 * s2 + 6], s[8 * s2 + 7]); pf[s2] = __builtin_bit_cast(bf16x8, w); }
#pragma unroll
                for (int dt = 0; dt < 2; ++dt)
#pragma unroll
                    for (int s2 = 0; s2 < 2; ++s2) o[qt][dt] = __builtin_amdgcn_mfma_f32_32x32x16_bf16(vf[dt][s2], pf[s2], o[qt][dt], 0, 0, 0);
            }
        }
#pragma unroll
        for (int qt = 0; qt < 2; ++qt) {
            const float lt = l[qt] + __shfl_xor(l[qt], 32) + __builtin_amdgcn_exp2f(sinkl - m[qt]), inv = 1.0f / lt;
            bf16* op = AO + (size_t)(b * SEQ + blk * 128 + qh * 64 + qt * 32 + r) * D + head * 64 + 4 * h;
#pragma unroll
            for (int dt = 0; dt < 2; ++dt)
#pragma unroll
                for (int gq = 0; gq < 4; ++gq) { v2u w; w.x = pk2(o[qt][dt][4 * gq] * inv, o[qt][dt][4 * gq + 1] * inv); w.y = pk2(o[qt][dt][4 * gq + 2] * inv, o[qt][dt][4 * gq + 3] * inv);
                    *(v2u*)(op + 32 * dt + 8 * gq) = w; }
        }
    }
}

struct Args { const float* in[16]; float* out; unsigned char* ws; int ph_lo, ph_hi; };
__global__ void __launch_bounds__(NWAVES * 64, 2) fwd_kernel(Args args) {
    extern __shared__ __attribute__((aligned(16))) unsigned char lds_raw[];
    LAS unsigned char* lds = (LAS unsigned char*)lds_raw;
    volatile LAS unsigned* MISC = (volatile LAS unsigned*)(lds + MISC_OFF);
    const int tid = threadIdx.x, lane = tid & 63, wave = __builtin_amdgcn_readfirstlane(tid >> 6);
    const int G = gridDim.x; const int bx = blockIdx.x; const int vcu = (G % 8 == 0) ? (bx % 8) * (G / 8) + bx / 8 : bx;
    unsigned char* ws = args.ws;
    unsigned* ctl = (unsigned*)(ws + WS_CTL);
    const float* x = args.in[0]; const float* conv_g = args.in[1]; const float* w_in = args.in[2]; const float* conv_w = args.in[3]; const float* w_out = args.in[4];
    const float* attn_g = args.in[5]; const float* w_qkv = args.in[6]; const float* sink = args.in[7]; const float* w_o = args.in[8]; const float* rel_bias = args.in[9];
    const float* ffn_g = args.in[10]; const float* w_pq = args.in[11]; const float* subk = args.in[12]; const float* pu = args.in[13]; const float* pv = args.in[14]; const float* fin_g = args.in[15];
    float* out = args.out;
    bf16* WinT = (bf16*)(ws + WS_WIN); bf16* WoutT = (bf16*)(ws + WS_WOUT); bf16* WqkvT = (bf16*)(ws + WS_WQKV); bf16* WoT = (bf16*)(ws + WS_WO); bf16* WpqT = (bf16*)(ws + WS_WPQ); bf16* SKb = (bf16*)(ws + WS_SK);
    float* SS = (float*)(ws + WS_SS); unsigned short* IDX = (unsigned short*)(ws + WS_IDX); float* HP = (float*)(ws + WS_HP); float* AA = (float*)(ws + WS_A); float* GATE = (float*)(ws + WS_GATE);
    bf16* XB = (bf16*)(ws + WS_XB); bf16* Y = (bf16*)(ws + WS_Y); unsigned char* U8 = ws + WS_U; unsigned char* V8 = ws + WS_V;
    bf16* G1 = (bf16*)(ws + WS_G1); bf16* PQ = (bf16*)(ws + WS_PQ); bf16* Qb = (bf16*)(ws + WS_Q); bf16* Kb = (bf16*)(ws + WS_K); bf16* VVb = (bf16*)(ws + WS_VV); bf16* AO = (bf16*)(ws + WS_AO);
    float* SS0 = SS; float* SS1 = SS + (size_t)T * 16; float* SS2 = SS + (size_t)2 * T * 16; float* SS3 = SS + (size_t)3 * T * 16; float* SS4 = SS + (size_t)4 * T * 16;

    for (int u = tid; u < (LDS_BYTES - LDSCTL_OFF) / 4; u += NWAVES * 64) ((LAS unsigned*)(lds + LDSCTL_OFF))[u] = 0u;
    __syncthreads();
    XcdBarrier bar; bar.bar = ctl + CW_BAR; bar.x = 0; bar.st = nullptr;
    if (!MK_PER_PHASE) bar = xcd_barrier_post(ctl + CW_BAR, MISC + 8);
    const int lo = args.ph_lo, hi = args.ph_hi;
#define IN(k) (lo <= (k) && (k) < hi)
#define SEAM(k) do { if (IN(k) && IN((k) + 1)) xcd_barrier(bar); } while (0)

    if (IN(0)) REPS(0) {
        P0Args a{x, conv_g, w_in, w_out, attn_g, w_qkv, w_o, ffn_g, w_pq, subk, pu, pv, WinT, WoutT, WqkvT, WoT, WpqT, SKb, U8, V8, XB, SS0};
        p0_prologue(a, lds, vcu, G, wave, lane, tid);
    }
    SEAM(0);
    if (IN(1)) REPS(1) {
        pg8::Gemm g{XB, WinT, T, NIN, D}; pg8::StaticOrder S; S.init(T, NIN, G, bx);
        pg8::EpiBf16RS E{G1, NIN, NIN / 256, nullptr, nullptr, 0, SS0};
        pg8::gemm_phase<pg8::EpiBf16RS, pg8::StaticOrder, true, true>(lds, g, S, E);
    }
    SEAM(1);
    if (IN(2)) REPS(2) conv_gate_phase(G1, conv_w, Y, vcu, G, tid);
    SEAM(2);
    if (IN(3)) REPS(3) {
        pg8::Gemm g{Y, WoutT, T, D, D}; pg8::StaticOrder S; S.init(T, D, G, bx);
        pg8::EpiResid E{x, out, XB, SS1};
        pg8::gemm_phase<pg8::EpiResid, pg8::StaticOrder, true, true>(lds, g, S, E);
    }
    SEAM(3);
    if (IN(4)) REPS(4) {
        pg8::Gemm g{XB, WpqT, T, NPQ, D}; pg8::StaticOrder S; S.init(T, NPQ, G, bx);
        pg8::EpiBf16RS E{PQ, NPQ, NPQ / 256, nullptr, nullptr, 0, SS1};
        pg8::gemm_phase<pg8::EpiBf16RS, pg8::StaticOrder, true, true>(lds, g, S, E);
    }
    SEAM(4);
    if (IN(5)) REPS(5) route_phase(PQ, SKb, IDX, GATE, lds, vcu, G, wave, lane, tid);
    SEAM(5);
    if (IN(6)) sliced_pass<0, false>(U8, IDX, XB, XB, HP, AA, out, SS2, ctl + CW_WQ + 64 * 0, MISC + 12, wave, lane, tid);
    SEAM(6);
    if (IN(7)) reduce_phase(HP, GATE, SS1, AA, vcu, G, tid);
    SEAM(7);
    if (IN(8)) sliced_pass<1, false>(V8, IDX, XB, XB, HP, AA, out, SS2, ctl + CW_WQ + 64 * 8, MISC + 12, wave, lane, tid);
    SEAM(8);
    if (IN(9)) REPS(9) {
        pg8::Gemm g{XB, WqkvT, T, NQKV, D}; pg8::StaticOrder S; S.init(T, NQKV, G, bx);
        pg8::EpiBf16RS E{Qb, D, 4, Kb, VVb, 256, SS2};
        pg8::gemm_phase<pg8::EpiBf16RS, pg8::StaticOrder, true, true>(lds, g, S, E);
    }
    SEAM(9);
    if (IN(10)) REPS(10) attn_phase(Qb, Kb, VVb, AO, rel_bias, sink, lds, vcu, G, wave, lane, tid);
    SEAM(10);
    if (IN(11)) {
        pg8::Gemm g{AO, WoT, T, D, D}; pg8::StaticOrder S; S.init(T, D, G, bx);
        pg8::EpiResid E{out, out, XB, SS3};
        pg8::gemm_phase<pg8::EpiResid, pg8::StaticOrder, true, true>(lds, g, S, E);
    }
    SEAM(11);
    if (IN(12)) REPS(12) {
        pg8::Gemm g{XB, WpqT + (size_t)NPQ * D, T, NPQ, D}; pg8::StaticOrder S; S.init(T, NPQ, G, bx);
        pg8::EpiBf16RS E{PQ, NPQ, NPQ / 256, nullptr, nullptr, 0, SS3};
        pg8::gemm_phase<pg8::EpiBf16RS, pg8::StaticOrder, true, true>(lds, g, S, E);
    }
    SEAM(12);
    if (IN(13)) REPS(13) route_phase(PQ, SKb + (size_t)8 * 2 * 128 * 128, IDX, GATE, lds, vcu, G, wave, lane, tid);
    SEAM(13);
    if (IN(14)) sliced_pass<0, true>(U8 + (size_t)NEXP * D, IDX, XB, XB, HP, AA, out, SS4, ctl + CW_WQ + 64 * 16, MISC + 12, wave, lane, tid);
    SEAM(14);
    if (IN(15)) reduce_phase(HP, GATE, SS3, AA, vcu, G, tid);
    SEAM(15);
    if (IN(16)) sliced_pass<1, true>(V8 + (size_t)NEXP * D, IDX, XB, XB, HP, AA, out, SS4, ctl + CW_WQ + 64 * 24, MISC + 12, wave, lane, tid);
    SEAM(16);
    if (IN(17)) final_phase(SS4, out, fin_g, vcu, G, wave, lane);
#undef IN
#undef SEAM
}

extern "C" void kernel_launch(void* const* d_in, const int* in_sizes, int n_in, void* d_out, int out_size, void* d_ws, size_t ws_size, hipStream_t stream) {
    static int grid = 0;
    if (grid == 0) {
        if (n_in != 16 || in_sizes[0] != T * D || out_size != T * D || ws_size < WS_END) { fprintf(stderr, "kernel_launch: unexpected shapes (n_in %d, in0 %d, out %d, ws %zu)\n", n_in, n_in > 0 ? in_sizes[0] : -1, out_size, ws_size); grid = -1; return; }
        int dev = 0, cus = 0, per_cu = 0;
        if (hipGetDevice(&dev) != hipSuccess || hipDeviceGetAttribute(&cus, hipDeviceAttributeMultiprocessorCount, dev) != hipSuccess) { grid = -1; return; }
        if (hipFuncSetAttribute((const void*)fwd_kernel, hipFuncAttributeMaxDynamicSharedMemorySize, LDS_BYTES) != hipSuccess) { fprintf(stderr, "kernel_launch: hipFuncSetAttribute failed\n"); grid = -1; return; }
        if (hipOccupancyMaxActiveBlocksPerMultiprocessor(&per_cu, (const void*)fwd_kernel, NWAVES * 64, LDS_BYTES) != hipSuccess || per_cu < 1) { fprintf(stderr, "kernel_launch: occupancy query says %d blocks per CU\n", per_cu); (void)hipGetLastError(); grid = -1; return; }
        grid = cus;
    }
    if (grid < 0) return;
    (void)hipMemsetAsync((char*)d_ws + WS_CTL, 0, CTL_ZERO_BYTES, stream);
    Args a{};
    for (int i = 0; i < 16; ++i) a.in[i] = (const float*)d_in[i];
    a.out = (float*)d_out; a.ws = (unsigned char*)d_ws;
#if MK_PER_PHASE
    for (int p = 0; p < NPH; ++p) { a.ph_lo = p; a.ph_hi = p + 1; hipLaunchKernelGGL(fwd_kernel, dim3(grid), dim3(NWAVES * 64), LDS_BYTES, stream, a); }
#else
    a.ph_lo = 0; a.ph_hi = NPH;
    hipLaunchKernelGGL(fwd_kernel, dim3(grid), dim3(NWAVES * 64), LDS_BYTES, stream, a);
#endif
}
```

```cpp
#include <hip/hip_runtime.h>
#include <cstdio>
#include <cstdint>
namespace pg8 {
#define PG8_LAS __attribute__((address_space(3)))
typedef unsigned short bf16_t;
typedef short bf16x8 __attribute__((ext_vector_type(8)));
typedef float f32x4 __attribute__((ext_vector_type(4)));
typedef unsigned u32x4 __attribute__((ext_vector_type(4)));
constexpr int BM = 256, BK = 64, HALF = 128, HTB = HALF * BK * 2  , STAGE_BYTES = 8 * HTB, NXCD = 8, WGM = 8;

__host__ __device__ __forceinline__ int lds_byte(int r, int c) { const int st = (r >> 4) * 2 + (c >> 5), rr = r & 15, cc = c & 31, ob = rr * 64 + cc * 2; return st * 1024 + (ob ^ (((ob >> 9) & 1) << 5)); }
__host__ __device__ __forceinline__ void stage_rc(int b, int& R, int& C) { const int st = b / 1024, sb = b % 1024, swz = sb ^ (((sb >> 9) & 1) << 5); R = (st >> 1) * 16 + swz / 64; C = (st & 1) * 32 + (swz % 64) / 2; }
__host__ __device__ __forceinline__ int perm32(int rho) { const int n = rho >> 4, i = rho & 15; return 8 * (i >> 2) + 4 * n + (i & 3); }

struct Unit { int pm, pn; };
struct Gemm { const bf16_t* A; const bf16_t* Bt; int M, N, K; };

struct StaticOrder {
    int nM, nN, nwg, G, c;
    __host__ __device__ void init(int M, int N, int G_, int c_) { nM = M / BM; nN = N / BM; nwg = nM * nN; G = G_; c = c_; }
    __host__ __device__ bool next(int i, Unit& u) const {
        const long L = (long)i * G + c; if (L >= nwg) return false;
        int wgid = (int)L; { const int q = nwg / NXCD, r = nwg % NXCD, xcd = wgid % NXCD, off = wgid / NXCD; wgid = (xcd < r ? xcd * (q + 1) : r * (q + 1) + (xcd - r) * q) + off; }
        const int nig = WGM * nN, gid = wgid / nig, fm = gid * WGM, gsz = (nM - fm) < WGM ? (nM - fm) : WGM;
        u.pm = fm + ((wgid % nig) % gsz); u.pn = (wgid % nig) / gsz; return true;
    }
    __device__ __forceinline__ void a_ready(const Unit&) const {}
    __device__ __forceinline__ void done(const Unit&) const {}
};

__device__ __forceinline__ unsigned cvt_pk_bf16(float lo, float hi) { unsigned r; asm volatile("v_cvt_pk_bf16_f32 %0, %1, %2" : "=v"(r) : "v"(lo), "v"(hi)); return r; }
typedef unsigned u32x2 __attribute__((ext_vector_type(2)));
__device__ __forceinline__ float row_rstd(const float* ss, int row) {
    const f32x4* p = (const f32x4*)(ss + (size_t)row * 16);
    const f32x4 a = p[0], b = p[1], c = p[2], d = p[3];
    const float s = (((a[0] + a[1]) + (a[2] + a[3])) + ((b[0] + b[1]) + (b[2] + b[3]))) + (((c[0] + c[1]) + (c[2] + c[3])) + ((d[0] + d[1]) + (d[2] + d[3])));
    return __builtin_amdgcn_rsqf(s * (1.0f / 1024.0f) + 1e-6f);
}
struct EpiBf16RS {
    static constexpr bool PERM = true, AFTER_DRAIN = false;
    bf16_t* O0; int ld0; int nt0; bf16_t* O1; bf16_t* O2; int ld1; const float* ss;
    __device__ __forceinline__ void operator()(const f32x4 (&acc)[2][2][4][2], const Unit& u, int wr, int wc, int fr, int fq) const {
        bf16_t* base; int ld, colt;
        if (u.pn < nt0) { base = O0; ld = ld0; colt = u.pn * BM; } else if (u.pn == nt0) { base = O1; ld = ld1; colt = 0; } else { base = O2; ld = ld1; colt = (u.pn - nt0 - 1) * BM; }
        const int row0 = u.pm * BM + wr * 64 + fr, col0 = colt + wc * 32 + 8 * fq;
#pragma unroll
        for (int ai = 0; ai < 2; ++ai)
#pragma unroll
            for (int m = 0; m < 4; ++m) { const int row = row0 + ai * HALF + m * 16; const float rs = row_rstd(ss, row); bf16_t* rowp = base + (size_t)row * ld + col0;
#pragma unroll
                for (int bj = 0; bj < 2; ++bj) { const f32x4 v0 = acc[ai][bj][m][0] * rs, v1 = acc[ai][bj][m][1] * rs;
                    u32x4 w; w.x = cvt_pk_bf16(v0[0], v0[1]); w.y = cvt_pk_bf16(v0[2], v0[3]); w.z = cvt_pk_bf16(v1[0], v1[1]); w.w = cvt_pk_bf16(v1[2], v1[3]);
                    *(u32x4*)(rowp + bj * HALF) = w; } }
    }
};
struct EpiResid {
    static constexpr bool PERM = false, AFTER_DRAIN = false;
    const float* base; float* out; bf16_t* xb; float* ss;
    __device__ __forceinline__ void operator()(const f32x4 (&acc)[2][2][4][2], const Unit& u, int wr, int wc, int fr, int fq) const {
        const int row0 = u.pm * BM + wr * 64 + fr, col0 = u.pn * BM + wc * 32 + 4 * fq;
#pragma unroll
        for (int ai = 0; ai < 2; ++ai)
#pragma unroll
            for (int m = 0; m < 4; ++m) { const int row = row0 + ai * HALF + m * 16; float sq = 0.f;
#pragma unroll
                for (int bj = 0; bj < 2; ++bj)
#pragma unroll
                    for (int n = 0; n < 2; ++n) { const size_t off = (size_t)row * 1024 + col0 + bj * HALF + n * 16;
                        const f32x4 o = *(const f32x4*)(base + off) + acc[ai][bj][m][n];
                        *(f32x4*)(out + off) = o; sq += (o[0] * o[0] + o[1] * o[1]) + (o[2] * o[2] + o[3] * o[3]);
                        u32x2 w; w.x = cvt_pk_bf16(o[0], o[1]); w.y = cvt_pk_bf16(o[2], o[3]); *(u32x2*)(xb + off) = w; }
                sq += __shfl_xor(sq, 16); sq += __shfl_xor(sq, 32);
                if (fq == 0) ss[(size_t)row * 16 + u.pn * 4 + wc] = sq; }
    }
};

template <class Epi, class Sched, bool ALIGN_EPI = false, bool SP2 = false>
__device__ __forceinline__ void gemm_phase(PG8_LAS unsigned char* lds, const Gemm g, const Sched& S, const Epi& E) {
    const int tid = threadIdx.x, wid = __builtin_amdgcn_readfirstlane(tid >> 6), lane = tid & 63, wr = wid >> 2, wc = wid & 3, fr = lane & 15, fq = lane >> 4;
    const int K = g.K, nt = K / BK;
    unsigned voffA[2], voffB[2];
#pragma unroll
    for (int i = 0; i < 2; ++i) { int R, C; stage_rc(tid * 16 + i * 8192, R, C); const int Rb = Epi::PERM ? ((R & ~31) + perm32(R & 31)) : R;
        voffA[i] = (unsigned)(R * K + C) * 2u; voffB[i] = (unsigned)(Rb * K + C) * 2u; }
    const size_t kstep = (size_t)(BK * 2);
    const size_t hstep = (size_t)HALF * K * 2;
    const size_t tstep = 2 * hstep;
    const unsigned ldsw = (unsigned)wid * 1024u;
    const int aoff = lds_byte(wr * 64 + fr, fq * 8), boff = lds_byte(wc * 32 + fr, fq * 8);
#define PG8_SA(b, h) (((b) * 2 + (h)) * HTB)
#define PG8_SB(b, h) ((4 + (b) * 2 + (h)) * HTB)
#define PG8_STAGE(bufoff, gbase, voff) do { _Pragma("unroll") for (int _i = 0; _i < 2; ++_i) \
        __builtin_amdgcn_global_load_lds((const unsigned*)((const char*)(gbase) + (voff)[_i]), (PG8_LAS unsigned*)(lds + (bufoff) + ldsw + _i * 8192), 16, 0, 0); } while (0)
#define PG8_LDA(dst, b, h) do { _Pragma("unroll") for (int m = 0; m < 4; ++m) _Pragma("unroll") for (int k = 0; k < 2; ++k) dst[m][k] = *(const PG8_LAS bf16x8*)(lds + PG8_SA(b, h) + aoff + m * 2048 + k * 1024); } while (0)
#define PG8_LDB(dst, b, h) do { _Pragma("unroll") for (int n = 0; n < 2; ++n) _Pragma("unroll") for (int k = 0; k < 2; ++k) dst[n][k] = *(const PG8_LAS bf16x8*)(lds + PG8_SB(b, h) + boff + n * 2048 + k * 1024); } while (0)
#define PG8_MMA(ai, bj, At, Bt) do { __builtin_amdgcn_s_setprio(1); _Pragma("unroll") for (int m = 0; m < 4; ++m) _Pragma("unroll") for (int n = 0; n < 2; ++n) _Pragma("unroll") for (int k = 0; k < 2; ++k) \
        acc[ai][bj][m][n] = __builtin_amdgcn_mfma_f32_16x16x32_bf16(Bt[n][k], At[m][k], acc[ai][bj][m][n], 0, 0, 0); __builtin_amdgcn_s_setprio(0); } while (0)
#define PG8_WAIT_V(n) asm volatile("s_waitcnt vmcnt(" #n ")" ::: "memory")
#define PG8_WAIT_L(n) asm volatile("s_waitcnt lgkmcnt(" #n ")" ::: "memory")
#define PG8_BAR __builtin_amdgcn_s_barrier()
#define PG8_SCHED __builtin_amdgcn_sched_barrier(0)
    Unit cur, nxt; int ui = 0;
    if (!S.next(0, cur)) return;
    f32x4 acc[2][2][4][2];
#pragma unroll
    for (int a = 0; a < 2; ++a)
#pragma unroll
        for (int b = 0; b < 2; ++b)
#pragma unroll
            for (int m = 0; m < 4; ++m)
#pragma unroll
                for (int n = 0; n < 2; ++n) acc[a][b][m][n] = (f32x4){0.f, 0.f, 0.f, 0.f};
    bf16x8 At[4][2], B0[2][2], B1[2][2];
    const char* cA = (const char*)g.A + (size_t)cur.pm * tstep; const char* cB = (const char*)g.Bt + (size_t)cur.pn * tstep;
    S.a_ready(cur);
    if constexpr (SP2) {
        PG8_STAGE(PG8_SB(0, 0), cB, voffB); PG8_STAGE(PG8_SB(0, 1), cB + hstep, voffB); PG8_STAGE(PG8_SA(0, 0), cA, voffA); PG8_STAGE(PG8_SA(0, 1), cA + hstep, voffA);
        if (wr == 1) PG8_BAR;
        PG8_WAIT_V(2); PG8_BAR;
        PG8_STAGE(PG8_SB(1, 0), cB + kstep, voffB); PG8_STAGE(PG8_SA(1, 0), cA + kstep, voffA); PG8_STAGE(PG8_SB(1, 1), cB + hstep + kstep, voffB);
        PG8_WAIT_V(6); PG8_BAR;
    } else {
        PG8_STAGE(PG8_SB(0, 0), cB, voffB); PG8_STAGE(PG8_SA(0, 0), cA, voffA); PG8_STAGE(PG8_SB(0, 1), cB + hstep, voffB); PG8_STAGE(PG8_SA(0, 1), cA + hstep, voffA);
        if (wr == 1) PG8_BAR;
        PG8_WAIT_V(4); PG8_BAR;
        PG8_STAGE(PG8_SB(1, 0), cB + kstep, voffB); PG8_STAGE(PG8_SA(1, 0), cA + kstep, voffA); PG8_STAGE(PG8_SB(1, 1), cB + hstep + kstep, voffB);
        PG8_WAIT_V(6); PG8_BAR;
    }
    for (;;) {
        const bool has_next = S.next(ui + 1, nxt);
        const char* nA = has_next ? (const char*)g.A + (size_t)nxt.pm * tstep : cA; const char* nB = has_next ? (const char*)g.Bt + (size_t)nxt.pn * tstep : cB;
        for (int t = 0; t < nt; t += 2) {
            const bool last = (t == nt - 2);
            const char* a1 = cA + (size_t)(t + 1) * kstep;
            const char* a2 = last ? nA : cA + (size_t)(t + 2) * kstep; const char* b2 = last ? nB : cB + (size_t)(t + 2) * kstep;
            const char* a3 = a2 + kstep; const char* b3 = b2 + kstep;
            if (last && has_next) S.a_ready(nxt);
            if constexpr (SP2) {
            PG8_LDB(B0, 0, 0); PG8_LDB(B1, 0, 1); PG8_SCHED; PG8_LDA(At, 0, 0); PG8_STAGE(PG8_SA(1, 1), a1 + hstep, voffA);
            PG8_WAIT_V(8); PG8_WAIT_L(0); PG8_BAR; PG8_MMA(0, 0, At, B0); PG8_MMA(0, 1, At, B1); PG8_BAR; PG8_SCHED;
            PG8_LDA(At, 0, 1); PG8_STAGE(PG8_SB(0, 0), b2, voffB); PG8_STAGE(PG8_SB(0, 1), b2 + hstep, voffB); PG8_STAGE(PG8_SA(0, 0), a2, voffA);
            PG8_WAIT_V(8); PG8_WAIT_L(0); PG8_BAR; PG8_MMA(1, 0, At, B0); PG8_MMA(1, 1, At, B1); PG8_BAR; PG8_SCHED;
            PG8_LDB(B0, 1, 0); PG8_LDB(B1, 1, 1); PG8_SCHED; PG8_LDA(At, 1, 0); PG8_STAGE(PG8_SA(0, 1), a2 + hstep, voffA);
            PG8_WAIT_V(8); PG8_WAIT_L(0); PG8_BAR; PG8_MMA(0, 0, At, B0); PG8_MMA(0, 1, At, B1); PG8_BAR; PG8_SCHED;
            PG8_LDA(At, 1, 1); PG8_STAGE(PG8_SB(1, 0), b3, voffB); PG8_STAGE(PG8_SB(1, 1), b3 + hstep, voffB); PG8_STAGE(PG8_SA(1, 0), a3, voffA);
            PG8_WAIT_V(8); PG8_WAIT_L(0); PG8_BAR; PG8_MMA(1, 0, At, B0); PG8_MMA(1, 1, At, B1); PG8_BAR; PG8_SCHED;
            } else {
            PG8_LDB(B0, 0, 0); PG8_SCHED; PG8_LDA(At, 0, 0); PG8_STAGE(PG8_SA(1, 1), a1 + hstep, voffA);
            PG8_WAIT_L(8); PG8_BAR; PG8_WAIT_L(0); PG8_MMA(0, 0, At, B0); PG8_BAR; PG8_SCHED;
            PG8_LDB(B1, 0, 1); PG8_STAGE(PG8_SB(0, 0), b2, voffB);
            PG8_BAR; PG8_WAIT_L(0); PG8_MMA(0, 1, At, B1); PG8_BAR;
            PG8_LDA(At, 0, 1); PG8_STAGE(PG8_SA(0, 0), a2, voffA);
            PG8_BAR; PG8_WAIT_L(0); PG8_MMA(1, 0, At, B0); PG8_BAR; PG8_SCHED;
            PG8_STAGE(PG8_SB(0, 1), b2 + hstep, voffB);
            PG8_WAIT_V(6); PG8_BAR; PG8_MMA(1, 1, At, B1); PG8_BAR;
            PG8_LDB(B0, 1, 0); PG8_SCHED; PG8_LDA(At, 1, 0); PG8_STAGE(PG8_SA(0, 1), a2 + hstep, voffA);
            PG8_WAIT_L(8); PG8_BAR; PG8_WAIT_L(0); PG8_MMA(0, 0, At, B0); PG8_BAR; PG8_SCHED;
            PG8_LDB(B1, 1, 1); PG8_STAGE(PG8_SB(1, 0), b3, voffB);
            PG8_BAR; PG8_WAIT_L(0); PG8_MMA(0, 1, At, B1); PG8_BAR;
            PG8_LDA(At, 1, 1); PG8_STAGE(PG8_SA(1, 0), a3, voffA);
            PG8_BAR; PG8_WAIT_L(0); PG8_MMA(1, 0, At, B0); PG8_BAR; PG8_SCHED;
            PG8_STAGE(PG8_SB(1, 1), b3 + hstep, voffB);
            PG8_WAIT_V(6); PG8_BAR; PG8_MMA(1, 1, At, B1); PG8_BAR;
            }
        }
        if constexpr (ALIGN_EPI) { if (wr == 0) PG8_BAR; }
        if constexpr (!Epi::AFTER_DRAIN) { E(acc, cur, wr, wc, fr, fq); S.done(cur); }
        if (!has_next) break;
#pragma unroll
        for (int a = 0; a < 2; ++a)
#pragma unroll
            for (int b = 0; b < 2; ++b)
#pragma unroll
                for (int m = 0; m < 4; ++m)
#pragma unroll
                    for (int n = 0; n < 2; ++n) acc[a][b][m][n] = (f32x4){0.f, 0.f, 0.f, 0.f};
        cur = nxt; cA = nA; cB = nB; ++ui;
        if constexpr (ALIGN_EPI) { if (wr == 1) PG8_BAR; }
    }
    PG8_WAIT_V(0);
    if constexpr (!ALIGN_EPI) { if (wr == 0) PG8_BAR; }
    PG8_BAR;
    if constexpr (Epi::AFTER_DRAIN) { E.fused(acc, cur, wr, wc, fr, fq, lds, wid, lane); S.done(cur); }
#undef PG8_SA
#undef PG8_SB
#undef PG8_STAGE
#undef PG8_LDA
#undef PG8_LDB
#undef PG8_MMA
#undef PG8_WAIT_V
#undef PG8_WAIT_L
#undef PG8_BAR
#undef PG8_SCHED
}
}

constexpr int NWAVES = 8;
constexpr int BATCH = 2, SEQ = 8192, D = 1024, T = BATCH * SEQ;
constexpr int NIN = 3072, NQKV = 1536, NPQ = 2048, NEXP = 16384;
constexpr float LOG2E = 1.4426950408889634f;
constexpr float QSCALE = 0.125f * LOG2E;
constexpr float NEGBIG = -1e30f;
#ifndef MK_PER_PHASE
#define MK_PER_PHASE 0
#endif
constexpr int NPH = 18;
#ifndef REP_MASK
#define REP_MASK 0
#endif
#define REPS(k) for (int rep_ = 0; rep_ < (((REP_MASK) >> (k)) & 1) + 1; ++rep_)

constexpr size_t MiB = 1u << 20;
constexpr size_t WS_CTL = 0, CTL_ZERO_BYTES = 65536;
constexpr size_t WS_WIN = 1 * MiB, WS_WOUT = 7 * MiB, WS_WQKV = 9 * MiB, WS_WO = 12 * MiB, WS_WPQ = 14 * MiB, WS_SK = 22 * MiB;
constexpr size_t WS_SS = 23 * MiB;
constexpr size_t WS_IDX = 28 * MiB, WS_GATE = 36 * MiB, WS_XB = 44 * MiB, WS_Y = 76 * MiB, WS_U = 108 * MiB, WS_V = 172 * MiB;
constexpr size_t WS_G1 = 236 * MiB, WS_PQ = 332 * MiB, WS_Q = 396 * MiB, WS_K = 428 * MiB, WS_VV = 436 * MiB, WS_AO = 444 * MiB, WS_END = 476 * MiB;
constexpr size_t WS_HP = WS_G1, WS_A = WS_G1 + 64 * MiB;
constexpr int CW_BAR = 4096;
constexpr int CW_WQ = 8192;

constexpr int RING_BYTES = 131072;
constexpr int LDSCTL_OFF = RING_BYTES, MISC_OFF = LDSCTL_OFF + 320;
constexpr int LDS_BYTES = 147456;

#define LAS __attribute__((address_space(3)))
typedef unsigned short bf16;
typedef unsigned v4u __attribute__((ext_vector_type(4)));
typedef unsigned v2u __attribute__((ext_vector_type(2)));
typedef float f32x4 __attribute__((ext_vector_type(4)));
typedef float f32x2 __attribute__((ext_vector_type(2)));
typedef float f32x16 __attribute__((ext_vector_type(16)));
typedef short bf16x8 __attribute__((ext_vector_type(8)));
typedef __bf16 bf16x2_t __attribute__((ext_vector_type(2)));
#define LDS_WAIT() asm volatile("s_waitcnt lgkmcnt(0)" ::: "memory")
#define DI __device__ __forceinline__

DI unsigned pk2(float lo, float hi) { f32x2 v = {lo, hi}; bf16x2_t b = __builtin_convertvector(v, bf16x2_t); return __builtin_bit_cast(unsigned, b); }
DI float bf_lo(unsigned u) { return __uint_as_float(u << 16); }
DI float bf_hi(unsigned u) { return __uint_as_float(u & 0xffff0000u); }
DI float wave_sum(float v) {
#pragma unroll
    for (int o = 1; o < 64; o <<= 1) v += __shfl_xor(v, o);
    return v;
}
#define XB_TMO      128
#define XB_XCNT(j)  (256  + 64 * (j))
#define XB_XSUB(j)  (1280 + 64 * (j))
#define XB_XGEN(j)  (2304 + 64 * (j))
#define XB_TOP      3328
#define XB_TOPGEN   3392
#define XCD_BAR_WORDS 3456
#define XB_SPIN_CAP (1u << 18)

__device__ __forceinline__ unsigned xb_ld(unsigned* p)              { return __hip_atomic_load(p, __ATOMIC_RELAXED, __HIP_MEMORY_SCOPE_AGENT); }
__device__ __forceinline__ unsigned xb_add(unsigned* p, unsigned v) { return __hip_atomic_fetch_add(p, v, __ATOMIC_RELAXED, __HIP_MEMORY_SCOPE_AGENT); }
__device__ __forceinline__ unsigned xb_xcc_id() { return (unsigned)__builtin_amdgcn_s_getreg((3 << 11) | 20) & 0xFu; }
#define XB_SPIN(cond, bar) do { unsigned _sp = 0; while (cond) { __builtin_amdgcn_s_sleep(1); \
    if ((++_sp & 255u) == 0u) { if (xb_ld(&(bar)[XB_TMO])) break; if (_sp > XB_SPIN_CAP) { atomicAdd(&(bar)[XB_TMO], 1u); break; } } } } while (0)

struct XcdBarrier {
    unsigned* bar; unsigned x;
    volatile LAS unsigned* st;
};

__device__ __forceinline__ XcdBarrier xcd_barrier_post(unsigned* bar, volatile LAS unsigned* st) {
    XcdBarrier b; b.bar = bar; b.x = xb_xcc_id(); b.st = st;
    if (threadIdx.x == 0) (void)xb_add(&bar[XB_XCNT(b.x)], 1u);
    return b;
}
__device__ __forceinline__ void xcd_barrier_complete(unsigned* bar, unsigned x, unsigned& nloc, unsigned& nx) {
    const unsigned G = gridDim.x * gridDim.y * gridDim.z;
    unsigned sum, cnt, mine, sp = 0u;
    for (;;) {
        sum = 0u; cnt = 0u; mine = 0u;
#pragma unroll
        for (unsigned j = 0; j < 16; ++j) { const unsigned c = xb_ld(&bar[XB_XCNT(j)]); sum += c; cnt += (c > 0u) ? 1u : 0u; mine = (j == x) ? c : mine; }
        if (sum == G) break;
        __builtin_amdgcn_s_sleep(1);
        if ((++sp & 255u) == 0u) { if (xb_ld(&bar[XB_TMO])) break; if (sp > XB_SPIN_CAP) { atomicAdd(&bar[XB_TMO], 1u); break; } }
    }
    nloc = mine > 0u ? mine : 1u; nx = cnt > 0u ? cnt : 1u;
}

__device__ __forceinline__ void xcd_barrier(const XcdBarrier& b) {
    asm volatile("s_waitcnt vmcnt(0)" ::: "memory");
    __syncthreads();
    if (threadIdx.x == 0) {
        unsigned* bar = b.bar;
        __builtin_amdgcn_s_waitcnt(0);
        unsigned nloc = b.st[0], nx = b.st[1];
        if (nloc == 0u) { xcd_barrier_complete(bar, b.x, nloc, nx); b.st[0] = nloc; b.st[1] = nx; }
        const unsigned old = xb_add(&bar[XB_XSUB(b.x)], 1u);
        const unsigned gen = old / nloc;
        if (old + 1u == (gen + 1u) * nloc) {
            __builtin_amdgcn_fence(__ATOMIC_RELEASE, "agent");
            asm volatile("s_waitcnt vmcnt(0)" ::: "memory");
            const unsigned og = xb_add(&bar[XB_TOP], 1u);
            const unsigned tg = og / nx;
            if (og + 1u == (tg + 1u) * nx) xb_add(&bar[XB_TOPGEN], 1u);
            else XB_SPIN(xb_ld(&bar[XB_TOPGEN]) == tg, bar);
            __builtin_amdgcn_fence(__ATOMIC_ACQUIRE, "agent");
            xb_add(&bar[XB_XGEN(b.x)], 1u);
            asm volatile("s_waitcnt vmcnt(0)" ::: "memory");
        } else {
            XB_SPIN(xb_ld(&bar[XB_XGEN(b.x)]) == gen, bar);
            __builtin_amdgcn_fence(__ATOMIC_ACQUIRE, "agent");
            asm volatile("s_waitcnt vmcnt(0)" ::: "memory");
        }
    }
    __syncthreads();
}

DI void p0_transpose_item(const float* W, int K, int N, bf16* WT, LAS float* scr, int item, int lane, const float* gain, int nscaled, float cscale) {
    const int nblk = N / 32, kb = item / nblk, nb = item % nblk, k0 = 64 * kb, n0 = 32 * nb;
#pragma unroll 8
    for (int i = 0; i < 32; ++i) { const int kk = 2 * i + (lane >> 5); float v = W[(size_t)(k0 + kk) * N + n0 + (lane & 31)]; if (gain) v *= gain[k0 + kk]; scr[kk * 33 + (lane & 31)] = v; }
    LDS_WAIT();
    const int c = lane & 7;
#pragma unroll
    for (int j = 0; j < 4; ++j) { const int n = (lane >> 3) + 8 * j; const LAS float* s = scr + (8 * c) * 33 + n; const float cs = (n0 + n < nscaled) ? cscale : 1.f;
        v4u o; o.x = pk2(s[0 * 33] * cs, s[1 * 33] * cs); o.y = pk2(s[2 * 33] * cs, s[3 * 33] * cs); o.z = pk2(s[4 * 33] * cs, s[5 * 33] * cs); o.w = pk2(s[6 * 33] * cs, s[7 * 33] * cs);
        *(v4u*)(WT + (size_t)(n0 + n) * K + k0 + 8 * c) = o; }
    LDS_WAIT();
}
struct P0Args { const float *x, *conv_g, *w_in, *w_out, *attn_g, *w_qkv, *w_o, *ffn_g, *w_pq, *subk, *pu, *pv;
                bf16 *WinT, *WoutT, *WqkvT, *WoT, *WpqT, *SKb; unsigned char *U8, *V8; bf16* XB; float* SS0; };
DI void p0_prologue(const P0Args& a, LAS unsigned char* lds, int vcu, int G, int wave, int lane, int tid) {
    LAS float* scr = (LAS float*)(lds + wave * 16384);
    const int gw = vcu * NWAVES + wave, NGW = G * NWAVES;
    constexpr int I_IN = 16 * (NIN / 32), I_OUT = 16 * (D / 32), I_QKV = 16 * (NQKV / 32), I_O = I_OUT, I_PQ = 16 * (NPQ / 32);
    constexpr int NITEMS = I_IN + I_OUT + I_QKV + I_O + 2 * I_PQ;
    for (int it = gw; it < NITEMS; it += NGW) {
        int r = it;
        if (r < I_IN) { p0_transpose_item(a.w_in, D, NIN, a.WinT, scr, r, lane, a.conv_g, 0, 1.f); continue; } r -= I_IN;
        if (r < I_OUT) { p0_transpose_item(a.w_out, D, D, a.WoutT, scr, r, lane, nullptr, 0, 1.f); continue; } r -= I_OUT;
        if (r < I_QKV) { p0_transpose_item(a.w_qkv, D, NQKV, a.WqkvT, scr, r, lane, a.attn_g, 1024, QSCALE); continue; } r -= I_QKV;
        if (r < I_O) { p0_transpose_item(a.w_o, D, D, a.WoT, scr, r, lane, nullptr, 0, 1.f); continue; } r -= I_O;
        if (r < I_PQ) { p0_transpose_item(a.w_pq, D, NPQ, a.WpqT, scr, r, lane, a.ffn_g, 0, 1.f); continue; } r -= I_PQ;
        p0_transpose_item(a.w_pq + (size_t)D * NPQ, D, NPQ, a.WpqT + (size_t)NPQ * D, scr, r, lane, a.ffn_g + D, 0, 1.f);
    }
    const size_t gt = (size_t)vcu * (NWAVES * 64) + tid, NGT = (size_t)G * NWAVES * 64;
    constexpr size_t C_SK = (size_t)2 * 8 * 2 * 128 * 128 / 8;
    for (size_t c = gt; c < C_SK; c += NGT) { const f32x4 v0 = *(const f32x4*)(a.subk + c * 8), v1 = *(const f32x4*)(a.subk + c * 8 + 4);
        v4u o; o.x = pk2(v0[0], v0[1]); o.y = pk2(v0[2], v0[3]); o.z = pk2(v1[0], v1[1]); o.w = pk2(v1[2], v1[3]); *(v4u*)(a.SKb + c * 8) = o; }
    constexpr size_t C_T16 = (size_t)2 * NEXP * D / 16;
    for (size_t c = gt; c < C_T16; c += NGT) { const int layer = (int)(c / ((size_t)NEXP * D / 16)), d0 = (int)(c % (D / 16)) * 16;
        v4u o;
#pragma unroll
        for (int q = 0; q < 4; ++q) { const f32x4 g = *(const f32x4*)(a.ffn_g + layer * D + d0 + 4 * q);
            const f32x4 v = __builtin_nontemporal_load((const f32x4*)(a.pu + c * 16 + 4 * q)) * g * 512.0f;
            unsigned w = 0u;
#pragma unroll
            for (int e = 0; e < 4; ++e) { const int qi = (int)__builtin_rintf(fminf(fmaxf(v[e], -127.f), 127.f)); w |= ((unsigned)qi & 0xffu) << (8 * e); }
            o[q] = w; }
        *(v4u*)(a.U8 + c * 16) = o; }
    for (size_t c = gt; c < C_T16; c += NGT) {
        v4u o;
#pragma unroll
        for (int q = 0; q < 4; ++q) { const f32x4 v = __builtin_nontemporal_load((const f32x4*)(a.pv + c * 16 + 4 * q)) * 1024.0f;
            int w = __builtin_amdgcn_cvt_pk_fp8_f32(v[0], v[1], 0, false); w = __builtin_amdgcn_cvt_pk_fp8_f32(v[2], v[3], w, true); o[q] = (unsigned)w; }
        *(v4u*)(a.V8 + c * 16) = o; }
    for (int m = gw; m < T; m += NGW) {
        const f32x4* xr = (const f32x4*)(a.x + (size_t)m * D) + lane; float s = 0.f; f32x4 v[4];
#pragma unroll
        for (int j = 0; j < 4; ++j) { v[j] = xr[64 * j]; s += (v[j][0] * v[j][0] + v[j][1] * v[j][1]) + (v[j][2] * v[j][2] + v[j][3] * v[j][3]); }
        s = wave_sum(s);
        v2u* o8 = (v2u*)(a.XB + (size_t)m * D) + lane;
#pragma unroll
        for (int j = 0; j < 4; ++j) { v2u w; w.x = pk2(v[j][0], v[j][1]); w.y = pk2(v[j][2], v[j][3]); o8[64 * j] = w; }
        if (lane < 4) { f32x4 z = {0.f, 0.f, 0.f, 0.f}; ((f32x4*)(a.SS0 + (size_t)(2 * T + m) * 16))[lane] = z; ((f32x4*)(a.SS0 + (size_t)(4 * T + m) * 16))[lane] = z;
            if (lane == 0) z[0] = s; ((f32x4*)(a.SS0 + (size_t)m * 16))[lane] = z; }
    }
}

DI void conv_gate_phase(const bf16* G1, const float* cw, bf16* Y, int vcu, int G, int tid) {
    const size_t gt = (size_t)vcu * (NWAVES * 64) + tid, NGT = (size_t)G * NWAVES * 64;
    for (size_t c = gt; c < (size_t)T * (D / 8); c += NGT) {
        const int t = (int)(c / (D / 8)), d0 = (int)(c % (D / 8)) * 8, ts = t % SEQ;
        const v4u gb = *(const v4u*)(G1 + (size_t)t * NIN + d0);
        float acc[8];
#pragma unroll
        for (int i = 0; i < 8; ++i) acc[i] = 0.f;
#pragma unroll
        for (int w = 0; w < 3; ++w) { const int tt = ts + w - 1;
            if (tt >= 0 && tt < SEQ) {
                const v4u gc = *(const v4u*)(G1 + (size_t)(t + w - 1) * NIN + D + d0), hh = *(const v4u*)(G1 + (size_t)(t + w - 1) * NIN + 2 * D + d0);
                const f32x4 w0 = *(const f32x4*)(cw + w * D + d0), w1 = *(const f32x4*)(cw + w * D + d0 + 4);
                acc[0] += w0[0] * (bf_lo(gc.x) * bf_lo(hh.x)); acc[1] += w0[1] * (bf_hi(gc.x) * bf_hi(hh.x));
                acc[2] += w0[2] * (bf_lo(gc.y) * bf_lo(hh.y)); acc[3] += w0[3] * (bf_hi(gc.y) * bf_hi(hh.y));
                acc[4] += w1[0] * (bf_lo(gc.z) * bf_lo(hh.z)); acc[5] += w1[1] * (bf_hi(gc.z) * bf_hi(hh.z));
                acc[6] += w1[2] * (bf_lo(gc.w) * bf_lo(hh.w)); acc[7] += w1[3] * (bf_hi(gc.w) * bf_hi(hh.w)); } }
        v4u o; o.x = pk2(acc[0] * bf_lo(gb.x), acc[1] * bf_hi(gb.x)); o.y = pk2(acc[2] * bf_lo(gb.y), acc[3] * bf_hi(gb.y));
        o.z = pk2(acc[4] * bf_lo(gb.z), acc[5] * bf_hi(gb.z)); o.w = pk2(acc[6] * bf_lo(gb.w), acc[7] * bf_hi(gb.w));
        *(v4u*)(Y + (size_t)t * D + d0) = o;
    }
}

template <int CTRL> DI unsigned dppu(unsigned v) { return (unsigned)__builtin_amdgcn_update_dpp(0, (int)v, CTRL, 0xf, 0xf, false); }
DI unsigned umax(unsigned a, unsigned b) { return a > b ? a : b; }
DI unsigned umin(unsigned a, unsigned b) { return a < b ? a : b; }
DI unsigned rowmax_u(unsigned v) { v = umax(v, dppu<0x128>(v)); v = umax(v, dppu<0x124>(v)); v = umax(v, dppu<0x122>(v)); v = umax(v, dppu<0x121>(v)); return v; }
DI float rowsum_f(float v) { v += __uint_as_float(dppu<0x128>(__float_as_uint(v))); v += __uint_as_float(dppu<0x124>(__float_as_uint(v))); v += __uint_as_float(dppu<0x122>(__float_as_uint(v))); v += __uint_as_float(dppu<0x121>(__float_as_uint(v))); return v; }
DI unsigned f2key(float f) { const unsigned u = __float_as_uint(f); return u ^ ((unsigned)((int)u >> 31) | 0x80000000u); }
DI float key2f(unsigned k) { const unsigned u = (k & 0x80000000u) ? (k ^ 0x80000000u) : ~k; return __uint_as_float(u); }
DI unsigned cand_ij(int c) {
    unsigned i, j;
    if (c < 16) { i = 0; j = c; } else if (c < 24) { i = 1; j = c - 16; } else if (c < 29) { i = 2; j = c - 24; } else if (c < 33) { i = 3; j = c - 29; }
    else if (c < 36) { i = 4; j = c - 33; } else if (c < 38) { i = 5; j = c - 36; } else if (c < 40) { i = 6; j = c - 38; } else if (c < 42) { i = 7; j = c - 40; }
    else { i = 8 + (c - 42); j = 0; }
    return (i & 15u) | (j << 4);
}
#define CE_DESC(a, b) do { const unsigned _hi = umax(a, b), _lo = umin(a, b); a = _hi; b = _lo; } while (0)
DI void route_phase(const bf16* PQ, const bf16* SK, unsigned short* IDX, float* GATE, LAS unsigned char* lds, int vcu, int G, int wave, int lane, int tid) {
    const int fr = lane & 15, fq = lane >> 4;
    LAS unsigned char* TAB = lds;
    LAS unsigned char* SKL = lds + 256;
    if (tid < 64) TAB[tid] = (unsigned char)(tid < 50 ? cand_ij(tid) : 0xff);
    LAS unsigned* gcnt = (LAS unsigned*)(lds + 128);
    constexpr int NITEM = (T / 128) * 8;
    for (int item0 = vcu; item0 < NITEM; ) {
        const int h = item0 & 7; int nrun = 0;
        for (int it = item0; it < NITEM && (it & 7) == h; it += G) ++nrun;
        __syncthreads();
        for (int c = tid; c < 2 * 128 * 16; c += NWAVES * 64) { const int row = c >> 4, c16 = c & 15;
            *(LAS v4u*)(SKL + row * 272 + c16 * 16) = *(const v4u*)(SK + (size_t)(h * 256 + row) * 128 + c16 * 8); }
        if (tid == 0) *gcnt = 0u;
        __syncthreads();
      for (;;) {
        unsigned grp = 0u; if (lane == 0) grp = __hip_atomic_fetch_add(gcnt, 1u, __ATOMIC_RELAXED, __HIP_MEMORY_SCOPE_WORKGROUP);
        grp = (unsigned)__builtin_amdgcn_readfirstlane((int)grp);
        if (grp >= (unsigned)(nrun * 8)) break;
        const int tile = (item0 + (int)(grp >> 3) * G) >> 3, t0 = tile * 128 + (int)(grp & 7u) * 16;
        unsigned res[2][4];
#pragma unroll
        for (int p = 0; p < 2; ++p) {
            bf16x8 af[4];
#pragma unroll
            for (int ks = 0; ks < 4; ++ks) af[ks] = *(const bf16x8*)(PQ + (size_t)(t0 + fr) * NPQ + h * 256 + p * 128 + ks * 32 + fq * 8);
            f32x4 acc[8];
#pragma unroll
            for (int n = 0; n < 8; ++n) { acc[n] = (f32x4){0.f, 0.f, 0.f, 0.f};
#pragma unroll
                for (int ks = 0; ks < 4; ++ks) { const bf16x8 bfr = *(const LAS bf16x8*)(SKL + (p * 128 + n * 16 + fr) * 272 + ks * 64 + fq * 16);
                    acc[n] = __builtin_amdgcn_mfma_f32_16x16x32_bf16(af[ks], bfr, acc[n], 0, 0, 0); } }
            unsigned L[4][8];
#pragma unroll
            for (int r = 0; r < 4; ++r)
#pragma unroll
                for (int n = 0; n < 8; ++n) L[r][n] = (f2key(acc[n][r]) & ~127u) | (unsigned)(127 - (16 * n + fr));
#define CE4(i, j) do { _Pragma("unroll") for (int r = 0; r < 4; ++r) CE_DESC(L[r][i], L[r][j]); } while (0)
            CE4(0, 1); CE4(2, 3); CE4(4, 5); CE4(6, 7);
            CE4(0, 2); CE4(1, 3); CE4(4, 6); CE4(5, 7);
            CE4(1, 2); CE4(5, 6); CE4(0, 4); CE4(3, 7);
            CE4(1, 5); CE4(2, 6);
            CE4(1, 4); CE4(3, 6);
            CE4(2, 4); CE4(3, 5);
            CE4(3, 4);
#undef CE4
            unsigned rr[4] = {0u, 0u, 0u, 0u};
#pragma unroll
            for (int k = 0; k < 16; ++k) {
                unsigned gm[4];
#pragma unroll
                for (int r = 0; r < 4; ++r) gm[r] = umax(L[r][0], dppu<0x128>(L[r][0]));
#pragma unroll
                for (int r = 0; r < 4; ++r) gm[r] = umax(gm[r], dppu<0x124>(gm[r]));
#pragma unroll
                for (int r = 0; r < 4; ++r) gm[r] = umax(gm[r], dppu<0x122>(gm[r]));
#pragma unroll
                for (int r = 0; r < 4; ++r) gm[r] = umax(gm[r], dppu<0x121>(gm[r]));
#pragma unroll
                for (int r = 0; r < 4; ++r) { rr[r] = (fr == k) ? gm[r] : rr[r]; const bool pop = (L[r][0] == gm[r]);
#pragma unroll
                    for (int n = 0; n < 7; ++n) L[r][n] = pop ? L[r][n + 1] : L[r][n];
                    L[r][7] = pop ? 0u : L[r][7]; }
            }
#pragma unroll
            for (int r = 0; r < 4; ++r) res[p][r] = rr[r];
        }
        const int gbase = (lane & 48) * 4;
        unsigned ck[4][4];
#pragma unroll
        for (int r = 0; r < 4; ++r)
#pragma unroll
            for (int s = 0; s < 4; ++s) { const int c = fr + 16 * s; const unsigned tb = TAB[c & 63];
                const unsigned k0 = (unsigned)__builtin_amdgcn_ds_bpermute(gbase + (int)(tb & 15u) * 4, (int)res[0][r]);
                const unsigned k1 = (unsigned)__builtin_amdgcn_ds_bpermute(gbase + (int)((tb >> 4) & 15u) * 4, (int)res[1][r]);
                const float v = key2f((k0 & ~127u) | 64u) + key2f((k1 & ~127u) | 64u);
                ck[r][s] = (c < 50) ? ((f2key(v) & ~63u) | (unsigned)(63 - c)) : 0u; }
        unsigned sel[4] = {0u, 0u, 0u, 0u};
#pragma unroll
        for (int k = 0; k < 16; ++k) {
            unsigned gm[4];
#pragma unroll
            for (int r = 0; r < 4; ++r) { const unsigned lm = umax(umax(ck[r][0], ck[r][1]), umax(ck[r][2], ck[r][3])); gm[r] = umax(lm, dppu<0x128>(lm)); }
#pragma unroll
            for (int r = 0; r < 4; ++r) gm[r] = umax(gm[r], dppu<0x124>(gm[r]));
#pragma unroll
            for (int r = 0; r < 4; ++r) gm[r] = umax(gm[r], dppu<0x122>(gm[r]));
#pragma unroll
            for (int r = 0; r < 4; ++r) gm[r] = umax(gm[r], dppu<0x121>(gm[r]));
#pragma unroll
            for (int r = 0; r < 4; ++r) { sel[r] = (fr == k) ? gm[r] : sel[r];
#pragma unroll
                for (int s = 0; s < 4; ++s) ck[r][s] = (ck[r][s] == gm[r]) ? 0u : ck[r][s]; }
        }
#pragma unroll
        for (int r = 0; r < 4; ++r) {
            const int t = t0 + 4 * fq + r;
            const int cs = 63 - (int)(sel[r] & 63u); const unsigned tb = TAB[cs & 63];
            const unsigned k0 = (unsigned)__builtin_amdgcn_ds_bpermute(gbase + (int)(tb & 15u) * 4, (int)res[0][r]);
            const unsigned k1 = (unsigned)__builtin_amdgcn_ds_bpermute(gbase + (int)((tb >> 4) & 15u) * 4, (int)res[1][r]);
            const int e = (127 - (int)(k0 & 127u)) * 128 + (127 - (int)(k1 & 127u));
            const float val = key2f((sel[r] & ~63u) | 32u), top = key2f((rowmax_u(sel[r]) & ~63u) | 32u);
            const float ex = __builtin_amdgcn_exp2f((val - top) * LOG2E), sum = rowsum_f(ex);
            IDX[(size_t)t * 128 + h * 16 + fr] = (unsigned short)e; GATE[(size_t)t * 128 + h * 16 + fr] = ex / sum;
        }
      }
        item0 += nrun * G;
    }
}

DI float dot8(v4u x, v4u u, float acc) {
    acc += bf_lo(x.x) * bf_lo(u.x); acc += bf_hi(x.x) * bf_hi(u.x); acc += bf_lo(x.y) * bf_lo(u.y); acc += bf_hi(x.y) * bf_hi(u.y);
    acc += bf_lo(x.z) * bf_lo(u.z); acc += bf_hi(x.z) * bf_hi(u.z); acc += bf_lo(x.w) * bf_lo(u.w); acc += bf_hi(x.w) * bf_hi(u.w);
    return acc;
}
DI void fma8(float* acc, float a, v4u v) {
    acc[0] += a * bf_lo(v.x); acc[1] += a * bf_hi(v.x); acc[2] += a * bf_lo(v.y); acc[3] += a * bf_hi(v.y);
    acc[4] += a * bf_lo(v.z); acc[5] += a * bf_hi(v.z); acc[6] += a * bf_lo(v.w); acc[7] += a * bf_hi(v.w);
}
DI f32x2 fp8lo(unsigned w) { return __builtin_amdgcn_cvt_pk_f32_fp8((int)w, false); }
DI f32x2 fp8hi(unsigned w) { return __builtin_amdgcn_cvt_pk_f32_fp8((int)w, true); }

template <int CTRL> DI float dppf(float v) { return __uint_as_float(dppu<CTRL>(__float_as_uint(v))); }
struct UTok { v4u xa, xb; v4u uw[16]; };
DI void u_issue(UTok& S, const unsigned char* U8s, const unsigned short* IDX, const bf16* XB, int t, int s, int lane) {
    const int g = lane >> 3, k = lane & 7;
    const int i0 = IDX[(size_t)t * 128 + lane], i1 = IDX[(size_t)t * 128 + 64 + lane];
    const v4u* xr = (const v4u*)(XB + (size_t)t * D + 128 * s + 16 * k);
    S.xa = xr[0]; S.xb = xr[1];
#pragma unroll
    for (int i = 0; i < 16; ++i) { const unsigned idx = (unsigned)__builtin_amdgcn_ds_bpermute((8 * (i & 7) + g) * 4, i < 8 ? i0 : i1);
        S.uw[i] = *(const v4u*)(U8s + (idx * 1024u + 16u * (unsigned)k)); }
}
DI void u_compute(const UTok& S, float* HPs, int t, int lane) {
    const int g = lane >> 3, k = lane & 7;
    const v4u xa = S.xa, xb = S.xb;
    float xv[16];
    xv[0] = bf_lo(xa.x); xv[1] = bf_hi(xa.x); xv[2] = bf_lo(xa.y); xv[3] = bf_hi(xa.y); xv[4] = bf_lo(xa.z); xv[5] = bf_hi(xa.z); xv[6] = bf_lo(xa.w); xv[7] = bf_hi(xa.w);
    xv[8] = bf_lo(xb.x); xv[9] = bf_hi(xb.x); xv[10] = bf_lo(xb.y); xv[11] = bf_hi(xb.y); xv[12] = bf_lo(xb.z); xv[13] = bf_hi(xb.z); xv[14] = bf_lo(xb.w); xv[15] = bf_hi(xb.w);
    float am = 0.f;
#pragma unroll
    for (int i = 0; i < 16; ++i) am = fmaxf(am, __builtin_fabsf(xv[i]));
    am = fmaxf(am, dppf<0xB1>(am)); am = fmaxf(am, dppf<0x4E>(am)); am = fmaxf(am, dppf<0x141>(am));
    am = fmaxf(am, 1e-20f);
    const float qs = 127.0f / am, dq = am * (1.0f / (127.0f * 512.0f));
    unsigned xq[4];
#pragma unroll
    for (int q = 0; q < 4; ++q) { unsigned w = 0u;
#pragma unroll
        for (int e = 0; e < 4; ++e) { const int qi = (int)__builtin_rintf(xv[4 * q + e] * qs); w |= ((unsigned)qi & 0xffu) << (8 * e); }
        xq[q] = w; }
    int p[16];
#pragma unroll
    for (int i = 0; i < 16; ++i) { int a0 = __builtin_amdgcn_sdot4((int)xq[0], (int)S.uw[i][0], 0, false), a1 = __builtin_amdgcn_sdot4((int)xq[1], (int)S.uw[i][1], 0, false);
        a0 = __builtin_amdgcn_sdot4((int)xq[2], (int)S.uw[i][2], a0, false); a1 = __builtin_amdgcn_sdot4((int)xq[3], (int)S.uw[i][3], a1, false);
        p[i] = a0 + a1; }
    const bool h4 = k >= 4, h1 = k & 1, h2 = k & 2;
    int q8[8], q4[4], q2[2];
#pragma unroll
    for (int j = 0; j < 8; ++j) { const int keep = h4 ? p[8 + j] : p[j], send = h4 ? p[j] : p[8 + j]; q8[j] = keep + (int)dppu<0x141>((unsigned)send); }
#pragma unroll
    for (int j = 0; j < 4; ++j) { const int keep = h1 ? q8[4 + j] : q8[j], send = h1 ? q8[j] : q8[4 + j]; q4[j] = keep + (int)dppu<0xB1>((unsigned)send); }
#pragma unroll
    for (int j = 0; j < 2; ++j) { const int keep = h2 ? q4[2 + j] : q4[j], send = h2 ? q4[j] : q4[2 + j]; q2[j] = keep + (int)dppu<0x4E>((unsigned)send); }
    const int ib = (h4 ? 8 : 0) + (h1 ? 4 : 0) + (h2 ? 2 : 0);
    HPs[(size_t)t * 128 + 8 * ib + g] = (float)q2[0] * dq; HPs[(size_t)t * 128 + 8 * ib + 8 + g] = (float)q2[1] * dq;
}
struct VTok { v4u vw[16]; float av[16]; };
DI void v_issue(VTok& S, const unsigned char* V8s, const unsigned short* IDX, const float* A, int t, int lane) {
    const int g = lane >> 3, k = lane & 7;
    const int i0 = IDX[(size_t)t * 128 + lane], i1 = IDX[(size_t)t * 128 + 64 + lane];
    const float a0 = A[(size_t)t * 128 + lane], a1 = A[(size_t)t * 128 + 64 + lane];
#pragma unroll
    for (int i = 0; i < 16; ++i) { const int ad = (8 * (i & 7) + g) * 4; const int idx = __builtin_amdgcn_ds_bpermute(ad, i < 8 ? i0 : i1);
        S.av[i] = __uint_as_float((unsigned)__builtin_amdgcn_ds_bpermute(ad, (int)__float_as_uint(i < 8 ? a0 : a1)));
        S.vw[i] = *(const v4u*)(V8s + ((unsigned)idx * 1024u + 16u * (unsigned)k)); }
}
template <bool FINAL>
DI void v_compute(const VTok& S, float* xf, bf16* XB, float* ss_out, int t, int s, int lane) {
    const int k = lane & 7;
    const bool b3 = lane & 8, b4 = lane & 16, b5 = lane & 32;
    const int col = 128 * s + 16 * k + (b3 ? 8 : 0) + (b4 ? 4 : 0) + (b5 ? 2 : 0);
    float* xo = xf + (size_t)t * D + col;
    f32x2 o = *(const f32x2*)xo;
    f32x2 acc[8];
#pragma unroll
    for (int i = 0; i < 8; ++i) acc[i] = (f32x2){0.f, 0.f};
#pragma unroll
    for (int i = 0; i < 16; ++i) { const f32x2 a2 = {S.av[i], S.av[i]};
#pragma unroll
        for (int q = 0; q < 4; ++q) { acc[2 * q] = __builtin_elementwise_fma(a2, fp8lo(S.vw[i][q]), acc[2 * q]); acc[2 * q + 1] = __builtin_elementwise_fma(a2, fp8hi(S.vw[i][q]), acc[2 * q + 1]); } }
    float v[16];
#pragma unroll
    for (int i = 0; i < 8; ++i) { v[2 * i] = acc[i].x; v[2 * i + 1] = acc[i].y; }
    float v8[8], v4[4], v2[2];
#pragma unroll
    for (int j = 0; j < 8; ++j) { const float keep = b3 ? v[8 + j] : v[j], send = b3 ? v[j] : v[8 + j]; v8[j] = keep + __shfl_xor(send, 8); }
#pragma unroll
    for (int j = 0; j < 4; ++j) { const float keep = b4 ? v8[4 + j] : v8[j], send = b4 ? v8[j] : v8[4 + j]; v4[j] = keep + __shfl_xor(send, 16); }
#pragma unroll
    for (int j = 0; j < 2; ++j) { const float keep = b5 ? v4[2 + j] : v4[j], send = b5 ? v4[j] : v4[2 + j]; v2[j] = keep + __shfl_xor(send, 32); }
    o.x += v2[0]; o.y += v2[1];
    *(f32x2*)xo = o;
    if (!FINAL) *(unsigned*)(XB + (size_t)t * D + col) = pk2(o.x, o.y);
    const float sq = wave_sum(o.x * o.x + o.y * o.y);
    if (lane == 0) ss_out[(size_t)t * 16 + s] = sq;
}
constexpr int XG = 8, XNG = T / XG;
DI unsigned wave_ticket(unsigned* head, int lane) {
    unsigned v = 0u; if (lane == 0) v = __hip_atomic_fetch_add(head, 1u, __ATOMIC_RELAXED, __HIP_MEMORY_SCOPE_AGENT);
    return (unsigned)__builtin_amdgcn_readfirstlane((int)v);
}
template <int PASS, bool FINAL>
DI void sliced_pass(const unsigned char* TAB, const unsigned short* IDX, const bf16* XBc, bf16* XBw, float* HP, const float* A, float* xf, float* ss_out,
                    unsigned* heads, unsigned* census, volatile LAS unsigned* slot, int wave, int lane, int tid) {
    const int own = (int)(xb_xcc_id() & 7u);
    __syncthreads();
    if (tid == 0) { unsigned all = 1u;
#pragma unroll 1
        for (int q = 0; q < 8; ++q) { const unsigned n = xb_ld(census + XB_XCNT(q)) + xb_ld(census + XB_XCNT(q + 8)); all &= (n > 0u) ? 1u : 0u; }
        slot[1] = all; }
    __syncthreads();
    const int nds = slot[1] ? 1 : 8;
#pragma unroll 1
    for (int ds = 0; ds < nds; ++ds) { const int s = (own + ds) & 7;
        unsigned* head = heads + 64 * s; const unsigned char* Ts = TAB + 128 * s;
        unsigned tk = wave_ticket(head, lane);
        if (tk >= (unsigned)XNG) continue;
        int t0 = (int)tk * XG;
        if (PASS == 0) { float* HPs = HP + (size_t)s * T * 128;
            UTok P, Q; u_issue(P, Ts, IDX, XBc, t0, s, lane);
            for (;;) { const unsigned nxt = wave_ticket(head, lane); int nt0 = 0;
#pragma unroll 1
                for (int j = 0; j < XG; j += 2) { u_issue(Q, Ts, IDX, XBc, t0 + j + 1, s, lane); u_compute(P, HPs, t0 + j, lane);
                    if (j + 2 < XG) u_issue(P, Ts, IDX, XBc, t0 + j + 2, s, lane); else { nt0 = (int)nxt * XG; if (nxt < (unsigned)XNG) u_issue(P, Ts, IDX, XBc, nt0, s, lane); }
                    u_compute(Q, HPs, t0 + j + 1, lane); }
                if (nxt >= (unsigned)XNG) break; t0 = nt0; }
        } else {
            VTok P, Q; v_issue(P, Ts, IDX, A, t0, lane);
            for (;;) { const unsigned nxt = wave_ticket(head, lane); int nt0 = 0;
#pragma unroll 1
                for (int j = 0; j < XG; j += 2) { v_issue(Q, Ts, IDX, A, t0 + j + 1, lane); v_compute<FINAL>(P, xf, XBw, ss_out, t0 + j, s, lane);
                    if (j + 2 < XG) v_issue(P, Ts, IDX, A, t0 + j + 2, lane); else { nt0 = (int)nxt * XG; if (nxt < (unsigned)XNG) v_issue(P, Ts, IDX, A, nt0, lane); }
                    v_compute<FINAL>(Q, xf, XBw, ss_out, t0 + j + 1, s, lane); }
                if (nxt >= (unsigned)XNG) break; t0 = nt0; }
        } }
}
DI void reduce_phase(const float* HP, const float* GATE, const float* ss_in, float* A, int vcu, int G, int tid) {
    const size_t gt = (size_t)vcu * (NWAVES * 64) + tid, NGT = (size_t)G * NWAVES * 64;
    for (size_t c = gt; c < (size_t)T * 128; c += NGT) { float h = 0.f;
#pragma unroll
        for (int s = 0; s < 8; ++s) h += HP[(size_t)s * T * 128 + c];
        h *= pg8::row_rstd(ss_in, (int)(c >> 7));
        A[c] = (1.0f / 1024.0f) * GATE[c] * (0.5f * h * (1.f + erff(h * 0.70710678118654752f))); }
}
DI void final_phase(const float* ss, float* xf, const float* fin_g, int vcu, int G, int wave, int lane) {
    for (int m = vcu * NWAVES + wave; m < T; m += G * NWAVES) { const float rf = pg8::row_rstd(ss, m);
        f32x4* xr = (f32x4*)(xf + (size_t)m * D) + lane;
#pragma unroll
        for (int j = 0; j < 4; ++j) xr[64 * j] = xr[64 * j] * rf * *((const f32x4*)fin_g + lane + 64 * j); }
}

DI int t5_bucket(int rel) {
    const int n = rel < 0 ? -rel : rel; int b;
    if (n < 8) b = n; else if (n < 12) b = 8; else if (n < 16) b = 9; else if (n < 23) b = 10; else if (n < 32) b = 11; else if (n < 46) b = 12; else if (n < 64) b = 13; else if (n < 91) b = 14; else b = 15;
    return b + (rel > 0 ? 16 : 0);
}
DI int crow(int reg, int h) { return (reg & 3) + 8 * (reg >> 2) + 4 * h; }
constexpr int AT_KL = 0, AT_KSTR = 144, AT_VT = 384 * AT_KSTR  , AT_VSTR = 776, AT_BT = AT_VT + 64 * AT_VSTR  , AT_END = AT_BT + 4 * 512 * 4;
static_assert(AT_END <= RING_BYTES, "attention LDS");
DI void attn_phase(const bf16* Qg, const bf16* Kg, const bf16* Vg, bf16* AO, const float* rel_bias, const float* sink, LAS unsigned char* lds, int vcu, int G, int wave, int lane, int tid) {
    const int r = lane & 31, h = lane >> 5;
    for (int unit = vcu; unit < BATCH * 4 * (SEQ / 128); unit += G) {
        const int b = unit / 256, kvh = (unit % 256) / 64, blk = unit % 64;
        __syncthreads();
        for (int c = tid; c < 384 * 8; c += NWAVES * 64) { const int row = c >> 3, c8 = c & 7, ts = blk * 128 - 128 + row;
            v4u kv = {0u, 0u, 0u, 0u}, vv = {0u, 0u, 0u, 0u};
            if (ts >= 0 && ts < SEQ) { const size_t g = (size_t)(b * SEQ + ts) * 256 + kvh * 64 + c8 * 8; kv = *(const v4u*)(Kg + g); vv = *(const v4u*)(Vg + g); }
            *(LAS v4u*)(lds + AT_KL + row * AT_KSTR + c8 * 16) = kv;
            LAS unsigned short* vt = (LAS unsigned short*)(lds + AT_VT) + (c8 * 8) * (AT_VSTR / 2) + row;
            vt[0 * (AT_VSTR / 2)] = (unsigned short)(vv.x & 0xffffu); vt[1 * (AT_VSTR / 2)] = (unsigned short)(vv.x >> 16);
            vt[2 * (AT_VSTR / 2)] = (unsigned short)(vv.y & 0xffffu); vt[3 * (AT_VSTR / 2)] = (unsigned short)(vv.y >> 16);
            vt[4 * (AT_VSTR / 2)] = (unsigned short)(vv.z & 0xffffu); vt[5 * (AT_VSTR / 2)] = (unsigned short)(vv.z >> 16);
            vt[6 * (AT_VSTR / 2)] = (unsigned short)(vv.w & 0xffffu); vt[7 * (AT_VSTR / 2)] = (unsigned short)(vv.w >> 16); }
        for (int c = tid; c < 4 * 512; c += NWAVES * 64) { const int g = c >> 9, i = c & 511, rel = i - 255;
            float v = NEGBIG; if (rel >= -128 && rel <= 128) v = rel_bias[t5_bucket(rel) * 16 + kvh * 4 + g] * LOG2E;
            *(LAS float*)(lds + AT_BT + c * 4) = v; }
        __syncthreads();
        const int g = wave >> 1, qh = wave & 1, head = kvh * 4 + g;
        const float sinkl = sink[head] * LOG2E;
        bf16x8 qf[2][4];
#pragma unroll
        for (int qt = 0; qt < 2; ++qt)
#pragma unroll
            for (int s = 0; s < 4; ++s) qf[qt][s] = *(const bf16x8*)(Qg + (size_t)(b * SEQ + blk * 128 + qh * 64 + qt * 32 + r) * D + head * 64 + s * 16 + h * 8);
        float m[2] = {sinkl, sinkl}, l[2] = {0.f, 0.f};
        f32x16 o[2][2];
#pragma unroll
        for (int qt = 0; qt < 2; ++qt)
#pragma unroll
            for (int dt = 0; dt < 2; ++dt)
#pragma unroll
                for (int i = 0; i < 16; ++i) o[qt][dt][i] = 0.f;
        int kt_lo = 2 * qh, kt_hi = 2 * qh + 9;
        if (blk == 0 && kt_lo < 4) kt_lo = 4;
        if (blk == SEQ / 128 - 1 && kt_hi > 7) kt_hi = 7;
#pragma unroll 1
        for (int kt = kt_lo; kt <= kt_hi; ++kt) {
            bf16x8 kf[4];
#pragma unroll
            for (int s = 0; s < 4; ++s) kf[s] = *(const LAS bf16x8*)(lds + AT_KL + (32 * kt + r) * AT_KSTR + s * 32 + h * 16);
            bf16x8 vf[2][2];
#pragma unroll
            for (int dt = 0; dt < 2; ++dt)
#pragma unroll
                for (int s2 = 0; s2 < 2; ++s2) { const LAS unsigned char* vp = lds + AT_VT + (32 * dt + r) * AT_VSTR + (32 * kt + 16 * s2 + 4 * h) * 2;
                    const v2u lo = *(const LAS v2u*)vp, hi2 = *(const LAS v2u*)(vp + 16); v4u w = {lo.x, lo.y, hi2.x, hi2.y}; vf[dt][s2] = __builtin_bit_cast(bf16x8, w); }
#pragma unroll
            for (int qt = 0; qt < 2; ++qt) {
                f32x16 s;
                const LAS float* bt = (const LAS float*)(lds + AT_BT) + g * 512 + 127 + 32 * kt + 4 * h - (64 * qh + 32 * qt + r);
#pragma unroll
                for (int i = 0; i < 16; ++i) s[i] = bt[(i & 3) + 8 * (i >> 2)];
#pragma unroll
                for (int k4 = 0; k4 < 4; ++k4) s = __builtin_amdgcn_mfma_f32_32x32x16_bf16(kf[k4], qf[qt][k4], s, 0, 0, 0);
                float mx = s[0];
#pragma unroll
                for (int i = 1; i < 16; ++i) mx = fmaxf(mx, s[i]);
                mx = fmaxf(mx, __shfl_xor(mx, 32));
                const float mn = fmaxf(m[qt], mx), al = __builtin_amdgcn_exp2f(m[qt] - mn); m[qt] = mn;
                float ps = 0.f;
#pragma unroll
                for (int i = 0; i < 16; ++i) { s[i] = __builtin_amdgcn_exp2f(s[i] - mn); ps += s[i]; }
                l[qt] = l[qt] * al + ps;
#pragma unroll
                for (int dt = 0; dt < 2; ++dt)
#pragma unroll
                    for (int i = 0; i < 16; ++i) o[qt][dt][i] *= al;
                bf16x8 pf[2];
#pragma unroll
                for (int s2 = 0; s2 < 2; ++s2) { v4u w; w.x = pk2(s[8 * s2 + 0], s[8 * s2 + 1]); w.y = pk2(s[8 * s2 + 2], s[8 * s2 + 3]); w.z = pk2(s[8 * s2 + 4], s[8 * s2 + 5]); w.w = pk2(s[8 * s2 + 6], s[8 * s2 + 7]); pf[s2] = __builtin_bit_cast(bf16x8, w); }
#pragma unroll
                for (int dt = 0; dt < 2; ++dt)
#pragma unroll
                    for (int s2 = 0; s2 < 2; ++s2) o[qt][dt] = __builtin_amdgcn_mfma_f32_32x32x16_bf16(vf[dt][s2], pf[s2], o[qt][dt], 0, 0, 0);
            }
        }
#pragma unroll
        for (int qt = 0; qt < 2; ++qt) {
            const float lt = l[qt] + __shfl_xor(l[qt], 32) + __builtin_amdgcn_exp2f(sinkl - m[qt]), inv = 1.0f / lt;
            bf16* op = AO + (size_t)(b * SEQ + blk * 128 + qh * 64 + qt * 32 + r) * D + head * 64 + 4 * h;
#pragma unroll
            for (int dt = 0; dt < 2; ++dt)
#pragma unroll
                for (int gq = 0; gq < 4; ++gq) { v2u w; w.x = pk2(o[qt][dt][4 * gq] * inv, o[qt][dt][4 * gq + 1] * inv); w.y = pk2(o[qt][dt][4 * gq + 2] * inv, o[qt][dt][4 * gq + 3] * inv);
                    *(v2u*)(op + 32 * dt + 8 * gq) = w; }
        }
    }
}

struct Args { const float* in[16]; float* out; unsigned char* ws; int ph_lo, ph_hi; };
__global__ void __launch_bounds__(NWAVES * 64, 2) fwd_kernel(Args args) {
    extern __shared__ __attribute__((aligned(16))) unsigned char lds_raw[];
    LAS unsigned char* lds = (LAS unsigned char*)lds_raw;
    volatile LAS unsigned* MISC = (volatile LAS unsigned*)(lds + MISC_OFF);
    const int tid = threadIdx.x, lane = tid & 63, wave = __builtin_amdgcn_readfirstlane(tid >> 6);
    const int G = gridDim.x; const int bx = blockIdx.x; const int vcu = (G % 8 == 0) ? (bx % 8) * (G / 8) + bx / 8 : bx;
    unsigned char* ws = args.ws;
    unsigned* ctl = (unsigned*)(ws + WS_CTL);
    const float* x = args.in[0]; const float* conv_g = args.in[1]; const float* w_in = args.in[2]; const float* conv_w = args.in[3]; const float* w_out = args.in[4];
    const float* attn_g = args.in[5]; const float* w_qkv = args.in[6]; const float* sink = args.in[7]; const float* w_o = args.in[8]; const float* rel_bias = args.in[9];
    const float* ffn_g = args.in[10]; const float* w_pq = args.in[11]; const float* subk = args.in[12]; const float* pu = args.in[13]; const float* pv = args.in[14]; const float* fin_g = args.in[15];
    float* out = args.out;
    bf16* WinT = (bf16*)(ws + WS_WIN); bf16* WoutT = (bf16*)(ws + WS_WOUT); bf16* WqkvT = (bf16*)(ws + WS_WQKV); bf16* WoT = (bf16*)(ws + WS_WO); bf16* WpqT = (bf16*)(ws + WS_WPQ); bf16* SKb = (bf16*)(ws + WS_SK);
    float* SS = (float*)(ws + WS_SS); unsigned short* IDX = (unsigned short*)(ws + WS_IDX); float* HP = (float*)(ws + WS_HP); float* AA = (float*)(ws + WS_A); float* GATE = (float*)(ws + WS_GATE);
    bf16* XB = (bf16*)(ws + WS_XB); bf16* Y = (bf16*)(ws + WS_Y); unsigned char* U8 = ws + WS_U; unsigned char* V8 = ws + WS_V;
    bf16* G1 = (bf16*)(ws + WS_G1); bf16* PQ = (bf16*)(ws + WS_PQ); bf16* Qb = (bf16*)(ws + WS_Q); bf16* Kb = (bf16*)(ws + WS_K); bf16* VVb = (bf16*)(ws + WS_VV); bf16* AO = (bf16*)(ws + WS_AO);
    float* SS0 = SS; float* SS1 = SS + (size_t)T * 16; float* SS2 = SS + (size_t)2 * T * 16; float* SS3 = SS + (size_t)3 * T * 16; float* SS4 = SS + (size_t)4 * T * 16;

    for (int u = tid; u < (LDS_BYTES - LDSCTL_OFF) / 4; u += NWAVES * 64) ((LAS unsigned*)(lds + LDSCTL_OFF))[u] = 0u;
    __syncthreads();
    XcdBarrier bar; bar.bar = ctl + CW_BAR; bar.x = 0; bar.st = nullptr;
    if (!MK_PER_PHASE) bar = xcd_barrier_post(ctl + CW_BAR, MISC + 8);
    const int lo = args.ph_lo, hi = args.ph_hi;
#define IN(k) (lo <= (k) && (k) < hi)
#define SEAM(k) do { if (IN(k) && IN((k) + 1)) xcd_barrier(bar); } while (0)

    if (IN(0)) REPS(0) {
        P0Args a{x, conv_g, w_in, w_out, attn_g, w_qkv, w_o, ffn_g, w_pq, subk, pu, pv, WinT, WoutT, WqkvT, WoT, WpqT, SKb, U8, V8, XB, SS0};
        p0_prologue(a, lds, vcu, G, wave, lane, tid);
    }
    SEAM(0);
    if (IN(1)) REPS(1) {
        pg8::Gemm g{XB, WinT, T, NIN, D}; pg8::StaticOrder S; S.init(T, NIN, G, bx);
        pg8::EpiBf16RS E{G1, NIN, NIN / 256, nullptr, nullptr, 0, SS0};
        pg8::gemm_phase<pg8::EpiBf16RS, pg8::StaticOrder, true, true>(lds, g, S, E);
    }
    SEAM(1);
    if (IN(2)) REPS(2) conv_gate_phase(G1, conv_w, Y, vcu, G, tid);
    SEAM(2);
    if (IN(3)) REPS(3) {
        pg8::Gemm g{Y, WoutT, T, D, D}; pg8::StaticOrder S; S.init(T, D, G, bx);
        pg8::EpiResid E{x, out, XB, SS1};
        pg8::gemm_phase<pg8::EpiResid, pg8::StaticOrder, true, true>(lds, g, S, E);
    }
    SEAM(3);
    if (IN(4)) REPS(4) {
        pg8::Gemm g{XB, WpqT, T, NPQ, D}; pg8::StaticOrder S; S.init(T, NPQ, G, bx);
        pg8::EpiBf16RS E{PQ, NPQ, NPQ / 256, nullptr, nullptr, 0, SS1};
        pg8::gemm_phase<pg8::EpiBf16RS, pg8::StaticOrder, true, true>(lds, g, S, E);
    }
    SEAM(4);
    if (IN(5)) REPS(5) route_phase(PQ, SKb, IDX, GATE, lds, vcu, G, wave, lane, tid);
    SEAM(5);
    if (IN(6)) sliced_pass<0, false>(U8, IDX, XB, XB, HP, AA, out, SS2, ctl + CW_WQ + 64 * 0, ctl + CW_BAR, MISC + 12, wave, lane, tid);
    SEAM(6);
    if (IN(7)) reduce_phase(HP, GATE, SS1, AA, vcu, G, tid);
    SEAM(7);
    if (IN(8)) sliced_pass<1, false>(V8, IDX, XB, XB, HP, AA, out, SS2, ctl + CW_WQ + 64 * 8, ctl + CW_BAR, MISC + 12, wave, lane, tid);
    SEAM(8);
    if (IN(9)) REPS(9) {
        pg8::Gemm g{XB, WqkvT, T, NQKV, D}; pg8::StaticOrder S; S.init(T, NQKV, G, bx);
        pg8::EpiBf16RS E{Qb, D, 4, Kb, VVb, 256, SS2};
        pg8::gemm_phase<pg8::EpiBf16RS, pg8::StaticOrder, true, true>(lds, g, S, E);
    }
    SEAM(9);
    if (IN(10)) REPS(10) attn_phase(Qb, Kb, VVb, AO, rel_bias, sink, lds, vcu, G, wave, lane, tid);
    SEAM(10);
    if (IN(11)) {
        pg8::Gemm g{AO, WoT, T, D, D}; pg8::StaticOrder S; S.init(T, D, G, bx);
        pg8::EpiResid E{out, out, XB, SS3};
        pg8::gemm_phase<pg8::EpiResid, pg8::StaticOrder, true, true>(lds, g, S, E);
    }
    SEAM(11);
    if (IN(12)) REPS(12) {
        pg8::Gemm g{XB, WpqT + (size_t)NPQ * D, T, NPQ, D}; pg8::StaticOrder S; S.init(T, NPQ, G, bx);
        pg8::EpiBf16RS E{PQ, NPQ, NPQ / 256, nullptr, nullptr, 0, SS3};
        pg8::gemm_phase<pg8::EpiBf16RS, pg8::StaticOrder, true, true>(lds, g, S, E);
    }
    SEAM(12);
    if (IN(13)) REPS(13) route_phase(PQ, SKb + (size_t)8 * 2 * 128 * 128, IDX, GATE, lds, vcu, G, wave, lane, tid);
    SEAM(13);
    if (IN(14)) sliced_pass<0, true>(U8 + (size_t)NEXP * D, IDX, XB, XB, HP, AA, out, SS4, ctl + CW_WQ + 64 * 16, ctl + CW_BAR, MISC + 12, wave, lane, tid);
    SEAM(14);
    if (IN(15)) reduce_phase(HP, GATE, SS3, AA, vcu, G, tid);
    SEAM(15);
    if (IN(16)) sliced_pass<1, true>(V8 + (size_t)NEXP * D, IDX, XB, XB, HP, AA, out, SS4, ctl + CW_WQ + 64 * 24, ctl + CW_BAR, MISC + 12, wave, lane, tid);
    SEAM(16);
    if (IN(17)) final_phase(SS4, out, fin_g, vcu, G, wave, lane);
#undef IN
#undef SEAM
}

extern "C" void kernel_launch(void* const* d_in, const int* in_sizes, int n_in, void* d_out, int out_size, void* d_ws, size_t ws_size, hipStream_t stream) {
    static int grid = 0;
    if (grid == 0) {
        if (n_in != 16 || in_sizes[0] != T * D || out_size != T * D || ws_size < WS_END) { fprintf(stderr, "kernel_launch: unexpected shapes (n_in %d, in0 %d, out %d, ws %zu)\n", n_in, n_in > 0 ? in_sizes[0] : -1, out_size, ws_size); grid = -1; return; }
        int dev = 0, cus = 0, per_cu = 0;
        if (hipGetDevice(&dev) != hipSuccess || hipDeviceGetAttribute(&cus, hipDeviceAttributeMultiprocessorCount, dev) != hipSuccess) { grid = -1; return; }
        if (hipFuncSetAttribute((const void*)fwd_kernel, hipFuncAttributeMaxDynamicSharedMemorySize, LDS_BYTES) != hipSuccess) { fprintf(stderr, "kernel_launch: hipFuncSetAttribute failed\n"); grid = -1; return; }
        if (hipOccupancyMaxActiveBlocksPerMultiprocessor(&per_cu, (const void*)fwd_kernel, NWAVES * 64, LDS_BYTES) != hipSuccess || per_cu < 1) { fprintf(stderr, "kernel_launch: occupancy query says %d blocks per CU\n", per_cu); (void)hipGetLastError(); grid = -1; return; }
        grid = cus;
    }
    if (grid < 0) return;
    (void)hipMemsetAsync((char*)d_ws + WS_CTL, 0, CTL_ZERO_BYTES, stream);
    Args a{};
    for (int i = 0; i < 16; ++i) a.in[i] = (const float*)d_in[i];
    a.out = (float*)d_out; a.ws = (unsigned char*)d_ws;
#if MK_PER_PHASE
    for (int p = 0; p < NPH; ++p) { a.ph_lo = p; a.ph_hi = p + 1; hipLaunchKernelGGL(fwd_kernel, dim3(grid), dim3(NWAVES * 64), LDS_BYTES, stream, a); }
#else
    a.ph_lo = 0; a.ph_hi = NPH;
    hipLaunchKernelGGL(fwd_kernel, dim3(grid), dim3(NWAVES * 64), LDS_BYTES, stream, a);
#endif
}
```

```cpp
#include <hip/hip_runtime.h>
#include <cstdio>
#include <cstdint>
namespace pg8 {
#define PG8_LAS __attribute__((address_space(3)))
typedef unsigned short bf16_t;
typedef short bf16x8 __attribute__((ext_vector_type(8)));
typedef float f32x4 __attribute__((ext_vector_type(4)));
typedef unsigned u32x4 __attribute__((ext_vector_type(4)));
constexpr int BM = 256, BK = 64, HALF = 128, HTB = HALF * BK * 2  , STAGE_BYTES = 8 * HTB, NXCD = 8, WGM = 8;

__host__ __device__ __forceinline__ int lds_byte(int r, int c) { const int st = (r >> 4) * 2 + (c >> 5), rr = r & 15, cc = c & 31, ob = rr * 64 + cc * 2; return st * 1024 + (ob ^ (((ob >> 9) & 1) << 5)); }
__host__ __device__ __forceinline__ void stage_rc(int b, int& R, int& C) { const int st = b / 1024, sb = b % 1024, swz = sb ^ (((sb >> 9) & 1) << 5); R = (st >> 1) * 16 + swz / 64; C = (st & 1) * 32 + (swz % 64) / 2; }
__host__ __device__ __forceinline__ int perm32(int rho) { const int n = rho >> 4, i = rho & 15; return 8 * (i >> 2) + 4 * n + (i & 3); }

struct Unit { int pm, pn; };
struct Gemm { const bf16_t* A; const bf16_t* Bt; int M, N, K; };

struct StaticOrder {
    int nM, nN, nwg, G, c;
    __host__ __device__ void init(int M, int N, int G_, int c_) { nM = M / BM; nN = N / BM; nwg = nM * nN; G = G_; c = c_; }
    __host__ __device__ bool next(int i, Unit& u) const {
        const long L = (long)i * G + c; if (L >= nwg) return false;
        int wgid = (int)L; { const int q = nwg / NXCD, r = nwg % NXCD, xcd = wgid % NXCD, off = wgid / NXCD; wgid = (xcd < r ? xcd * (q + 1) : r * (q + 1) + (xcd - r) * q) + off; }
        const int nig = WGM * nN, gid = wgid / nig, fm = gid * WGM, gsz = (nM - fm) < WGM ? (nM - fm) : WGM;
        u.pm = fm + ((wgid % nig) % gsz); u.pn = (wgid % nig) / gsz; return true;
    }
    __device__ __forceinline__ void a_ready(const Unit&) const {}
    __device__ __forceinline__ void done(const Unit&) const {}
};

__device__ __forceinline__ unsigned cvt_pk_bf16(float lo, float hi) { unsigned r; asm volatile("v_cvt_pk_bf16_f32 %0, %1, %2" : "=v"(r) : "v"(lo), "v"(hi)); return r; }
typedef unsigned u32x2 __attribute__((ext_vector_type(2)));
__device__ __forceinline__ float row_rstd(const float* ss, int row) {
    const f32x4* p = (const f32x4*)(ss + (size_t)row * 16);
    const f32x4 a = p[0], b = p[1], c = p[2], d = p[3];
    const float s = (((a[0] + a[1]) + (a[2] + a[3])) + ((b[0] + b[1]) + (b[2] + b[3]))) + (((c[0] + c[1]) + (c[2] + c[3])) + ((d[0] + d[1]) + (d[2] + d[3])));
    return __builtin_amdgcn_rsqf(s * (1.0f / 1024.0f) + 1e-6f);
}
struct EpiBf16RS {
    static constexpr bool PERM = true, AFTER_DRAIN = false;
    bf16_t* O0; int ld0; int nt0; bf16_t* O1; bf16_t* O2; int ld1; const float* ss;
    __device__ __forceinline__ void operator()(const f32x4 (&acc)[2][2][4][2], const Unit& u, int wr, int wc, int fr, int fq) const {
        bf16_t* base; int ld, colt;
        if (u.pn < nt0) { base = O0; ld = ld0; colt = u.pn * BM; } else if (u.pn == nt0) { base = O1; ld = ld1; colt = 0; } else { base = O2; ld = ld1; colt = (u.pn - nt0 - 1) * BM; }
        const int row0 = u.pm * BM + wr * 64 + fr, col0 = colt + wc * 32 + 8 * fq;
#pragma unroll
        for (int ai = 0; ai < 2; ++ai)
#pragma unroll
            for (int m = 0; m < 4; ++m) { const int row = row0 + ai * HALF + m * 16; const float rs = row_rstd(ss, row); bf16_t* rowp = base + (size_t)row * ld + col0;
#pragma unroll
                for (int bj = 0; bj < 2; ++bj) { const f32x4 v0 = acc[ai][bj][m][0] * rs, v1 = acc[ai][bj][m][1] * rs;
                    u32x4 w; w.x = cvt_pk_bf16(v0[0], v0[1]); w.y = cvt_pk_bf16(v0[2], v0[3]); w.z = cvt_pk_bf16(v1[0], v1[1]); w.w = cvt_pk_bf16(v1[2], v1[3]);
                    *(u32x4*)(rowp + bj * HALF) = w; } }
    }
};
struct EpiResid {
    static constexpr bool PERM = false, AFTER_DRAIN = false;
    const float* base; float* out; bf16_t* xb; float* ss;
    __device__ __forceinline__ void operator()(const f32x4 (&acc)[2][2][4][2], const Unit& u, int wr, int wc, int fr, int fq) const {
        const int row0 = u.pm * BM + wr * 64 + fr, col0 = u.pn * BM + wc * 32 + 4 * fq;
#pragma unroll
        for (int ai = 0; ai < 2; ++ai)
#pragma unroll
            for (int m = 0; m < 4; ++m) { const int row = row0 + ai * HALF + m * 16; float sq = 0.f;
#pragma unroll
                for (int bj = 0; bj < 2; ++bj)
#pragma unroll
                    for (int n = 0; n < 2; ++n) { const size_t off = (size_t)row * 1024 + col0 + bj * HALF + n * 16;
                        const f32x4 o = *(const f32x4*)(base + off) + acc[ai][bj][m][n];
                        *(f32x4*)(out + off) = o; sq += (o[0] * o[0] + o[1] * o[1]) + (o[2] * o[2] + o[3] * o[3]);
                        u32x2 w; w.x = cvt_pk_bf16(o[0], o[1]); w.y = cvt_pk_bf16(o[2], o[3]); *(u32x2*)(xb + off) = w; }
                sq += __shfl_xor(sq, 16); sq += __shfl_xor(sq, 32);
                if (fq == 0) ss[(size_t)row * 16 + u.pn * 4 + wc] = sq; }
    }
};

template <class Epi, class Sched, bool ALIGN_EPI = false, bool SP2 = false>
__device__ __forceinline__ void gemm_phase(PG8_LAS unsigned char* lds, const Gemm g, const Sched& S, const Epi& E) {
    const int tid = threadIdx.x, wid = __builtin_amdgcn_readfirstlane(tid >> 6), lane = tid & 63, wr = wid >> 2, wc = wid & 3, fr = lane & 15, fq = lane >> 4;
    const int K = g.K, nt = K / BK;
    unsigned voffA[2], voffB[2];
#pragma unroll
    for (int i = 0; i < 2; ++i) { int R, C; stage_rc(tid * 16 + i * 8192, R, C); const int Rb = Epi::PERM ? ((R & ~31) + perm32(R & 31)) : R;
        voffA[i] = (unsigned)(R * K + C) * 2u; voffB[i] = (unsigned)(Rb * K + C) * 2u; }
    const size_t kstep = (size_t)(BK * 2);
    const size_t hstep = (size_t)HALF * K * 2;
    const size_t tstep = 2 * hstep;
    const unsigned ldsw = (unsigned)wid * 1024u;
    const int aoff = lds_byte(wr * 64 + fr, fq * 8), boff = lds_byte(wc * 32 + fr, fq * 8);
#define PG8_SA(b, h) (((b) * 2 + (h)) * HTB)
#define PG8_SB(b, h) ((4 + (b) * 2 + (h)) * HTB)
#define PG8_STAGE(bufoff, gbase, voff) do { _Pragma("unroll") for (int _i = 0; _i < 2; ++_i) \
        __builtin_amdgcn_global_load_lds((const unsigned*)((const char*)(gbase) + (voff)[_i]), (PG8_LAS unsigned*)(lds + (bufoff) + ldsw + _i * 8192), 16, 0, 0); } while (0)
#define PG8_LDA(dst, b, h) do { _Pragma("unroll") for (int m = 0; m < 4; ++m) _Pragma("unroll") for (int k = 0; k < 2; ++k) dst[m][k] = *(const PG8_LAS bf16x8*)(lds + PG8_SA(b, h) + aoff + m * 2048 + k * 1024); } while (0)
#define PG8_LDB(dst, b, h) do { _Pragma("unroll") for (int n = 0; n < 2; ++n) _Pragma("unroll") for (int k = 0; k < 2; ++k) dst[n][k] = *(const PG8_LAS bf16x8*)(lds + PG8_SB(b, h) + boff + n * 2048 + k * 1024); } while (0)
#define PG8_MMA(ai, bj, At, Bt) do { __builtin_amdgcn_s_setprio(1); _Pragma("unroll") for (int m = 0; m < 4; ++m) _Pragma("unroll") for (int n = 0; n < 2; ++n) _Pragma("unroll") for (int k = 0; k < 2; ++k) \
        acc[ai][bj][m][n] = __builtin_amdgcn_mfma_f32_16x16x32_bf16(Bt[n][k], At[m][k], acc[ai][bj][m][n], 0, 0, 0); __builtin_amdgcn_s_setprio(0); } while (0)
#define PG8_WAIT_V(n) asm volatile("s_waitcnt vmcnt(" #n ")" ::: "memory")
#define PG8_WAIT_L(n) asm volatile("s_waitcnt lgkmcnt(" #n ")" ::: "memory")
#define PG8_BAR __builtin_amdgcn_s_barrier()
#define PG8_SCHED __builtin_amdgcn_sched_barrier(0)
    Unit cur, nxt; int ui = 0;
    if (!S.next(0, cur)) return;
    f32x4 acc[2][2][4][2];
#pragma unroll
    for (int a = 0; a < 2; ++a)
#pragma unroll
        for (int b = 0; b < 2; ++b)
#pragma unroll
            for (int m = 0; m < 4; ++m)
#pragma unroll
                for (int n = 0; n < 2; ++n) acc[a][b][m][n] = (f32x4){0.f, 0.f, 0.f, 0.f};
    bf16x8 At[4][2], B0[2][2], B1[2][2];
    const char* cA = (const char*)g.A + (size_t)cur.pm * tstep; const char* cB = (const char*)g.Bt + (size_t)cur.pn * tstep;
    S.a_ready(cur);
    if constexpr (SP2) {
        PG8_STAGE(PG8_SB(0, 0), cB, voffB); PG8_STAGE(PG8_SB(0, 1), cB + hstep, voffB); PG8_STAGE(PG8_SA(0, 0), cA, voffA); PG8_STAGE(PG8_SA(0, 1), cA + hstep, voffA);
        if (wr == 1) PG8_BAR;
        PG8_WAIT_V(2); PG8_BAR;
        PG8_STAGE(PG8_SB(1, 0), cB + kstep, voffB); PG8_STAGE(PG8_SA(1, 0), cA + kstep, voffA); PG8_STAGE(PG8_SB(1, 1), cB + hstep + kstep, voffB);
        PG8_WAIT_V(6); PG8_BAR;
    } else {
        PG8_STAGE(PG8_SB(0, 0), cB, voffB); PG8_STAGE(PG8_SA(0, 0), cA, voffA); PG8_STAGE(PG8_SB(0, 1), cB + hstep, voffB); PG8_STAGE(PG8_SA(0, 1), cA + hstep, voffA);
        if (wr == 1) PG8_BAR;
        PG8_WAIT_V(4); PG8_BAR;
        PG8_STAGE(PG8_SB(1, 0), cB + kstep, voffB); PG8_STAGE(PG8_SA(1, 0), cA + kstep, voffA); PG8_STAGE(PG8_SB(1, 1), cB + hstep + kstep, voffB);
        PG8_WAIT_V(6); PG8_BAR;
    }
    for (;;) {
        const bool has_next = S.next(ui + 1, nxt);
        const char* nA = has_next ? (const char*)g.A + (size_t)nxt.pm * tstep : cA; const char* nB = has_next ? (const char*)g.Bt + (size_t)nxt.pn * tstep : cB;
        for (int t = 0; t < nt; t += 2) {
            const bool last = (t == nt - 2);
            const char* a1 = cA + (size_t)(t + 1) * kstep;
            const char* a2 = last ? nA : cA + (size_t)(t + 2) * kstep; const char* b2 = last ? nB : cB + (size_t)(t + 2) * kstep;
            const char* a3 = a2 + kstep; const char* b3 = b2 + kstep;
            if (last && has_next) S.a_ready(nxt);
            if constexpr (SP2) {
            PG8_LDB(B0, 0, 0); PG8_LDB(B1, 0, 1); PG8_SCHED; PG8_LDA(At, 0, 0); PG8_STAGE(PG8_SA(1, 1), a1 + hstep, voffA);
            PG8_WAIT_V(8); PG8_WAIT_L(0); PG8_BAR; PG8_MMA(0, 0, At, B0); PG8_MMA(0, 1, At, B1); PG8_BAR; PG8_SCHED;
            PG8_LDA(At, 0, 1); PG8_STAGE(PG8_SB(0, 0), b2, voffB); PG8_STAGE(PG8_SB(0, 1), b2 + hstep, voffB); PG8_STAGE(PG8_SA(0, 0), a2, voffA);
            PG8_WAIT_V(8); PG8_WAIT_L(0); PG8_BAR; PG8_MMA(1, 0, At, B0); PG8_MMA(1, 1, At, B1); PG8_BAR; PG8_SCHED;
            PG8_LDB(B0, 1, 0); PG8_LDB(B1, 1, 1); PG8_SCHED; PG8_LDA(At, 1, 0); PG8_STAGE(PG8_SA(0, 1), a2 + hstep, voffA);
            PG8_WAIT_V(8); PG8_WAIT_L(0); PG8_BAR; PG8_MMA(0, 0, At, B0); PG8_MMA(0, 1, At, B1); PG8_BAR; PG8_SCHED;
            PG8_LDA(At, 1, 1); PG8_STAGE(PG8_SB(1, 0), b3, voffB); PG8_STAGE(PG8_SB(1, 1), b3 + hstep, voffB); PG8_STAGE(PG8_SA(1, 0), a3, voffA);
            PG8_WAIT_V(8); PG8_WAIT_L(0); PG8_BAR; PG8_MMA(1, 0, At, B0); PG8_MMA(1, 1, At, B1); PG8_BAR; PG8_SCHED;
            } else {
            PG8_LDB(B0, 0, 0); PG8_SCHED; PG8_LDA(At, 0, 0); PG8_STAGE(PG8_SA(1, 1), a1 + hstep, voffA);
            PG8_WAIT_L(8); PG8_BAR; PG8_WAIT_L(0); PG8_MMA(0, 0, At, B0); PG8_BAR; PG8_SCHED;
            PG8_LDB(B1, 0, 1); PG8_STAGE(PG8_SB(0, 0), b2, voffB);
            PG8_BAR; PG8_WAIT_L(0); PG8_MMA(0, 1, At, B1); PG8_BAR;
            PG8_LDA(At, 0, 1); PG8_STAGE(PG8_SA(0, 0), a2, voffA);
            PG8_BAR; PG8_WAIT_L(0); PG8_MMA(1, 0, At, B0); PG8_BAR; PG8_SCHED;
            PG8_STAGE(PG8_SB(0, 1), b2 + hstep, voffB);
            PG8_WAIT_V(6); PG8_BAR; PG8_MMA(1, 1, At, B1); PG8_BAR;
            PG8_LDB(B0, 1, 0); PG8_SCHED; PG8_LDA(At, 1, 0); PG8_STAGE(PG8_SA(0, 1), a2 + hstep, voffA);
            PG8_WAIT_L(8); PG8_BAR; PG8_WAIT_L(0); PG8_MMA(0, 0, At, B0); PG8_BAR; PG8_SCHED;
            PG8_LDB(B1, 1, 1); PG8_STAGE(PG8_SB(1, 0), b3, voffB);
            PG8_BAR; PG8_WAIT_L(0); PG8_MMA(0, 1, At, B1); PG8_BAR;
            PG8_LDA(At, 1, 1); PG8_STAGE(PG8_SA(1, 0), a3, voffA);
            PG8_BAR; PG8_WAIT_L(0); PG8_MMA(1, 0, At, B0); PG8_BAR; PG8_SCHED;
            PG8_STAGE(PG8_SB(1, 1), b3 + hstep, voffB);
            PG8_WAIT_V(6); PG8_BAR; PG8_MMA(1, 1, At, B1); PG8_BAR;
            }
        }
        if constexpr (ALIGN_EPI) { if (wr == 0) PG8_BAR; }
        if constexpr (!Epi::AFTER_DRAIN) { E(acc, cur, wr, wc, fr, fq); S.done(cur); }
        if (!has_next) break;
#pragma unroll
        for (int a = 0; a < 2; ++a)
#pragma unroll
            for (int b = 0; b < 2; ++b)
#pragma unroll
                for (int m = 0; m < 4; ++m)
#pragma unroll
                    for (int n = 0; n < 2; ++n) acc[a][b][m][n] = (f32x4){0.f, 0.f, 0.f, 0.f};
        cur = nxt; cA = nA; cB = nB; ++ui;
        if constexpr (ALIGN_EPI) { if (wr == 1) PG8_BAR; }
    }
    PG8_WAIT_V(0);
    if constexpr (!ALIGN_EPI) { if (wr == 0) PG8_BAR; }
    PG8_BAR;
    if constexpr (Epi::AFTER_DRAIN) { E.fused(acc, cur, wr, wc, fr, fq, lds, wid, lane); S.done(cur); }
#undef PG8_SA
#undef PG8_SB
#undef PG8_STAGE
#undef PG8_LDA
#undef PG8_LDB
#undef PG8_MMA
#undef PG8_WAIT_V
#undef PG8_WAIT_L
#undef PG8_BAR
#undef PG8_SCHED
}
}

constexpr int NWAVES = 8;
constexpr int BATCH = 2, SEQ = 8192, D = 1024, T = BATCH * SEQ;
constexpr int NIN = 3072, NQKV = 1536, NPQ = 2048, NEXP = 16384;
constexpr float LOG2E = 1.4426950408889634f;
constexpr float QSCALE = 0.125f * LOG2E;
constexpr float NEGBIG = -1e30f;
#ifndef MK_PER_PHASE
#define MK_PER_PHASE 0
#endif
constexpr int NPH = 18;
#ifndef REP_MASK
#define REP_MASK 0
#endif
#define REPS(k) for (int rep_ = 0; rep_ < (((REP_MASK) >> (k)) & 1) + 1; ++rep_)

constexpr size_t MiB = 1u << 20;
constexpr size_t WS_CTL = 0, CTL_ZERO_BYTES = 65536;
constexpr size_t WS_WIN = 1 * MiB, WS_WOUT = 7 * MiB, WS_WQKV = 9 * MiB, WS_WO = 12 * MiB, WS_WPQ = 14 * MiB, WS_SK = 22 * MiB;
constexpr size_t WS_SS = 23 * MiB;
constexpr size_t WS_IDX = 28 * MiB, WS_GATE = 36 * MiB, WS_XB = 44 * MiB, WS_Y = 76 * MiB, WS_U = 108 * MiB, WS_V = 172 * MiB;
constexpr size_t WS_G1 = 236 * MiB, WS_PQ = 332 * MiB, WS_Q = 396 * MiB, WS_K = 428 * MiB, WS_VV = 436 * MiB, WS_AO = 444 * MiB, WS_END = 476 * MiB;
constexpr size_t WS_HP = WS_G1, WS_A = WS_G1 + 64 * MiB;
constexpr int CW_BAR = 4096;
constexpr int CW_WQ = 8192;

constexpr int RING_BYTES = 131072;
constexpr int LDSCTL_OFF = RING_BYTES, MISC_OFF = LDSCTL_OFF + 320;
constexpr int LDS_BYTES = 147456;

#define LAS __attribute__((address_space(3)))
typedef unsigned short bf16;
typedef unsigned v4u __attribute__((ext_vector_type(4)));
typedef unsigned v2u __attribute__((ext_vector_type(2)));
typedef float f32x4 __attribute__((ext_vector_type(4)));
typedef float f32x2 __attribute__((ext_vector_type(2)));
typedef float f32x16 __attribute__((ext_vector_type(16)));
typedef short bf16x8 __attribute__((ext_vector_type(8)));
typedef __bf16 bf16x2_t __attribute__((ext_vector_type(2)));
#define LDS_WAIT() asm volatile("s_waitcnt lgkmcnt(0)" ::: "memory")
#define DI __device__ __forceinline__

DI unsigned pk2(float lo, float hi) { f32x2 v = {lo, hi}; bf16x2_t b = __builtin_convertvector(v, bf16x2_t); return __builtin_bit_cast(unsigned, b); }
DI float bf_lo(unsigned u) { return __uint_as_float(u << 16); }
DI float bf_hi(unsigned u) { return __uint_as_float(u & 0xffff0000u); }
DI float wave_sum(float v) {
#pragma unroll
    for (int o = 1; o < 64; o <<= 1) v += __shfl_xor(v, o);
    return v;
}
#define XB_TMO      128
#define XB_XCNT(j)  (256  + 64 * (j))
#define XB_XSUB(j)  (1280 + 64 * (j))
#define XB_XGEN(j)  (2304 + 64 * (j))
#define XB_TOP      3328
#define XB_TOPGEN   3392
#define XCD_BAR_WORDS 3456
#define XB_SPIN_CAP (1u << 18)

__device__ __forceinline__ unsigned xb_ld(unsigned* p)              { return __hip_atomic_load(p, __ATOMIC_RELAXED, __HIP_MEMORY_SCOPE_AGENT); }
__device__ __forceinline__ unsigned xb_add(unsigned* p, unsigned v) { return __hip_atomic_fetch_add(p, v, __ATOMIC_RELAXED, __HIP_MEMORY_SCOPE_AGENT); }
__device__ __forceinline__ unsigned xb_xcc_id() { return (unsigned)__builtin_amdgcn_s_getreg((3 << 11) | 20) & 0xFu; }
#define XB_SPIN(cond, bar) do { unsigned _sp = 0; while (cond) { __builtin_amdgcn_s_sleep(1); \
    if ((++_sp & 255u) == 0u) { if (xb_ld(&(bar)[XB_TMO])) break; if (_sp > XB_SPIN_CAP) { atomicAdd(&(bar)[XB_TMO], 1u); break; } } } } while (0)

struct XcdBarrier {
    unsigned* bar; unsigned x;
    volatile LAS unsigned* st;
};

__device__ __forceinline__ XcdBarrier xcd_barrier_post(unsigned* bar, volatile LAS unsigned* st) {
    XcdBarrier b; b.bar = bar; b.x = xb_xcc_id(); b.st = st;
    if (threadIdx.x == 0) (void)xb_add(&bar[XB_XCNT(b.x)], 1u);
    return b;
}
__device__ __forceinline__ void xcd_barrier_complete(unsigned* bar, unsigned x, unsigned& nloc, unsigned& nx) {
    const unsigned G = gridDim.x * gridDim.y * gridDim.z;
    unsigned sum, cnt, mine, sp = 0u;
    for (;;) {
        sum = 0u; cnt = 0u; mine = 0u;
#pragma unroll
        for (unsigned j = 0; j < 16; ++j) { const unsigned c = xb_ld(&bar[XB_XCNT(j)]); sum += c; cnt += (c > 0u) ? 1u : 0u; mine = (j == x) ? c : mine; }
        if (sum == G) break;
        __builtin_amdgcn_s_sleep(1);
        if ((++sp & 255u) == 0u) { if (xb_ld(&bar[XB_TMO])) break; if (sp > XB_SPIN_CAP) { atomicAdd(&bar[XB_TMO], 1u); break; } }
    }
    nloc = mine > 0u ? mine : 1u; nx = cnt > 0u ? cnt : 1u;
}

__device__ __forceinline__ void xcd_barrier(const XcdBarrier& b) {
    asm volatile("s_waitcnt vmcnt(0)" ::: "memory");
    __syncthreads();
    if (threadIdx.x == 0) {
        unsigned* bar = b.bar;
        __builtin_amdgcn_s_waitcnt(0);
        unsigned nloc = b.st[0], nx = b.st[1];
        if (nloc == 0u) { xcd_barrier_complete(bar, b.x, nloc, nx); b.st[0] = nloc; b.st[1] = nx; }
        const unsigned old = xb_add(&bar[XB_XSUB(b.x)], 1u);
        const unsigned gen = old / nloc;
        if (old + 1u == (gen + 1u) * nloc) {
            __builtin_amdgcn_fence(__ATOMIC_RELEASE, "agent");
            asm volatile("s_waitcnt vmcnt(0)" ::: "memory");
            const unsigned og = xb_add(&bar[XB_TOP], 1u);
            const unsigned tg = og / nx;
            if (og + 1u == (tg + 1u) * nx) xb_add(&bar[XB_TOPGEN], 1u);
            else XB_SPIN(xb_ld(&bar[XB_TOPGEN]) == tg, bar);
            __builtin_amdgcn_fence(__ATOMIC_ACQUIRE, "agent");
            xb_add(&bar[XB_XGEN(b.x)], 1u);
            asm volatile("s_waitcnt vmcnt(0)" ::: "memory");
        } else {
            XB_SPIN(xb_ld(&bar[XB_XGEN(b.x)]) == gen, bar);
            __builtin_amdgcn_fence(__ATOMIC_ACQUIRE, "agent");
            asm volatile("s_waitcnt vmcnt(0)" ::: "memory");
        }
    }
    __syncthreads();
}

DI void p0_transpose_item(const float* W, int K, int N, bf16* WT, LAS float* scr, int item, int lane, const float* gain, int nscaled, float cscale) {
    const int nblk = N / 32, kb = item / nblk, nb = item % nblk, k0 = 64 * kb, n0 = 32 * nb;
    float tv[32];
#pragma unroll
    for (int i = 0; i < 32; ++i) tv[i] = W[(size_t)(k0 + 2 * i + (lane >> 5)) * N + n0 + (lane & 31)];
#pragma unroll
    for (int i = 0; i < 32; ++i) { const int kk = 2 * i + (lane >> 5); float v = tv[i]; if (gain) v *= gain[k0 + kk]; scr[kk * 33 + (lane & 31)] = v; }
    LDS_WAIT();
    const int c = lane & 7;
#pragma unroll
    for (int j = 0; j < 4; ++j) { const int n = (lane >> 3) + 8 * j; const LAS float* s = scr + (8 * c) * 33 + n; const float cs = (n0 + n < nscaled) ? cscale : 1.f;
        v4u o; o.x = pk2(s[0 * 33] * cs, s[1 * 33] * cs); o.y = pk2(s[2 * 33] * cs, s[3 * 33] * cs); o.z = pk2(s[4 * 33] * cs, s[5 * 33] * cs); o.w = pk2(s[6 * 33] * cs, s[7 * 33] * cs);
        *(v4u*)(WT + (size_t)(n0 + n) * K + k0 + 8 * c) = o; }
    LDS_WAIT();
}
struct P0Args { const float *x, *conv_g, *w_in, *w_out, *attn_g, *w_qkv, *w_o, *ffn_g, *w_pq, *subk, *pu, *pv;
                bf16 *WinT, *WoutT, *WqkvT, *WoT, *WpqT, *SKb; unsigned char *U8, *V8; bf16* XB; float* SS0; };
DI void p0_prologue(const P0Args& a, LAS unsigned char* lds, int vcu, int G, int wave, int lane, int tid) {
    LAS float* scr = (LAS float*)(lds + wave * 16384);
    const int gw = vcu * NWAVES + wave, NGW = G * NWAVES;
    constexpr int I_IN = 16 * (NIN / 32), I_OUT = 16 * (D / 32), I_QKV = 16 * (NQKV / 32), I_O = I_OUT, I_PQ = 16 * (NPQ / 32);
    constexpr int NITEMS = I_IN + I_OUT + I_QKV + I_O + 2 * I_PQ;
    for (int it = gw; it < NITEMS; it += NGW) {
        int r = it;
        if (r < I_IN) { p0_transpose_item(a.w_in, D, NIN, a.WinT, scr, r, lane, a.conv_g, 0, 1.f); continue; } r -= I_IN;
        if (r < I_OUT) { p0_transpose_item(a.w_out, D, D, a.WoutT, scr, r, lane, nullptr, 0, 1.f); continue; } r -= I_OUT;
        if (r < I_QKV) { p0_transpose_item(a.w_qkv, D, NQKV, a.WqkvT, scr, r, lane, a.attn_g, 1024, QSCALE); continue; } r -= I_QKV;
        if (r < I_O) { p0_transpose_item(a.w_o, D, D, a.WoT, scr, r, lane, nullptr, 0, 1.f); continue; } r -= I_O;
        if (r < I_PQ) { p0_transpose_item(a.w_pq, D, NPQ, a.WpqT, scr, r, lane, a.ffn_g, 0, 1.f); continue; } r -= I_PQ;
        p0_transpose_item(a.w_pq + (size_t)D * NPQ, D, NPQ, a.WpqT + (size_t)NPQ * D, scr, r, lane, a.ffn_g + D, 0, 1.f);
    }
    const size_t gt = (size_t)vcu * (NWAVES * 64) + tid, NGT = (size_t)G * NWAVES * 64;
    constexpr size_t C_SK = (size_t)2 * 8 * 2 * 128 * 128 / 8;
    for (size_t c = gt; c < C_SK; c += NGT) { const f32x4 v0 = *(const f32x4*)(a.subk + c * 8), v1 = *(const f32x4*)(a.subk + c * 8 + 4);
        v4u o; o.x = pk2(v0[0], v0[1]); o.y = pk2(v0[2], v0[3]); o.z = pk2(v1[0], v1[1]); o.w = pk2(v1[2], v1[3]); *(v4u*)(a.SKb + c * 8) = o; }
    { const size_t gwv = (size_t)gw, NB = (size_t)2 * NEXP * D / 2048;
      for (size_t blk = gwv; blk < 2 * NB; blk += (size_t)NGW) { const bool isv = blk >= NB; const size_t bb = isv ? blk - NB : blk; const int layer = (int)(bb / (NB / 2));
        const float* src = (isv ? a.pv : a.pu) + bb * 2048; unsigned char* dst = (isv ? a.V8 : a.U8) + bb * 2048;
        f32x4 v[8];
#pragma unroll
        for (int j = 0; j < 8; ++j) v[j] = __builtin_nontemporal_load((const f32x4*)(src + 256 * j) + lane);
#pragma unroll
        for (int j = 0; j < 8; ++j) { unsigned w;
            if (isv) { const f32x4 t = v[j] * 1024.0f; int wi = __builtin_amdgcn_cvt_pk_fp8_f32(t[0], t[1], 0, false); wi = __builtin_amdgcn_cvt_pk_fp8_f32(t[2], t[3], wi, true); w = (unsigned)wi; }
            else { const f32x4 g = *((const f32x4*)(a.ffn_g + layer * D + 256 * (j & 3)) + lane); const f32x4 t = v[j] * g * 512.0f; w = 0u;
#pragma unroll
                for (int e = 0; e < 4; ++e) { const int qi = (int)__builtin_rintf(fminf(fmaxf(t[e], -127.f), 127.f)); w |= ((unsigned)qi & 0xffu) << (8 * e); } }
            *((unsigned*)(dst + 256 * j) + lane) = w; } } }
    for (int m0 = 2 * gw; m0 < T; m0 += 2 * NGW) {
        f32x4 v[2][4]; float s2[2];
#pragma unroll
        for (int r = 0; r < 2; ++r)
#pragma unroll
            for (int j = 0; j < 4; ++j) v[r][j] = *((const f32x4*)(a.x + (size_t)(m0 + r) * D) + lane + 64 * j);
#pragma unroll
        for (int r = 0; r < 2; ++r) { float s = 0.f;
#pragma unroll
            for (int j = 0; j < 4; ++j) s += (v[r][j][0] * v[r][j][0] + v[r][j][1] * v[r][j][1]) + (v[r][j][2] * v[r][j][2] + v[r][j][3] * v[r][j][3]);
            s2[r] = wave_sum(s); }
#pragma unroll
        for (int r = 0; r < 2; ++r) { const int m = m0 + r;
            v2u* o8 = (v2u*)(a.XB + (size_t)m * D) + lane;
#pragma unroll
            for (int j = 0; j < 4; ++j) { v2u w; w.x = pk2(v[r][j][0], v[r][j][1]); w.y = pk2(v[r][j][2], v[r][j][3]); o8[64 * j] = w; }
            if (lane < 4) { f32x4 z = {0.f, 0.f, 0.f, 0.f}; ((f32x4*)(a.SS0 + (size_t)(2 * T + m) * 16))[lane] = z; ((f32x4*)(a.SS0 + (size_t)(4 * T + m) * 16))[lane] = z;
                if (lane == 0) z[0] = s2[r]; ((f32x4*)(a.SS0 + (size_t)m * 16))[lane] = z; } }
    }
}

DI void conv_gate_phase(const bf16* G1, const float* cw, bf16* Y, int vcu, int G, int tid) {
    const size_t gt = (size_t)vcu * (NWAVES * 64) + tid, NGT = (size_t)G * NWAVES * 64;
    for (size_t c = gt; c < (size_t)T * (D / 8); c += NGT) {
        const int t = (int)(c / (D / 8)), d0 = (int)(c % (D / 8)) * 8, ts = t % SEQ;
        const v4u gb = *(const v4u*)(G1 + (size_t)t * NIN + d0);
        float acc[8];
#pragma unroll
        for (int i = 0; i < 8; ++i) acc[i] = 0.f;
#pragma unroll
        for (int w = 0; w < 3; ++w) { const int tt = ts + w - 1;
            if (tt >= 0 && tt < SEQ) {
                const v4u gc = *(const v4u*)(G1 + (size_t)(t + w - 1) * NIN + D + d0), hh = *(const v4u*)(G1 + (size_t)(t + w - 1) * NIN + 2 * D + d0);
                const f32x4 w0 = *(const f32x4*)(cw + w * D + d0), w1 = *(const f32x4*)(cw + w * D + d0 + 4);
                acc[0] += w0[0] * (bf_lo(gc.x) * bf_lo(hh.x)); acc[1] += w0[1] * (bf_hi(gc.x) * bf_hi(hh.x));
                acc[2] += w0[2] * (bf_lo(gc.y) * bf_lo(hh.y)); acc[3] += w0[3] * (bf_hi(gc.y) * bf_hi(hh.y));
                acc[4] += w1[0] * (bf_lo(gc.z) * bf_lo(hh.z)); acc[5] += w1[1] * (bf_hi(gc.z) * bf_hi(hh.z));
                acc[6] += w1[2] * (bf_lo(gc.w) * bf_lo(hh.w)); acc[7] += w1[3] * (bf_hi(gc.w) * bf_hi(hh.w)); } }
        v4u o; o.x = pk2(acc[0] * bf_lo(gb.x), acc[1] * bf_hi(gb.x)); o.y = pk2(acc[2] * bf_lo(gb.y), acc[3] * bf_hi(gb.y));
        o.z = pk2(acc[4] * bf_lo(gb.z), acc[5] * bf_hi(gb.z)); o.w = pk2(acc[6] * bf_lo(gb.w), acc[7] * bf_hi(gb.w));
        *(v4u*)(Y + (size_t)t * D + d0) = o;
    }
}

template <int CTRL> DI unsigned dppu(unsigned v) { return (unsigned)__builtin_amdgcn_update_dpp(0, (int)v, CTRL, 0xf, 0xf, false); }
DI unsigned umax(unsigned a, unsigned b) { return a > b ? a : b; }
DI unsigned umin(unsigned a, unsigned b) { return a < b ? a : b; }
DI unsigned rowmax_u(unsigned v) { v = umax(v, dppu<0x128>(v)); v = umax(v, dppu<0x124>(v)); v = umax(v, dppu<0x122>(v)); v = umax(v, dppu<0x121>(v)); return v; }
DI float rowsum_f(float v) { v += __uint_as_float(dppu<0x128>(__float_as_uint(v))); v += __uint_as_float(dppu<0x124>(__float_as_uint(v))); v += __uint_as_float(dppu<0x122>(__float_as_uint(v))); v += __uint_as_float(dppu<0x121>(__float_as_uint(v))); return v; }
DI unsigned f2key(float f) { const unsigned u = __float_as_uint(f); return u ^ ((unsigned)((int)u >> 31) | 0x80000000u); }
DI float key2f(unsigned k) { const unsigned u = (k & 0x80000000u) ? (k ^ 0x80000000u) : ~k; return __uint_as_float(u); }
DI unsigned cand_ij(int c) {
    unsigned i, j;
    if (c < 16) { i = 0; j = c; } else if (c < 24) { i = 1; j = c - 16; } else if (c < 29) { i = 2; j = c - 24; } else if (c < 33) { i = 3; j = c - 29; }
    else if (c < 36) { i = 4; j = c - 33; } else if (c < 38) { i = 5; j = c - 36; } else if (c < 40) { i = 6; j = c - 38; } else if (c < 42) { i = 7; j = c - 40; }
    else { i = 8 + (c - 42); j = 0; }
    return (i & 15u) | (j << 4);
}
#define CE_DESC(a, b) do { const unsigned _hi = umax(a, b), _lo = umin(a, b); a = _hi; b = _lo; } while (0)
DI void route_phase(const bf16* PQ, const bf16* SK, unsigned short* IDX, float* GATE, LAS unsigned char* lds, int vcu, int G, int wave, int lane, int tid) {
    const int fr = lane & 15, fq = lane >> 4;
    LAS unsigned char* TAB = lds;
    LAS unsigned char* SKL = lds + 256;
    if (tid < 64) TAB[tid] = (unsigned char)(tid < 50 ? cand_ij(tid) : 0xff);
    LAS unsigned* gcnt = (LAS unsigned*)(lds + 128);
    constexpr int NITEM = (T / 128) * 8;
    for (int item0 = vcu; item0 < NITEM; ) {
        const int h = item0 & 7; int nrun = 0;
        for (int it = item0; it < NITEM && (it & 7) == h; it += G) ++nrun;
        __syncthreads();
        for (int c = tid; c < 2 * 128 * 16; c += NWAVES * 64) { const int row = c >> 4, c16 = c & 15;
            *(LAS v4u*)(SKL + row * 272 + c16 * 16) = *(const v4u*)(SK + (size_t)(h * 256 + row) * 128 + c16 * 8); }
        if (tid == 0) *gcnt = 0u;
        __syncthreads();
      for (;;) {
        unsigned grp = 0u; if (lane == 0) grp = __hip_atomic_fetch_add(gcnt, 1u, __ATOMIC_RELAXED, __HIP_MEMORY_SCOPE_WORKGROUP);
        grp = (unsigned)__builtin_amdgcn_readfirstlane((int)grp);
        if (grp >= (unsigned)(nrun * 8)) break;
        const int tile = (item0 + (int)(grp >> 3) * G) >> 3, t0 = tile * 128 + (int)(grp & 7u) * 16;
        unsigned res[2][4];
#pragma unroll
        for (int p = 0; p < 2; ++p) {
            bf16x8 af[4];
#pragma unroll
            for (int ks = 0; ks < 4; ++ks) af[ks] = *(const bf16x8*)(PQ + (size_t)(t0 + fr) * NPQ + h * 256 + p * 128 + ks * 32 + fq * 8);
            f32x4 acc[8];
#pragma unroll
            for (int n = 0; n < 8; ++n) { acc[n] = (f32x4){0.f, 0.f, 0.f, 0.f};
#pragma unroll
                for (int ks = 0; ks < 4; ++ks) { const bf16x8 bfr = *(const LAS bf16x8*)(SKL + (p * 128 + n * 16 + fr) * 272 + ks * 64 + fq * 16);
                    acc[n] = __builtin_amdgcn_mfma_f32_16x16x32_bf16(af[ks], bfr, acc[n], 0, 0, 0); } }
            unsigned L[4][8];
#pragma unroll
            for (int r = 0; r < 4; ++r)
#pragma unroll
                for (int n = 0; n < 8; ++n) L[r][n] = (f2key(acc[n][r]) & ~127u) | (unsigned)(127 - (16 * n + fr));
#define CE4(i, j) do { _Pragma("unroll") for (int r = 0; r < 4; ++r) CE_DESC(L[r][i], L[r][j]); } while (0)
            CE4(0, 1); CE4(2, 3); CE4(4, 5); CE4(6, 7);
            CE4(0, 2); CE4(1, 3); CE4(4, 6); CE4(5, 7);
            CE4(1, 2); CE4(5, 6); CE4(0, 4); CE4(3, 7);
            CE4(1, 5); CE4(2, 6);
            CE4(1, 4); CE4(3, 6);
            CE4(2, 4); CE4(3, 5);
            CE4(3, 4);
#undef CE4
            unsigned rr[4] = {0u, 0u, 0u, 0u};
#pragma unroll
            for (int k = 0; k < 16; ++k) {
                unsigned gm[4];
#pragma unroll
                for (int r = 0; r < 4; ++r) gm[r] = umax(L[r][0], dppu<0x128>(L[r][0]));
#pragma unroll
                for (int r = 0; r < 4; ++r) gm[r] = umax(gm[r], dppu<0x124>(gm[r]));
#pragma unroll
                for (int r = 0; r < 4; ++r) gm[r] = umax(gm[r], dppu<0x122>(gm[r]));
#pragma unroll
                for (int r = 0; r < 4; ++r) gm[r] = umax(gm[r], dppu<0x121>(gm[r]));
#pragma unroll
                for (int r = 0; r < 4; ++r) { rr[r] = (fr == k) ? gm[r] : rr[r]; const bool pop = (L[r][0] == gm[r]);
#pragma unroll
                    for (int n = 0; n < 7; ++n) L[r][n] = pop ? L[r][n + 1] : L[r][n];
                    L[r][7] = pop ? 0u : L[r][7]; }
            }
#pragma unroll
            for (int r = 0; r < 4; ++r) res[p][r] = rr[r];
        }
        const int gbase = (lane & 48) * 4;
        unsigned ck[4][4];
#pragma unroll
        for (int r = 0; r < 4; ++r)
#pragma unroll
            for (int s = 0; s < 4; ++s) { const int c = fr + 16 * s; const unsigned tb = TAB[c & 63];
                const unsigned k0 = (unsigned)__builtin_amdgcn_ds_bpermute(gbase + (int)(tb & 15u) * 4, (int)res[0][r]);
                const unsigned k1 = (unsigned)__builtin_amdgcn_ds_bpermute(gbase + (int)((tb >> 4) & 15u) * 4, (int)res[1][r]);
                const float v = key2f((k0 & ~127u) | 64u) + key2f((k1 & ~127u) | 64u);
                ck[r][s] = (c < 50) ? ((f2key(v) & ~63u) | (unsigned)(63 - c)) : 0u; }
        unsigned sel[4] = {0u, 0u, 0u, 0u};
#pragma unroll
        for (int k = 0; k < 16; ++k) {
            unsigned gm[4];
#pragma unroll
            for (int r = 0; r < 4; ++r) { const unsigned lm = umax(umax(ck[r][0], ck[r][1]), umax(ck[r][2], ck[r][3])); gm[r] = umax(lm, dppu<0x128>(lm)); }
#pragma unroll
            for (int r = 0; r < 4; ++r) gm[r] = umax(gm[r], dppu<0x124>(gm[r]));
#pragma unroll
            for (int r = 0; r < 4; ++r) gm[r] = umax(gm[r], dppu<0x122>(gm[r]));
#pragma unroll
            for (int r = 0; r < 4; ++r) gm[r] = umax(gm[r], dppu<0x121>(gm[r]));
#pragma unroll
            for (int r = 0; r < 4; ++r) { sel[r] = (fr == k) ? gm[r] : sel[r];
#pragma unroll
                for (int s = 0; s < 4; ++s) ck[r][s] = (ck[r][s] == gm[r]) ? 0u : ck[r][s]; }
        }
#pragma unroll
        for (int r = 0; r < 4; ++r) {
            const int t = t0 + 4 * fq + r;
            const int cs = 63 - (int)(sel[r] & 63u); const unsigned tb = TAB[cs & 63];
            const unsigned k0 = (unsigned)__builtin_amdgcn_ds_bpermute(gbase + (int)(tb & 15u) * 4, (int)res[0][r]);
            const unsigned k1 = (unsigned)__builtin_amdgcn_ds_bpermute(gbase + (int)((tb >> 4) & 15u) * 4, (int)res[1][r]);
            const int e = (127 - (int)(k0 & 127u)) * 128 + (127 - (int)(k1 & 127u));
            const float val = key2f((sel[r] & ~63u) | 32u), top = key2f((rowmax_u(sel[r]) & ~63u) | 32u);
            const float ex = __builtin_amdgcn_exp2f((val - top) * LOG2E), sum = rowsum_f(ex);
            IDX[(size_t)t * 128 + h * 16 + fr] = (unsigned short)e; GATE[(size_t)t * 128 + h * 16 + fr] = ex / sum;
        }
      }
        item0 += nrun * G;
    }
}

DI float dot8(v4u x, v4u u, float acc) {
    acc += bf_lo(x.x) * bf_lo(u.x); acc += bf_hi(x.x) * bf_hi(u.x); acc += bf_lo(x.y) * bf_lo(u.y); acc += bf_hi(x.y) * bf_hi(u.y);
    acc += bf_lo(x.z) * bf_lo(u.z); acc += bf_hi(x.z) * bf_hi(u.z); acc += bf_lo(x.w) * bf_lo(u.w); acc += bf_hi(x.w) * bf_hi(u.w);
    return acc;
}
DI void fma8(float* acc, float a, v4u v) {
    acc[0] += a * bf_lo(v.x); acc[1] += a * bf_hi(v.x); acc[2] += a * bf_lo(v.y); acc[3] += a * bf_hi(v.y);
    acc[4] += a * bf_lo(v.z); acc[5] += a * bf_hi(v.z); acc[6] += a * bf_lo(v.w); acc[7] += a * bf_hi(v.w);
}
DI f32x2 fp8lo(unsigned w) { return __builtin_amdgcn_cvt_pk_f32_fp8((int)w, false); }
DI f32x2 fp8hi(unsigned w) { return __builtin_amdgcn_cvt_pk_f32_fp8((int)w, true); }

template <int CTRL> DI float dppf(float v) { return __uint_as_float(dppu<CTRL>(__float_as_uint(v))); }
struct UTok { v4u xa, xb; v4u uw[16]; };
DI void u_issue(UTok& S, const unsigned char* U8s, const unsigned short* IDX, const bf16* XB, int t, int s, int lane) {
    const int g = lane >> 3, k = lane & 7;
    const int i0 = IDX[(size_t)t * 128 + lane], i1 = IDX[(size_t)t * 128 + 64 + lane];
    const v4u* xr = (const v4u*)(XB + (size_t)t * D + 128 * s + 16 * k);
    S.xa = xr[0]; S.xb = xr[1];
#pragma unroll
    for (int i = 0; i < 16; ++i) { const unsigned idx = (unsigned)__builtin_amdgcn_ds_bpermute((8 * (i & 7) + g) * 4, i < 8 ? i0 : i1);
        S.uw[i] = *(const v4u*)(U8s + (idx * 1024u + 16u * (unsigned)k)); }
}
DI void u_compute(const UTok& S, float* HPs, int t, int lane) {
    const int g = lane >> 3, k = lane & 7;
    const v4u xa = S.xa, xb = S.xb;
    float xv[16];
    xv[0] = bf_lo(xa.x); xv[1] = bf_hi(xa.x); xv[2] = bf_lo(xa.y); xv[3] = bf_hi(xa.y); xv[4] = bf_lo(xa.z); xv[5] = bf_hi(xa.z); xv[6] = bf_lo(xa.w); xv[7] = bf_hi(xa.w);
    xv[8] = bf_lo(xb.x); xv[9] = bf_hi(xb.x); xv[10] = bf_lo(xb.y); xv[11] = bf_hi(xb.y); xv[12] = bf_lo(xb.z); xv[13] = bf_hi(xb.z); xv[14] = bf_lo(xb.w); xv[15] = bf_hi(xb.w);
    float am = 0.f;
#pragma unroll
    for (int i = 0; i < 16; ++i) am = fmaxf(am, __builtin_fabsf(xv[i]));
    am = fmaxf(am, dppf<0xB1>(am)); am = fmaxf(am, dppf<0x4E>(am)); am = fmaxf(am, dppf<0x141>(am));
    am = fmaxf(am, 1e-20f);
    const float qs = 127.0f / am, dq = am * (1.0f / (127.0f * 512.0f));
    unsigned xq[4];
#pragma unroll
    for (int q = 0; q < 4; ++q) { unsigned w = 0u;
#pragma unroll
        for (int e = 0; e < 4; ++e) { const int qi = (int)__builtin_rintf(xv[4 * q + e] * qs); w |= ((unsigned)qi & 0xffu) << (8 * e); }
        xq[q] = w; }
    int p[16];
#pragma unroll
    for (int i = 0; i < 16; ++i) { int a0 = __builtin_amdgcn_sdot4((int)xq[0], (int)S.uw[i][0], 0, false), a1 = __builtin_amdgcn_sdot4((int)xq[1], (int)S.uw[i][1], 0, false);
        a0 = __builtin_amdgcn_sdot4((int)xq[2], (int)S.uw[i][2], a0, false); a1 = __builtin_amdgcn_sdot4((int)xq[3], (int)S.uw[i][3], a1, false);
        p[i] = a0 + a1; }
    const bool h4 = k >= 4, h1 = k & 1, h2 = k & 2;
    int q8[8], q4[4], q2[2];
#pragma unroll
    for (int j = 0; j < 8; ++j) { const int keep = h4 ? p[8 + j] : p[j], send = h4 ? p[j] : p[8 + j]; q8[j] = keep + (int)dppu<0x141>((unsigned)send); }
#pragma unroll
    for (int j = 0; j < 4; ++j) { const int keep = h1 ? q8[4 + j] : q8[j], send = h1 ? q8[j] : q8[4 + j]; q4[j] = keep + (int)dppu<0xB1>((unsigned)send); }
#pragma unroll
    for (int j = 0; j < 2; ++j) { const int keep = h2 ? q4[2 + j] : q4[j], send = h2 ? q4[j] : q4[2 + j]; q2[j] = keep + (int)dppu<0x4E>((unsigned)send); }
    const int ib = (h4 ? 8 : 0) + (h1 ? 4 : 0) + (h2 ? 2 : 0);
    HPs[(size_t)t * 128 + 8 * ib + g] = (float)q2[0] * dq; HPs[(size_t)t * 128 + 8 * ib + 8 + g] = (float)q2[1] * dq;
}
struct VTok { v4u vw[16]; float av[16]; };
DI void v_issue(VTok& S, const unsigned char* V8s, const unsigned short* IDX, const float* A, int t, int lane) {
    const int g = lane >> 3, k = lane & 7;
    const int i0 = IDX[(size_t)t * 128 + lane], i1 = IDX[(size_t)t * 128 + 64 + lane];
    const float a0 = A[(size_t)t * 128 + lane], a1 = A[(size_t)t * 128 + 64 + lane];
#pragma unroll
    for (int i = 0; i < 16; ++i) { const int ad = (8 * (i & 7) + g) * 4; const int idx = __builtin_amdgcn_ds_bpermute(ad, i < 8 ? i0 : i1);
        S.av[i] = __uint_as_float((unsigned)__builtin_amdgcn_ds_bpermute(ad, (int)__float_as_uint(i < 8 ? a0 : a1)));
        S.vw[i] = *(const v4u*)(V8s + ((unsigned)idx * 1024u + 16u * (unsigned)k)); }
}
template <bool FINAL>
DI void v_compute(const VTok& S, float* xf, bf16* XB, float* ss_out, int t, int s, int lane) {
    const int k = lane & 7;
    const bool b3 = lane & 8, b4 = lane & 16, b5 = lane & 32;
    const int col = 128 * s + 16 * k + (b3 ? 8 : 0) + (b4 ? 4 : 0) + (b5 ? 2 : 0);
    float* xo = xf + (size_t)t * D + col;
    f32x2 o = *(const f32x2*)xo;
    f32x2 acc[8];
#pragma unroll
    for (int i = 0; i < 8; ++i) acc[i] = (f32x2){0.f, 0.f};
#pragma unroll
    for (int i = 0; i < 16; ++i) { const f32x2 a2 = {S.av[i], S.av[i]};
#pragma unroll
        for (int q = 0; q < 4; ++q) { acc[2 * q] = __builtin_elementwise_fma(a2, fp8lo(S.vw[i][q]), acc[2 * q]); acc[2 * q + 1] = __builtin_elementwise_fma(a2, fp8hi(S.vw[i][q]), acc[2 * q + 1]); } }
    float v[16];
#pragma unroll
    for (int i = 0; i < 8; ++i) { v[2 * i] = acc[i].x; v[2 * i + 1] = acc[i].y; }
    float v8[8], v4[4], v2[2];
#pragma unroll
    for (int j = 0; j < 8; ++j) { const float keep = b3 ? v[8 + j] : v[j], send = b3 ? v[j] : v[8 + j]; v8[j] = keep + __shfl_xor(send, 8); }
#pragma unroll
    for (int j = 0; j < 4; ++j) { const float keep = b4 ? v8[4 + j] : v8[j], send = b4 ? v8[j] : v8[4 + j]; v4[j] = keep + __shfl_xor(send, 16); }
#pragma unroll
    for (int j = 0; j < 2; ++j) { const float keep = b5 ? v4[2 + j] : v4[j], send = b5 ? v4[j] : v4[2 + j]; v2[j] = keep + __shfl_xor(send, 32); }
    o.x += v2[0]; o.y += v2[1];
    *(f32x2*)xo = o;
    if (!FINAL) *(unsigned*)(XB + (size_t)t * D + col) = pk2(o.x, o.y);
    const float sq = wave_sum(o.x * o.x + o.y * o.y);
    if (lane == 0) ss_out[(size_t)t * 16 + s] = sq;
}
constexpr int XG = 8, XNG = T / XG;
DI unsigned wave_ticket(unsigned* head, int lane) {
    unsigned v = 0u; if (lane == 0) v = __hip_atomic_fetch_add(head, 1u, __ATOMIC_RELAXED, __HIP_MEMORY_SCOPE_AGENT);
    return (unsigned)__builtin_amdgcn_readfirstlane((int)v);
}
template <int PASS, bool FINAL>
DI void sliced_pass(const unsigned char* TAB, const unsigned short* IDX, const bf16* XBc, bf16* XBw, float* HP, const float* A, float* xf, float* ss_out,
                    unsigned* heads, unsigned* census, volatile LAS unsigned* slot, int wave, int lane, int tid) {
    const int own = (int)(xb_xcc_id() & 7u);
    __syncthreads();
    if (tid == 0) { unsigned all = 1u;
#pragma unroll 1
        for (int q = 0; q < 8; ++q) { const unsigned n = xb_ld(census + XB_XCNT(q)) + xb_ld(census + XB_XCNT(q + 8)); all &= (n > 0u) ? 1u : 0u; }
        slot[1] = all; }
    __syncthreads();
    const int nds = slot[1] ? 1 : 8;
#pragma unroll 1
    for (int ds = 0; ds < nds; ++ds) { const int s = (own + ds) & 7;
        unsigned* head = heads + 64 * s; const unsigned char* Ts = TAB + 128 * s;
        unsigned tk = wave_ticket(head, lane);
        if (tk >= (unsigned)XNG) continue;
        int t0 = (int)tk * XG;
        if (PASS == 0) { float* HPs = HP + (size_t)s * T * 128;
            UTok P, Q; u_issue(P, Ts, IDX, XBc, t0, s, lane);
            for (;;) { const unsigned nxt = wave_ticket(head, lane); int nt0 = 0;
#pragma unroll 1
                for (int j = 0; j < XG; j += 2) { u_issue(Q, Ts, IDX, XBc, t0 + j + 1, s, lane); u_compute(P, HPs, t0 + j, lane);
                    if (j + 2 < XG) u_issue(P, Ts, IDX, XBc, t0 + j + 2, s, lane); else { nt0 = (int)nxt * XG; if (nxt < (unsigned)XNG) u_issue(P, Ts, IDX, XBc, nt0, s, lane); }
                    u_compute(Q, HPs, t0 + j + 1, lane); }
                if (nxt >= (unsigned)XNG) break; t0 = nt0; }
        } else {
            VTok P, Q; v_issue(P, Ts, IDX, A, t0, lane);
            for (;;) { const unsigned nxt = wave_ticket(head, lane); int nt0 = 0;
#pragma unroll 1
                for (int j = 0; j < XG; j += 2) { v_issue(Q, Ts, IDX, A, t0 + j + 1, lane); v_compute<FINAL>(P, xf, XBw, ss_out, t0 + j, s, lane);
                    if (j + 2 < XG) v_issue(P, Ts, IDX, A, t0 + j + 2, lane); else { nt0 = (int)nxt * XG; if (nxt < (unsigned)XNG) v_issue(P, Ts, IDX, A, nt0, lane); }
                    v_compute<FINAL>(Q, xf, XBw, ss_out, t0 + j + 1, s, lane); }
                if (nxt >= (unsigned)XNG) break; t0 = nt0; }
        } }
}
DI void reduce_phase(const float* HP, const float* GATE, const float* ss_in, float* A, int vcu, int G, int tid) {
    const size_t gt = (size_t)vcu * (NWAVES * 64) + tid, NGT = (size_t)G * NWAVES * 64;
    for (size_t c = gt; c < (size_t)T * 128; c += NGT) { float h = 0.f;
#pragma unroll
        for (int s = 0; s < 8; ++s) h += HP[(size_t)s * T * 128 + c];
        h *= pg8::row_rstd(ss_in, (int)(c >> 7));
        A[c] = (1.0f / 1024.0f) * GATE[c] * (0.5f * h * (1.f + erff(h * 0.70710678118654752f))); }
}
DI void final_phase(const float* ss, float* xf, const float* fin_g, int vcu, int G, int wave, int lane) {
    for (int m = vcu * NWAVES + wave; m < T; m += G * NWAVES) { const float rf = pg8::row_rstd(ss, m);
        f32x4* xr = (f32x4*)(xf + (size_t)m * D) + lane;
#pragma unroll
        for (int j = 0; j < 4; ++j) xr[64 * j] = xr[64 * j] * rf * *((const f32x4*)fin_g + lane + 64 * j); }
}

DI int t5_bucket(int rel) {
    const int n = rel < 0 ? -rel : rel; int b;
    if (n < 8) b = n; else if (n < 12) b = 8; else if (n < 16) b = 9; else if (n < 23) b = 10; else if (n < 32) b = 11; else if (n < 46) b = 12; else if (n < 64) b = 13; else if (n < 91) b = 14; else b = 15;
    return b + (rel > 0 ? 16 : 0);
}
DI int crow(int reg, int h) { return (reg & 3) + 8 * (reg >> 2) + 4 * h; }
constexpr int AT_KL = 0, AT_KSTR = 144, AT_VT = 384 * AT_KSTR  , AT_VSTR = 776, AT_BT = AT_VT + 64 * AT_VSTR  , AT_END = AT_BT + 4 * 512 * 4;
static_assert(AT_END <= RING_BYTES, "attention LDS");
DI void attn_phase(const bf16* Qg, const bf16* Kg, const bf16* Vg, bf16* AO, const float* rel_bias, const float* sink, LAS unsigned char* lds, int vcu, int G, int wave, int lane, int tid) {
    const int r = lane & 31, h = lane >> 5;
    for (int unit = vcu; unit < BATCH * 4 * (SEQ / 128); unit += G) {
        const int b = unit / 256, kvh = (unit % 256) / 64, blk = unit % 64;
        __syncthreads();
        for (int c = tid; c < 384 * 8; c += NWAVES * 64) { const int row = c >> 3, c8 = c & 7, ts = blk * 128 - 128 + row;
            v4u kv = {0u, 0u, 0u, 0u}, vv = {0u, 0u, 0u, 0u};
            if (ts >= 0 && ts < SEQ) { const size_t g = (size_t)(b * SEQ + ts) * 256 + kvh * 64 + c8 * 8; kv = *(const v4u*)(Kg + g); vv = *(const v4u*)(Vg + g); }
            *(LAS v4u*)(lds + AT_KL + row * AT_KSTR + c8 * 16) = kv;
            LAS unsigned short* vt = (LAS unsigned short*)(lds + AT_VT) + (c8 * 8) * (AT_VSTR / 2) + row;
            vt[0 * (AT_VSTR / 2)] = (unsigned short)(vv.x & 0xffffu); vt[1 * (AT_VSTR / 2)] = (unsigned short)(vv.x >> 16);
            vt[2 * (AT_VSTR / 2)] = (unsigned short)(vv.y & 0xffffu); vt[3 * (AT_VSTR / 2)] = (unsigned short)(vv.y >> 16);
            vt[4 * (AT_VSTR / 2)] = (unsigned short)(vv.z & 0xffffu); vt[5 * (AT_VSTR / 2)] = (unsigned short)(vv.z >> 16);
            vt[6 * (AT_VSTR / 2)] = (unsigned short)(vv.w & 0xffffu); vt[7 * (AT_VSTR / 2)] = (unsigned short)(vv.w >> 16); }
        for (int c = tid; c < 4 * 512; c += NWAVES * 64) { const int g = c >> 9, i = c & 511, rel = i - 255;
            float v = NEGBIG; if (rel >= -128 && rel <= 128) v = rel_bias[t5_bucket(rel) * 16 + kvh * 4 + g] * LOG2E;
            *(LAS float*)(lds + AT_BT + c * 4) = v; }
        __syncthreads();
        const int g = wave >> 1, qh = wave & 1, head = kvh * 4 + g;
        const float sinkl = sink[head] * LOG2E;
        bf16x8 qf[2][4];
#pragma unroll
        for (int qt = 0; qt < 2; ++qt)
#pragma unroll
            for (int s = 0; s < 4; ++s) qf[qt][s] = *(const bf16x8*)(Qg + (size_t)(b * SEQ + blk * 128 + qh * 64 + qt * 32 + r) * D + head * 64 + s * 16 + h * 8);
        float m[2] = {sinkl, sinkl}, l[2] = {0.f, 0.f};
        f32x16 o[2][2];
#pragma unroll
        for (int qt = 0; qt < 2; ++qt)
#pragma unroll
            for (int dt = 0; dt < 2; ++dt)
#pragma unroll
                for (int i = 0; i < 16; ++i) o[qt][dt][i] = 0.f;
        int kt_lo = 2 * qh, kt_hi = 2 * qh + 9;
        if (blk == 0 && kt_lo < 4) kt_lo = 4;
        if (blk == SEQ / 128 - 1 && kt_hi > 7) kt_hi = 7;
#pragma unroll 1
        for (int kt = kt_lo; kt <= kt_hi; ++kt) {
            bf16x8 kf[4];
#pragma unroll
            for (int s = 0; s < 4; ++s) kf[s] = *(const LAS bf16x8*)(lds + AT_KL + (32 * kt + r) * AT_KSTR + s * 32 + h * 16);
            bf16x8 vf[2][2];
#pragma unroll
            for (int dt = 0; dt < 2; ++dt)
#pragma unroll
                for (int s2 = 0; s2 < 2; ++s2) { const LAS unsigned char* vp = lds + AT_VT + (32 * dt + r) * AT_VSTR + (32 * kt + 16 * s2 + 4 * h) * 2;
                    const v2u lo = *(const LAS v2u*)vp, hi2 = *(const LAS v2u*)(vp + 16); v4u w = {lo.x, lo.y, hi2.x, hi2.y}; vf[dt][s2] = __builtin_bit_cast(bf16x8, w); }
#pragma unroll
            for (int qt = 0; qt < 2; ++qt) {
                f32x16 s;
                const LAS float* bt = (const LAS float*)(lds + AT_BT) + g * 512 + 127 + 32 * kt + 4 * h - (64 * qh + 32 * qt + r);
#pragma unroll
                for (int i = 0; i < 16; ++i) s[i] = bt[(i & 3) + 8 * (i >> 2)];
#pragma unroll
                for (int k4 = 0; k4 < 4; ++k4) s = __builtin_amdgcn_mfma_f32_32x32x16_bf16(kf[k4], qf[qt][k4], s, 0, 0, 0);
                float mx = s[0];
#pragma unroll
                for (int i = 1; i < 16; ++i) mx = fmaxf(mx, s[i]);
                mx = fmaxf(mx, __shfl_xor(mx, 32));
                const float mn = fmaxf(m[qt], mx), al = __builtin_amdgcn_exp2f(m[qt] - mn); m[qt] = mn;
                float ps = 0.f;
#pragma unroll
                for (int i = 0; i < 16; ++i) { s[i] = __builtin_amdgcn_exp2f(s[i] - mn); ps += s[i]; }
                l[qt] = l[qt] * al + ps;
#pragma unroll
                for (int dt = 0; dt < 2; ++dt)
#pragma unroll
                    for (int i = 0; i < 16; ++i) o[qt][dt][i] *= al;
                bf16x8 pf[2];
#pragma unroll
                for (int s2 = 0; s2 < 2; ++s2) { v4u w; w.x = pk2(s[8 * s2 + 0], s[8 * s2 + 1]); w.y = pk2(s[8 * s2 + 2], s[8 * s2 + 3]); w.z = pk2(s[8 * s2 + 4], s[8 * s2 + 5]); w.w = pk2(s[8 * s2 + 6], s[8 * s2 + 7]); pf[s2] = __builtin_bit_cast(bf16x8, w); }
#pragma unroll
                for (int dt = 0; dt < 2; ++dt)
#pragma unroll
                    for (int s2 = 0; s2 < 2; ++s2) o[qt][dt] = __builtin_amdgcn_mfma_f32_32x32x16_bf16(vf[dt][s2], pf[s2], o[qt][dt], 0, 0, 0);
            }
        }
#pragma unroll
        for (int qt = 0; qt < 2; ++qt) {
            const float lt = l[qt] + __shfl_xor(l[qt], 32) + __builtin_amdgcn_exp2f(sinkl - m[qt]), inv = 1.0f / lt;
            bf16* op = AO + (size_t)(b * SEQ + blk * 128 + qh * 64 + qt * 32 + r) * D + head * 64 + 4 * h;
#pragma unroll
            for (int dt = 0; dt < 2; ++dt)
#pragma unroll
                for (int gq = 0; gq < 4; ++gq) { v2u w; w.x = pk2(o[qt][dt][4 * gq] * inv, o[qt][dt][4 * gq + 1] * inv); w.y = pk2(o[qt][dt][4 * gq + 2] * inv, o[qt][dt][4 * gq + 3] * inv);
                    *(v2u*)(op + 32 * dt + 8 * gq) = w; }
        }
    }
}

struct Args { const float* in[16]; float* out; unsigned char* ws; int ph_lo, ph_hi; };
__global__ void __launch_bounds__(NWAVES * 64, 2) fwd_kernel(Args args) {
    extern __shared__ __attribute__((aligned(16))) unsigned char lds_raw[];
    LAS unsigned char* lds = (LAS unsigned char*)lds_raw;
    volatile LAS unsigned* MISC = (volatile LAS unsigned*)(lds + MISC_OFF);
    const int tid = threadIdx.x, lane = tid & 63, wave = __builtin_amdgcn_readfirstlane(tid >> 6);
    const int G = gridDim.x; const int bx = blockIdx.x; const int vcu = (G % 8 == 0) ? (bx % 8) * (G / 8) + bx / 8 : bx;
    unsigned char* ws = args.ws;
    unsigned* ctl = (unsigned*)(ws + WS_CTL);
    const float* x = args.in[0]; const float* conv_g = args.in[1]; const float* w_in = args.in[2]; const float* conv_w = args.in[3]; const float* w_out = args.in[4];
    const float* attn_g = args.in[5]; const float* w_qkv = args.in[6]; const float* sink = args.in[7]; const float* w_o = args.in[8]; const float* rel_bias = args.in[9];
    const float* ffn_g = args.in[10]; const float* w_pq = args.in[11]; const float* subk = args.in[12]; const float* pu = args.in[13]; const float* pv = args.in[14]; const float* fin_g = args.in[15];
    float* out = args.out;
    bf16* WinT = (bf16*)(ws + WS_WIN); bf16* WoutT = (bf16*)(ws + WS_WOUT); bf16* WqkvT = (bf16*)(ws + WS_WQKV); bf16* WoT = (bf16*)(ws + WS_WO); bf16* WpqT = (bf16*)(ws + WS_WPQ); bf16* SKb = (bf16*)(ws + WS_SK);
    float* SS = (float*)(ws + WS_SS); unsigned short* IDX = (unsigned short*)(ws + WS_IDX); float* HP = (float*)(ws + WS_HP); float* AA = (float*)(ws + WS_A); float* GATE = (float*)(ws + WS_GATE);
    bf16* XB = (bf16*)(ws + WS_XB); bf16* Y = (bf16*)(ws + WS_Y); unsigned char* U8 = ws + WS_U; unsigned char* V8 = ws + WS_V;
    bf16* G1 = (bf16*)(ws + WS_G1); bf16* PQ = (bf16*)(ws + WS_PQ); bf16* Qb = (bf16*)(ws + WS_Q); bf16* Kb = (bf16*)(ws + WS_K); bf16* VVb = (bf16*)(ws + WS_VV); bf16* AO = (bf16*)(ws + WS_AO);
    float* SS0 = SS; float* SS1 = SS + (size_t)T * 16; float* SS2 = SS + (size_t)2 * T * 16; float* SS3 = SS + (size_t)3 * T * 16; float* SS4 = SS + (size_t)4 * T * 16;

    for (int u = tid; u < (LDS_BYTES - LDSCTL_OFF) / 4; u += NWAVES * 64) ((LAS unsigned*)(lds + LDSCTL_OFF))[u] = 0u;
    __syncthreads();
    XcdBarrier bar; bar.bar = ctl + CW_BAR; bar.x = 0; bar.st = nullptr;
    if (!MK_PER_PHASE) bar = xcd_barrier_post(ctl + CW_BAR, MISC + 8);
    const int lo = args.ph_lo, hi = args.ph_hi;
#define IN(k) (lo <= (k) && (k) < hi)
#define SEAM(k) do { if (IN(k) && IN((k) + 1)) xcd_barrier(bar); } while (0)

    if (IN(0)) REPS(0) {
        P0Args a{x, conv_g, w_in, w_out, attn_g, w_qkv, w_o, ffn_g, w_pq, subk, pu, pv, WinT, WoutT, WqkvT, WoT, WpqT, SKb, U8, V8, XB, SS0};
        p0_prologue(a, lds, vcu, G, wave, lane, tid);
    }
    SEAM(0);
    if (IN(1)) REPS(1) {
        pg8::Gemm g{XB, WinT, T, NIN, D}; pg8::StaticOrder S; S.init(T, NIN, G, bx);
        pg8::EpiBf16RS E{G1, NIN, NIN / 256, nullptr, nullptr, 0, SS0};
        pg8::gemm_phase<pg8::EpiBf16RS, pg8::StaticOrder, true, true>(lds, g, S, E);
    }
    SEAM(1);
    if (IN(2)) REPS(2) conv_gate_phase(G1, conv_w, Y, vcu, G, tid);
    SEAM(2);
    if (IN(3)) REPS(3) {
        pg8::Gemm g{Y, WoutT, T, D, D}; pg8::StaticOrder S; S.init(T, D, G, bx);
        pg8::EpiResid E{x, out, XB, SS1};
        pg8::gemm_phase<pg8::EpiResid, pg8::StaticOrder, true, true>(lds, g, S, E);
    }
    SEAM(3);
    if (IN(4)) REPS(4) {
        pg8::Gemm g{XB, WpqT, T, NPQ, D}; pg8::StaticOrder S; S.init(T, NPQ, G, bx);
        pg8::EpiBf16RS E{PQ, NPQ, NPQ / 256, nullptr, nullptr, 0, SS1};
        pg8::gemm_phase<pg8::EpiBf16RS, pg8::StaticOrder, true, true>(lds, g, S, E);
    }
    SEAM(4);
    if (IN(5)) REPS(5) route_phase(PQ, SKb, IDX, GATE, lds, vcu, G, wave, lane, tid);
    SEAM(5);
    if (IN(6)) sliced_pass<0, false>(U8, IDX, XB, XB, HP, AA, out, SS2, ctl + CW_WQ + 64 * 0, ctl + CW_BAR, MISC + 12, wave, lane, tid);
    SEAM(6);
    if (IN(7)) reduce_phase(HP, GATE, SS1, AA, vcu, G, tid);
    SEAM(7);
    if (IN(8)) sliced_pass<1, false>(V8, IDX, XB, XB, HP, AA, out, SS2, ctl + CW_WQ + 64 * 8, ctl + CW_BAR, MISC + 12, wave, lane, tid);
    SEAM(8);
    if (IN(9)) REPS(9) {
        pg8::Gemm g{XB, WqkvT, T, NQKV, D}; pg8::StaticOrder S; S.init(T, NQKV, G, bx);
        pg8::EpiBf16RS E{Qb, D, 4, Kb, VVb, 256, SS2};
        pg8::gemm_phase<pg8::EpiBf16RS, pg8::StaticOrder, true, true>(lds, g, S, E);
    }
    SEAM(9);
    if (IN(10)) REPS(10) attn_phase(Qb, Kb, VVb, AO, rel_bias, sink, lds, vcu, G, wave, lane, tid);
    SEAM(10);
    if (IN(11)) {
        pg8::Gemm g{AO, WoT, T, D, D}; pg8::StaticOrder S; S.init(T, D, G, bx);
        pg8::EpiResid E{out, out, XB, SS3};
        pg8::gemm_phase<pg8::EpiResid, pg8::StaticOrder, true, true>(lds, g, S, E);
    }
    SEAM(11);
    if (IN(12)) REPS(12) {
        pg8::Gemm g{XB, WpqT + (size_t)NPQ * D, T, NPQ, D}; pg8::StaticOrder S; S.init(T, NPQ, G, bx);
        pg8::EpiBf16RS E{PQ, NPQ, NPQ / 256, nullptr, nullptr, 0, SS3};
        pg8::gemm_phase<pg8::EpiBf16RS, pg8::StaticOrder, true, true>(lds, g, S, E);
    }
    SEAM(12);
    if (IN(13)) REPS(13) route_phase(PQ, SKb + (size_t)8 * 2 * 128 * 128, IDX, GATE, lds, vcu, G, wave, lane, tid);
    SEAM(13);
    if (IN(14)) sliced_pass<0, true>(U8 + (size_t)NEXP * D, IDX, XB, XB, HP, AA, out, SS4, ctl + CW_WQ + 64 * 16, ctl + CW_BAR, MISC + 12, wave, lane, tid);
    SEAM(14);
    if (IN(15)) reduce_phase(HP, GATE, SS3, AA, vcu, G, tid);
    SEAM(15);
    if (IN(16)) sliced_pass<1, true>(V8 + (size_t)NEXP * D, IDX, XB, XB, HP, AA, out, SS4, ctl + CW_WQ + 64 * 24, ctl + CW_BAR, MISC + 12, wave, lane, tid);
    SEAM(16);
    if (IN(17)) final_phase(SS4, out, fin_g, vcu, G, wave, lane);
#undef IN
#undef SEAM
}

extern "C" void kernel_launch(void* const* d_in, const int* in_sizes, int n_in, void* d_out, int out_size, void* d_ws, size_t ws_size, hipStream_t stream) {
    static int grid = 0;
    if (grid == 0) {
        if (n_in != 16 || in_sizes[0] != T * D || out_size != T * D || ws_size < WS_END) { fprintf(stderr, "kernel_launch: unexpected shapes (n_in %d, in0 %d, out %d, ws %zu)\n", n_in, n_in > 0 ? in_sizes[0] : -1, out_size, ws_size); grid = -1; return; }
        int dev = 0, cus = 0, per_cu = 0;
        if (hipGetDevice(&dev) != hipSuccess || hipDeviceGetAttribute(&cus, hipDeviceAttributeMultiprocessorCount, dev) != hipSuccess) { grid = -1; return; }
        if (hipFuncSetAttribute((const void*)fwd_kernel, hipFuncAttributeMaxDynamicSharedMemorySize, LDS_BYTES) != hipSuccess) { fprintf(stderr, "kernel_launch: hipFuncSetAttribute failed\n"); grid = -1; return; }
        if (hipOccupancyMaxActiveBlocksPerMultiprocessor(&per_cu, (const void*)fwd_kernel, NWAVES * 64, LDS_BYTES) != hipSuccess || per_cu < 1) { fprintf(stderr, "kernel_launch: occupancy query says %d blocks per CU\n", per_cu); (void)hipGetLastError(); grid = -1; return; }
        grid = cus;
    }
    if (grid < 0) return;
    (void)hipMemsetAsync((char*)d_ws + WS_CTL, 0, CTL_ZERO_BYTES, stream);
    Args a{};
    for (int i = 0; i < 16; ++i) a.in[i] = (const float*)d_in[i];
    a.out = (float*)d_out; a.ws = (unsigned char*)d_ws;
#if MK_PER_PHASE
    for (int p = 0; p < NPH; ++p) { a.ph_lo = p; a.ph_hi = p + 1; hipLaunchKernelGGL(fwd_kernel, dim3(grid), dim3(NWAVES * 64), LDS_BYTES, stream, a); }
#else
    a.ph_lo = 0; a.ph_hi = NPH;
    hipLaunchKernelGGL(fwd_kernel, dim3(grid), dim3(NWAVES * 64), LDS_BYTES, stream, a);
#endif
}
```

```cpp
#include <hip/hip_runtime.h>
#include <cstdio>
#include <cstdint>
namespace pg8 {
#define PG8_LAS __attribute__((address_space(3)))
typedef unsigned short bf16_t;
typedef short bf16x8 __attribute__((ext_vector_type(8)));
typedef float f32x4 __attribute__((ext_vector_type(4)));
typedef unsigned u32x4 __attribute__((ext_vector_type(4)));
constexpr int BM = 256, BK = 64, HALF = 128, HTB = HALF * BK * 2  , STAGE_BYTES = 8 * HTB, NXCD = 8, WGM = 8;

__host__ __device__ __forceinline__ int lds_byte(int r, int c) { const int st = (r >> 4) * 2 + (c >> 5), rr = r & 15, cc = c & 31, ob = rr * 64 + cc * 2; return st * 1024 + (ob ^ (((ob >> 9) & 1) << 5)); }
__host__ __device__ __forceinline__ void stage_rc(int b, int& R, int& C) { const int st = b / 1024, sb = b % 1024, swz = sb ^ (((sb >> 9) & 1) << 5); R = (st >> 1) * 16 + swz / 64; C = (st & 1) * 32 + (swz % 64) / 2; }
__host__ __device__ __forceinline__ int perm32(int rho) { const int n = rho >> 4, i = rho & 15; return 8 * (i >> 2) + 4 * n + (i & 3); }

struct Unit { int pm, pn; };
struct Gemm { const bf16_t* A; const bf16_t* Bt; int M, N, K; };

struct StaticOrder {
    int nM, nN, nwg, G, c;
    __host__ __device__ void init(int M, int N, int G_, int c_) { nM = M / BM; nN = N / BM; nwg = nM * nN; G = G_; c = c_; }
    __host__ __device__ bool next(int i, Unit& u) const {
        const long L = (long)i * G + c; if (L >= nwg) return false;
        int wgid = (int)L; { const int q = nwg / NXCD, r = nwg % NXCD, xcd = wgid % NXCD, off = wgid / NXCD; wgid = (xcd < r ? xcd * (q + 1) : r * (q + 1) + (xcd - r) * q) + off; }
        const int nig = WGM * nN, gid = wgid / nig, fm = gid * WGM, gsz = (nM - fm) < WGM ? (nM - fm) : WGM;
        u.pm = fm + ((wgid % nig) % gsz); u.pn = (wgid % nig) / gsz; return true;
    }
    __device__ __forceinline__ void a_ready(const Unit&) const {}
    __device__ __forceinline__ void done(const Unit&) const {}
};

__device__ __forceinline__ unsigned cvt_pk_bf16(float lo, float hi) { unsigned r; asm volatile("v_cvt_pk_bf16_f32 %0, %1, %2" : "=v"(r) : "v"(lo), "v"(hi)); return r; }
typedef unsigned u32x2 __attribute__((ext_vector_type(2)));
__device__ __forceinline__ float row_rstd(const float* ss, int row) {
    const f32x4* p = (const f32x4*)(ss + (size_t)row * 16);
    const f32x4 a = p[0], b = p[1], c = p[2], d = p[3];
    const float s = (((a[0] + a[1]) + (a[2] + a[3])) + ((b[0] + b[1]) + (b[2] + b[3]))) + (((c[0] + c[1]) + (c[2] + c[3])) + ((d[0] + d[1]) + (d[2] + d[3])));
    return __builtin_amdgcn_rsqf(s * (1.0f / 1024.0f) + 1e-6f);
}
struct EpiBf16RS {
    static constexpr bool PERM = true, AFTER_DRAIN = false;
    bf16_t* O0; int ld0; int nt0; bf16_t* O1; bf16_t* O2; int ld1; const float* ss;
    __device__ __forceinline__ void operator()(const f32x4 (&acc)[2][2][4][2], const Unit& u, int wr, int wc, int fr, int fq) const {
        bf16_t* base; int ld, colt;
        if (u.pn < nt0) { base = O0; ld = ld0; colt = u.pn * BM; } else if (u.pn == nt0) { base = O1; ld = ld1; colt = 0; } else { base = O2; ld = ld1; colt = (u.pn - nt0 - 1) * BM; }
        const int row0 = u.pm * BM + wr * 64 + fr, col0 = colt + wc * 32 + 8 * fq;
#pragma unroll
        for (int ai = 0; ai < 2; ++ai)
#pragma unroll
            for (int m = 0; m < 4; ++m) { const int row = row0 + ai * HALF + m * 16; const float rs = row_rstd(ss, row); bf16_t* rowp = base + (size_t)row * ld + col0;
#pragma unroll
                for (int bj = 0; bj < 2; ++bj) { const f32x4 v0 = acc[ai][bj][m][0] * rs, v1 = acc[ai][bj][m][1] * rs;
                    u32x4 w; w.x = cvt_pk_bf16(v0[0], v0[1]); w.y = cvt_pk_bf16(v0[2], v0[3]); w.z = cvt_pk_bf16(v1[0], v1[1]); w.w = cvt_pk_bf16(v1[2], v1[3]);
                    *(u32x4*)(rowp + bj * HALF) = w; } }
    }
};
struct EpiResid {
    static constexpr bool PERM = false, AFTER_DRAIN = false;
    const float* base; float* out; bf16_t* xb; float* ss;
    __device__ __forceinline__ void operator()(const f32x4 (&acc)[2][2][4][2], const Unit& u, int wr, int wc, int fr, int fq) const {
        const int row0 = u.pm * BM + wr * 64 + fr, col0 = u.pn * BM + wc * 32 + 4 * fq;
#pragma unroll
        for (int ai = 0; ai < 2; ++ai)
#pragma unroll
            for (int m = 0; m < 4; ++m) { const int row = row0 + ai * HALF + m * 16; float sq = 0.f;
#pragma unroll
                for (int bj = 0; bj < 2; ++bj)
#pragma unroll
                    for (int n = 0; n < 2; ++n) { const size_t off = (size_t)row * 1024 + col0 + bj * HALF + n * 16;
                        const f32x4 o = *(const f32x4*)(base + off) + acc[ai][bj][m][n];
                        *(f32x4*)(out + off) = o; sq += (o[0] * o[0] + o[1] * o[1]) + (o[2] * o[2] + o[3] * o[3]);
                        u32x2 w; w.x = cvt_pk_bf16(o[0], o[1]); w.y = cvt_pk_bf16(o[2], o[3]); *(u32x2*)(xb + off) = w; }
                sq += __shfl_xor(sq, 16); sq += __shfl_xor(sq, 32);
                if (fq == 0) ss[(size_t)row * 16 + u.pn * 4 + wc] = sq; }
    }
};

template <class Epi, class Sched, bool ALIGN_EPI = false, bool SP2 = false>
__device__ __forceinline__ void gemm_phase(PG8_LAS unsigned char* lds, const Gemm g, const Sched& S, const Epi& E) {
    const int tid = threadIdx.x, wid = __builtin_amdgcn_readfirstlane(tid >> 6), lane = tid & 63, wr = wid >> 2, wc = wid & 3, fr = lane & 15, fq = lane >> 4;
    const int K = g.K, nt = K / BK;
    unsigned voffA[2], voffB[2];
#pragma unroll
    for (int i = 0; i < 2; ++i) { int R, C; stage_rc(tid * 16 + i * 8192, R, C); const int Rb = Epi::PERM ? ((R & ~31) + perm32(R & 31)) : R;
        voffA[i] = (unsigned)(R * K + C) * 2u; voffB[i] = (unsigned)(Rb * K + C) * 2u; }
    const size_t kstep = (size_t)(BK * 2);
    const size_t hstep = (size_t)HALF * K * 2;
    const size_t tstep = 2 * hstep;
    const unsigned ldsw = (unsigned)wid * 1024u;
    const int aoff = lds_byte(wr * 64 + fr, fq * 8), boff = lds_byte(wc * 32 + fr, fq * 8);
#define PG8_SA(b, h) (((b) * 2 + (h)) * HTB)
#define PG8_SB(b, h) ((4 + (b) * 2 + (h)) * HTB)
#define PG8_STAGE(bufoff, gbase, voff) do { _Pragma("unroll") for (int _i = 0; _i < 2; ++_i) \
        __builtin_amdgcn_global_load_lds((const unsigned*)((const char*)(gbase) + (voff)[_i]), (PG8_LAS unsigned*)(lds + (bufoff) + ldsw + _i * 8192), 16, 0, 0); } while (0)
#define PG8_LDA(dst, b, h) do { _Pragma("unroll") for (int m = 0; m < 4; ++m) _Pragma("unroll") for (int k = 0; k < 2; ++k) dst[m][k] = *(const PG8_LAS bf16x8*)(lds + PG8_SA(b, h) + aoff + m * 2048 + k * 1024); } while (0)
#define PG8_LDB(dst, b, h) do { _Pragma("unroll") for (int n = 0; n < 2; ++n) _Pragma("unroll") for (int k = 0; k < 2; ++k) dst[n][k] = *(const PG8_LAS bf16x8*)(lds + PG8_SB(b, h) + boff + n * 2048 + k * 1024); } while (0)
#define PG8_MMA(ai, bj, At, Bt) do { __builtin_amdgcn_s_setprio(1); _Pragma("unroll") for (int m = 0; m < 4; ++m) _Pragma("unroll") for (int n = 0; n < 2; ++n) _Pragma("unroll") for (int k = 0; k < 2; ++k) \
        acc[ai][bj][m][n] = __builtin_amdgcn_mfma_f32_16x16x32_bf16(Bt[n][k], At[m][k], acc[ai][bj][m][n], 0, 0, 0); __builtin_amdgcn_s_setprio(0); } while (0)
#define PG8_WAIT_V(n) asm volatile("s_waitcnt vmcnt(" #n ")" ::: "memory")
#define PG8_WAIT_L(n) asm volatile("s_waitcnt lgkmcnt(" #n ")" ::: "memory")
#define PG8_BAR __builtin_amdgcn_s_barrier()
#define PG8_SCHED __builtin_amdgcn_sched_barrier(0)
    Unit cur, nxt; int ui = 0;
    if (!S.next(0, cur)) return;
    f32x4 acc[2][2][4][2];
#pragma unroll
    for (int a = 0; a < 2; ++a)
#pragma unroll
        for (int b = 0; b < 2; ++b)
#pragma unroll
            for (int m = 0; m < 4; ++m)
#pragma unroll
                for (int n = 0; n < 2; ++n) acc[a][b][m][n] = (f32x4){0.f, 0.f, 0.f, 0.f};
    bf16x8 At[4][2], B0[2][2], B1[2][2];
    const char* cA = (const char*)g.A + (size_t)cur.pm * tstep; const char* cB = (const char*)g.Bt + (size_t)cur.pn * tstep;
    S.a_ready(cur);
    if constexpr (SP2) {
        PG8_STAGE(PG8_SB(0, 0), cB, voffB); PG8_STAGE(PG8_SB(0, 1), cB + hstep, voffB); PG8_STAGE(PG8_SA(0, 0), cA, voffA); PG8_STAGE(PG8_SA(0, 1), cA + hstep, voffA);
        if (wr == 1) PG8_BAR;
        PG8_WAIT_V(2); PG8_BAR;
        PG8_STAGE(PG8_SB(1, 0), cB + kstep, voffB); PG8_STAGE(PG8_SA(1, 0), cA + kstep, voffA); PG8_STAGE(PG8_SB(1, 1), cB + hstep + kstep, voffB);
        PG8_WAIT_V(6); PG8_BAR;
    } else {
        PG8_STAGE(PG8_SB(0, 0), cB, voffB); PG8_STAGE(PG8_SA(0, 0), cA, voffA); PG8_STAGE(PG8_SB(0, 1), cB + hstep, voffB); PG8_STAGE(PG8_SA(0, 1), cA + hstep, voffA);
        if (wr == 1) PG8_BAR;
        PG8_WAIT_V(4); PG8_BAR;
        PG8_STAGE(PG8_SB(1, 0), cB + kstep, voffB); PG8_STAGE(PG8_SA(1, 0), cA + kstep, voffA); PG8_STAGE(PG8_SB(1, 1), cB + hstep + kstep, voffB);
        PG8_WAIT_V(6); PG8_BAR;
    }
    for (;;) {
        const bool has_next = S.next(ui + 1, nxt);
        const char* nA = has_next ? (const char*)g.A + (size_t)nxt.pm * tstep : cA; const char* nB = has_next ? (const char*)g.Bt + (size_t)nxt.pn * tstep : cB;
        for (int t = 0; t < nt; t += 2) {
            const bool last = (t == nt - 2);
            const char* a1 = cA + (size_t)(t + 1) * kstep;
            const char* a2 = last ? nA : cA + (size_t)(t + 2) * kstep; const char* b2 = last ? nB : cB + (size_t)(t + 2) * kstep;
            const char* a3 = a2 + kstep; const char* b3 = b2 + kstep;
            if (last && has_next) S.a_ready(nxt);
            if constexpr (SP2) {
            PG8_LDB(B0, 0, 0); PG8_LDB(B1, 0, 1); PG8_SCHED; PG8_LDA(At, 0, 0); PG8_STAGE(PG8_SA(1, 1), a1 + hstep, voffA);
            PG8_WAIT_V(8); PG8_WAIT_L(0); PG8_BAR; PG8_MMA(0, 0, At, B0); PG8_MMA(0, 1, At, B1); PG8_BAR; PG8_SCHED;
            PG8_LDA(At, 0, 1); PG8_STAGE(PG8_SB(0, 0), b2, voffB); PG8_STAGE(PG8_SB(0, 1), b2 + hstep, voffB); PG8_STAGE(PG8_SA(0, 0), a2, voffA);
            PG8_WAIT_V(8); PG8_WAIT_L(0); PG8_BAR; PG8_MMA(1, 0, At, B0); PG8_MMA(1, 1, At, B1); PG8_BAR; PG8_SCHED;
            PG8_LDB(B0, 1, 0); PG8_LDB(B1, 1, 1); PG8_SCHED; PG8_LDA(At, 1, 0); PG8_STAGE(PG8_SA(0, 1), a2 + hstep, voffA);
            PG8_WAIT_V(8); PG8_WAIT_L(0); PG8_BAR; PG8_MMA(0, 0, At, B0); PG8_MMA(0, 1, At, B1); PG8_BAR; PG8_SCHED;
            PG8_LDA(At, 1, 1); PG8_STAGE(PG8_SB(1, 0), b3, voffB); PG8_STAGE(PG8_SB(1, 1), b3 + hstep, voffB); PG8_STAGE(PG8_SA(1, 0), a3, voffA);
            PG8_WAIT_V(8); PG8_WAIT_L(0); PG8_BAR; PG8_MMA(1, 0, At, B0); PG8_MMA(1, 1, At, B1); PG8_BAR; PG8_SCHED;
            } else {
            PG8_LDB(B0, 0, 0); PG8_SCHED; PG8_LDA(At, 0, 0); PG8_STAGE(PG8_SA(1, 1), a1 + hstep, voffA);
            PG8_WAIT_L(8); PG8_BAR; PG8_WAIT_L(0); PG8_MMA(0, 0, At, B0); PG8_BAR; PG8_SCHED;
            PG8_LDB(B1, 0, 1); PG8_STAGE(PG8_SB(0, 0), b2, voffB);
            PG8_BAR; PG8_WAIT_L(0); PG8_MMA(0, 1, At, B1); PG8_BAR;
            PG8_LDA(At, 0, 1); PG8_STAGE(PG8_SA(0, 0), a2, voffA);
            PG8_BAR; PG8_WAIT_L(0); PG8_MMA(1, 0, At, B0); PG8_BAR; PG8_SCHED;
            PG8_STAGE(PG8_SB(0, 1), b2 + hstep, voffB);
            PG8_WAIT_V(6); PG8_BAR; PG8_MMA(1, 1, At, B1); PG8_BAR;
            PG8_LDB(B0, 1, 0); PG8_SCHED; PG8_LDA(At, 1, 0); PG8_STAGE(PG8_SA(0, 1), a2 + hstep, voffA);
            PG8_WAIT_L(8); PG8_BAR; PG8_WAIT_L(0); PG8_MMA(0, 0, At, B0); PG8_BAR; PG8_SCHED;
            PG8_LDB(B1, 1, 1); PG8_STAGE(PG8_SB(1, 0), b3, voffB);
            PG8_BAR; PG8_WAIT_L(0); PG8_MMA(0, 1, At, B1); PG8_BAR;
            PG8_LDA(At, 1, 1); PG8_STAGE(PG8_SA(1, 0), a3, voffA);
            PG8_BAR; PG8_WAIT_L(0); PG8_MMA(1, 0, At, B0); PG8_BAR; PG8_SCHED;
            PG8_STAGE(PG8_SB(1, 1), b3 + hstep, voffB);
            PG8_WAIT_V(6); PG8_BAR; PG8_MMA(1, 1, At, B1); PG8_BAR;
            }
        }
        if constexpr (ALIGN_EPI) { if (wr == 0) PG8_BAR; }
        if constexpr (!Epi::AFTER_DRAIN) { E(acc, cur, wr, wc, fr, fq); S.done(cur); }
        if (!has_next) break;
#pragma unroll
        for (int a = 0; a < 2; ++a)
#pragma unroll
            for (int b = 0; b < 2; ++b)
#pragma unroll
                for (int m = 0; m < 4; ++m)
#pragma unroll
                    for (int n = 0; n < 2; ++n) acc[a][b][m][n] = (f32x4){0.f, 0.f, 0.f, 0.f};
        cur = nxt; cA = nA; cB = nB; ++ui;
        if constexpr (ALIGN_EPI) { if (wr == 1) PG8_BAR; }
    }
    PG8_WAIT_V(0);
    if constexpr (!ALIGN_EPI) { if (wr == 0) PG8_BAR; }
    PG8_BAR;
    if constexpr (Epi::AFTER_DRAIN) { E.fused(acc, cur, wr, wc, fr, fq, lds, wid, lane); S.done(cur); }
#undef PG8_SA
#undef PG8_SB
#undef PG8_STAGE
#undef PG8_LDA
#undef PG8_LDB
#undef PG8_MMA
#undef PG8_WAIT_V
#undef PG8_WAIT_L
#undef PG8_BAR
#undef PG8_SCHED
}
}

constexpr int NWAVES = 8;
constexpr int BATCH = 2, SEQ = 8192, D = 1024, T = BATCH * SEQ;
constexpr int NIN = 3072, NQKV = 1536, NPQ = 2048, NEXP = 16384;
constexpr float LOG2E = 1.4426950408889634f;
constexpr float QSCALE = 0.125f * LOG2E;
constexpr float NEGBIG = -1e30f;
#ifndef MK_PER_PHASE
#define MK_PER_PHASE 0
#endif
constexpr int NPH = 18;
#ifndef REP_MASK
#define REP_MASK 0
#endif
#define REPS(k) for (int rep_ = 0; rep_ < (((REP_MASK) >> (k)) & 1) + 1; ++rep_)

constexpr size_t MiB = 1u << 20;
constexpr size_t WS_CTL = 0, CTL_ZERO_BYTES = 65536;
constexpr size_t WS_WIN = 1 * MiB, WS_WOUT = 7 * MiB, WS_WQKV = 9 * MiB, WS_WO = 12 * MiB, WS_WPQ = 14 * MiB, WS_SK = 22 * MiB;
constexpr size_t WS_SS = 23 * MiB;
constexpr size_t WS_IDX = 28 * MiB, WS_GATE = 36 * MiB, WS_XB = 44 * MiB, WS_Y = 76 * MiB, WS_U = 108 * MiB, WS_V = 172 * MiB;
constexpr size_t WS_G1 = 236 * MiB, WS_PQ = 332 * MiB, WS_Q = 396 * MiB, WS_K = 428 * MiB, WS_VV = 436 * MiB, WS_AO = 444 * MiB, WS_END = 476 * MiB;
constexpr size_t WS_HP = WS_G1, WS_A = WS_G1 + 64 * MiB;
constexpr int CW_BAR = 4096;
constexpr int CW_WQ = 8192;

constexpr int RING_BYTES = 131072;
constexpr int LDSCTL_OFF = 143360, MISC_OFF = LDSCTL_OFF + 320;
constexpr int SC_STRIDE = 260, SC_TAB_OFF = 135168;
constexpr int LDS_BYTES = 147456;

#define LAS __attribute__((address_space(3)))
typedef unsigned short bf16;
typedef unsigned v4u __attribute__((ext_vector_type(4)));
typedef unsigned v2u __attribute__((ext_vector_type(2)));
typedef float f32x4 __attribute__((ext_vector_type(4)));
typedef float f32x2 __attribute__((ext_vector_type(2)));
typedef float f32x16 __attribute__((ext_vector_type(16)));
typedef short bf16x8 __attribute__((ext_vector_type(8)));
typedef __bf16 bf16x2_t __attribute__((ext_vector_type(2)));
#define LDS_WAIT() asm volatile("s_waitcnt lgkmcnt(0)" ::: "memory")
#define DI __device__ __forceinline__

DI unsigned pk2(float lo, float hi) { f32x2 v = {lo, hi}; bf16x2_t b = __builtin_convertvector(v, bf16x2_t); return __builtin_bit_cast(unsigned, b); }
DI float bf_lo(unsigned u) { return __uint_as_float(u << 16); }
DI float bf_hi(unsigned u) { return __uint_as_float(u & 0xffff0000u); }
DI float wave_sum(float v) {
#pragma unroll
    for (int o = 1; o < 64; o <<= 1) v += __shfl_xor(v, o);
    return v;
}
#define XB_TMO      128
#define XB_XCNT(j)  (256  + 64 * (j))
#define XB_XSUB(j)  (1280 + 64 * (j))
#define XB_XGEN(j)  (2304 + 64 * (j))
#define XB_TOP      3328
#define XB_TOPGEN   3392
#define XCD_BAR_WORDS 3456
#define XB_SPIN_CAP (1u << 18)

__device__ __forceinline__ unsigned xb_ld(unsigned* p)              { return __hip_atomic_load(p, __ATOMIC_RELAXED, __HIP_MEMORY_SCOPE_AGENT); }
__device__ __forceinline__ unsigned xb_add(unsigned* p, unsigned v) { return __hip_atomic_fetch_add(p, v, __ATOMIC_RELAXED, __HIP_MEMORY_SCOPE_AGENT); }
__device__ __forceinline__ unsigned xb_xcc_id() { return (unsigned)__builtin_amdgcn_s_getreg((3 << 11) | 20) & 0xFu; }
#define XB_SPIN(cond, bar) do { unsigned _sp = 0; while (cond) { __builtin_amdgcn_s_sleep(1); \
    if ((++_sp & 255u) == 0u) { if (xb_ld(&(bar)[XB_TMO])) break; if (_sp > XB_SPIN_CAP) { atomicAdd(&(bar)[XB_TMO], 1u); break; } } } } while (0)

struct XcdBarrier {
    unsigned* bar; unsigned x;
    volatile LAS unsigned* st;
};

__device__ __forceinline__ XcdBarrier xcd_barrier_post(unsigned* bar, volatile LAS unsigned* st) {
    XcdBarrier b; b.bar = bar; b.x = xb_xcc_id(); b.st = st;
    if (threadIdx.x == 0) (void)xb_add(&bar[XB_XCNT(b.x)], 1u);
    return b;
}
__device__ __forceinline__ void xcd_barrier_complete(unsigned* bar, unsigned x, unsigned& nloc, unsigned& nx) {
    const unsigned G = gridDim.x * gridDim.y * gridDim.z;
    unsigned sum, cnt, mine, sp = 0u;
    for (;;) {
        sum = 0u; cnt = 0u; mine = 0u;
#pragma unroll
        for (unsigned j = 0; j < 16; ++j) { const unsigned c = xb_ld(&bar[XB_XCNT(j)]); sum += c; cnt += (c > 0u) ? 1u : 0u; mine = (j == x) ? c : mine; }
        if (sum == G) break;
        __builtin_amdgcn_s_sleep(1);
        if ((++sp & 255u) == 0u) { if (xb_ld(&bar[XB_TMO])) break; if (sp > XB_SPIN_CAP) { atomicAdd(&bar[XB_TMO], 1u); break; } }
    }
    nloc = mine > 0u ? mine : 1u; nx = cnt > 0u ? cnt : 1u;
}

__device__ __forceinline__ void xcd_barrier(const XcdBarrier& b) {
    asm volatile("s_waitcnt vmcnt(0)" ::: "memory");
    __syncthreads();
    if (threadIdx.x == 0) {
        unsigned* bar = b.bar;
        __builtin_amdgcn_s_waitcnt(0);
        unsigned nloc = b.st[0], nx = b.st[1];
        if (nloc == 0u) { xcd_barrier_complete(bar, b.x, nloc, nx); b.st[0] = nloc; b.st[1] = nx; }
        const unsigned old = xb_add(&bar[XB_XSUB(b.x)], 1u);
        const unsigned gen = old / nloc;
        if (old + 1u == (gen + 1u) * nloc) {
            __builtin_amdgcn_fence(__ATOMIC_RELEASE, "agent");
            asm volatile("s_waitcnt vmcnt(0)" ::: "memory");
            const unsigned og = xb_add(&bar[XB_TOP], 1u);
            const unsigned tg = og / nx;
            if (og + 1u == (tg + 1u) * nx) xb_add(&bar[XB_TOPGEN], 1u);
            else XB_SPIN(xb_ld(&bar[XB_TOPGEN]) == tg, bar);
            __builtin_amdgcn_fence(__ATOMIC_ACQUIRE, "agent");
            xb_add(&bar[XB_XGEN(b.x)], 1u);
            asm volatile("s_waitcnt vmcnt(0)" ::: "memory");
        } else {
            XB_SPIN(xb_ld(&bar[XB_XGEN(b.x)]) == gen, bar);
            __builtin_amdgcn_fence(__ATOMIC_ACQUIRE, "agent");
            asm volatile("s_waitcnt vmcnt(0)" ::: "memory");
        }
    }
    __syncthreads();
}

DI void p0_transpose_item(const float* W, int K, int N, bf16* WT, LAS float* scr, int item, int lane, const float* gain, int nscaled, float cscale) {
    const int nblk = N / 32, kb = item / nblk, nb = item % nblk, k0 = 64 * kb, n0 = 32 * nb;
    float tv[32];
#pragma unroll
    for (int i = 0; i < 32; ++i) tv[i] = W[(size_t)(k0 + 2 * i + (lane >> 5)) * N + n0 + (lane & 31)];
#pragma unroll
    for (int i = 0; i < 32; ++i) { const int kk = 2 * i + (lane >> 5); float v = tv[i]; if (gain) v *= gain[k0 + kk]; scr[kk * 33 + (lane & 31)] = v; }
    LDS_WAIT();
    const int c = lane & 7;
#pragma unroll
    for (int j = 0; j < 4; ++j) { const int n = (lane >> 3) + 8 * j; const LAS float* s = scr + (8 * c) * 33 + n; const float cs = (n0 + n < nscaled) ? cscale : 1.f;
        v4u o; o.x = pk2(s[0 * 33] * cs, s[1 * 33] * cs); o.y = pk2(s[2 * 33] * cs, s[3 * 33] * cs); o.z = pk2(s[4 * 33] * cs, s[5 * 33] * cs); o.w = pk2(s[6 * 33] * cs, s[7 * 33] * cs);
        *(v4u*)(WT + (size_t)(n0 + n) * K + k0 + 8 * c) = o; }
    LDS_WAIT();
}
struct P0Args { const float *x, *conv_g, *w_in, *w_out, *attn_g, *w_qkv, *w_o, *ffn_g, *w_pq, *subk, *pu, *pv;
                bf16 *WinT, *WoutT, *WqkvT, *WoT, *WpqT, *SKb; unsigned char *U8, *V8; bf16* XB; float* SS0; };
DI void p0_prologue(const P0Args& a, LAS unsigned char* lds, int vcu, int G, int wave, int lane, int tid) {
    LAS float* scr = (LAS float*)(lds + wave * 16384);
    const int gw = vcu * NWAVES + wave, NGW = G * NWAVES;
    constexpr int I_IN = 16 * (NIN / 32), I_OUT = 16 * (D / 32), I_QKV = 16 * (NQKV / 32), I_O = I_OUT;
    constexpr int NITEMS = I_IN + I_OUT + I_QKV + I_O;
    for (int it = gw; it < NITEMS; it += NGW) {
        int r = it;
        if (r < I_IN) { p0_transpose_item(a.w_in, D, NIN, a.WinT, scr, r, lane, a.conv_g, 0, 1.f); continue; } r -= I_IN;
        if (r < I_OUT) { p0_transpose_item(a.w_out, D, D, a.WoutT, scr, r, lane, nullptr, 0, 1.f); continue; } r -= I_OUT;
        if (r < I_QKV) { p0_transpose_item(a.w_qkv, D, NQKV, a.WqkvT, scr, r, lane, a.attn_g, 1024, QSCALE); continue; } r -= I_QKV;
        p0_transpose_item(a.w_o, D, D, a.WoT, scr, r, lane, nullptr, 0, 1.f);
    }
    { const int fr = lane & 15, fq = lane >> 4;
      for (int task = gw; task < 2 * 16 * 8 * 16; task += NGW) { const int kc = task & 15, nt = (task >> 4) & 7, hp = (task >> 7) & 15, l = task >> 11;
        const float* skp = a.subk + ((size_t)(l * 16 + hp) * 128 + nt * 16 + fr) * 128 + fq * 8;
        bf16x8 bfr[4];
#pragma unroll
        for (int ks = 0; ks < 4; ++ks) { const f32x4 v0 = *(const f32x4*)(skp + ks * 32), v1 = *(const f32x4*)(skp + ks * 32 + 4);
            v4u w; w.x = pk2(v0[0], v0[1]); w.y = pk2(v0[2], v0[3]); w.z = pk2(v1[0], v1[1]); w.w = pk2(v1[2], v1[3]); bfr[ks] = __builtin_bit_cast(bf16x8, w); }
#pragma unroll 1
        for (int kt = 0; kt < 4; ++kt) { const int k0 = kc * 64 + kt * 16;
            const float* wp = a.w_pq + ((size_t)l * D + k0 + fr) * NPQ + hp * 128 + fq * 8;
            f32x4 acc = {0.f, 0.f, 0.f, 0.f};
#pragma unroll
            for (int ks = 0; ks < 4; ++ks) { const f32x4 v0 = *(const f32x4*)(wp + ks * 32), v1 = *(const f32x4*)(wp + ks * 32 + 4);
                v4u w; w.x = pk2(v0[0], v0[1]); w.y = pk2(v0[2], v0[3]); w.z = pk2(v1[0], v1[1]); w.w = pk2(v1[2], v1[3]);
                acc = __builtin_amdgcn_mfma_f32_16x16x32_bf16(__builtin_bit_cast(bf16x8, w), bfr[ks], acc, 0, 0, 0); }
            const f32x4 g = *(const f32x4*)(a.ffn_g + l * D + k0 + 4 * fq); acc = acc * g;
            v2u o; o.x = pk2(acc[0], acc[1]); o.y = pk2(acc[2], acc[3]);
            *(v2u*)(a.WpqT + ((size_t)l * NPQ + hp * 128 + nt * 16 + fr) * D + k0 + 4 * fq) = o; } } }
    const size_t gt = (size_t)vcu * (NWAVES * 64) + tid, NGT = (size_t)G * NWAVES * 64;
    { const size_t gwv = (size_t)gw, NB = (size_t)2 * NEXP * D / 2048;
      for (size_t blk = gwv; blk < 2 * NB; blk += (size_t)NGW) { const bool isv = blk >= NB; const size_t bb = isv ? blk - NB : blk; const int layer = (int)(bb / (NB / 2));
        const float* src = (isv ? a.pv : a.pu) + bb * 2048; unsigned char* dst = (isv ? a.V8 : a.U8) + bb * 2048;
        f32x4 v[8];
#pragma unroll
        for (int j = 0; j < 8; ++j) v[j] = __builtin_nontemporal_load((const f32x4*)(src + 256 * j) + lane);
#pragma unroll
        for (int j = 0; j < 8; ++j) { unsigned w;
            if (isv) { const f32x4 t = v[j] * 1024.0f; int wi = __builtin_amdgcn_cvt_pk_fp8_f32(t[0], t[1], 0, false); wi = __builtin_amdgcn_cvt_pk_fp8_f32(t[2], t[3], wi, true); w = (unsigned)wi; }
            else { const f32x4 g = *((const f32x4*)(a.ffn_g + layer * D + 256 * (j & 3)) + lane); const f32x4 t = v[j] * g * 512.0f; w = 0u;
#pragma unroll
                for (int e = 0; e < 4; ++e) { const int qi = (int)__builtin_rintf(fminf(fmaxf(t[e], -127.f), 127.f)); w |= ((unsigned)qi & 0xffu) << (8 * e); } }
            *((unsigned*)(dst + 256 * j) + lane) = w; } } }
    for (int m0 = 2 * gw; m0 < T; m0 += 2 * NGW) {
        f32x4 v[2][4]; float s2[2];
#pragma unroll
        for (int r = 0; r < 2; ++r)
#pragma unroll
            for (int j = 0; j < 4; ++j) v[r][j] = *((const f32x4*)(a.x + (size_t)(m0 + r) * D) + lane + 64 * j);
#pragma unroll
        for (int r = 0; r < 2; ++r) { float s = 0.f;
#pragma unroll
            for (int j = 0; j < 4; ++j) s += (v[r][j][0] * v[r][j][0] + v[r][j][1] * v[r][j][1]) + (v[r][j][2] * v[r][j][2] + v[r][j][3] * v[r][j][3]);
            s2[r] = wave_sum(s); }
#pragma unroll
        for (int r = 0; r < 2; ++r) { const int m = m0 + r;
            v2u* o8 = (v2u*)(a.XB + (size_t)m * D) + lane;
#pragma unroll
            for (int j = 0; j < 4; ++j) { v2u w; w.x = pk2(v[r][j][0], v[r][j][1]); w.y = pk2(v[r][j][2], v[r][j][3]); o8[64 * j] = w; }
            if (lane < 4) { f32x4 z = {0.f, 0.f, 0.f, 0.f}; ((f32x4*)(a.SS0 + (size_t)(2 * T + m) * 16))[lane] = z; ((f32x4*)(a.SS0 + (size_t)(4 * T + m) * 16))[lane] = z;
                if (lane == 0) z[0] = s2[r]; ((f32x4*)(a.SS0 + (size_t)m * 16))[lane] = z; } }
    }
}

DI void conv_gate_phase(const bf16* G1, const float* cw, bf16* Y, int vcu, int G, int tid) {
    const size_t gt = (size_t)vcu * (NWAVES * 64) + tid, NGT = (size_t)G * NWAVES * 64;
    for (size_t c = gt; c < (size_t)T * (D / 8); c += NGT) {
        const int t = (int)(c / (D / 8)), d0 = (int)(c % (D / 8)) * 8, ts = t % SEQ;
        const v4u gb = *(const v4u*)(G1 + (size_t)t * NIN + d0);
        float acc[8];
#pragma unroll
        for (int i = 0; i < 8; ++i) acc[i] = 0.f;
#pragma unroll
        for (int w = 0; w < 3; ++w) { const int tt = ts + w - 1;
            if (tt >= 0 && tt < SEQ) {
                const v4u gc = *(const v4u*)(G1 + (size_t)(t + w - 1) * NIN + D + d0), hh = *(const v4u*)(G1 + (size_t)(t + w - 1) * NIN + 2 * D + d0);
                const f32x4 w0 = *(const f32x4*)(cw + w * D + d0), w1 = *(const f32x4*)(cw + w * D + d0 + 4);
                acc[0] += w0[0] * (bf_lo(gc.x) * bf_lo(hh.x)); acc[1] += w0[1] * (bf_hi(gc.x) * bf_hi(hh.x));
                acc[2] += w0[2] * (bf_lo(gc.y) * bf_lo(hh.y)); acc[3] += w0[3] * (bf_hi(gc.y) * bf_hi(hh.y));
                acc[4] += w1[0] * (bf_lo(gc.z) * bf_lo(hh.z)); acc[5] += w1[1] * (bf_hi(gc.z) * bf_hi(hh.z));
                acc[6] += w1[2] * (bf_lo(gc.w) * bf_lo(hh.w)); acc[7] += w1[3] * (bf_hi(gc.w) * bf_hi(hh.w)); } }
        v4u o; o.x = pk2(acc[0] * bf_lo(gb.x), acc[1] * bf_hi(gb.x)); o.y = pk2(acc[2] * bf_lo(gb.y), acc[3] * bf_hi(gb.y));
        o.z = pk2(acc[4] * bf_lo(gb.z), acc[5] * bf_hi(gb.z)); o.w = pk2(acc[6] * bf_lo(gb.w), acc[7] * bf_hi(gb.w));
        *(v4u*)(Y + (size_t)t * D + d0) = o;
    }
}

template <int CTRL> DI unsigned dppu(unsigned v) { return (unsigned)__builtin_amdgcn_update_dpp(0, (int)v, CTRL, 0xf, 0xf, false); }
DI unsigned umax(unsigned a, unsigned b) { return a > b ? a : b; }
DI unsigned umin(unsigned a, unsigned b) { return a < b ? a : b; }
DI unsigned rowmax_u(unsigned v) { v = umax(v, dppu<0x128>(v)); v = umax(v, dppu<0x124>(v)); v = umax(v, dppu<0x122>(v)); v = umax(v, dppu<0x121>(v)); return v; }
DI float rowsum_f(float v) { v += __uint_as_float(dppu<0x128>(__float_as_uint(v))); v += __uint_as_float(dppu<0x124>(__float_as_uint(v))); v += __uint_as_float(dppu<0x122>(__float_as_uint(v))); v += __uint_as_float(dppu<0x121>(__float_as_uint(v))); return v; }
DI unsigned f2key(float f) { const unsigned u = __float_as_uint(f); return u ^ ((unsigned)((int)u >> 31) | 0x80000000u); }
DI float key2f(unsigned k) { const unsigned u = (k & 0x80000000u) ? (k ^ 0x80000000u) : ~k; return __uint_as_float(u); }
DI unsigned cand_ij(int c) {
    unsigned i, j;
    if (c < 16) { i = 0; j = c; } else if (c < 24) { i = 1; j = c - 16; } else if (c < 29) { i = 2; j = c - 24; } else if (c < 33) { i = 3; j = c - 29; }
    else if (c < 36) { i = 4; j = c - 33; } else if (c < 38) { i = 5; j = c - 36; } else if (c < 40) { i = 6; j = c - 38; } else if (c < 42) { i = 7; j = c - 40; }
    else { i = 8 + (c - 42); j = 0; }
    return (i & 15u) | (j << 4);
}
#define CE_DESC(a, b) do { const unsigned _hi = umax(a, b), _lo = umin(a, b); a = _hi; b = _lo; } while (0)
DI void topk_group(const LAS float* SC, int srow0, int t0, int h, unsigned short* IDX, float* GATE, const LAS unsigned char* TAB, int lane) {
    const int fr = lane & 15, fq = lane >> 4;
        unsigned res[2][4];
#pragma unroll
        for (int p = 0; p < 2; ++p) {
            f32x4 acc[8];
#pragma unroll
            for (int n = 0; n < 8; ++n)
#pragma unroll
                for (int r = 0; r < 4; ++r) acc[n][r] = SC[(srow0 + 4 * fq + r) * SC_STRIDE + p * 128 + 16 * n + fr];
            unsigned L[4][8];
#pragma unroll
            for (int r = 0; r < 4; ++r)
#pragma unroll
                for (int n = 0; n < 8; ++n) L[r][n] = (f2key(acc[n][r]) & ~127u) | (unsigned)(127 - (16 * n + fr));
#define CE4(i, j) do { _Pragma("unroll") for (int r = 0; r < 4; ++r) CE_DESC(L[r][i], L[r][j]); } while (0)
            CE4(0, 1); CE4(2, 3); CE4(4, 5); CE4(6, 7);
            CE4(0, 2); CE4(1, 3); CE4(4, 6); CE4(5, 7);
            CE4(1, 2); CE4(5, 6); CE4(0, 4); CE4(3, 7);
            CE4(1, 5); CE4(2, 6);
            CE4(1, 4); CE4(3, 6);
            CE4(2, 4); CE4(3, 5);
            CE4(3, 4);
#undef CE4
            unsigned rr[4] = {0u, 0u, 0u, 0u};
#pragma unroll
            for (int k = 0; k < 16; ++k) {
                unsigned gm[4];
#pragma unroll
                for (int r = 0; r < 4; ++r) gm[r] = umax(L[r][0], dppu<0x128>(L[r][0]));
#pragma unroll
                for (int r = 0; r < 4; ++r) gm[r] = umax(gm[r], dppu<0x124>(gm[r]));
#pragma unroll
                for (int r = 0; r < 4; ++r) gm[r] = umax(gm[r], dppu<0x122>(gm[r]));
#pragma unroll
                for (int r = 0; r < 4; ++r) gm[r] = umax(gm[r], dppu<0x121>(gm[r]));
#pragma unroll
                for (int r = 0; r < 4; ++r) { rr[r] = (fr == k) ? gm[r] : rr[r]; const bool pop = (L[r][0] == gm[r]);
#pragma unroll
                    for (int n = 0; n < 7; ++n) L[r][n] = pop ? L[r][n + 1] : L[r][n];
                    L[r][7] = pop ? 0u : L[r][7]; }
            }
#pragma unroll
            for (int r = 0; r < 4; ++r) res[p][r] = rr[r];
        }
        const int gbase = (lane & 48) * 4;
        unsigned ck[4][4];
#pragma unroll
        for (int r = 0; r < 4; ++r)
#pragma unroll
            for (int s = 0; s < 4; ++s) { const int c = fr + 16 * s; const unsigned tb = TAB[c & 63];
                const unsigned k0 = (unsigned)__builtin_amdgcn_ds_bpermute(gbase + (int)(tb & 15u) * 4, (int)res[0][r]);
                const unsigned k1 = (unsigned)__builtin_amdgcn_ds_bpermute(gbase + (int)((tb >> 4) & 15u) * 4, (int)res[1][r]);
                const float v = key2f((k0 & ~127u) | 64u) + key2f((k1 & ~127u) | 64u);
                ck[r][s] = (c < 50) ? ((f2key(v) & ~63u) | (unsigned)(63 - c)) : 0u; }
        unsigned sel[4] = {0u, 0u, 0u, 0u};
#pragma unroll
        for (int k = 0; k < 16; ++k) {
            unsigned gm[4];
#pragma unroll
            for (int r = 0; r < 4; ++r) { const unsigned lm = umax(umax(ck[r][0], ck[r][1]), umax(ck[r][2], ck[r][3])); gm[r] = umax(lm, dppu<0x128>(lm)); }
#pragma unroll
            for (int r = 0; r < 4; ++r) gm[r] = umax(gm[r], dppu<0x124>(gm[r]));
#pragma unroll
            for (int r = 0; r < 4; ++r) gm[r] = umax(gm[r], dppu<0x122>(gm[r]));
#pragma unroll
            for (int r = 0; r < 4; ++r) gm[r] = umax(gm[r], dppu<0x121>(gm[r]));
#pragma unroll
            for (int r = 0; r < 4; ++r) { sel[r] = (fr == k) ? gm[r] : sel[r];
#pragma unroll
                for (int s = 0; s < 4; ++s) ck[r][s] = (ck[r][s] == gm[r]) ? 0u : ck[r][s]; }
        }
#pragma unroll
        for (int r = 0; r < 4; ++r) {
            const int t = t0 + 4 * fq + r;
            const int cs = 63 - (int)(sel[r] & 63u); const unsigned tb = TAB[cs & 63];
            const unsigned k0 = (unsigned)__builtin_amdgcn_ds_bpermute(gbase + (int)(tb & 15u) * 4, (int)res[0][r]);
            const unsigned k1 = (unsigned)__builtin_amdgcn_ds_bpermute(gbase + (int)((tb >> 4) & 15u) * 4, (int)res[1][r]);
            const int e = (127 - (int)(k0 & 127u)) * 128 + (127 - (int)(k1 & 127u));
            const float val = key2f((sel[r] & ~63u) | 32u), top = key2f((rowmax_u(sel[r]) & ~63u) | 32u);
            const float ex = __builtin_amdgcn_exp2f((val - top) * LOG2E), sum = rowsum_f(ex);
            IDX[(size_t)t * 128 + h * 16 + fr] = (unsigned short)e; GATE[(size_t)t * 128 + h * 16 + fr] = ex / sum;
        }
}
struct EpiRoute {
    static constexpr bool PERM = true, AFTER_DRAIN = true;
    const float* ss; unsigned short* IDX; float* GATE;
    DI void fused(pg8::f32x4 (&acc)[2][2][4][2], const pg8::Unit& u, int wr, int wc, int fr, int fq, LAS unsigned char* lds, int wid, int lane) const {
        LAS float* SC = (LAS float*)lds; LAS unsigned char* TAB = lds + SC_TAB_OFF; LAS unsigned* gcnt = (LAS unsigned*)(lds + SC_TAB_OFF + 128);
        const int tid = wid * 64 + lane;
        if (tid < 64) TAB[tid] = (unsigned char)(tid < 50 ? cand_ij(tid) : 0xff);
#pragma unroll
        for (int ai = 0; ai < 2; ++ai) {
            __syncthreads();
#pragma unroll
            for (int m = 0; m < 4; ++m) { const int row = wr * 64 + m * 16 + fr; const float rs = pg8::row_rstd(ss, u.pm * 256 + ai * 128 + row);
#pragma unroll
                for (int bj = 0; bj < 2; ++bj)
#pragma unroll
                    for (int n = 0; n < 2; ++n) *(LAS f32x4*)(SC + row * SC_STRIDE + bj * 128 + wc * 32 + 8 * fq + 4 * n) = acc[ai][bj][m][n] * rs; }
            if (tid == 0) *gcnt = 0u;
            __syncthreads();
            for (;;) {
                unsigned grp = 0u; if (lane == 0) grp = __hip_atomic_fetch_add(gcnt, 1u, __ATOMIC_RELAXED, __HIP_MEMORY_SCOPE_WORKGROUP);
                grp = (unsigned)__builtin_amdgcn_readfirstlane((int)grp);
                if (grp >= 8u) break;
                topk_group(SC, (int)grp * 16, u.pm * 256 + ai * 128 + (int)grp * 16, u.pn, IDX, GATE, TAB, lane);
            }
        }
        __syncthreads();
    }
};
struct OneUnit { pg8::Unit u;
    DI bool next(int i, pg8::Unit& o) const { if (i != 0) return false; o = u; return true; }
    DI void a_ready(const pg8::Unit&) const {}
    DI void done(const pg8::Unit&) const {}
};

DI float dot8(v4u x, v4u u, float acc) {
    acc += bf_lo(x.x) * bf_lo(u.x); acc += bf_hi(x.x) * bf_hi(u.x); acc += bf_lo(x.y) * bf_lo(u.y); acc += bf_hi(x.y) * bf_hi(u.y);
    acc += bf_lo(x.z) * bf_lo(u.z); acc += bf_hi(x.z) * bf_hi(u.z); acc += bf_lo(x.w) * bf_lo(u.w); acc += bf_hi(x.w) * bf_hi(u.w);
    return acc;
}
DI void fma8(float* acc, float a, v4u v) {
    acc[0] += a * bf_lo(v.x); acc[1] += a * bf_hi(v.x); acc[2] += a * bf_lo(v.y); acc[3] += a * bf_hi(v.y);
    acc[4] += a * bf_lo(v.z); acc[5] += a * bf_hi(v.z); acc[6] += a * bf_lo(v.w); acc[7] += a * bf_hi(v.w);
}
DI f32x2 fp8lo(unsigned w) { return __builtin_amdgcn_cvt_pk_f32_fp8((int)w, false); }
DI f32x2 fp8hi(unsigned w) { return __builtin_amdgcn_cvt_pk_f32_fp8((int)w, true); }

template <int CTRL> DI float dppf(float v) { return __uint_as_float(dppu<CTRL>(__float_as_uint(v))); }
constexpr int XG = 8, XNG = T / XG;
DI unsigned wave_ticket(unsigned* head, int lane) {
    unsigned v = 0u; if (lane == 0) v = __hip_atomic_fetch_add(head, 1u, __ATOMIC_RELAXED, __HIP_MEMORY_SCOPE_AGENT);
    return (unsigned)__builtin_amdgcn_readfirstlane((int)v);
}
struct USmall { int i0, i1; v4u xa, xb; };
DI void u_small(USmall& S, const unsigned short* IDX, const bf16* XB, int t, int s, int lane) {
    S.i0 = IDX[(size_t)t * 128 + lane]; S.i1 = IDX[(size_t)t * 128 + 64 + lane];
    const v4u* xr = (const v4u*)(XB + (size_t)t * D + 128 * s + 16 * (lane & 7)); S.xa = xr[0]; S.xb = xr[1];
}
DI void u_token(USmall& SC, const v4u (&GC)[16], const USmall& SN, v4u (&GN)[16], const unsigned char* U8s, const unsigned short* IDX, const bf16* XB, float* HPs, int t, int t2, int s, int lane) {
    const int g = lane >> 3, k = lane & 7;
    const v4u xa = SC.xa, xb = SC.xb;
    float xv[16];
    xv[0] = bf_lo(xa.x); xv[1] = bf_hi(xa.x); xv[2] = bf_lo(xa.y); xv[3] = bf_hi(xa.y); xv[4] = bf_lo(xa.z); xv[5] = bf_hi(xa.z); xv[6] = bf_lo(xa.w); xv[7] = bf_hi(xa.w);
    xv[8] = bf_lo(xb.x); xv[9] = bf_hi(xb.x); xv[10] = bf_lo(xb.y); xv[11] = bf_hi(xb.y); xv[12] = bf_lo(xb.z); xv[13] = bf_hi(xb.z); xv[14] = bf_lo(xb.w); xv[15] = bf_hi(xb.w);
    float am = 0.f;
#pragma unroll
    for (int i = 0; i < 16; ++i) am = fmaxf(am, __builtin_fabsf(xv[i]));
    am = fmaxf(am, dppf<0xB1>(am)); am = fmaxf(am, dppf<0x4E>(am)); am = fmaxf(am, dppf<0x141>(am));
    am = fmaxf(am, 1e-20f);
    const float qs = 127.0f / am, dq = am * (1.0f / (127.0f * 512.0f));
    unsigned xq[4];
#pragma unroll
    for (int q = 0; q < 4; ++q) { unsigned w = 0u;
#pragma unroll
        for (int e = 0; e < 4; ++e) { const int qi = (int)__builtin_rintf(xv[4 * q + e] * qs); w |= ((unsigned)qi & 0xffu) << (8 * e); }
        xq[q] = w; }
    u_small(SC, IDX, XB, t2, s, lane);
    int p[16];
#pragma unroll
    for (int i = 0; i < 16; ++i) {
        const unsigned idx = (unsigned)__builtin_amdgcn_ds_bpermute((8 * (i & 7) + g) * 4, i < 8 ? SN.i0 : SN.i1);
        GN[i] = *(const v4u*)(U8s + (idx * 1024u + 16u * (unsigned)k));
        int a0 = __builtin_amdgcn_sdot4((int)xq[0], (int)GC[i][0], 0, false), a1 = __builtin_amdgcn_sdot4((int)xq[1], (int)GC[i][1], 0, false);
        a0 = __builtin_amdgcn_sdot4((int)xq[2], (int)GC[i][2], a0, false); a1 = __builtin_amdgcn_sdot4((int)xq[3], (int)GC[i][3], a1, false);
        p[i] = a0 + a1;
        __builtin_amdgcn_sched_barrier(0); }
    const bool h4 = k >= 4, h1 = k & 1, h2 = k & 2;
    int q8[8], q4[4], q2[2];
#pragma unroll
    for (int j = 0; j < 8; ++j) { const int keep = h4 ? p[8 + j] : p[j], send = h4 ? p[j] : p[8 + j]; q8[j] = keep + (int)dppu<0x141>((unsigned)send); }
#pragma unroll
    for (int j = 0; j < 4; ++j) { const int keep = h1 ? q8[4 + j] : q8[j], send = h1 ? q8[j] : q8[4 + j]; q4[j] = keep + (int)dppu<0xB1>((unsigned)send); }
#pragma unroll
    for (int j = 0; j < 2; ++j) { const int keep = h2 ? q4[2 + j] : q4[j], send = h2 ? q4[j] : q4[2 + j]; q2[j] = keep + (int)dppu<0x4E>((unsigned)send); }
    const int ib = (h4 ? 8 : 0) + (h1 ? 4 : 0) + (h2 ? 2 : 0);
    HPs[(size_t)t * 128 + 8 * ib + g] = (float)q2[0] * dq; HPs[(size_t)t * 128 + 8 * ib + 8 + g] = (float)q2[1] * dq;
}
struct VSmall { int i0, i1; float a0, a1; f32x2 xo; };
DI void v_small(VSmall& S, const unsigned short* IDX, const float* A, const float* xf, int t, int s, int lane) {
    S.i0 = IDX[(size_t)t * 128 + lane]; S.i1 = IDX[(size_t)t * 128 + 64 + lane]; S.a0 = A[(size_t)t * 128 + lane]; S.a1 = A[(size_t)t * 128 + 64 + lane];
    S.xo = *(const f32x2*)(xf + (size_t)t * D + 128 * s + 16 * (lane & 7) + ((lane & 8) ? 8 : 0) + ((lane & 16) ? 4 : 0) + ((lane & 32) ? 2 : 0));
}
template <bool FINAL>
DI void v_token(VSmall& SC, const v4u (&GC)[16], const VSmall& SN, v4u (&GN)[16], const unsigned char* V8s, const unsigned short* IDX, const float* A, float* xf, bf16* XB, float* ss_out,
                int t, int t2, int s, int lane) {
    const int g = lane >> 3, k = lane & 7;
    const bool b3 = lane & 8, b4 = lane & 16, b5 = lane & 32;
    float av[16];
#pragma unroll
    for (int i = 0; i < 16; ++i) av[i] = __uint_as_float((unsigned)__builtin_amdgcn_ds_bpermute((8 * (i & 7) + g) * 4, (int)__float_as_uint(i < 8 ? SC.a0 : SC.a1)));
    f32x2 o = SC.xo;
    v_small(SC, IDX, A, xf, t2, s, lane);
    f32x2 acc[8];
#pragma unroll
    for (int i = 0; i < 8; ++i) acc[i] = (f32x2){0.f, 0.f};
#pragma unroll
    for (int i = 0; i < 16; ++i) {
        const unsigned idx = (unsigned)__builtin_amdgcn_ds_bpermute((8 * (i & 7) + g) * 4, i < 8 ? SN.i0 : SN.i1);
        GN[i] = *(const v4u*)(V8s + (idx * 1024u + 16u * (unsigned)k));
        const f32x2 a2 = {av[i], av[i]};
#pragma unroll
        for (int q = 0; q < 4; ++q) { acc[2 * q] = __builtin_elementwise_fma(a2, fp8lo(GC[i][q]), acc[2 * q]); acc[2 * q + 1] = __builtin_elementwise_fma(a2, fp8hi(GC[i][q]), acc[2 * q + 1]); }
        __builtin_amdgcn_sched_barrier(0); }
    float v[16];
#pragma unroll
    for (int i = 0; i < 8; ++i) { v[2 * i] = acc[i].x; v[2 * i + 1] = acc[i].y; }
    float v8[8], v4[4], v2[2];
#pragma unroll
    for (int j = 0; j < 8; ++j) { const float keep = b3 ? v[8 + j] : v[j], send = b3 ? v[j] : v[8 + j]; v8[j] = keep + __shfl_xor(send, 8); }
#pragma unroll
    for (int j = 0; j < 4; ++j) { const float keep = b4 ? v8[4 + j] : v8[j], send = b4 ? v8[j] : v8[4 + j]; v4[j] = keep + __shfl_xor(send, 16); }
#pragma unroll
    for (int j = 0; j < 2; ++j) { const float keep = b5 ? v4[2 + j] : v4[j], send = b5 ? v4[j] : v4[2 + j]; v2[j] = keep + __shfl_xor(send, 32); }
    const int col = 128 * s + 16 * k + (b3 ? 8 : 0) + (b4 ? 4 : 0) + (b5 ? 2 : 0);
    float* xo = xf + (size_t)t * D + col;
    o.x += v2[0]; o.y += v2[1];
    *(f32x2*)xo = o;
    if (!FINAL) *(unsigned*)(XB + (size_t)t * D + col) = pk2(o.x, o.y);
    const float sq = wave_sum(o.x * o.x + o.y * o.y);
    if (lane == 0) ss_out[(size_t)t * 16 + s] = sq;
}
template <int PASS, bool FINAL>
DI void sliced_pass(const unsigned char* TAB, const unsigned short* IDX, const bf16* XBc, bf16* XBw, float* HP, const float* A, float* xf, float* ss_out,
                    unsigned* heads, unsigned* census, volatile LAS unsigned* slot, int wave, int lane, int tid) {
    const int own = (int)(xb_xcc_id() & 7u);
    __syncthreads();
    if (tid == 0) { unsigned all = 1u;
#pragma unroll 1
        for (int q = 0; q < 8; ++q) { const unsigned n = xb_ld(census + XB_XCNT(q)) + xb_ld(census + XB_XCNT(q + 8)); all &= (n > 0u) ? 1u : 0u; }
        slot[1] = all; }
    __syncthreads();
    const int nds = slot[1] ? 1 : 8;
#pragma unroll 1
    for (int ds = 0; ds < nds; ++ds) { const int s = (own + ds) & 7;
        unsigned* head = heads + 64 * s; const unsigned char* Ts = TAB + 128 * s; float* HPs = HP + (size_t)s * T * 128;
        unsigned tk = wave_ticket(head, lane);
        if (tk >= (unsigned)XNG) continue;
        unsigned nxt = wave_ticket(head, lane);
#define TOK_AT(dj) ((j + (dj) < XG) ? (int)tk * XG + j + (dj) : (nxt < (unsigned)XNG ? (int)nxt * XG + j + (dj) - XG : (int)tk * XG + XG - 1))
        int j = 0;
        if (PASS == 0) {
            USmall S0, S1; v4u G0[16], G1[16];
            u_small(S0, IDX, XBc, (int)tk * XG, s, lane); u_small(S1, IDX, XBc, (int)tk * XG + 1, s, lane);
            { const int g = lane >> 3, k = lane & 7;
#pragma unroll
              for (int i = 0; i < 16; ++i) { const unsigned idx = (unsigned)__builtin_amdgcn_ds_bpermute((8 * (i & 7) + g) * 4, i < 8 ? S0.i0 : S0.i1); G0[i] = *(const v4u*)(Ts + (idx * 1024u + 16u * (unsigned)k)); } }
            for (;;) {
#pragma unroll 1
                for (j = 0; j < XG; j += 2) {
                    u_token(S0, G0, S1, G1, Ts, IDX, XBc, HPs, (int)tk * XG + j, TOK_AT(2), s, lane);
                    { const int jj = j; j = jj + 1; const int t3 = TOK_AT(2); j = jj; u_token(S1, G1, S0, G0, Ts, IDX, XBc, HPs, (int)tk * XG + j + 1, t3, s, lane); } }
                if (nxt >= (unsigned)XNG) break; tk = nxt; nxt = wave_ticket(head, lane); }
        } else {
            VSmall S0, S1; v4u G0[16], G1[16];
            v_small(S0, IDX, A, xf, (int)tk * XG, s, lane); v_small(S1, IDX, A, xf, (int)tk * XG + 1, s, lane);
            { const int g = lane >> 3, k = lane & 7;
#pragma unroll
              for (int i = 0; i < 16; ++i) { const unsigned idx = (unsigned)__builtin_amdgcn_ds_bpermute((8 * (i & 7) + g) * 4, i < 8 ? S0.i0 : S0.i1); G0[i] = *(const v4u*)(Ts + (idx * 1024u + 16u * (unsigned)k)); } }
            for (;;) {
#pragma unroll 1
                for (j = 0; j < XG; j += 2) {
                    v_token<FINAL>(S0, G0, S1, G1, Ts, IDX, A, xf, XBw, ss_out, (int)tk * XG + j, TOK_AT(2), s, lane);
                    { const int jj = j; j = jj + 1; const int t3 = TOK_AT(2); j = jj; v_token<FINAL>(S1, G1, S0, G0, Ts, IDX, A, xf, XBw, ss_out, (int)tk * XG + j + 1, t3, s, lane); } }
                if (nxt >= (unsigned)XNG) break; tk = nxt; nxt = wave_ticket(head, lane); }
        }
#undef TOK_AT
    }
}
DI void reduce_phase(const float* HP, const float* GATE, const float* ss_in, float* A, int vcu, int G, int tid) {
    const size_t gt = (size_t)vcu * (NWAVES * 64) + tid, NGT = (size_t)G * NWAVES * 64;
    for (size_t c = gt; c < (size_t)T * 128; c += NGT) { float h = 0.f;
#pragma unroll
        for (int s = 0; s < 8; ++s) h += HP[(size_t)s * T * 128 + c];
        h *= pg8::row_rstd(ss_in, (int)(c >> 7));
        A[c] = (1.0f / 1024.0f) * GATE[c] * (0.5f * h * (1.f + erff(h * 0.70710678118654752f))); }
}
DI void final_phase(const float* ss, float* xf, const float* fin_g, int vcu, int G, int wave, int lane) {
    for (int m = vcu * NWAVES + wave; m < T; m += G * NWAVES) { const float rf = pg8::row_rstd(ss, m);
        f32x4* xr = (f32x4*)(xf + (size_t)m * D) + lane;
#pragma unroll
        for (int j = 0; j < 4; ++j) xr[64 * j] = xr[64 * j] * rf * *((const f32x4*)fin_g + lane + 64 * j); }
}

DI int t5_bucket(int rel) {
    const int n = rel < 0 ? -rel : rel; int b;
    if (n < 8) b = n; else if (n < 12) b = 8; else if (n < 16) b = 9; else if (n < 23) b = 10; else if (n < 32) b = 11; else if (n < 46) b = 12; else if (n < 64) b = 13; else if (n < 91) b = 14; else b = 15;
    return b + (rel > 0 ? 16 : 0);
}
DI int crow(int reg, int h) { return (reg & 3) + 8 * (reg >> 2) + 4 * h; }
constexpr int AT_KL = 0, AT_KSTR = 144, AT_VT = 384 * AT_KSTR  , AT_VSTR = 776, AT_BT = AT_VT + 64 * AT_VSTR  , AT_END = AT_BT + 4 * 512 * 4;
static_assert(AT_END <= RING_BYTES, "attention LDS");
DI void attn_phase(const bf16* Qg, const bf16* Kg, const bf16* Vg, bf16* AO, const float* rel_bias, const float* sink, LAS unsigned char* lds, int vcu, int G, int wave, int lane, int tid) {
    const int r = lane & 31, h = lane >> 5;
    for (int unit = vcu; unit < BATCH * 4 * (SEQ / 128); unit += G) {
        const int b = unit / 256, kvh = (unit % 256) / 64, blk = unit % 64;
        __syncthreads();
        for (int c = tid; c < 384 * 8; c += NWAVES * 64) { const int row = c >> 3, c8 = c & 7, ts = blk * 128 - 128 + row;
            v4u kv = {0u, 0u, 0u, 0u}, vv = {0u, 0u, 0u, 0u};
            if (ts >= 0 && ts < SEQ) { const size_t g = (size_t)(b * SEQ + ts) * 256 + kvh * 64 + c8 * 8; kv = *(const v4u*)(Kg + g); vv = *(const v4u*)(Vg + g); }
            *(LAS v4u*)(lds + AT_KL + row * AT_KSTR + c8 * 16) = kv;
            LAS unsigned short* vt = (LAS unsigned short*)(lds + AT_VT) + (c8 * 8) * (AT_VSTR / 2) + row;
            vt[0 * (AT_VSTR / 2)] = (unsigned short)(vv.x & 0xffffu); vt[1 * (AT_VSTR / 2)] = (unsigned short)(vv.x >> 16);
            vt[2 * (AT_VSTR / 2)] = (unsigned short)(vv.y & 0xffffu); vt[3 * (AT_VSTR / 2)] = (unsigned short)(vv.y >> 16);
            vt[4 * (AT_VSTR / 2)] = (unsigned short)(vv.z & 0xffffu); vt[5 * (AT_VSTR / 2)] = (unsigned short)(vv.z >> 16);
            vt[6 * (AT_VSTR / 2)] = (unsigned short)(vv.w & 0xffffu); vt[7 * (AT_VSTR / 2)] = (unsigned short)(vv.w >> 16); }
        for (int c = tid; c < 4 * 512; c += NWAVES * 64) { const int g = c >> 9, i = c & 511, rel = i - 255;
            float v = NEGBIG; if (rel >= -128 && rel <= 128) v = rel_bias[t5_bucket(rel) * 16 + kvh * 4 + g] * LOG2E;
            *(LAS float*)(lds + AT_BT + c * 4) = v; }
        __syncthreads();
        const int g = wave >> 1, qh = wave & 1, head = kvh * 4 + g;
        const float sinkl = sink[head] * LOG2E;
        bf16x8 qf[2][4];
#pragma unroll
        for (int qt = 0; qt < 2; ++qt)
#pragma unroll
            for (int s = 0; s < 4; ++s) qf[qt][s] = *(const bf16x8*)(Qg + (size_t)(b * SEQ + blk * 128 + qh * 64 + qt * 32 + r) * D + head * 64 + s * 16 + h * 8);
        float m[2] = {sinkl, sinkl}, l[2] = {0.f, 0.f};
        f32x16 o[2][2];
#pragma unroll
        for (int qt = 0; qt < 2; ++qt)
#pragma unroll
            for (int dt = 0; dt < 2; ++dt)
#pragma unroll
                for (int i = 0; i < 16; ++i) o[qt][dt][i] = 0.f;
        int kt_lo = 2 * qh, kt_hi = 2 * qh + 9;
        if (blk == 0 && kt_lo < 4) kt_lo = 4;
        if (blk == SEQ / 128 - 1 && kt_hi > 7) kt_hi = 7;
#pragma unroll 1
        for (int kt = kt_lo; kt <= kt_hi; ++kt) {
            bf16x8 kf[4];
#pragma unroll
            for (int s = 0; s < 4; ++s) kf[s] = *(const LAS bf16x8*)(lds + AT_KL + (32 * kt + r) * AT_KSTR + s * 32 + h * 16);
            bf16x8 vf[2][2];
#pragma unroll
            for (int dt = 0; dt < 2; ++dt)
#pragma unroll
                for (int s2 = 0; s2 < 2; ++s2) { const LAS unsigned char* vp = lds + AT_VT + (32 * dt + r) * AT_VSTR + (32 * kt + 16 * s2 + 4 * h) * 2;
                    const v2u lo = *(const LAS v2u*)vp, hi2 = *(const LAS v2u*)(vp + 16); v4u w = {lo.x, lo.y, hi2.x, hi2.y}; vf[dt][s2] = __builtin_bit_cast(bf16x8, w); }
#pragma unroll
            for (int qt = 0; qt < 2; ++qt) {
                f32x16 s;
                const LAS float* bt = (const LAS float*)(lds + AT_BT) + g * 512 + 127 + 32 * kt + 4 * h - (64 * qh + 32 * qt + r);
#pragma unroll
                for (int i = 0; i < 16; ++i) s[i] = bt[(i & 3) + 8 * (i >> 2)];
#pragma unroll
                for (int k4 = 0; k4 < 4; ++k4) s = __builtin_amdgcn_mfma_f32_32x32x16_bf16(kf[k4], qf[qt][k4], s, 0, 0, 0);
                float mx = s[0];
#pragma unroll
                for (int i = 1; i < 16; ++i) mx = fmaxf(mx, s[i]);
                mx = fmaxf(mx, __shfl_xor(mx, 32));
                const float mn = fmaxf(m[qt], mx), al = __builtin_amdgcn_exp2f(m[qt] - mn); m[qt] = mn;
                float ps = 0.f;
#pragma unroll
                for (int i = 0; i < 16; ++i) { s[i] = __builtin_amdgcn_exp2f(s[i] - mn); ps += s[i]; }
                l[qt] = l[qt] * al + ps;
#pragma unroll
                for (int dt = 0; dt < 2; ++dt)
#pragma unroll
                    for (int i = 0; i < 16; ++i) o[qt][dt][i] *= al;
                bf16x8 pf[2];
#pragma unroll
                for (int s2 = 0; s2 < 2; ++s2) { v4u w; w.x = pk2(s[8 * s2 + 0], s[8 * s2 + 1]); w.y = pk2(s[8 * s2 + 2], s[8 * s2 + 3]); w.z = pk2(s[8 * s2 + 4], s[8 * s2 + 5]); w.w = pk2(s[8 * s2 + 6], s[8 * s2 + 7]); pf[s2] = __builtin_bit_cast(bf16x8, w); }
#pragma unroll
                for (int dt = 0; dt < 2; ++dt)
#pragma unroll
                    for (int s2 = 0; s2 < 2; ++s2) o[qt][dt] = __builtin_amdgcn_mfma_f32_32x32x16_bf16(vf[dt][s2], pf[s2], o[qt][dt], 0, 0, 0);
            }
        }
#pragma unroll
        for (int qt = 0; qt < 2; ++qt) {
            const float lt = l[qt] + __shfl_xor(l[qt], 32) + __builtin_amdgcn_exp2f(sinkl - m[qt]), inv = 1.0f / lt;
            bf16* op = AO + (size_t)(b * SEQ + blk * 128 + qh * 64 + qt * 32 + r) * D + head * 64 + 4 * h;
#pragma unroll
            for (int dt = 0; dt < 2; ++dt)
#pragma unroll
                for (int gq = 0; gq < 4; ++gq) { v2u w; w.x = pk2(o[qt][dt][4 * gq] * inv, o[qt][dt][4 * gq + 1] * inv); w.y = pk2(o[qt][dt][4 * gq + 2] * inv, o[qt][dt][4 * gq + 3] * inv);
                    *(v2u*)(op + 32 * dt + 8 * gq) = w; }
        }
    }
}

struct Args { const float* in[16]; float* out; unsigned char* ws; int ph_lo, ph_hi; };
__global__ void __launch_bounds__(NWAVES * 64, 2) fwd_kernel(Args args) {
    extern __shared__ __attribute__((aligned(16))) unsigned char lds_raw[];
    LAS unsigned char* lds = (LAS unsigned char*)lds_raw;
    volatile LAS unsigned* MISC = (volatile LAS unsigned*)(lds + MISC_OFF);
    const int tid = threadIdx.x, lane = tid & 63, wave = __builtin_amdgcn_readfirstlane(tid >> 6);
    const int G = gridDim.x; const int bx = blockIdx.x; const int vcu = (G % 8 == 0) ? (bx % 8) * (G / 8) + bx / 8 : bx;
    unsigned char* ws = args.ws;
    unsigned* ctl = (unsigned*)(ws + WS_CTL);
    const float* x = args.in[0]; const float* conv_g = args.in[1]; const float* w_in = args.in[2]; const float* conv_w = args.in[3]; const float* w_out = args.in[4];
    const float* attn_g = args.in[5]; const float* w_qkv = args.in[6]; const float* sink = args.in[7]; const float* w_o = args.in[8]; const float* rel_bias = args.in[9];
    const float* ffn_g = args.in[10]; const float* w_pq = args.in[11]; const float* subk = args.in[12]; const float* pu = args.in[13]; const float* pv = args.in[14]; const float* fin_g = args.in[15];
    float* out = args.out;
    bf16* WinT = (bf16*)(ws + WS_WIN); bf16* WoutT = (bf16*)(ws + WS_WOUT); bf16* WqkvT = (bf16*)(ws + WS_WQKV); bf16* WoT = (bf16*)(ws + WS_WO); bf16* WpqT = (bf16*)(ws + WS_WPQ); bf16* SKb = (bf16*)(ws + WS_SK);
    float* SS = (float*)(ws + WS_SS); unsigned short* IDX = (unsigned short*)(ws + WS_IDX); float* HP = (float*)(ws + WS_HP); float* AA = (float*)(ws + WS_A); float* GATE = (float*)(ws + WS_GATE);
    bf16* XB = (bf16*)(ws + WS_XB); bf16* Y = (bf16*)(ws + WS_Y); unsigned char* U8 = ws + WS_U; unsigned char* V8 = ws + WS_V;
    bf16* G1 = (bf16*)(ws + WS_G1); bf16* PQ = (bf16*)(ws + WS_PQ); bf16* Qb = (bf16*)(ws + WS_Q); bf16* Kb = (bf16*)(ws + WS_K); bf16* VVb = (bf16*)(ws + WS_VV); bf16* AO = (bf16*)(ws + WS_AO);
    float* SS0 = SS; float* SS1 = SS + (size_t)T * 16; float* SS2 = SS + (size_t)2 * T * 16; float* SS3 = SS + (size_t)3 * T * 16; float* SS4 = SS + (size_t)4 * T * 16;

    for (int u = tid; u < (LDS_BYTES - LDSCTL_OFF) / 4; u += NWAVES * 64) ((LAS unsigned*)(lds + LDSCTL_OFF))[u] = 0u;
    __syncthreads();
    XcdBarrier bar; bar.bar = ctl + CW_BAR; bar.x = 0; bar.st = nullptr;
    if (!MK_PER_PHASE) bar = xcd_barrier_post(ctl + CW_BAR, MISC + 8);
    const int lo = args.ph_lo, hi = args.ph_hi;
#define IN(k) (lo <= (k) && (k) < hi)
#define SEAM(k) do { if (IN(k) && IN((k) + 1)) xcd_barrier(bar); } while (0)

    if (IN(0)) REPS(0) {
        P0Args a{x, conv_g, w_in, w_out, attn_g, w_qkv, w_o, ffn_g, w_pq, subk, pu, pv, WinT, WoutT, WqkvT, WoT, WpqT, SKb, U8, V8, XB, SS0};
        p0_prologue(a, lds, vcu, G, wave, lane, tid);
    }
    SEAM(0);
    if (IN(1)) REPS(1) {
        pg8::Gemm g{XB, WinT, T, NIN, D}; pg8::StaticOrder S; S.init(T, NIN, G, bx);
        pg8::EpiBf16RS E{G1, NIN, NIN / 256, nullptr, nullptr, 0, SS0};
        pg8::gemm_phase<pg8::EpiBf16RS, pg8::StaticOrder, true, true>(lds, g, S, E);
    }
    SEAM(1);
    if (IN(2)) REPS(2) conv_gate_phase(G1, conv_w, Y, vcu, G, tid);
    SEAM(2);
    if (IN(3)) REPS(3) {
        pg8::Gemm g{Y, WoutT, T, D, D}; pg8::StaticOrder S; S.init(T, D, G, bx);
        pg8::EpiResid E{x, out, XB, SS1};
        pg8::gemm_phase<pg8::EpiResid, pg8::StaticOrder, true, true>(lds, g, S, E);
    }
    SEAM(3);
    if (IN(4)) {
        pg8::Gemm g{XB, WpqT, T, NPQ, D}; pg8::StaticOrder S; S.init(T, NPQ, G, bx); EpiRoute E{SS1, IDX, GATE}; pg8::Unit uu;
        for (int i = 0; S.next(i, uu); ++i) { OneUnit O{uu}; pg8::gemm_phase<EpiRoute, OneUnit, false, true>(lds, g, O, E); }
    }
    SEAM(4);
    if (IN(6)) sliced_pass<0, false>(U8, IDX, XB, XB, HP, AA, out, SS2, ctl + CW_WQ + 64 * 0, ctl + CW_BAR, MISC + 12, wave, lane, tid);
    SEAM(6);
    if (IN(7)) reduce_phase(HP, GATE, SS1, AA, vcu, G, tid);
    SEAM(7);
    if (IN(8)) sliced_pass<1, false>(V8, IDX, XB, XB, HP, AA, out, SS2, ctl + CW_WQ + 64 * 8, ctl + CW_BAR, MISC + 12, wave, lane, tid);
    SEAM(8);
    if (IN(9)) REPS(9) {
        pg8::Gemm g{XB, WqkvT, T, NQKV, D}; pg8::StaticOrder S; S.init(T, NQKV, G, bx);
        pg8::EpiBf16RS E{Qb, D, 4, Kb, VVb, 256, SS2};
        pg8::gemm_phase<pg8::EpiBf16RS, pg8::StaticOrder, true, true>(lds, g, S, E);
    }
    SEAM(9);
    if (IN(10)) REPS(10) attn_phase(Qb, Kb, VVb, AO, rel_bias, sink, lds, vcu, G, wave, lane, tid);
    SEAM(10);
    if (IN(11)) {
        pg8::Gemm g{AO, WoT, T, D, D}; pg8::StaticOrder S; S.init(T, D, G, bx);
        pg8::EpiResid E{out, out, XB, SS3};
        pg8::gemm_phase<pg8::EpiResid, pg8::StaticOrder, true, true>(lds, g, S, E);
    }
    SEAM(11);
    if (IN(12)) {
        pg8::Gemm g{XB, WpqT + (size_t)NPQ * D, T, NPQ, D}; pg8::StaticOrder S; S.init(T, NPQ, G, bx); EpiRoute E{SS3, IDX, GATE}; pg8::Unit uu;
        for (int i = 0; S.next(i, uu); ++i) { OneUnit O{uu}; pg8::gemm_phase<EpiRoute, OneUnit, false, true>(lds, g, O, E); }
    }
    SEAM(12);
    if (IN(14)) sliced_pass<0, true>(U8 + (size_t)NEXP * D, IDX, XB, XB, HP, AA, out, SS4, ctl + CW_WQ + 64 * 16, ctl + CW_BAR, MISC + 12, wave, lane, tid);
    SEAM(14);
    if (IN(15)) reduce_phase(HP, GATE, SS3, AA, vcu, G, tid);
    SEAM(15);
    if (IN(16)) sliced_pass<1, true>(V8 + (size_t)NEXP * D, IDX, XB, XB, HP, AA, out, SS4, ctl + CW_WQ + 64 * 24, ctl + CW_BAR, MISC + 12, wave, lane, tid);
    SEAM(16);
    if (IN(17)) final_phase(SS4, out, fin_g, vcu, G, wave, lane);
#undef IN
#undef SEAM
}

extern "C" void kernel_launch(void* const* d_in, const int* in_sizes, int n_in, void* d_out, int out_size, void* d_ws, size_t ws_size, hipStream_t stream) {
    static int grid = 0;
    if (grid == 0) {
        if (n_in != 16 || in_sizes[0] != T * D || out_size != T * D || ws_size < WS_END) { fprintf(stderr, "kernel_launch: unexpected shapes (n_in %d, in0 %d, out %d, ws %zu)\n", n_in, n_in > 0 ? in_sizes[0] : -1, out_size, ws_size); grid = -1; return; }
        int dev = 0, cus = 0, per_cu = 0;
        if (hipGetDevice(&dev) != hipSuccess || hipDeviceGetAttribute(&cus, hipDeviceAttributeMultiprocessorCount, dev) != hipSuccess) { grid = -1; return; }
        if (hipFuncSetAttribute((const void*)fwd_kernel, hipFuncAttributeMaxDynamicSharedMemorySize, LDS_BYTES) != hipSuccess) { fprintf(stderr, "kernel_launch: hipFuncSetAttribute failed\n"); grid = -1; return; }
        if (hipOccupancyMaxActiveBlocksPerMultiprocessor(&per_cu, (const void*)fwd_kernel, NWAVES * 64, LDS_BYTES) != hipSuccess || per_cu < 1) { fprintf(stderr, "kernel_launch: occupancy query says %d blocks per CU\n", per_cu); (void)hipGetLastError(); grid = -1; return; }
        grid = cus;
    }
    if (grid < 0) return;
    (void)hipMemsetAsync((char*)d_ws + WS_CTL, 0, CTL_ZERO_BYTES, stream);
    Args a{};
    for (int i = 0; i < 16; ++i) a.in[i] = (const float*)d_in[i];
    a.out = (float*)d_out; a.ws = (unsigned char*)d_ws;
#if MK_PER_PHASE
    for (int p = 0; p < NPH; ++p) { a.ph_lo = p; a.ph_hi = p + 1; hipLaunchKernelGGL(fwd_kernel, dim3(grid), dim3(NWAVES * 64), LDS_BYTES, stream, a); }
#else
    a.ph_lo = 0; a.ph_hi = NPH;
    hipLaunchKernelGGL(fwd_kernel, dim3(grid), dim3(NWAVES * 64), LDS_BYTES, stream, a);
#endif
}
```

```cpp
#include <hip/hip_runtime.h>
#include <cstdio>
#include <cstdint>
namespace pg8 {
#define PG8_LAS __attribute__((address_space(3)))
typedef unsigned short bf16_t;
typedef short bf16x8 __attribute__((ext_vector_type(8)));
typedef float f32x4 __attribute__((ext_vector_type(4)));
typedef unsigned u32x4 __attribute__((ext_vector_type(4)));
constexpr int BM = 256, BK = 64, HALF = 128, HTB = HALF * BK * 2  , STAGE_BYTES = 8 * HTB, NXCD = 8, WGM = 8;

__host__ __device__ __forceinline__ int lds_byte(int r, int c) { const int st = (r >> 4) * 2 + (c >> 5), rr = r & 15, cc = c & 31, ob = rr * 64 + cc * 2; return st * 1024 + (ob ^ (((ob >> 9) & 1) << 5)); }
__host__ __device__ __forceinline__ void stage_rc(int b, int& R, int& C) { const int st = b / 1024, sb = b % 1024, swz = sb ^ (((sb >> 9) & 1) << 5); R = (st >> 1) * 16 + swz / 64; C = (st & 1) * 32 + (swz % 64) / 2; }
__host__ __device__ __forceinline__ int perm32(int rho) { const int n = rho >> 4, i = rho & 15; return 8 * (i >> 2) + 4 * n + (i & 3); }

struct Unit { int pm, pn; };
struct Gemm { const bf16_t* A; const bf16_t* Bt; int M, N, K; };

struct StaticOrder {
    int nM, nN, nwg, G, c;
    __host__ __device__ void init(int M, int N, int G_, int c_) { nM = M / BM; nN = N / BM; nwg = nM * nN; G = G_; c = c_; }
    __host__ __device__ bool next(int i, Unit& u) const {
        const long L = (long)i * G + c; if (L >= nwg) return false;
        int wgid = (int)L; { const int q = nwg / NXCD, r = nwg % NXCD, xcd = wgid % NXCD, off = wgid / NXCD; wgid = (xcd < r ? xcd * (q + 1) : r * (q + 1) + (xcd - r) * q) + off; }
        const int nig = WGM * nN, gid = wgid / nig, fm = gid * WGM, gsz = (nM - fm) < WGM ? (nM - fm) : WGM;
        u.pm = fm + ((wgid % nig) % gsz); u.pn = (wgid % nig) / gsz; return true;
    }
    __device__ __forceinline__ void a_ready(const Unit&) const {}
    __device__ __forceinline__ void done(const Unit&) const {}
};

__device__ __forceinline__ unsigned cvt_pk_bf16(float lo, float hi) { unsigned r; asm volatile("v_cvt_pk_bf16_f32 %0, %1, %2" : "=v"(r) : "v"(lo), "v"(hi)); return r; }
typedef unsigned u32x2 __attribute__((ext_vector_type(2)));
__device__ __forceinline__ float row_rstd(const float* ss, int row) {
    const f32x4* p = (const f32x4*)(ss + (size_t)row * 16);
    const f32x4 a = p[0], b = p[1], c = p[2], d = p[3];
    const float s = (((a[0] + a[1]) + (a[2] + a[3])) + ((b[0] + b[1]) + (b[2] + b[3]))) + (((c[0] + c[1]) + (c[2] + c[3])) + ((d[0] + d[1]) + (d[2] + d[3])));
    return __builtin_amdgcn_rsqf(s * (1.0f / 1024.0f) + 1e-6f);
}
struct EpiBf16RS {
    static constexpr bool PERM = true, AFTER_DRAIN = false;
    bf16_t* O0; int ld0; int nt0; bf16_t* O1; bf16_t* O2; int ld1; const float* ss;
    __device__ __forceinline__ void operator()(const f32x4 (&acc)[2][2][4][2], const Unit& u, int wr, int wc, int fr, int fq) const {
        bf16_t* base; int ld, colt;
        if (u.pn < nt0) { base = O0; ld = ld0; colt = u.pn * BM; } else if (u.pn == nt0) { base = O1; ld = ld1; colt = 0; } else { base = O2; ld = ld1; colt = (u.pn - nt0 - 1) * BM; }
        const int row0 = u.pm * BM + wr * 64 + fr, col0 = colt + wc * 32 + 8 * fq;
#pragma unroll
        for (int ai = 0; ai < 2; ++ai)
#pragma unroll
            for (int m = 0; m < 4; ++m) { const int row = row0 + ai * HALF + m * 16; const float rs = row_rstd(ss, row); bf16_t* rowp = base + (size_t)row * ld + col0;
#pragma unroll
                for (int bj = 0; bj < 2; ++bj) { const f32x4 v0 = acc[ai][bj][m][0] * rs, v1 = acc[ai][bj][m][1] * rs;
                    u32x4 w; w.x = cvt_pk_bf16(v0[0], v0[1]); w.y = cvt_pk_bf16(v0[2], v0[3]); w.z = cvt_pk_bf16(v1[0], v1[1]); w.w = cvt_pk_bf16(v1[2], v1[3]);
                    *(u32x4*)(rowp + bj * HALF) = w; } }
    }
};
struct EpiResid {
    static constexpr bool PERM = false, AFTER_DRAIN = false;
    const float* base; float* out; bf16_t* xb; float* ss;
    __device__ __forceinline__ void operator()(const f32x4 (&acc)[2][2][4][2], const Unit& u, int wr, int wc, int fr, int fq) const {
        const int row0 = u.pm * BM + wr * 64 + fr, col0 = u.pn * BM + wc * 32 + 4 * fq;
#pragma unroll
        for (int ai = 0; ai < 2; ++ai)
#pragma unroll
            for (int m = 0; m < 4; ++m) { const int row = row0 + ai * HALF + m * 16; float sq = 0.f;
#pragma unroll
                for (int bj = 0; bj < 2; ++bj)
#pragma unroll
                    for (int n = 0; n < 2; ++n) { const size_t off = (size_t)row * 1024 + col0 + bj * HALF + n * 16;
                        const f32x4 o = *(const f32x4*)(base + off) + acc[ai][bj][m][n];
                        *(f32x4*)(out + off) = o; sq += (o[0] * o[0] + o[1] * o[1]) + (o[2] * o[2] + o[3] * o[3]);
                        u32x2 w; w.x = cvt_pk_bf16(o[0], o[1]); w.y = cvt_pk_bf16(o[2], o[3]); *(u32x2*)(xb + off) = w; }
                sq += __shfl_xor(sq, 16); sq += __shfl_xor(sq, 32);
                if (fq == 0) ss[(size_t)row * 16 + u.pn * 4 + wc] = sq; }
    }
};

template <class Epi, class Sched, bool ALIGN_EPI = false, bool SP2 = false>
__device__ __forceinline__ void gemm_phase(PG8_LAS unsigned char* lds, const Gemm g, const Sched& S, const Epi& E) {
    const int tid = threadIdx.x, wid = __builtin_amdgcn_readfirstlane(tid >> 6), lane = tid & 63, wr = wid >> 2, wc = wid & 3, fr = lane & 15, fq = lane >> 4;
    const int K = g.K, nt = K / BK;
    unsigned voffA[2], voffB[2];
#pragma unroll
    for (int i = 0; i < 2; ++i) { int R, C; stage_rc(tid * 16 + i * 8192, R, C); const int Rb = Epi::PERM ? ((R & ~31) + perm32(R & 31)) : R;
        voffA[i] = (unsigned)(R * K + C) * 2u; voffB[i] = (unsigned)(Rb * K + C) * 2u; }
    const size_t kstep = (size_t)(BK * 2);
    const size_t hstep = (size_t)HALF * K * 2;
    const size_t tstep = 2 * hstep;
    const unsigned ldsw = (unsigned)wid * 1024u;
    const int aoff = lds_byte(wr * 64 + fr, fq * 8), boff = lds_byte(wc * 32 + fr, fq * 8);
#define PG8_SA(b, h) (((b) * 2 + (h)) * HTB)
#define PG8_SB(b, h) ((4 + (b) * 2 + (h)) * HTB)
#define PG8_STAGE(bufoff, gbase, voff) do { _Pragma("unroll") for (int _i = 0; _i < 2; ++_i) \
        __builtin_amdgcn_global_load_lds((const unsigned*)((const char*)(gbase) + (voff)[_i]), (PG8_LAS unsigned*)(lds + (bufoff) + ldsw + _i * 8192), 16, 0, 0); } while (0)
#define PG8_LDA(dst, b, h) do { _Pragma("unroll") for (int m = 0; m < 4; ++m) _Pragma("unroll") for (int k = 0; k < 2; ++k) dst[m][k] = *(const PG8_LAS bf16x8*)(lds + PG8_SA(b, h) + aoff + m * 2048 + k * 1024); } while (0)
#define PG8_LDB(dst, b, h) do { _Pragma("unroll") for (int n = 0; n < 2; ++n) _Pragma("unroll") for (int k = 0; k < 2; ++k) dst[n][k] = *(const PG8_LAS bf16x8*)(lds + PG8_SB(b, h) + boff + n * 2048 + k * 1024); } while (0)
#define PG8_MMA(ai, bj, At, Bt) do { __builtin_amdgcn_s_setprio(1); _Pragma("unroll") for (int m = 0; m < 4; ++m) _Pragma("unroll") for (int n = 0; n < 2; ++n) _Pragma("unroll") for (int k = 0; k < 2; ++k) \
        acc[ai][bj][m][n] = __builtin_amdgcn_mfma_f32_16x16x32_bf16(Bt[n][k], At[m][k], acc[ai][bj][m][n], 0, 0, 0); __builtin_amdgcn_s_setprio(0); } while (0)
#define PG8_WAIT_V(n) asm volatile("s_waitcnt vmcnt(" #n ")" ::: "memory")
#define PG8_WAIT_L(n) asm volatile("s_waitcnt lgkmcnt(" #n ")" ::: "memory")
#define PG8_BAR __builtin_amdgcn_s_barrier()
#define PG8_SCHED __builtin_amdgcn_sched_barrier(0)
    Unit cur, nxt; int ui = 0;
    if (!S.next(0, cur)) return;
    f32x4 acc[2][2][4][2];
#pragma unroll
    for (int a = 0; a < 2; ++a)
#pragma unroll
        for (int b = 0; b < 2; ++b)
#pragma unroll
            for (int m = 0; m < 4; ++m)
#pragma unroll
                for (int n = 0; n < 2; ++n) acc[a][b][m][n] = (f32x4){0.f, 0.f, 0.f, 0.f};
    bf16x8 At[4][2], B0[2][2], B1[2][2];
    const char* cA = (const char*)g.A + (size_t)cur.pm * tstep; const char* cB = (const char*)g.Bt + (size_t)cur.pn * tstep;
    S.a_ready(cur);
    if constexpr (SP2) {
        PG8_STAGE(PG8_SB(0, 0), cB, voffB); PG8_STAGE(PG8_SB(0, 1), cB + hstep, voffB); PG8_STAGE(PG8_SA(0, 0), cA, voffA); PG8_STAGE(PG8_SA(0, 1), cA + hstep, voffA);
        if (wr == 1) PG8_BAR;
        PG8_WAIT_V(2); PG8_BAR;
        PG8_STAGE(PG8_SB(1, 0), cB + kstep, voffB); PG8_STAGE(PG8_SA(1, 0), cA + kstep, voffA); PG8_STAGE(PG8_SB(1, 1), cB + hstep + kstep, voffB);
        PG8_WAIT_V(6); PG8_BAR;
    } else {
        PG8_STAGE(PG8_SB(0, 0), cB, voffB); PG8_STAGE(PG8_SA(0, 0), cA, voffA); PG8_STAGE(PG8_SB(0, 1), cB + hstep, voffB); PG8_STAGE(PG8_SA(0, 1), cA + hstep, voffA);
        if (wr == 1) PG8_BAR;
        PG8_WAIT_V(4); PG8_BAR;
        PG8_STAGE(PG8_SB(1, 0), cB + kstep, voffB); PG8_STAGE(PG8_SA(1, 0), cA + kstep, voffA); PG8_STAGE(PG8_SB(1, 1), cB + hstep + kstep, voffB);
        PG8_WAIT_V(6); PG8_BAR;
    }
    for (;;) {
        const bool has_next = S.next(ui + 1, nxt);
        const char* nA = has_next ? (const char*)g.A + (size_t)nxt.pm * tstep : cA; const char* nB = has_next ? (const char*)g.Bt + (size_t)nxt.pn * tstep : cB;
        for (int t = 0; t < nt; t += 2) {
            const bool last = (t == nt - 2);
            const char* a1 = cA + (size_t)(t + 1) * kstep;
            const char* a2 = last ? nA : cA + (size_t)(t + 2) * kstep; const char* b2 = last ? nB : cB + (size_t)(t + 2) * kstep;
            const char* a3 = a2 + kstep; const char* b3 = b2 + kstep;
            if (last && has_next) S.a_ready(nxt);
            if constexpr (SP2) {
            PG8_LDB(B0, 0, 0); PG8_LDB(B1, 0, 1); PG8_SCHED; PG8_LDA(At, 0, 0); PG8_STAGE(PG8_SA(1, 1), a1 + hstep, voffA);
            PG8_WAIT_V(8); PG8_WAIT_L(0); PG8_BAR; PG8_MMA(0, 0, At, B0); PG8_MMA(0, 1, At, B1); PG8_BAR; PG8_SCHED;
            PG8_LDA(At, 0, 1); PG8_STAGE(PG8_SB(0, 0), b2, voffB); PG8_STAGE(PG8_SB(0, 1), b2 + hstep, voffB); PG8_STAGE(PG8_SA(0, 0), a2, voffA);
            PG8_WAIT_V(8); PG8_WAIT_L(0); PG8_BAR; PG8_MMA(1, 0, At, B0); PG8_MMA(1, 1, At, B1); PG8_BAR; PG8_SCHED;
            PG8_LDB(B0, 1, 0); PG8_LDB(B1, 1, 1); PG8_SCHED; PG8_LDA(At, 1, 0); PG8_STAGE(PG8_SA(0, 1), a2 + hstep, voffA);
            PG8_WAIT_V(8); PG8_WAIT_L(0); PG8_BAR; PG8_MMA(0, 0, At, B0); PG8_MMA(0, 1, At, B1); PG8_BAR; PG8_SCHED;
            PG8_LDA(At, 1, 1); PG8_STAGE(PG8_SB(1, 0), b3, voffB); PG8_STAGE(PG8_SB(1, 1), b3 + hstep, voffB); PG8_STAGE(PG8_SA(1, 0), a3, voffA);
            PG8_WAIT_V(8); PG8_WAIT_L(0); PG8_BAR; PG8_MMA(1, 0, At, B0); PG8_MMA(1, 1, At, B1); PG8_BAR; PG8_SCHED;
            } else {
            PG8_LDB(B0, 0, 0); PG8_SCHED; PG8_LDA(At, 0, 0); PG8_STAGE(PG8_SA(1, 1), a1 + hstep, voffA);
            PG8_WAIT_L(8); PG8_BAR; PG8_WAIT_L(0); PG8_MMA(0, 0, At, B0); PG8_BAR; PG8_SCHED;
            PG8_LDB(B1, 0, 1); PG8_STAGE(PG8_SB(0, 0), b2, voffB);
            PG8_BAR; PG8_WAIT_L(0); PG8_MMA(0, 1, At, B1); PG8_BAR;
            PG8_LDA(At, 0, 1); PG8_STAGE(PG8_SA(0, 0), a2, voffA);
            PG8_BAR; PG8_WAIT_L(0); PG8_MMA(1, 0, At, B0); PG8_BAR; PG8_SCHED;
            PG8_STAGE(PG8_SB(0, 1), b2 + hstep, voffB);
            PG8_WAIT_V(6); PG8_BAR; PG8_MMA(1, 1, At, B1); PG8_BAR;
            PG8_LDB(B0, 1, 0); PG8_SCHED; PG8_LDA(At, 1, 0); PG8_STAGE(PG8_SA(0, 1), a2 + hstep, voffA);
            PG8_WAIT_L(8); PG8_BAR; PG8_WAIT_L(0); PG8_MMA(0, 0, At, B0); PG8_BAR; PG8_SCHED;
            PG8_LDB(B1, 1, 1); PG8_STAGE(PG8_SB(1, 0), b3, voffB);
            PG8_BAR; PG8_WAIT_L(0); PG8_MMA(0, 1, At, B1); PG8_BAR;
            PG8_LDA(At, 1, 1); PG8_STAGE(PG8_SA(1, 0), a3, voffA);
            PG8_BAR; PG8_WAIT_L(0); PG8_MMA(1, 0, At, B0); PG8_BAR; PG8_SCHED;
            PG8_STAGE(PG8_SB(1, 1), b3 + hstep, voffB);
            PG8_WAIT_V(6); PG8_BAR; PG8_MMA(1, 1, At, B1); PG8_BAR;
            }
        }
        if constexpr (ALIGN_EPI) { if (wr == 0) PG8_BAR; }
        if constexpr (!Epi::AFTER_DRAIN) { E(acc, cur, wr, wc, fr, fq); S.done(cur); }
        if (!has_next) break;
#pragma unroll
        for (int a = 0; a < 2; ++a)
#pragma unroll
            for (int b = 0; b < 2; ++b)
#pragma unroll
                for (int m = 0; m < 4; ++m)
#pragma unroll
                    for (int n = 0; n < 2; ++n) acc[a][b][m][n] = (f32x4){0.f, 0.f, 0.f, 0.f};
        cur = nxt; cA = nA; cB = nB; ++ui;
        if constexpr (ALIGN_EPI) { if (wr == 1) PG8_BAR; }
    }
    PG8_WAIT_V(0);
    if constexpr (!ALIGN_EPI) { if (wr == 0) PG8_BAR; }
    PG8_BAR;
    if constexpr (Epi::AFTER_DRAIN) { E.fused(acc, cur, wr, wc, fr, fq, lds, wid, lane); S.done(cur); }
#undef PG8_SA
#undef PG8_SB
#undef PG8_STAGE
#undef PG8_LDA
#undef PG8_LDB
#undef PG8_MMA
#undef PG8_WAIT_V
#undef PG8_WAIT_L
#undef PG8_BAR
#undef PG8_SCHED
}
}

constexpr int NWAVES = 8;
constexpr int BATCH = 2, SEQ = 8192, D = 1024, T = BATCH * SEQ;
constexpr int NIN = 3072, NQKV = 1536, NPQ = 2048, NEXP = 16384;
constexpr float LOG2E = 1.4426950408889634f;
constexpr float QSCALE = 0.125f * LOG2E;
constexpr float NEGBIG = -1e30f;
#ifndef MK_PER_PHASE
#define MK_PER_PHASE 0
#endif
constexpr int NPH = 18;
#ifndef REP_MASK
#define REP_MASK 0
#endif
#define REPS(k) for (int rep_ = 0; rep_ < (((REP_MASK) >> (k)) & 1) + 1; ++rep_)

constexpr size_t MiB = 1u << 20;
constexpr size_t WS_CTL = 0, CTL_ZERO_BYTES = 65536;
constexpr size_t WS_WIN = 1 * MiB, WS_WOUT = 7 * MiB, WS_WQKV = 9 * MiB, WS_WO = 12 * MiB, WS_WPQ = 14 * MiB, WS_SK = 22 * MiB;
constexpr size_t WS_SS = 23 * MiB;
constexpr size_t WS_IDX = 28 * MiB, WS_GATE = 36 * MiB, WS_XB = 44 * MiB, WS_Y = 76 * MiB, WS_U = 108 * MiB, WS_V = 172 * MiB;
constexpr size_t WS_G1 = 236 * MiB, WS_PQ = 332 * MiB, WS_Q = 396 * MiB, WS_K = 428 * MiB, WS_VV = 436 * MiB, WS_AO = 444 * MiB, WS_END = 476 * MiB;
constexpr size_t WS_HP = WS_G1, WS_A = WS_G1 + 64 * MiB;
constexpr int CW_BAR = 4096;
constexpr int CW_WQ = 8192;

constexpr int RING_BYTES = 131072;
constexpr int LDSCTL_OFF = 143360, MISC_OFF = LDSCTL_OFF + 320;
constexpr int SC_STRIDE = 260, SC_TAB_OFF = 135168;
constexpr int LDS_BYTES = 147456;

#define LAS __attribute__((address_space(3)))
typedef unsigned short bf16;
typedef unsigned v4u __attribute__((ext_vector_type(4)));
typedef unsigned v2u __attribute__((ext_vector_type(2)));
typedef float f32x4 __attribute__((ext_vector_type(4)));
typedef float f32x2 __attribute__((ext_vector_type(2)));
typedef float f32x16 __attribute__((ext_vector_type(16)));
typedef short bf16x8 __attribute__((ext_vector_type(8)));
typedef __bf16 bf16x2_t __attribute__((ext_vector_type(2)));
#define LDS_WAIT() asm volatile("s_waitcnt lgkmcnt(0)" ::: "memory")
#define DI __device__ __forceinline__

DI unsigned pk2(float lo, float hi) { f32x2 v = {lo, hi}; bf16x2_t b = __builtin_convertvector(v, bf16x2_t); return __builtin_bit_cast(unsigned, b); }
DI float bf_lo(unsigned u) { return __uint_as_float(u << 16); }
DI float bf_hi(unsigned u) { return __uint_as_float(u & 0xffff0000u); }
DI float wave_sum(float v) {
#pragma unroll
    for (int o = 1; o < 64; o <<= 1) v += __shfl_xor(v, o);
    return v;
}
#define XB_TMO      128
#define XB_XCNT(j)  (256  + 64 * (j))
#define XB_XSUB(j)  (1280 + 64 * (j))
#define XB_XGEN(j)  (2304 + 64 * (j))
#define XB_TOP      3328
#define XB_TOPGEN   3392
#define XCD_BAR_WORDS 3456
#define XB_SPIN_CAP (1u << 18)

__device__ __forceinline__ unsigned xb_ld(unsigned* p)              { return __hip_atomic_load(p, __ATOMIC_RELAXED, __HIP_MEMORY_SCOPE_AGENT); }
__device__ __forceinline__ unsigned xb_add(unsigned* p, unsigned v) { return __hip_atomic_fetch_add(p, v, __ATOMIC_RELAXED, __HIP_MEMORY_SCOPE_AGENT); }
__device__ __forceinline__ unsigned xb_xcc_id() { return (unsigned)__builtin_amdgcn_s_getreg((3 << 11) | 20) & 0xFu; }
#define XB_SPIN(cond, bar) do { unsigned _sp = 0; while (cond) { __builtin_amdgcn_s_sleep(1); \
    if ((++_sp & 255u) == 0u) { if (xb_ld(&(bar)[XB_TMO])) break; if (_sp > XB_SPIN_CAP) { atomicAdd(&(bar)[XB_TMO], 1u); break; } } } } while (0)

struct XcdBarrier {
    unsigned* bar; unsigned x;
    volatile LAS unsigned* st;
};

__device__ __forceinline__ XcdBarrier xcd_barrier_post(unsigned* bar, volatile LAS unsigned* st) {
    XcdBarrier b; b.bar = bar; b.x = xb_xcc_id(); b.st = st;
    if (threadIdx.x == 0) (void)xb_add(&bar[XB_XCNT(b.x)], 1u);
    return b;
}
__device__ __forceinline__ void xcd_barrier_complete(unsigned* bar, unsigned x, unsigned& nloc, unsigned& nx) {
    const unsigned G = gridDim.x * gridDim.y * gridDim.z;
    unsigned sum, cnt, mine, sp = 0u;
    for (;;) {
        sum = 0u; cnt = 0u; mine = 0u;
#pragma unroll
        for (unsigned j = 0; j < 16; ++j) { const unsigned c = xb_ld(&bar[XB_XCNT(j)]); sum += c; cnt += (c > 0u) ? 1u : 0u; mine = (j == x) ? c : mine; }
        if (sum == G) break;
        __builtin_amdgcn_s_sleep(1);
        if ((++sp & 255u) == 0u) { if (xb_ld(&bar[XB_TMO])) break; if (sp > XB_SPIN_CAP) { atomicAdd(&bar[XB_TMO], 1u); break; } }
    }
    nloc = mine > 0u ? mine : 1u; nx = cnt > 0u ? cnt : 1u;
}

__device__ __forceinline__ void xcd_barrier(const XcdBarrier& b) {
    asm volatile("s_waitcnt vmcnt(0)" ::: "memory");
    __syncthreads();
    if (threadIdx.x == 0) {
        unsigned* bar = b.bar;
        __builtin_amdgcn_s_waitcnt(0);
        unsigned nloc = b.st[0], nx = b.st[1];
        if (nloc == 0u) { xcd_barrier_complete(bar, b.x, nloc, nx); b.st[0] = nloc; b.st[1] = nx; }
        const unsigned old = xb_add(&bar[XB_XSUB(b.x)], 1u);
        const unsigned gen = old / nloc;
        if (old + 1u == (gen + 1u) * nloc) {
            __builtin_amdgcn_fence(__ATOMIC_RELEASE, "agent");
            asm volatile("s_waitcnt vmcnt(0)" ::: "memory");
            const unsigned og = xb_add(&bar[XB_TOP], 1u);
            const unsigned tg = og / nx;
            if (og + 1u == (tg + 1u) * nx) xb_add(&bar[XB_TOPGEN], 1u);
            else XB_SPIN(xb_ld(&bar[XB_TOPGEN]) == tg, bar);
            __builtin_amdgcn_fence(__ATOMIC_ACQUIRE, "agent");
            xb_add(&bar[XB_XGEN(b.x)], 1u);
            asm volatile("s_waitcnt vmcnt(0)" ::: "memory");
        } else {
            XB_SPIN(xb_ld(&bar[XB_XGEN(b.x)]) == gen, bar);
            __builtin_amdgcn_fence(__ATOMIC_ACQUIRE, "agent");
            asm volatile("s_waitcnt vmcnt(0)" ::: "memory");
        }
    }
    __syncthreads();
}

DI void p0_transpose_item(const float* W, int K, int N, bf16* WT, LAS float* scr, int item, int lane, const float* gain, int nscaled, float cscale) {
    const int nblk = N / 32, kb = item / nblk, nb = item % nblk, k0 = 64 * kb, n0 = 32 * nb;
    float tv[32];
#pragma unroll
    for (int i = 0; i < 32; ++i) tv[i] = W[(size_t)(k0 + 2 * i + (lane >> 5)) * N + n0 + (lane & 31)];
#pragma unroll
    for (int i = 0; i < 32; ++i) { const int kk = 2 * i + (lane >> 5); float v = tv[i]; if (gain) v *= gain[k0 + kk]; scr[kk * 33 + (lane & 31)] = v; }
    LDS_WAIT();
    const int c = lane & 7;
#pragma unroll
    for (int j = 0; j < 4; ++j) { const int n = (lane >> 3) + 8 * j; const LAS float* s = scr + (8 * c) * 33 + n; const float cs = (n0 + n < nscaled) ? cscale : 1.f;
        v4u o; o.x = pk2(s[0 * 33] * cs, s[1 * 33] * cs); o.y = pk2(s[2 * 33] * cs, s[3 * 33] * cs); o.z = pk2(s[4 * 33] * cs, s[5 * 33] * cs); o.w = pk2(s[6 * 33] * cs, s[7 * 33] * cs);
        *(v4u*)(WT + (size_t)(n0 + n) * K + k0 + 8 * c) = o; }
    LDS_WAIT();
}
DI void table_blocks(const float* pu, const float* pv, const float* ffn_g, unsigned char* U8, unsigned char* V8, size_t b0, size_t b1, size_t w, size_t nw, int lane) {
    constexpr size_t NB = (size_t)2 * NEXP * D / 2048;
    for (size_t blk = b0 + w; blk < b1; blk += nw) { const bool isv = blk >= NB; const size_t bb = isv ? blk - NB : blk; const int layer = (int)(bb / (NB / 2));
        const float* src = (isv ? pv : pu) + bb * 2048; unsigned char* dst = (isv ? V8 : U8) + bb * 2048;
        f32x4 v[8];
#pragma unroll
        for (int j = 0; j < 8; ++j) v[j] = __builtin_nontemporal_load((const f32x4*)(src + 256 * j) + lane);
#pragma unroll
        for (int j = 0; j < 8; ++j) { unsigned wd;
            if (isv) { const f32x4 t = v[j] * 1024.0f; int wi = __builtin_amdgcn_cvt_pk_fp8_f32(t[0], t[1], 0, false); wi = __builtin_amdgcn_cvt_pk_fp8_f32(t[2], t[3], wi, true); wd = (unsigned)wi; }
            else { const f32x4 g = *((const f32x4*)(ffn_g + layer * D + 256 * (j & 3)) + lane); const f32x4 t = v[j] * g * 512.0f; wd = 0u;
#pragma unroll
                for (int e = 0; e < 4; ++e) { const int qi = (int)__builtin_rintf(fminf(fmaxf(t[e], -127.f), 127.f)); wd |= ((unsigned)qi & 0xffu) << (8 * e); } }
            *((unsigned*)(dst + 256 * j) + lane) = wd; } }
}
struct P0Args { const float *x, *conv_g, *w_in, *w_out, *attn_g, *w_qkv, *w_o, *ffn_g, *w_pq, *subk, *pu, *pv;
                bf16 *WinT, *WoutT, *WqkvT, *WoT, *WpqT, *SKb; unsigned char *U8, *V8; bf16* XB; float* SS0; };
DI void p0_prologue(const P0Args& a, LAS unsigned char* lds, int vcu, int G, int wave, int lane, int tid) {
    LAS float* scr = (LAS float*)(lds + wave * 16384);
    const int gw = vcu * NWAVES + wave, NGW = G * NWAVES;
    constexpr int I_IN = 16 * (NIN / 32), I_OUT = 16 * (D / 32), I_QKV = 16 * (NQKV / 32), I_O = I_OUT;
    constexpr int NITEMS = I_IN + I_OUT + I_QKV + I_O;
    for (int it = gw; it < NITEMS; it += NGW) {
        int r = it;
        if (r < I_IN) { p0_transpose_item(a.w_in, D, NIN, a.WinT, scr, r, lane, a.conv_g, 0, 1.f); continue; } r -= I_IN;
        if (r < I_OUT) { p0_transpose_item(a.w_out, D, D, a.WoutT, scr, r, lane, nullptr, 0, 1.f); continue; } r -= I_OUT;
        if (r < I_QKV) { p0_transpose_item(a.w_qkv, D, NQKV, a.WqkvT, scr, r, lane, a.attn_g, 1024, QSCALE); continue; } r -= I_QKV;
        p0_transpose_item(a.w_o, D, D, a.WoT, scr, r, lane, nullptr, 0, 1.f);
    }
    { const int fr = lane & 15, fq = lane >> 4;
      for (int task = gw; task < 2 * 16 * 8 * 16; task += NGW) { const int kc = task & 15, nt = (task >> 4) & 7, hp = (task >> 7) & 15, l = task >> 11;
        const float* skp = a.subk + ((size_t)(l * 16 + hp) * 128 + nt * 16 + fr) * 128 + fq * 8;
        bf16x8 bfr[4];
#pragma unroll
        for (int ks = 0; ks < 4; ++ks) { const f32x4 v0 = *(const f32x4*)(skp + ks * 32), v1 = *(const f32x4*)(skp + ks * 32 + 4);
            v4u w; w.x = pk2(v0[0], v0[1]); w.y = pk2(v0[2], v0[3]); w.z = pk2(v1[0], v1[1]); w.w = pk2(v1[2], v1[3]); bfr[ks] = __builtin_bit_cast(bf16x8, w); }
#pragma unroll 1
        for (int kt = 0; kt < 4; ++kt) { const int k0 = kc * 64 + kt * 16;
            const float* wp = a.w_pq + ((size_t)l * D + k0 + fr) * NPQ + hp * 128 + fq * 8;
            f32x4 acc = {0.f, 0.f, 0.f, 0.f};
#pragma unroll
            for (int ks = 0; ks < 4; ++ks) { const f32x4 v0 = *(const f32x4*)(wp + ks * 32), v1 = *(const f32x4*)(wp + ks * 32 + 4);
                v4u w; w.x = pk2(v0[0], v0[1]); w.y = pk2(v0[2], v0[3]); w.z = pk2(v1[0], v1[1]); w.w = pk2(v1[2], v1[3]);
                acc = __builtin_amdgcn_mfma_f32_16x16x32_bf16(__builtin_bit_cast(bf16x8, w), bfr[ks], acc, 0, 0, 0); }
            const f32x4 g = *(const f32x4*)(a.ffn_g + l * D + k0 + 4 * fq); acc = acc * g;
            v2u o; o.x = pk2(acc[0], acc[1]); o.y = pk2(acc[2], acc[3]);
            *(v2u*)(a.WpqT + ((size_t)l * NPQ + hp * 128 + nt * 16 + fr) * D + k0 + 4 * fq) = o; } } }
    const size_t gt = (size_t)vcu * (NWAVES * 64) + tid, NGT = (size_t)G * NWAVES * 64;
    { constexpr size_t NB = (size_t)2 * NEXP * D / 2048;
      table_blocks(a.pu, a.pv, a.ffn_g, a.U8, a.V8, 0, NB / 2, (size_t)gw, (size_t)NGW, lane);
      table_blocks(a.pu, a.pv, a.ffn_g, a.U8, a.V8, NB, 2 * NB, (size_t)gw, (size_t)NGW, lane);
      if (G != 256) table_blocks(a.pu, a.pv, a.ffn_g, a.U8, a.V8, NB / 2, NB, (size_t)gw, (size_t)NGW, lane); }
    for (int m0 = 2 * gw; m0 < T; m0 += 2 * NGW) {
        f32x4 v[2][4]; float s2[2];
#pragma unroll
        for (int r = 0; r < 2; ++r)
#pragma unroll
            for (int j = 0; j < 4; ++j) v[r][j] = *((const f32x4*)(a.x + (size_t)(m0 + r) * D) + lane + 64 * j);
#pragma unroll
        for (int r = 0; r < 2; ++r) { float s = 0.f;
#pragma unroll
            for (int j = 0; j < 4; ++j) s += (v[r][j][0] * v[r][j][0] + v[r][j][1] * v[r][j][1]) + (v[r][j][2] * v[r][j][2] + v[r][j][3] * v[r][j][3]);
            s2[r] = wave_sum(s); }
#pragma unroll
        for (int r = 0; r < 2; ++r) { const int m = m0 + r;
            v2u* o8 = (v2u*)(a.XB + (size_t)m * D) + lane;
#pragma unroll
            for (int j = 0; j < 4; ++j) { v2u w; w.x = pk2(v[r][j][0], v[r][j][1]); w.y = pk2(v[r][j][2], v[r][j][3]); o8[64 * j] = w; }
            if (lane < 4) { f32x4 z = {0.f, 0.f, 0.f, 0.f}; ((f32x4*)(a.SS0 + (size_t)(2 * T + m) * 16))[lane] = z; ((f32x4*)(a.SS0 + (size_t)(4 * T + m) * 16))[lane] = z;
                if (lane == 0) z[0] = s2[r]; ((f32x4*)(a.SS0 + (size_t)m * 16))[lane] = z; } }
    }
}

DI void conv_gate_phase(const bf16* G1, const float* cw, bf16* Y, int vcu, int G, int tid) {
    const size_t gt = (size_t)vcu * (NWAVES * 64) + tid, NGT = (size_t)G * NWAVES * 64;
    for (size_t c = gt; c < (size_t)T * (D / 8); c += NGT) {
        const int t = (int)(c / (D / 8)), d0 = (int)(c % (D / 8)) * 8, ts = t % SEQ;
        const v4u gb = *(const v4u*)(G1 + (size_t)t * NIN + d0);
        float acc[8];
#pragma unroll
        for (int i = 0; i < 8; ++i) acc[i] = 0.f;
#pragma unroll
        for (int w = 0; w < 3; ++w) { const int tt = ts + w - 1;
            if (tt >= 0 && tt < SEQ) {
                const v4u gc = *(const v4u*)(G1 + (size_t)(t + w - 1) * NIN + D + d0), hh = *(const v4u*)(G1 + (size_t)(t + w - 1) * NIN + 2 * D + d0);
                const f32x4 w0 = *(const f32x4*)(cw + w * D + d0), w1 = *(const f32x4*)(cw + w * D + d0 + 4);
                acc[0] += w0[0] * (bf_lo(gc.x) * bf_lo(hh.x)); acc[1] += w0[1] * (bf_hi(gc.x) * bf_hi(hh.x));
                acc[2] += w0[2] * (bf_lo(gc.y) * bf_lo(hh.y)); acc[3] += w0[3] * (bf_hi(gc.y) * bf_hi(hh.y));
                acc[4] += w1[0] * (bf_lo(gc.z) * bf_lo(hh.z)); acc[5] += w1[1] * (bf_hi(gc.z) * bf_hi(hh.z));
                acc[6] += w1[2] * (bf_lo(gc.w) * bf_lo(hh.w)); acc[7] += w1[3] * (bf_hi(gc.w) * bf_hi(hh.w)); } }
        v4u o; o.x = pk2(acc[0] * bf_lo(gb.x), acc[1] * bf_hi(gb.x)); o.y = pk2(acc[2] * bf_lo(gb.y), acc[3] * bf_hi(gb.y));
        o.z = pk2(acc[4] * bf_lo(gb.z), acc[5] * bf_hi(gb.z)); o.w = pk2(acc[6] * bf_lo(gb.w), acc[7] * bf_hi(gb.w));
        *(v4u*)(Y + (size_t)t * D + d0) = o;
    }
}

template <int CTRL> DI unsigned dppu(unsigned v) { return (unsigned)__builtin_amdgcn_update_dpp(0, (int)v, CTRL, 0xf, 0xf, false); }
DI unsigned umax(unsigned a, unsigned b) { return a > b ? a : b; }
DI unsigned umin(unsigned a, unsigned b) { return a < b ? a : b; }
DI unsigned rowmax_u(unsigned v) { v = umax(v, dppu<0x128>(v)); v = umax(v, dppu<0x124>(v)); v = umax(v, dppu<0x122>(v)); v = umax(v, dppu<0x121>(v)); return v; }
DI float rowsum_f(float v) { v += __uint_as_float(dppu<0x128>(__float_as_uint(v))); v += __uint_as_float(dppu<0x124>(__float_as_uint(v))); v += __uint_as_float(dppu<0x122>(__float_as_uint(v))); v += __uint_as_float(dppu<0x121>(__float_as_uint(v))); return v; }
DI unsigned f2key(float f) { const unsigned u = __float_as_uint(f); return u ^ ((unsigned)((int)u >> 31) | 0x80000000u); }
DI float key2f(unsigned k) { const unsigned u = (k & 0x80000000u) ? (k ^ 0x80000000u) : ~k; return __uint_as_float(u); }
DI unsigned cand_ij(int c) {
    unsigned i, j;
    if (c < 16) { i = 0; j = c; } else if (c < 24) { i = 1; j = c - 16; } else if (c < 29) { i = 2; j = c - 24; } else if (c < 33) { i = 3; j = c - 29; }
    else if (c < 36) { i = 4; j = c - 33; } else if (c < 38) { i = 5; j = c - 36; } else if (c < 40) { i = 6; j = c - 38; } else if (c < 42) { i = 7; j = c - 40; }
    else { i = 8 + (c - 42); j = 0; }
    return (i & 15u) | (j << 4);
}
#define CE_DESC(a, b) do { const unsigned _hi = umax(a, b), _lo = umin(a, b); a = _hi; b = _lo; } while (0)
DI void topk_group(const LAS float* SC, int srow0, int t0, int h, unsigned short* IDX, float* GATE, const LAS unsigned char* TAB, int lane) {
    const int fr = lane & 15, fq = lane >> 4;
        unsigned res[2][4];
#pragma unroll
        for (int p = 0; p < 2; ++p) {
            f32x4 acc[8];
#pragma unroll
            for (int n = 0; n < 8; ++n)
#pragma unroll
                for (int r = 0; r < 4; ++r) acc[n][r] = SC[(srow0 + 4 * fq + r) * SC_STRIDE + p * 128 + 16 * n + fr];
            unsigned L[4][8];
#pragma unroll
            for (int r = 0; r < 4; ++r)
#pragma unroll
                for (int n = 0; n < 8; ++n) L[r][n] = (f2key(acc[n][r]) & ~127u) | (unsigned)(127 - (16 * n + fr));
#define CE4(i, j) do { _Pragma("unroll") for (int r = 0; r < 4; ++r) CE_DESC(L[r][i], L[r][j]); } while (0)
            CE4(0, 1); CE4(2, 3); CE4(4, 5); CE4(6, 7);
            CE4(0, 2); CE4(1, 3); CE4(4, 6); CE4(5, 7);
            CE4(1, 2); CE4(5, 6); CE4(0, 4); CE4(3, 7);
            CE4(1, 5); CE4(2, 6);
            CE4(1, 4); CE4(3, 6);
            CE4(2, 4); CE4(3, 5);
            CE4(3, 4);
#undef CE4
            unsigned rr[4] = {0u, 0u, 0u, 0u};
#pragma unroll
            for (int k = 0; k < 16; ++k) {
                unsigned gm[4];
#pragma unroll
                for (int r = 0; r < 4; ++r) gm[r] = umax(L[r][0], dppu<0x128>(L[r][0]));
#pragma unroll
                for (int r = 0; r < 4; ++r) gm[r] = umax(gm[r], dppu<0x124>(gm[r]));
#pragma unroll
                for (int r = 0; r < 4; ++r) gm[r] = umax(gm[r], dppu<0x122>(gm[r]));
#pragma unroll
                for (int r = 0; r < 4; ++r) gm[r] = umax(gm[r], dppu<0x121>(gm[r]));
#pragma unroll
                for (int r = 0; r < 4; ++r) { rr[r] = (fr == k) ? gm[r] : rr[r]; const bool pop = (L[r][0] == gm[r]);
#pragma unroll
                    for (int n = 0; n < 7; ++n) L[r][n] = pop ? L[r][n + 1] : L[r][n];
                    L[r][7] = pop ? 0u : L[r][7]; }
            }
#pragma unroll
            for (int r = 0; r < 4; ++r) res[p][r] = rr[r];
        }
        const int gbase = (lane & 48) * 4;
        unsigned ck[4][4];
#pragma unroll
        for (int r = 0; r < 4; ++r)
#pragma unroll
            for (int s = 0; s < 4; ++s) { const int c = fr + 16 * s; const unsigned tb = TAB[c & 63];
                const unsigned k0 = (unsigned)__builtin_amdgcn_ds_bpermute(gbase + (int)(tb & 15u) * 4, (int)res[0][r]);
                const unsigned k1 = (unsigned)__builtin_amdgcn_ds_bpermute(gbase + (int)((tb >> 4) & 15u) * 4, (int)res[1][r]);
                const float v = key2f((k0 & ~127u) | 64u) + key2f((k1 & ~127u) | 64u);
                ck[r][s] = (c < 50) ? ((f2key(v) & ~63u) | (unsigned)(63 - c)) : 0u; }
        unsigned sel[4] = {0u, 0u, 0u, 0u};
#pragma unroll
        for (int k = 0; k < 16; ++k) {
            unsigned gm[4];
#pragma unroll
            for (int r = 0; r < 4; ++r) { const unsigned lm = umax(umax(ck[r][0], ck[r][1]), umax(ck[r][2], ck[r][3])); gm[r] = umax(lm, dppu<0x128>(lm)); }
#pragma unroll
            for (int r = 0; r < 4; ++r) gm[r] = umax(gm[r], dppu<0x124>(gm[r]));
#pragma unroll
            for (int r = 0; r < 4; ++r) gm[r] = umax(gm[r], dppu<0x122>(gm[r]));
#pragma unroll
            for (int r = 0; r < 4; ++r) gm[r] = umax(gm[r], dppu<0x121>(gm[r]));
#pragma unroll
            for (int r = 0; r < 4; ++r) { sel[r] = (fr == k) ? gm[r] : sel[r];
#pragma unroll
                for (int s = 0; s < 4; ++s) ck[r][s] = (ck[r][s] == gm[r]) ? 0u : ck[r][s]; }
        }
#pragma unroll
        for (int r = 0; r < 4; ++r) {
            const int t = t0 + 4 * fq + r;
            const int cs = 63 - (int)(sel[r] & 63u); const unsigned tb = TAB[cs & 63];
            const unsigned k0 = (unsigned)__builtin_amdgcn_ds_bpermute(gbase + (int)(tb & 15u) * 4, (int)res[0][r]);
            const unsigned k1 = (unsigned)__builtin_amdgcn_ds_bpermute(gbase + (int)((tb >> 4) & 15u) * 4, (int)res[1][r]);
            const int e = (127 - (int)(k0 & 127u)) * 128 + (127 - (int)(k1 & 127u));
            const float val = key2f((sel[r] & ~63u) | 32u), top = key2f((rowmax_u(sel[r]) & ~63u) | 32u);
            const float ex = __builtin_amdgcn_exp2f((val - top) * LOG2E), sum = rowsum_f(ex);
            IDX[(size_t)t * 128 + h * 16 + fr] = (unsigned short)e; GATE[(size_t)t * 128 + h * 16 + fr] = ex / sum;
        }
}
struct EpiRoute {
    static constexpr bool PERM = true, AFTER_DRAIN = true;
    const float* ss; unsigned short* IDX; float* GATE;
    DI void fused(pg8::f32x4 (&acc)[2][2][4][2], const pg8::Unit& u, int wr, int wc, int fr, int fq, LAS unsigned char* lds, int wid, int lane) const {
        LAS float* SC = (LAS float*)lds; LAS unsigned char* TAB = lds + SC_TAB_OFF; LAS unsigned* gcnt = (LAS unsigned*)(lds + SC_TAB_OFF + 128);
        const int tid = wid * 64 + lane;
        if (tid < 64) TAB[tid] = (unsigned char)(tid < 50 ? cand_ij(tid) : 0xff);
#pragma unroll
        for (int ai = 0; ai < 2; ++ai) {
            __syncthreads();
#pragma unroll
            for (int m = 0; m < 4; ++m) { const int row = wr * 64 + m * 16 + fr; const float rs = pg8::row_rstd(ss, u.pm * 256 + ai * 128 + row);
#pragma unroll
                for (int bj = 0; bj < 2; ++bj)
#pragma unroll
                    for (int n = 0; n < 2; ++n) *(LAS f32x4*)(SC + row * SC_STRIDE + bj * 128 + wc * 32 + 8 * fq + 4 * n) = acc[ai][bj][m][n] * rs; }
            if (tid == 0) *gcnt = 0u;
            __syncthreads();
            for (;;) {
                unsigned grp = 0u; if (lane == 0) grp = __hip_atomic_fetch_add(gcnt, 1u, __ATOMIC_RELAXED, __HIP_MEMORY_SCOPE_WORKGROUP);
                grp = (unsigned)__builtin_amdgcn_readfirstlane((int)grp);
                if (grp >= 8u) break;
                topk_group(SC, (int)grp * 16, u.pm * 256 + ai * 128 + (int)grp * 16, u.pn, IDX, GATE, TAB, lane);
            }
        }
        __syncthreads();
    }
};
struct OneUnit { pg8::Unit u;
    DI bool next(int i, pg8::Unit& o) const { if (i != 0) return false; o = u; return true; }
    DI void a_ready(const pg8::Unit&) const {}
    DI void done(const pg8::Unit&) const {}
};

DI float dot8(v4u x, v4u u, float acc) {
    acc += bf_lo(x.x) * bf_lo(u.x); acc += bf_hi(x.x) * bf_hi(u.x); acc += bf_lo(x.y) * bf_lo(u.y); acc += bf_hi(x.y) * bf_hi(u.y);
    acc += bf_lo(x.z) * bf_lo(u.z); acc += bf_hi(x.z) * bf_hi(u.z); acc += bf_lo(x.w) * bf_lo(u.w); acc += bf_hi(x.w) * bf_hi(u.w);
    return acc;
}
DI void fma8(float* acc, float a, v4u v) {
    acc[0] += a * bf_lo(v.x); acc[1] += a * bf_hi(v.x); acc[2] += a * bf_lo(v.y); acc[3] += a * bf_hi(v.y);
    acc[4] += a * bf_lo(v.z); acc[5] += a * bf_hi(v.z); acc[6] += a * bf_lo(v.w); acc[7] += a * bf_hi(v.w);
}
DI f32x2 fp8lo(unsigned w) { return __builtin_amdgcn_cvt_pk_f32_fp8((int)w, false); }
DI f32x2 fp8hi(unsigned w) { return __builtin_amdgcn_cvt_pk_f32_fp8((int)w, true); }

template <int CTRL> DI float dppf(float v) { return __uint_as_float(dppu<CTRL>(__float_as_uint(v))); }
constexpr int XG = 8, XNG = T / XG;
DI unsigned wave_ticket(unsigned* head, int lane) {
    unsigned v = 0u; if (lane == 0) v = __hip_atomic_fetch_add(head, 1u, __ATOMIC_RELAXED, __HIP_MEMORY_SCOPE_AGENT);
    return (unsigned)__builtin_amdgcn_readfirstlane((int)v);
}
struct USmall { int i0, i1; v4u xa, xb; };
DI void u_small(USmall& S, const unsigned short* IDX, const bf16* XB, int t, int s, int lane) {
    S.i0 = IDX[(size_t)t * 128 + lane]; S.i1 = IDX[(size_t)t * 128 + 64 + lane];
    const v4u* xr = (const v4u*)(XB + (size_t)t * D + 128 * s + 16 * (lane & 7)); S.xa = xr[0]; S.xb = xr[1];
}
DI void u_token(USmall& SC, const v4u (&GC)[16], const USmall& SN, v4u (&GN)[16], const unsigned char* U8s, const unsigned short* IDX, const bf16* XB, float* HPs, int t, int t2, int s, int lane) {
    const int g = lane >> 3, k = lane & 7;
    const v4u xa = SC.xa, xb = SC.xb;
    float xv[16];
    xv[0] = bf_lo(xa.x); xv[1] = bf_hi(xa.x); xv[2] = bf_lo(xa.y); xv[3] = bf_hi(xa.y); xv[4] = bf_lo(xa.z); xv[5] = bf_hi(xa.z); xv[6] = bf_lo(xa.w); xv[7] = bf_hi(xa.w);
    xv[8] = bf_lo(xb.x); xv[9] = bf_hi(xb.x); xv[10] = bf_lo(xb.y); xv[11] = bf_hi(xb.y); xv[12] = bf_lo(xb.z); xv[13] = bf_hi(xb.z); xv[14] = bf_lo(xb.w); xv[15] = bf_hi(xb.w);
    float am = 0.f;
#pragma unroll
    for (int i = 0; i < 16; ++i) am = fmaxf(am, __builtin_fabsf(xv[i]));
    am = fmaxf(am, dppf<0xB1>(am)); am = fmaxf(am, dppf<0x4E>(am)); am = fmaxf(am, dppf<0x141>(am));
    am = fmaxf(am, 1e-20f);
    const float qs = 127.0f / am, dq = am * (1.0f / (127.0f * 512.0f));
    unsigned xq[4];
#pragma unroll
    for (int q = 0; q < 4; ++q) { unsigned w = 0u;
#pragma unroll
        for (int e = 0; e < 4; ++e) { const int qi = (int)__builtin_rintf(xv[4 * q + e] * qs); w |= ((unsigned)qi & 0xffu) << (8 * e); }
        xq[q] = w; }
    u_small(SC, IDX, XB, t2, s, lane);
    int p[16];
#pragma unroll
    for (int i = 0; i < 16; ++i) {
        const unsigned idx = (unsigned)__builtin_amdgcn_ds_bpermute((8 * g + (i & 7)) * 4, i < 8 ? SN.i0 : SN.i1);
        GN[i] = *(const v4u*)(U8s + (idx * 1024u + 16u * (unsigned)k));
        int a0 = __builtin_amdgcn_sdot4((int)xq[0], (int)GC[i][0], 0, false), a1 = __builtin_amdgcn_sdot4((int)xq[1], (int)GC[i][1], 0, false);
        a0 = __builtin_amdgcn_sdot4((int)xq[2], (int)GC[i][2], a0, false); a1 = __builtin_amdgcn_sdot4((int)xq[3], (int)GC[i][3], a1, false);
        p[i] = a0 + a1;
        __builtin_amdgcn_sched_barrier(0); }
    const bool h4 = k >= 4, h2 = k & 2, h1 = k & 1;
    int q8[8], q4[4], q2[2];
#pragma unroll
    for (int j = 0; j < 8; ++j) { const int keep = h4 ? p[8 + j] : p[j], send = h4 ? p[j] : p[8 + j]; q8[j] = keep + (int)dppu<0x141>((unsigned)send); }
#pragma unroll
    for (int j = 0; j < 4; ++j) { const int keep = h2 ? q8[4 + j] : q8[j], send = h2 ? q8[j] : q8[4 + j]; q4[j] = keep + (int)dppu<0x4E>((unsigned)send); }
#pragma unroll
    for (int j = 0; j < 2; ++j) { const int keep = h1 ? q4[2 + j] : q4[j], send = h1 ? q4[j] : q4[2 + j]; q2[j] = keep + (int)dppu<0xB1>((unsigned)send); }
    *(f32x2*)(HPs + (size_t)t * 128 + (h4 ? 64 : 0) + 8 * g + 2 * (k & 3)) = (f32x2){(float)q2[0] * dq, (float)q2[1] * dq};
}
DI float wave_sum_dpp63(float v) {
    v += dppf<0xB1>(v); v += dppf<0x4E>(v); v += dppf<0x141>(v); v += dppf<0x140>(v);
    v += __uint_as_float((unsigned)__builtin_amdgcn_update_dpp(0, (int)__float_as_uint(v), 0x142, 0xa, 0xf, false));
    v += __uint_as_float((unsigned)__builtin_amdgcn_update_dpp(0, (int)__float_as_uint(v), 0x143, 0xc, 0xf, false));
    return v;
}
struct VSmall { int i0, i1; float a0, a1; f32x2 xo; };
DI void v_small(VSmall& S, const unsigned short* IDX, const float* A, const float* xf, int t, int s, int lane) {
    S.i0 = IDX[(size_t)t * 128 + lane]; S.i1 = IDX[(size_t)t * 128 + 64 + lane]; S.a0 = A[(size_t)t * 128 + lane]; S.a1 = A[(size_t)t * 128 + 64 + lane];
    S.xo = *(const f32x2*)(xf + (size_t)t * D + 128 * s + 2 * lane);
}
template <bool FINAL>
DI void v_token(VSmall& SC, const v4u (&GC)[16], const VSmall& SN, v4u (&GN)[16], const unsigned char* V8s, const unsigned short* IDX, const float* A, float* xf, bf16* XB, float* ss_out,
                int t, int t2, int s, int lane) {
    const int g = lane >> 3, k = lane & 7;
    const bool b3 = lane & 8, b4 = lane & 16, b5 = lane & 32;
    float av[16];
#pragma unroll
    for (int i = 0; i < 16; ++i) av[i] = __uint_as_float((unsigned)__builtin_amdgcn_ds_bpermute((8 * g + (i & 7)) * 4, (int)__float_as_uint(i < 8 ? SC.a0 : SC.a1)));
    f32x2 o = SC.xo;
    v_small(SC, IDX, A, xf, t2, s, lane);
    f32x2 acc[8];
#pragma unroll
    for (int i = 0; i < 8; ++i) acc[i] = (f32x2){0.f, 0.f};
#pragma unroll
    for (int i = 0; i < 16; ++i) {
        const unsigned idx = (unsigned)__builtin_amdgcn_ds_bpermute((8 * g + (i & 7)) * 4, i < 8 ? SN.i0 : SN.i1);
        GN[i] = *(const v4u*)(V8s + (idx * 1024u + 16u * (unsigned)k));
        const f32x2 a2 = {av[i], av[i]};
#pragma unroll
        for (int q = 0; q < 4; ++q) { acc[2 * q] = __builtin_elementwise_fma(a2, fp8lo(GC[i][q]), acc[2 * q]); acc[2 * q + 1] = __builtin_elementwise_fma(a2, fp8hi(GC[i][q]), acc[2 * q + 1]); }
        __builtin_amdgcn_sched_barrier(0); }
    float v[16];
#pragma unroll
    for (int i = 0; i < 8; ++i) { v[2 * i] = acc[i].x; v[2 * i + 1] = acc[i].y; }
    float v8[8], v4[4], v2[2];
#pragma unroll
    for (int j = 0; j < 8; ++j) { const float keep = b3 ? v[8 + j] : v[j], send = b3 ? v[j] : v[8 + j]; v8[j] = keep + dppf<0x128>(send); }
#pragma unroll
    for (int j = 0; j < 4; ++j) { const float keep = b4 ? v8[4 + j] : v8[j], send = b4 ? v8[j] : v8[4 + j]; v4[j] = keep + __shfl_xor(send, 16); }
#pragma unroll
    for (int j = 0; j < 2; ++j) { const float keep = b5 ? v4[2 + j] : v4[j], send = b5 ? v4[j] : v4[2 + j]; v2[j] = keep + __shfl_xor(send, 32); }
    const int tl = (8 * k + (b3 ? 4 : 0) + (b4 ? 2 : 0) + (b5 ? 1 : 0)) * 4;
    const float s0 = __uint_as_float((unsigned)__builtin_amdgcn_ds_permute(tl, (int)__float_as_uint(v2[0]))), s1 = __uint_as_float((unsigned)__builtin_amdgcn_ds_permute(tl, (int)__float_as_uint(v2[1])));
    const int col = 128 * s + 2 * lane;
    float* xo = xf + (size_t)t * D + col;
    o.x += s0; o.y += s1;
    *(f32x2*)xo = o;
    if (!FINAL) *(unsigned*)(XB + (size_t)t * D + col) = pk2(o.x, o.y);
    const float sq = wave_sum_dpp63(o.x * o.x + o.y * o.y);
    if (lane == 63) ss_out[(size_t)t * 16 + s] = sq;
}
template <int PASS, bool FINAL>
DI void sliced_pass(const unsigned char* TAB, const unsigned short* IDX, const bf16* XBc, bf16* XBw, float* HP, const float* A, float* xf, float* ss_out,
                    unsigned* heads, unsigned* census, volatile LAS unsigned* slot, int wave, int lane, int tid) {
    const int own = (int)(xb_xcc_id() & 7u);
    __syncthreads();
    if (tid == 0) { unsigned all = 1u;
#pragma unroll 1
        for (int q = 0; q < 8; ++q) { const unsigned n = xb_ld(census + XB_XCNT(q)) + xb_ld(census + XB_XCNT(q + 8)); all &= (n > 0u) ? 1u : 0u; }
        slot[1] = all; }
    __syncthreads();
    const int nds = slot[1] ? 1 : 8;
#pragma unroll 1
    for (int ds = 0; ds < nds; ++ds) { const int s = (own + ds) & 7;
        unsigned* head = heads + 64 * s; const unsigned char* Ts = TAB + 128 * s; float* HPs = HP + (size_t)s * T * 128;
        unsigned tk = wave_ticket(head, lane);
        if (tk >= (unsigned)XNG) continue;
        unsigned nxt = wave_ticket(head, lane);
#define TOK_AT(dj) ((j + (dj) < XG) ? (int)tk * XG + j + (dj) : (nxt < (unsigned)XNG ? (int)nxt * XG + j + (dj) - XG : (int)tk * XG + XG - 1))
        int j = 0;
        if (PASS == 0) {
            USmall S0, S1; v4u G0[16], G1[16];
            u_small(S0, IDX, XBc, (int)tk * XG, s, lane); u_small(S1, IDX, XBc, (int)tk * XG + 1, s, lane);
            { const int g = lane >> 3, k = lane & 7;
#pragma unroll
              for (int i = 0; i < 16; ++i) { const unsigned idx = (unsigned)__builtin_amdgcn_ds_bpermute((8 * g + (i & 7)) * 4, i < 8 ? S0.i0 : S0.i1); G0[i] = *(const v4u*)(Ts + (idx * 1024u + 16u * (unsigned)k)); } }
            for (;;) {
#pragma unroll 1
                for (j = 0; j < XG; j += 2) {
                    u_token(S0, G0, S1, G1, Ts, IDX, XBc, HPs, (int)tk * XG + j, TOK_AT(2), s, lane);
                    { const int jj = j; j = jj + 1; const int t3 = TOK_AT(2); j = jj; u_token(S1, G1, S0, G0, Ts, IDX, XBc, HPs, (int)tk * XG + j + 1, t3, s, lane); } }
                if (nxt >= (unsigned)XNG) break; tk = nxt; nxt = wave_ticket(head, lane); }
        } else {
            VSmall S0, S1; v4u G0[16], G1[16];
            v_small(S0, IDX, A, xf, (int)tk * XG, s, lane); v_small(S1, IDX, A, xf, (int)tk * XG + 1, s, lane);
            { const int g = lane >> 3, k = lane & 7;
#pragma unroll
              for (int i = 0; i < 16; ++i) { const unsigned idx = (unsigned)__builtin_amdgcn_ds_bpermute((8 * g + (i & 7)) * 4, i < 8 ? S0.i0 : S0.i1); G0[i] = *(const v4u*)(Ts + (idx * 1024u + 16u * (unsigned)k)); } }
            for (;;) {
#pragma unroll 1
                for (j = 0; j < XG; j += 2) {
                    v_token<FINAL>(S0, G0, S1, G1, Ts, IDX, A, xf, XBw, ss_out, (int)tk * XG + j, TOK_AT(2), s, lane);
                    { const int jj = j; j = jj + 1; const int t3 = TOK_AT(2); j = jj; v_token<FINAL>(S1, G1, S0, G0, Ts, IDX, A, xf, XBw, ss_out, (int)tk * XG + j + 1, t3, s, lane); } }
                if (nxt >= (unsigned)XNG) break; tk = nxt; nxt = wave_ticket(head, lane); }
        }
#undef TOK_AT
    }
}
DI void reduce_phase(const float* HP, const float* GATE, const float* ss_in, float* A, int vcu, int G, int tid) {
    const size_t gt = (size_t)vcu * (NWAVES * 64) + tid, NGT = (size_t)G * NWAVES * 64;
    for (size_t c = gt; c < (size_t)T * 128; c += NGT) { float h = 0.f;
#pragma unroll
        for (int s = 0; s < 8; ++s) h += HP[(size_t)s * T * 128 + c];
        h *= pg8::row_rstd(ss_in, (int)(c >> 7));
        A[c] = (1.0f / 1024.0f) * GATE[c] * (0.5f * h * (1.f + erff(h * 0.70710678118654752f))); }
}
DI void final_phase(const float* ss, float* xf, const float* fin_g, int vcu, int G, int wave, int lane) {
    for (int m0 = 2 * (vcu * NWAVES + wave); m0 < T; m0 += 2 * G * NWAVES) {
        f32x4 v[2][4]; float rf[2];
#pragma unroll
        for (int r = 0; r < 2; ++r) { rf[r] = pg8::row_rstd(ss, m0 + r);
#pragma unroll
            for (int j = 0; j < 4; ++j) v[r][j] = *((const f32x4*)(xf + (size_t)(m0 + r) * D) + lane + 64 * j); }
#pragma unroll
        for (int r = 0; r < 2; ++r)
#pragma unroll
            for (int j = 0; j < 4; ++j) *((f32x4*)(xf + (size_t)(m0 + r) * D) + lane + 64 * j) = v[r][j] * rf[r] * *((const f32x4*)fin_g + lane + 64 * j); }
}

DI int t5_bucket(int rel) {
    const int n = rel < 0 ? -rel : rel; int b;
    if (n < 8) b = n; else if (n < 12) b = 8; else if (n < 16) b = 9; else if (n < 23) b = 10; else if (n < 32) b = 11; else if (n < 46) b = 12; else if (n < 64) b = 13; else if (n < 91) b = 14; else b = 15;
    return b + (rel > 0 ? 16 : 0);
}
DI int crow(int reg, int h) { return (reg & 3) + 8 * (reg >> 2) + 4 * h; }
constexpr int AT_KL = 0, AT_KSTR = 144, AT_VT = 384 * AT_KSTR  , AT_VSTR = 776, AT_BT = AT_VT + 64 * AT_VSTR  , AT_END = AT_BT + 4 * 512 * 4;
static_assert(AT_END <= RING_BYTES, "attention LDS");
DI void attn_phase(const bf16* Qg, const bf16* Kg, const bf16* Vg, bf16* AO, const float* rel_bias, const float* sink, LAS unsigned char* lds, int vcu, int G, int wave, int lane, int tid) {
    const int r = lane & 31, h = lane >> 5;
    for (int unit = vcu; unit < BATCH * 4 * (SEQ / 128); unit += G) {
        const int b = unit / 256, kvh = (unit % 256) / 64, blk = unit % 64;
        __syncthreads();
        for (int c = tid; c < 384 * 8; c += NWAVES * 64) { const int row = c >> 3, c8 = c & 7, ts = blk * 128 - 128 + row;
            v4u kv = {0u, 0u, 0u, 0u}, vv = {0u, 0u, 0u, 0u};
            if (ts >= 0 && ts < SEQ) { const size_t g = (size_t)(b * SEQ + ts) * 256 + kvh * 64 + c8 * 8; kv = *(const v4u*)(Kg + g); vv = *(const v4u*)(Vg + g); }
            *(LAS v4u*)(lds + AT_KL + row * AT_KSTR + c8 * 16) = kv;
            LAS unsigned short* vt = (LAS unsigned short*)(lds + AT_VT) + (c8 * 8) * (AT_VSTR / 2) + row;
            vt[0 * (AT_VSTR / 2)] = (unsigned short)(vv.x & 0xffffu); vt[1 * (AT_VSTR / 2)] = (unsigned short)(vv.x >> 16);
            vt[2 * (AT_VSTR / 2)] = (unsigned short)(vv.y & 0xffffu); vt[3 * (AT_VSTR / 2)] = (unsigned short)(vv.y >> 16);
            vt[4 * (AT_VSTR / 2)] = (unsigned short)(vv.z & 0xffffu); vt[5 * (AT_VSTR / 2)] = (unsigned short)(vv.z >> 16);
            vt[6 * (AT_VSTR / 2)] = (unsigned short)(vv.w & 0xffffu); vt[7 * (AT_VSTR / 2)] = (unsigned short)(vv.w >> 16); }
        for (int c = tid; c < 4 * 512; c += NWAVES * 64) { const int g = c >> 9, i = c & 511, rel = i - 255;
            float v = NEGBIG; if (rel >= -128 && rel <= 128) v = rel_bias[t5_bucket(rel) * 16 + kvh * 4 + g] * LOG2E;
            *(LAS float*)(lds + AT_BT + c * 4) = v; }
        __syncthreads();
        const int g = wave >> 1, qh = wave & 1, head = kvh * 4 + g;
        const float sinkl = sink[head] * LOG2E;
        bf16x8 qf[2][4];
#pragma unroll
        for (int qt = 0; qt < 2; ++qt)
#pragma unroll
            for (int s = 0; s < 4; ++s) qf[qt][s] = *(const bf16x8*)(Qg + (size_t)(b * SEQ + blk * 128 + qh * 64 + qt * 32 + r) * D + head * 64 + s * 16 + h * 8);
        float m[2] = {sinkl, sinkl}, l[2] = {0.f, 0.f};
        f32x16 o[2][2];
#pragma unroll
        for (int qt = 0; qt < 2; ++qt)
#pragma unroll
            for (int dt = 0; dt < 2; ++dt)
#pragma unroll
                for (int i = 0; i < 16; ++i) o[qt][dt][i] = 0.f;
        int kt_lo = 2 * qh, kt_hi = 2 * qh + 9;
        if (blk == 0 && kt_lo < 4) kt_lo = 4;
        if (blk == SEQ / 128 - 1 && kt_hi > 7) kt_hi = 7;
#pragma unroll 1
        for (int kt = kt_lo; kt <= kt_hi; ++kt) {
            bf16x8 kf[4];
#pragma unroll
            for (int s = 0; s < 4; ++s) kf[s] = *(const LAS bf16x8*)(lds + AT_KL + (32 * kt + r) * AT_KSTR + s * 32 + h * 16);
            bf16x8 vf[2][2];
#pragma unroll
            for (int dt = 0; dt < 2; ++dt)
#pragma unroll
                for (int s2 = 0; s2 < 2; ++s2) { const LAS unsigned char* vp = lds + AT_VT + (32 * dt + r) * AT_VSTR + (32 * kt + 16 * s2 + 4 * h) * 2;
                    const v2u lo = *(const LAS v2u*)vp, hi2 = *(const LAS v2u*)(vp + 16); v4u w = {lo.x, lo.y, hi2.x, hi2.y}; vf[dt][s2] = __builtin_bit_cast(bf16x8, w); }
#pragma unroll
            for (int qt = 0; qt < 2; ++qt) {
                f32x16 s;
                const LAS float* bt = (const LAS float*)(lds + AT_BT) + g * 512 + 127 + 32 * kt + 4 * h - (64 * qh + 32 * qt + r);
#pragma unroll
                for (int i = 0; i < 16; ++i) s[i] = bt[(i & 3) + 8 * (i >> 2)];
#pragma unroll
                for (int k4 = 0; k4 < 4; ++k4) s = __builtin_amdgcn_mfma_f32_32x32x16_bf16(kf[k4], qf[qt][k4], s, 0, 0, 0);
                float mx = s[0];
#pragma unroll
                for (int i = 1; i < 16; ++i) mx = fmaxf(mx, s[i]);
                mx = fmaxf(mx, __shfl_xor(mx, 32));
                const float mn = fmaxf(m[qt], mx), al = __builtin_amdgcn_exp2f(m[qt] - mn); m[qt] = mn;
                float ps = 0.f;
#pragma unroll
                for (int i = 0; i < 16; ++i) { s[i] = __builtin_amdgcn_exp2f(s[i] - mn); ps += s[i]; }
                l[qt] = l[qt] * al + ps;
#pragma unroll
                for (int dt = 0; dt < 2; ++dt)
#pragma unroll
                    for (int i = 0; i < 16; ++i) o[qt][dt][i] *= al;
                bf16x8 pf[2];
#pragma unroll
                for (int s2 = 0; s2 < 2; ++s2) { v4u w; w.x = pk2(s[8 * s2 + 0], s[8 * s2 + 1]); w.y = pk2(s[8 * s2 + 2], s[8 * s2 + 3]); w.z = pk2(s[8 * s2 + 4], s[8 * s2 + 5]); w.w = pk2(s[8 * s2 + 6], s[8 * s2 + 7]); pf[s2] = __builtin_bit_cast(bf16x8, w); }
#pragma unroll
                for (int dt = 0; dt < 2; ++dt)
#pragma unroll
                    for (int s2 = 0; s2 < 2; ++s2) o[qt][dt] = __builtin_amdgcn_mfma_f32_32x32x16_bf16(vf[dt][s2], pf[s2], o[qt][dt], 0, 0, 0);
            }
        }
#pragma unroll
        for (int qt = 0; qt < 2; ++qt) {
            const float lt = l[qt] + __shfl_xor(l[qt], 32) + __builtin_amdgcn_exp2f(sinkl - m[qt]), inv = 1.0f / lt;
            bf16* op = AO + (size_t)(b * SEQ + blk * 128 + qh * 64 + qt * 32 + r) * D + head * 64 + 4 * h;
#pragma unroll
            for (int dt = 0; dt < 2; ++dt)
#pragma unroll
                for (int gq = 0; gq < 4; ++gq) { v2u w; w.x = pk2(o[qt][dt][4 * gq] * inv, o[qt][dt][4 * gq + 1] * inv); w.y = pk2(o[qt][dt][4 * gq + 2] * inv, o[qt][dt][4 * gq + 3] * inv);
                    *(v2u*)(op + 32 * dt + 8 * gq) = w; }
        }
    }
}

struct Args { const float* in[16]; float* out; unsigned char* ws; int ph_lo, ph_hi; };
__global__ void __launch_bounds__(NWAVES * 64, 2) fwd_kernel(Args args) {
    extern __shared__ __attribute__((aligned(16))) unsigned char lds_raw[];
    LAS unsigned char* lds = (LAS unsigned char*)lds_raw;
    volatile LAS unsigned* MISC = (volatile LAS unsigned*)(lds + MISC_OFF);
    const int tid = threadIdx.x, lane = tid & 63, wave = __builtin_amdgcn_readfirstlane(tid >> 6);
    const int G = gridDim.x; const int bx = blockIdx.x; const int vcu = (G % 8 == 0) ? (bx % 8) * (G / 8) + bx / 8 : bx;
    unsigned char* ws = args.ws;
    unsigned* ctl = (unsigned*)(ws + WS_CTL);
    const float* x = args.in[0]; const float* conv_g = args.in[1]; const float* w_in = args.in[2]; const float* conv_w = args.in[3]; const float* w_out = args.in[4];
    const float* attn_g = args.in[5]; const float* w_qkv = args.in[6]; const float* sink = args.in[7]; const float* w_o = args.in[8]; const float* rel_bias = args.in[9];
    const float* ffn_g = args.in[10]; const float* w_pq = args.in[11]; const float* subk = args.in[12]; const float* pu = args.in[13]; const float* pv = args.in[14]; const float* fin_g = args.in[15];
    float* out = args.out;
    bf16* WinT = (bf16*)(ws + WS_WIN); bf16* WoutT = (bf16*)(ws + WS_WOUT); bf16* WqkvT = (bf16*)(ws + WS_WQKV); bf16* WoT = (bf16*)(ws + WS_WO); bf16* WpqT = (bf16*)(ws + WS_WPQ); bf16* SKb = (bf16*)(ws + WS_SK);
    float* SS = (float*)(ws + WS_SS); unsigned short* IDX = (unsigned short*)(ws + WS_IDX); float* HP = (float*)(ws + WS_HP); float* AA = (float*)(ws + WS_A); float* GATE = (float*)(ws + WS_GATE);
    bf16* XB = (bf16*)(ws + WS_XB); bf16* Y = (bf16*)(ws + WS_Y); unsigned char* U8 = ws + WS_U; unsigned char* V8 = ws + WS_V;
    bf16* G1 = (bf16*)(ws + WS_G1); bf16* PQ = (bf16*)(ws + WS_PQ); bf16* Qb = (bf16*)(ws + WS_Q); bf16* Kb = (bf16*)(ws + WS_K); bf16* VVb = (bf16*)(ws + WS_VV); bf16* AO = (bf16*)(ws + WS_AO);
    float* SS0 = SS; float* SS1 = SS + (size_t)T * 16; float* SS2 = SS + (size_t)2 * T * 16; float* SS3 = SS + (size_t)3 * T * 16; float* SS4 = SS + (size_t)4 * T * 16;

    for (int u = tid; u < (LDS_BYTES - LDSCTL_OFF) / 4; u += NWAVES * 64) ((LAS unsigned*)(lds + LDSCTL_OFF))[u] = 0u;
    __syncthreads();
    XcdBarrier bar; bar.bar = ctl + CW_BAR; bar.x = 0; bar.st = nullptr;
    if (!MK_PER_PHASE) bar = xcd_barrier_post(ctl + CW_BAR, MISC + 8);
    const int lo = args.ph_lo, hi = args.ph_hi;
#define IN(k) (lo <= (k) && (k) < hi)
#define SEAM(k) do { if (IN(k) && IN((k) + 1)) xcd_barrier(bar); } while (0)

    if (IN(0)) REPS(0) {
        P0Args a{x, conv_g, w_in, w_out, attn_g, w_qkv, w_o, ffn_g, w_pq, subk, pu, pv, WinT, WoutT, WqkvT, WoT, WpqT, SKb, U8, V8, XB, SS0};
        p0_prologue(a, lds, vcu, G, wave, lane, tid);
    }
    SEAM(0);
    if (IN(1)) REPS(1) {
        pg8::Gemm g{XB, WinT, T, NIN, D}; pg8::StaticOrder S; S.init(T, NIN, G, bx);
        pg8::EpiBf16RS E{G1, NIN, NIN / 256, nullptr, nullptr, 0, SS0};
        pg8::gemm_phase<pg8::EpiBf16RS, pg8::StaticOrder, true, true>(lds, g, S, E);
    }
    SEAM(1);
    if (IN(2)) REPS(2) conv_gate_phase(G1, conv_w, Y, vcu, G, tid);
    SEAM(2);
    if (IN(3)) REPS(3) {
        pg8::Gemm g{Y, WoutT, T, D, D}; pg8::StaticOrder S; S.init(T, D, G, bx);
        pg8::EpiResid E{x, out, XB, SS1};
        pg8::gemm_phase<pg8::EpiResid, pg8::StaticOrder, true, true>(lds, g, S, E);
    }
    SEAM(3);
    if (IN(4)) {
        pg8::Gemm g{XB, WpqT, T, NPQ, D}; pg8::StaticOrder S; S.init(T, NPQ, G, bx); EpiRoute E{SS1, IDX, GATE}; pg8::Unit uu;
        for (int i = 0; S.next(i, uu); ++i) { OneUnit O{uu}; pg8::gemm_phase<EpiRoute, OneUnit, false, true>(lds, g, O, E); }
    }
    SEAM(4);
    if (IN(6)) sliced_pass<0, false>(U8, IDX, XB, XB, HP, AA, out, SS2, ctl + CW_WQ + 64 * 0, ctl + CW_BAR, MISC + 12, wave, lane, tid);
    SEAM(6);
    if (IN(7)) reduce_phase(HP, GATE, SS1, AA, vcu, G, tid);
    SEAM(7);
    if (IN(8)) sliced_pass<1, false>(V8, IDX, XB, XB, HP, AA, out, SS2, ctl + CW_WQ + 64 * 8, ctl + CW_BAR, MISC + 12, wave, lane, tid);
    SEAM(8);
    if (IN(9)) REPS(9) {
        pg8::Gemm g{XB, WqkvT, T, NQKV, D}; pg8::StaticOrder S; S.init(T, NQKV, G, bx);
        pg8::EpiBf16RS E{Qb, D, 4, Kb, VVb, 256, SS2};
        pg8::gemm_phase<pg8::EpiBf16RS, pg8::StaticOrder, true, true>(lds, g, S, E);
        if (G == 256 && bx >= 128) { constexpr size_t NB = (size_t)2 * NEXP * D / 2048; table_blocks(pu, pv, ffn_g, U8, V8, NB / 2, NB, (size_t)((bx - 128) * NWAVES + wave), (size_t)128 * NWAVES, lane); }
    }
    SEAM(9);
    if (IN(10)) REPS(10) attn_phase(Qb, Kb, VVb, AO, rel_bias, sink, lds, vcu, G, wave, lane, tid);
    SEAM(10);
    if (IN(11)) {
        pg8::Gemm g{AO, WoT, T, D, D}; pg8::StaticOrder S; S.init(T, D, G, bx);
        pg8::EpiResid E{out, out, XB, SS3};
        pg8::gemm_phase<pg8::EpiResid, pg8::StaticOrder, true, true>(lds, g, S, E);
    }
    SEAM(11);
    if (IN(12)) {
        pg8::Gemm g{XB, WpqT + (size_t)NPQ * D, T, NPQ, D}; pg8::StaticOrder S; S.init(T, NPQ, G, bx); EpiRoute E{SS3, IDX, GATE}; pg8::Unit uu;
        for (int i = 0; S.next(i, uu); ++i) { OneUnit O{uu}; pg8::gemm_phase<EpiRoute, OneUnit, false, true>(lds, g, O, E); }
    }
    SEAM(12);
    if (IN(14)) sliced_pass<0, true>(U8 + (size_t)NEXP * D, IDX, XB, XB, HP, AA, out, SS4, ctl + CW_WQ + 64 * 16, ctl + CW_BAR, MISC + 12, wave, lane, tid);
    SEAM(14);
    if (IN(15)) reduce_phase(HP, GATE, SS3, AA, vcu, G, tid);
    SEAM(15);
    if (IN(16)) sliced_pass<1, true>(V8 + (size_t)NEXP * D, IDX, XB, XB, HP, AA, out, SS4, ctl + CW_WQ + 64 * 24, ctl + CW_BAR, MISC + 12, wave, lane, tid);
    SEAM(16);
    if (IN(17)) final_phase(SS4, out, fin_g, vcu, G, wave, lane);
#undef IN
#undef SEAM
}

extern "C" void kernel_launch(void* const* d_in, const int* in_sizes, int n_in, void* d_out, int out_size, void* d_ws, size_t ws_size, hipStream_t stream) {
    static int grid = 0;
    if (grid == 0) {
        if (n_in != 16 || in_sizes[0] != T * D || out_size != T * D || ws_size < WS_END) { fprintf(stderr, "kernel_launch: unexpected shapes (n_in %d, in0 %d, out %d, ws %zu)\n", n_in, n_in > 0 ? in_sizes[0] : -1, out_size, ws_size); grid = -1; return; }
        int dev = 0, cus = 0, per_cu = 0;
        if (hipGetDevice(&dev) != hipSuccess || hipDeviceGetAttribute(&cus, hipDeviceAttributeMultiprocessorCount, dev) != hipSuccess) { grid = -1; return; }
        if (hipFuncSetAttribute((const void*)fwd_kernel, hipFuncAttributeMaxDynamicSharedMemorySize, LDS_BYTES) != hipSuccess) { fprintf(stderr, "kernel_launch: hipFuncSetAttribute failed\n"); grid = -1; return; }
        if (hipOccupancyMaxActiveBlocksPerMultiprocessor(&per_cu, (const void*)fwd_kernel, NWAVES * 64, LDS_BYTES) != hipSuccess || per_cu < 1) { fprintf(stderr, "kernel_launch: occupancy query says %d blocks per CU\n", per_cu); (void)hipGetLastError(); grid = -1; return; }
        grid = cus;
    }
    if (grid < 0) return;
    (void)hipMemsetAsync((char*)d_ws + WS_CTL, 0, CTL_ZERO_BYTES, stream);
    Args a{};
    for (int i = 0; i < 16; ++i) a.in[i] = (const float*)d_in[i];
    a.out = (float*)d_out; a.ws = (unsigned char*)d_ws;
#if MK_PER_PHASE
    for (int p = 0; p < NPH; ++p) { a.ph_lo = p; a.ph_hi = p + 1; hipLaunchKernelGGL(fwd_kernel, dim3(grid), dim3(NWAVES * 64), LDS_BYTES, stream, a); }
#else
    a.ph_lo = 0; a.ph_hi = NPH;
    hipLaunchKernelGGL(fwd_kernel, dim3(grid), dim3(NWAVES * 64), LDS_BYTES, stream, a);
#endif
}
```

```cpp
#include <hip/hip_runtime.h>
#include <cstdio>
#include <cstdint>
namespace pg8 {
#define PG8_LAS __attribute__((address_space(3)))
typedef unsigned short bf16_t;
typedef short bf16x8 __attribute__((ext_vector_type(8)));
typedef float f32x4 __attribute__((ext_vector_type(4)));
typedef unsigned u32x4 __attribute__((ext_vector_type(4)));
constexpr int BM = 256, BK = 64, HALF = 128, HTB = HALF * BK * 2  , STAGE_BYTES = 8 * HTB, NXCD = 8, WGM = 8;

__host__ __device__ __forceinline__ int lds_byte(int r, int c) { const int st = (r >> 4) * 2 + (c >> 5), rr = r & 15, cc = c & 31, ob = rr * 64 + cc * 2; return st * 1024 + (ob ^ (((ob >> 9) & 1) << 5)); }
__host__ __device__ __forceinline__ void stage_rc(int b, int& R, int& C) { const int st = b / 1024, sb = b % 1024, swz = sb ^ (((sb >> 9) & 1) << 5); R = (st >> 1) * 16 + swz / 64; C = (st & 1) * 32 + (swz % 64) / 2; }
__host__ __device__ __forceinline__ int perm32(int rho) { const int n = rho >> 4, i = rho & 15; return 8 * (i >> 2) + 4 * n + (i & 3); }

struct Unit { int pm, pn; };
struct Gemm { const bf16_t* A; const bf16_t* Bt; int M, N, K; };

struct StaticOrder {
    int nM, nN, nwg, G, c;
    __host__ __device__ void init(int M, int N, int G_, int c_) { nM = M / BM; nN = N / BM; nwg = nM * nN; G = G_; c = c_; }
    __host__ __device__ bool next(int i, Unit& u) const {
        const long L = (long)i * G + c; if (L >= nwg) return false;
        int wgid = (int)L; { const int q = nwg / NXCD, r = nwg % NXCD, xcd = wgid % NXCD, off = wgid / NXCD; wgid = (xcd < r ? xcd * (q + 1) : r * (q + 1) + (xcd - r) * q) + off; }
        const int nig = WGM * nN, gid = wgid / nig, fm = gid * WGM, gsz = (nM - fm) < WGM ? (nM - fm) : WGM;
        u.pm = fm + ((wgid % nig) % gsz); u.pn = (wgid % nig) / gsz; return true;
    }
    __device__ __forceinline__ void a_ready(const Unit&) const {}
    __device__ __forceinline__ void done(const Unit&) const {}
};

__device__ __forceinline__ unsigned cvt_pk_bf16(float lo, float hi) { unsigned r; asm volatile("v_cvt_pk_bf16_f32 %0, %1, %2" : "=v"(r) : "v"(lo), "v"(hi)); return r; }
typedef unsigned u32x2 __attribute__((ext_vector_type(2)));
__device__ __forceinline__ float row_rstd(const float* ss, int row) {
    const f32x4* p = (const f32x4*)(ss + (size_t)row * 16);
    const f32x4 a = p[0], b = p[1], c = p[2], d = p[3];
    const float s = (((a[0] + a[1]) + (a[2] + a[3])) + ((b[0] + b[1]) + (b[2] + b[3]))) + (((c[0] + c[1]) + (c[2] + c[3])) + ((d[0] + d[1]) + (d[2] + d[3])));
    return __builtin_amdgcn_rsqf(s * (1.0f / 1024.0f) + 1e-6f);
}
struct EpiBf16RS {
    static constexpr bool PERM = true, AFTER_DRAIN = false;
    bf16_t* O0; int ld0; int nt0; bf16_t* O1; bf16_t* O2; int ld1; const float* ss;
    __device__ __forceinline__ void operator()(const f32x4 (&acc)[2][2][4][2], const Unit& u, int wr, int wc, int fr, int fq) const {
        bf16_t* base; int ld, colt;
        if (u.pn < nt0) { base = O0; ld = ld0; colt = u.pn * BM; } else if (u.pn == nt0) { base = O1; ld = ld1; colt = 0; } else { base = O2; ld = ld1; colt = (u.pn - nt0 - 1) * BM; }
        const int row0 = u.pm * BM + wr * 64 + fr, col0 = colt + wc * 32 + 8 * fq;
#pragma unroll
        for (int ai = 0; ai < 2; ++ai)
#pragma unroll
            for (int m = 0; m < 4; ++m) { const int row = row0 + ai * HALF + m * 16; const float rs = row_rstd(ss, row); bf16_t* rowp = base + (size_t)row * ld + col0;
#pragma unroll
                for (int bj = 0; bj < 2; ++bj) { const f32x4 v0 = acc[ai][bj][m][0] * rs, v1 = acc[ai][bj][m][1] * rs;
                    u32x4 w; w.x = cvt_pk_bf16(v0[0], v0[1]); w.y = cvt_pk_bf16(v0[2], v0[3]); w.z = cvt_pk_bf16(v1[0], v1[1]); w.w = cvt_pk_bf16(v1[2], v1[3]);
                    *(u32x4*)(rowp + bj * HALF) = w; } }
    }
};
template <bool BASEF32> struct EpiResid {
    static constexpr bool PERM = true, AFTER_DRAIN = false;
    const float* basef; bf16_t* xb; float* ss;
    __device__ __forceinline__ void operator()(const f32x4 (&acc)[2][2][4][2], const Unit& u, int wr, int wc, int fr, int fq) const {
        const int row0 = u.pm * BM + wr * 64 + fr, col0 = u.pn * BM + wc * 32 + 8 * fq;
#pragma unroll
        for (int ai = 0; ai < 2; ++ai)
#pragma unroll
            for (int m = 0; m < 4; ++m) { const int row = row0 + ai * HALF + m * 16; float sq = 0.f;
#pragma unroll
                for (int bj = 0; bj < 2; ++bj) { const size_t off = (size_t)row * 1024 + col0 + bj * HALF;
                    f32x4 b0, b1;
                    if (BASEF32) { b0 = *(const f32x4*)(basef + off); b1 = *(const f32x4*)(basef + off + 4); }
                    else { const u32x4 w = *(const u32x4*)(xb + off);
                        b0 = (f32x4){__uint_as_float(w.x << 16), __uint_as_float(w.x & 0xffff0000u), __uint_as_float(w.y << 16), __uint_as_float(w.y & 0xffff0000u)};
                        b1 = (f32x4){__uint_as_float(w.z << 16), __uint_as_float(w.z & 0xffff0000u), __uint_as_float(w.w << 16), __uint_as_float(w.w & 0xffff0000u)}; }
                    const f32x4 o0 = b0 + acc[ai][bj][m][0], o1 = b1 + acc[ai][bj][m][1];
                    sq += ((o0[0] * o0[0] + o0[1] * o0[1]) + (o0[2] * o0[2] + o0[3] * o0[3])) + ((o1[0] * o1[0] + o1[1] * o1[1]) + (o1[2] * o1[2] + o1[3] * o1[3]));
                    u32x4 w; w.x = cvt_pk_bf16(o0[0], o0[1]); w.y = cvt_pk_bf16(o0[2], o0[3]); w.z = cvt_pk_bf16(o1[0], o1[1]); w.w = cvt_pk_bf16(o1[2], o1[3]);
                    *(u32x4*)(xb + off) = w; }
                sq += __shfl_xor(sq, 16); sq += __shfl_xor(sq, 32);
                if (fq == 0) ss[(size_t)row * 16 + u.pn * 4 + wc] = sq; }
    }
};

template <class Epi, class Sched, bool ALIGN_EPI = false, bool SP2 = false>
__device__ __forceinline__ void gemm_phase(PG8_LAS unsigned char* lds, const Gemm g, const Sched& S, const Epi& E) {
    const int tid = threadIdx.x, wid = __builtin_amdgcn_readfirstlane(tid >> 6), lane = tid & 63, wr = wid >> 2, wc = wid & 3, fr = lane & 15, fq = lane >> 4;
    const int K = g.K, nt = K / BK;
    unsigned voffA[2], voffB[2];
#pragma unroll
    for (int i = 0; i < 2; ++i) { int R, C; stage_rc(tid * 16 + i * 8192, R, C); const int Rb = Epi::PERM ? ((R & ~31) + perm32(R & 31)) : R;
        voffA[i] = (unsigned)(R * K + C) * 2u; voffB[i] = (unsigned)(Rb * K + C) * 2u; }
    const size_t kstep = (size_t)(BK * 2);
    const size_t hstep = (size_t)HALF * K * 2;
    const size_t tstep = 2 * hstep;
    const unsigned ldsw = (unsigned)wid * 1024u;
    const int aoff = lds_byte(wr * 64 + fr, fq * 8), boff = lds_byte(wc * 32 + fr, fq * 8);
#define PG8_SA(b, h) (((b) * 2 + (h)) * HTB)
#define PG8_SB(b, h) ((4 + (b) * 2 + (h)) * HTB)
#define PG8_STAGE(bufoff, gbase, voff) do { _Pragma("unroll") for (int _i = 0; _i < 2; ++_i) \
        __builtin_amdgcn_global_load_lds((const unsigned*)((const char*)(gbase) + (voff)[_i]), (PG8_LAS unsigned*)(lds + (bufoff) + ldsw + _i * 8192), 16, 0, 0); } while (0)
#define PG8_LDA(dst, b, h) do { _Pragma("unroll") for (int m = 0; m < 4; ++m) _Pragma("unroll") for (int k = 0; k < 2; ++k) dst[m][k] = *(const PG8_LAS bf16x8*)(lds + PG8_SA(b, h) + aoff + m * 2048 + k * 1024); } while (0)
#define PG8_LDB(dst, b, h) do { _Pragma("unroll") for (int n = 0; n < 2; ++n) _Pragma("unroll") for (int k = 0; k < 2; ++k) dst[n][k] = *(const PG8_LAS bf16x8*)(lds + PG8_SB(b, h) + boff + n * 2048 + k * 1024); } while (0)
#define PG8_MMA(ai, bj, At, Bt) do { __builtin_amdgcn_s_setprio(1); _Pragma("unroll") for (int m = 0; m < 4; ++m) _Pragma("unroll") for (int n = 0; n < 2; ++n) _Pragma("unroll") for (int k = 0; k < 2; ++k) \
        acc[ai][bj][m][n] = __builtin_amdgcn_mfma_f32_16x16x32_bf16(Bt[n][k], At[m][k], acc[ai][bj][m][n], 0, 0, 0); __builtin_amdgcn_s_setprio(0); } while (0)
#define PG8_WAIT_V(n) asm volatile("s_waitcnt vmcnt(" #n ")" ::: "memory")
#define PG8_WAIT_L(n) asm volatile("s_waitcnt lgkmcnt(" #n ")" ::: "memory")
#define PG8_BAR __builtin_amdgcn_s_barrier()
#define PG8_SCHED __builtin_amdgcn_sched_barrier(0)
    Unit cur, nxt; int ui = 0;
    if (!S.next(0, cur)) return;
    f32x4 acc[2][2][4][2];
#pragma unroll
    for (int a = 0; a < 2; ++a)
#pragma unroll
        for (int b = 0; b < 2; ++b)
#pragma unroll
            for (int m = 0; m < 4; ++m)
#pragma unroll
                for (int n = 0; n < 2; ++n) acc[a][b][m][n] = (f32x4){0.f, 0.f, 0.f, 0.f};
    bf16x8 At[4][2], B0[2][2], B1[2][2];
    const char* cA = (const char*)g.A + (size_t)cur.pm * tstep; const char* cB = (const char*)g.Bt + (size_t)cur.pn * tstep;
    S.a_ready(cur);
    if constexpr (SP2) {
        PG8_STAGE(PG8_SB(0, 0), cB, voffB); PG8_STAGE(PG8_SB(0, 1), cB + hstep, voffB); PG8_STAGE(PG8_SA(0, 0), cA, voffA); PG8_STAGE(PG8_SA(0, 1), cA + hstep, voffA);
        if (wr == 1) PG8_BAR;
        PG8_WAIT_V(2); PG8_BAR;
        PG8_STAGE(PG8_SB(1, 0), cB + kstep, voffB); PG8_STAGE(PG8_SA(1, 0), cA + kstep, voffA); PG8_STAGE(PG8_SB(1, 1), cB + hstep + kstep, voffB);
        PG8_WAIT_V(6); PG8_BAR;
    } else {
        PG8_STAGE(PG8_SB(0, 0), cB, voffB); PG8_STAGE(PG8_SA(0, 0), cA, voffA); PG8_STAGE(PG8_SB(0, 1), cB + hstep, voffB); PG8_STAGE(PG8_SA(0, 1), cA + hstep, voffA);
        if (wr == 1) PG8_BAR;
        PG8_WAIT_V(4); PG8_BAR;
        PG8_STAGE(PG8_SB(1, 0), cB + kstep, voffB); PG8_STAGE(PG8_SA(1, 0), cA + kstep, voffA); PG8_STAGE(PG8_SB(1, 1), cB + hstep + kstep, voffB);
        PG8_WAIT_V(6); PG8_BAR;
    }
    for (;;) {
        const bool has_next = S.next(ui + 1, nxt);
        const char* nA = has_next ? (const char*)g.A + (size_t)nxt.pm * tstep : cA; const char* nB = has_next ? (const char*)g.Bt + (size_t)nxt.pn * tstep : cB;
        for (int t = 0; t < nt; t += 2) {
            const bool last = (t == nt - 2);
            const char* a1 = cA + (size_t)(t + 1) * kstep;
            const char* a2 = last ? nA : cA + (size_t)(t + 2) * kstep; const char* b2 = last ? nB : cB + (size_t)(t + 2) * kstep;
            const char* a3 = a2 + kstep; const char* b3 = b2 + kstep;
            if (last && has_next) S.a_ready(nxt);
            if constexpr (SP2) {
            PG8_LDB(B0, 0, 0); PG8_LDB(B1, 0, 1); PG8_SCHED; PG8_LDA(At, 0, 0); PG8_STAGE(PG8_SA(1, 1), a1 + hstep, voffA);
            PG8_WAIT_V(8); PG8_WAIT_L(0); PG8_BAR; PG8_MMA(0, 0, At, B0); PG8_MMA(0, 1, At, B1); PG8_BAR; PG8_SCHED;
            PG8_LDA(At, 0, 1); PG8_STAGE(PG8_SB(0, 0), b2, voffB); PG8_STAGE(PG8_SB(0, 1), b2 + hstep, voffB); PG8_STAGE(PG8_SA(0, 0), a2, voffA);
            PG8_WAIT_V(8); PG8_WAIT_L(0); PG8_BAR; PG8_MMA(1, 0, At, B0); PG8_MMA(1, 1, At, B1); PG8_BAR; PG8_SCHED;
            PG8_LDB(B0, 1, 0); PG8_LDB(B1, 1, 1); PG8_SCHED; PG8_LDA(At, 1, 0); PG8_STAGE(PG8_SA(0, 1), a2 + hstep, voffA);
            PG8_WAIT_V(8); PG8_WAIT_L(0); PG8_BAR; PG8_MMA(0, 0, At, B0); PG8_MMA(0, 1, At, B1); PG8_BAR; PG8_SCHED;
            PG8_LDA(At, 1, 1); PG8_STAGE(PG8_SB(1, 0), b3, voffB); PG8_STAGE(PG8_SB(1, 1), b3 + hstep, voffB); PG8_STAGE(PG8_SA(1, 0), a3, voffA);
            PG8_WAIT_V(8); PG8_WAIT_L(0); PG8_BAR; PG8_MMA(1, 0, At, B0); PG8_MMA(1, 1, At, B1); PG8_BAR; PG8_SCHED;
            } else {
            PG8_LDB(B0, 0, 0); PG8_SCHED; PG8_LDA(At, 0, 0); PG8_STAGE(PG8_SA(1, 1), a1 + hstep, voffA);
            PG8_WAIT_L(8); PG8_BAR; PG8_WAIT_L(0); PG8_MMA(0, 0, At, B0); PG8_BAR; PG8_SCHED;
            PG8_LDB(B1, 0, 1); PG8_STAGE(PG8_SB(0, 0), b2, voffB);
            PG8_BAR; PG8_WAIT_L(0); PG8_MMA(0, 1, At, B1); PG8_BAR;
            PG8_LDA(At, 0, 1); PG8_STAGE(PG8_SA(0, 0), a2, voffA);
            PG8_BAR; PG8_WAIT_L(0); PG8_MMA(1, 0, At, B0); PG8_BAR; PG8_SCHED;
            PG8_STAGE(PG8_SB(0, 1), b2 + hstep, voffB);
            PG8_WAIT_V(6); PG8_BAR; PG8_MMA(1, 1, At, B1); PG8_BAR;
            PG8_LDB(B0, 1, 0); PG8_SCHED; PG8_LDA(At, 1, 0); PG8_STAGE(PG8_SA(0, 1), a2 + hstep, voffA);
            PG8_WAIT_L(8); PG8_BAR; PG8_WAIT_L(0); PG8_MMA(0, 0, At, B0); PG8_BAR; PG8_SCHED;
            PG8_LDB(B1, 1, 1); PG8_STAGE(PG8_SB(1, 0), b3, voffB);
            PG8_BAR; PG8_WAIT_L(0); PG8_MMA(0, 1, At, B1); PG8_BAR;
            PG8_LDA(At, 1, 1); PG8_STAGE(PG8_SA(1, 0), a3, voffA);
            PG8_BAR; PG8_WAIT_L(0); PG8_MMA(1, 0, At, B0); PG8_BAR; PG8_SCHED;
            PG8_STAGE(PG8_SB(1, 1), b3 + hstep, voffB);
            PG8_WAIT_V(6); PG8_BAR; PG8_MMA(1, 1, At, B1); PG8_BAR;
            }
        }
        if constexpr (ALIGN_EPI) { if (wr == 0) PG8_BAR; }
        if constexpr (!Epi::AFTER_DRAIN) { E(acc, cur, wr, wc, fr, fq); S.done(cur); }
        if (!has_next) break;
#pragma unroll
        for (int a = 0; a < 2; ++a)
#pragma unroll
            for (int b = 0; b < 2; ++b)
#pragma unroll
                for (int m = 0; m < 4; ++m)
#pragma unroll
                    for (int n = 0; n < 2; ++n) acc[a][b][m][n] = (f32x4){0.f, 0.f, 0.f, 0.f};
        cur = nxt; cA = nA; cB = nB; ++ui;
        if constexpr (ALIGN_EPI) { if (wr == 1) PG8_BAR; }
    }
    PG8_WAIT_V(0);
    if constexpr (!ALIGN_EPI) { if (wr == 0) PG8_BAR; }
    PG8_BAR;
    if constexpr (Epi::AFTER_DRAIN) { E.fused(acc, cur, wr, wc, fr, fq, lds, wid, lane); S.done(cur); }
#undef PG8_SA
#undef PG8_SB
#undef PG8_STAGE
#undef PG8_LDA
#undef PG8_LDB
#undef PG8_MMA
#undef PG8_WAIT_V
#undef PG8_WAIT_L
#undef PG8_BAR
#undef PG8_SCHED
}
}

constexpr int NWAVES = 8;
constexpr int BATCH = 2, SEQ = 8192, D = 1024, T = BATCH * SEQ;
constexpr int NIN = 3072, NQKV = 1536, NPQ = 2048, NEXP = 16384;
constexpr float LOG2E = 1.4426950408889634f;
constexpr float QSCALE = 0.125f * LOG2E;
constexpr float NEGBIG = -1e30f;
#ifndef MK_PER_PHASE
#define MK_PER_PHASE 0
#endif
constexpr int NPH = 18;
#ifndef REP_MASK
#define REP_MASK 0
#endif
#define REPS(k) for (int rep_ = 0; rep_ < (((REP_MASK) >> (k)) & 1) + 1; ++rep_)

constexpr size_t MiB = 1u << 20;
constexpr size_t WS_CTL = 0, CTL_ZERO_BYTES = 65536;
constexpr size_t WS_WIN = 1 * MiB, WS_WOUT = 7 * MiB, WS_WQKV = 9 * MiB, WS_WO = 12 * MiB, WS_WPQ = 14 * MiB, WS_SK = 22 * MiB;
constexpr size_t WS_SS = 23 * MiB;
constexpr size_t WS_IDX = 28 * MiB, WS_GATE = 36 * MiB, WS_XB = 44 * MiB, WS_Y = 76 * MiB, WS_U = 108 * MiB, WS_V = 172 * MiB;
constexpr size_t WS_G1 = 236 * MiB, WS_PQ = 332 * MiB, WS_Q = 396 * MiB, WS_K = 428 * MiB, WS_VV = 436 * MiB, WS_AO = 444 * MiB, WS_END = 476 * MiB;
constexpr size_t WS_HP = WS_G1, WS_A = WS_G1 + 64 * MiB;
constexpr int CW_BAR = 4096;
constexpr int CW_WQ = 8192;

constexpr int RING_BYTES = 131072;
constexpr int LDSCTL_OFF = 143360, MISC_OFF = LDSCTL_OFF + 320;
constexpr int SC_STRIDE = 260, SC_TAB_OFF = 135168;
constexpr int LDS_BYTES = 147456;

#define LAS __attribute__((address_space(3)))
typedef unsigned short bf16;
typedef unsigned v4u __attribute__((ext_vector_type(4)));
typedef unsigned v2u __attribute__((ext_vector_type(2)));
typedef float f32x4 __attribute__((ext_vector_type(4)));
typedef float f32x2 __attribute__((ext_vector_type(2)));
typedef float f32x16 __attribute__((ext_vector_type(16)));
typedef short bf16x8 __attribute__((ext_vector_type(8)));
typedef __bf16 bf16x2_t __attribute__((ext_vector_type(2)));
#define LDS_WAIT() asm volatile("s_waitcnt lgkmcnt(0)" ::: "memory")
#define DI __device__ __forceinline__

DI unsigned pk2(float lo, float hi) { f32x2 v = {lo, hi}; bf16x2_t b = __builtin_convertvector(v, bf16x2_t); return __builtin_bit_cast(unsigned, b); }
DI float bf_lo(unsigned u) { return __uint_as_float(u << 16); }
DI float bf_hi(unsigned u) { return __uint_as_float(u & 0xffff0000u); }
DI float wave_sum(float v) {
#pragma unroll
    for (int o = 1; o < 64; o <<= 1) v += __shfl_xor(v, o);
    return v;
}
#define XB_TMO      128
#define XB_XCNT(j)  (256  + 64 * (j))
#define XB_XSUB(j)  (1280 + 64 * (j))
#define XB_XGEN(j)  (2304 + 64 * (j))
#define XB_TOP      3328
#define XB_TOPGEN   3392
#define XCD_BAR_WORDS 3456
#define XB_SPIN_CAP (1u << 18)

__device__ __forceinline__ unsigned xb_ld(unsigned* p)              { return __hip_atomic_load(p, __ATOMIC_RELAXED, __HIP_MEMORY_SCOPE_AGENT); }
__device__ __forceinline__ unsigned xb_add(unsigned* p, unsigned v) { return __hip_atomic_fetch_add(p, v, __ATOMIC_RELAXED, __HIP_MEMORY_SCOPE_AGENT); }
__device__ __forceinline__ unsigned xb_xcc_id() { return (unsigned)__builtin_amdgcn_s_getreg((3 << 11) | 20) & 0xFu; }
#define XB_SPIN(cond, bar) do { unsigned _sp = 0; while (cond) { __builtin_amdgcn_s_sleep(1); \
    if ((++_sp & 255u) == 0u) { if (xb_ld(&(bar)[XB_TMO])) break; if (_sp > XB_SPIN_CAP) { atomicAdd(&(bar)[XB_TMO], 1u); break; } } } } while (0)

struct XcdBarrier {
    unsigned* bar; unsigned x;
    volatile LAS unsigned* st;
};

__device__ __forceinline__ XcdBarrier xcd_barrier_post(unsigned* bar, volatile LAS unsigned* st) {
    XcdBarrier b; b.bar = bar; b.x = xb_xcc_id(); b.st = st;
    if (threadIdx.x == 0) (void)xb_add(&bar[XB_XCNT(b.x)], 1u);
    return b;
}
__device__ __forceinline__ void xcd_barrier_complete(unsigned* bar, unsigned x, unsigned& nloc, unsigned& nx) {
    const unsigned G = gridDim.x * gridDim.y * gridDim.z;
    unsigned sum, cnt, mine, sp = 0u;
    for (;;) {
        sum = 0u; cnt = 0u; mine = 0u;
#pragma unroll
        for (unsigned j = 0; j < 16; ++j) { const unsigned c = xb_ld(&bar[XB_XCNT(j)]); sum += c; cnt += (c > 0u) ? 1u : 0u; mine = (j == x) ? c : mine; }
        if (sum == G) break;
        __builtin_amdgcn_s_sleep(1);
        if ((++sp & 255u) == 0u) { if (xb_ld(&bar[XB_TMO])) break; if (sp > XB_SPIN_CAP) { atomicAdd(&bar[XB_TMO], 1u); break; } }
    }
    nloc = mine > 0u ? mine : 1u; nx = cnt > 0u ? cnt : 1u;
}

__device__ __forceinline__ void xcd_barrier(const XcdBarrier& b) {
    asm volatile("s_waitcnt vmcnt(0)" ::: "memory");
    __syncthreads();
    if (threadIdx.x == 0) {
        unsigned* bar = b.bar;
        __builtin_amdgcn_s_waitcnt(0);
        unsigned nloc = b.st[0], nx = b.st[1];
        if (nloc == 0u) { xcd_barrier_complete(bar, b.x, nloc, nx); b.st[0] = nloc; b.st[1] = nx; }
        const unsigned old = xb_add(&bar[XB_XSUB(b.x)], 1u);
        const unsigned gen = old / nloc;
        if (old + 1u == (gen + 1u) * nloc) {
            __builtin_amdgcn_fence(__ATOMIC_RELEASE, "agent");
            asm volatile("s_waitcnt vmcnt(0)" ::: "memory");
            const unsigned og = xb_add(&bar[XB_TOP], 1u);
            const unsigned tg = og / nx;
            if (og + 1u == (tg + 1u) * nx) xb_add(&bar[XB_TOPGEN], 1u);
            else XB_SPIN(xb_ld(&bar[XB_TOPGEN]) == tg, bar);
            __builtin_amdgcn_fence(__ATOMIC_ACQUIRE, "agent");
            xb_add(&bar[XB_XGEN(b.x)], 1u);
            asm volatile("s_waitcnt vmcnt(0)" ::: "memory");
        } else {
            XB_SPIN(xb_ld(&bar[XB_XGEN(b.x)]) == gen, bar);
            __builtin_amdgcn_fence(__ATOMIC_ACQUIRE, "agent");
            asm volatile("s_waitcnt vmcnt(0)" ::: "memory");
        }
    }
    __syncthreads();
}

DI void p0_transpose_item(const float* W, int K, int N, bf16* WT, LAS float* scr, int item, int lane, const float* gain, int nscaled, float cscale) {
    const int nblk = N / 32, kb = item / nblk, nb = item % nblk, k0 = 64 * kb, n0 = 32 * nb;
    float tv[32];
#pragma unroll
    for (int i = 0; i < 32; ++i) tv[i] = W[(size_t)(k0 + 2 * i + (lane >> 5)) * N + n0 + (lane & 31)];
#pragma unroll
    for (int i = 0; i < 32; ++i) { const int kk = 2 * i + (lane >> 5); float v = tv[i]; if (gain) v *= gain[k0 + kk]; scr[kk * 33 + (lane & 31)] = v; }
    LDS_WAIT();
    const int c = lane & 7;
#pragma unroll
    for (int j = 0; j < 4; ++j) { const int n = (lane >> 3) + 8 * j; const LAS float* s = scr + (8 * c) * 33 + n; const float cs = (n0 + n < nscaled) ? cscale : 1.f;
        v4u o; o.x = pk2(s[0 * 33] * cs, s[1 * 33] * cs); o.y = pk2(s[2 * 33] * cs, s[3 * 33] * cs); o.z = pk2(s[4 * 33] * cs, s[5 * 33] * cs); o.w = pk2(s[6 * 33] * cs, s[7 * 33] * cs);
        *(v4u*)(WT + (size_t)(n0 + n) * K + k0 + 8 * c) = o; }
    LDS_WAIT();
}
DI void table_blocks(const float* pu, const float* pv, const float* ffn_g, unsigned char* U8, unsigned char* V8, size_t b0, size_t b1, size_t w, size_t nw, int lane) {
    constexpr size_t NB = (size_t)2 * NEXP * D / 2048;
    for (size_t blk = b0 + w; blk < b1; blk += nw) { const bool isv = blk >= NB; const size_t bb = isv ? blk - NB : blk; const int layer = (int)(bb / (NB / 2));
        const float* src = (isv ? pv : pu) + bb * 2048; unsigned char* dst = (isv ? V8 : U8) + bb * 2048;
        f32x4 v[8];
#pragma unroll
        for (int j = 0; j < 8; ++j) v[j] = __builtin_nontemporal_load((const f32x4*)(src + 256 * j) + lane);
#pragma unroll
        for (int j = 0; j < 8; ++j) { unsigned wd;
            if (isv) { const f32x4 t = v[j] * 1024.0f; int wi = __builtin_amdgcn_cvt_pk_fp8_f32(t[0], t[1], 0, false); wi = __builtin_amdgcn_cvt_pk_fp8_f32(t[2], t[3], wi, true); wd = (unsigned)wi; }
            else { const f32x4 g = *((const f32x4*)(ffn_g + layer * D + 256 * (j & 3)) + lane); const f32x4 t = v[j] * g * 512.0f; wd = 0u;
#pragma unroll
                for (int e = 0; e < 4; ++e) { const int qi = (int)__builtin_rintf(fminf(fmaxf(t[e], -127.f), 127.f)); wd |= ((unsigned)qi & 0xffu) << (8 * e); } }
            *((unsigned*)(dst + 256 * j) + lane) = wd; } }
}
struct P0Args { const float *x, *conv_g, *w_in, *w_out, *attn_g, *w_qkv, *w_o, *ffn_g, *w_pq, *subk, *pu, *pv;
                bf16 *WinT, *WoutT, *WqkvT, *WoT, *WpqT, *SKb; unsigned char *U8, *V8; bf16* XB; float* SS0; };
DI void p0_prologue(const P0Args& a, LAS unsigned char* lds, int vcu, int G, int wave, int lane, int tid) {
    LAS float* scr = (LAS float*)(lds + wave * 16384);
    const int gw = vcu * NWAVES + wave, NGW = G * NWAVES;
    constexpr int I_IN = 16 * (NIN / 32), I_OUT = 16 * (D / 32), I_QKV = 16 * (NQKV / 32), I_O = I_OUT;
    constexpr int NITEMS = I_IN + I_OUT + I_QKV + I_O;
    for (int it = gw; it < NITEMS; it += NGW) {
        int r = it;
        if (r < I_IN) { p0_transpose_item(a.w_in, D, NIN, a.WinT, scr, r, lane, a.conv_g, 0, 1.f); continue; } r -= I_IN;
        if (r < I_OUT) { p0_transpose_item(a.w_out, D, D, a.WoutT, scr, r, lane, nullptr, 0, 1.f); continue; } r -= I_OUT;
        if (r < I_QKV) { p0_transpose_item(a.w_qkv, D, NQKV, a.WqkvT, scr, r, lane, a.attn_g, 1024, QSCALE); continue; } r -= I_QKV;
        p0_transpose_item(a.w_o, D, D, a.WoT, scr, r, lane, nullptr, 0, 1.f);
    }
    { const int fr = lane & 15, fq = lane >> 4;
      for (int task = gw; task < 2 * 16 * 8 * 16; task += NGW) { const int kc = task & 15, nt = (task >> 4) & 7, hp = (task >> 7) & 15, l = task >> 11;
        const float* skp = a.subk + ((size_t)(l * 16 + hp) * 128 + nt * 16 + fr) * 128 + fq * 8;
        bf16x8 bfr[4];
#pragma unroll
        for (int ks = 0; ks < 4; ++ks) { const f32x4 v0 = *(const f32x4*)(skp + ks * 32), v1 = *(const f32x4*)(skp + ks * 32 + 4);
            v4u w; w.x = pk2(v0[0], v0[1]); w.y = pk2(v0[2], v0[3]); w.z = pk2(v1[0], v1[1]); w.w = pk2(v1[2], v1[3]); bfr[ks] = __builtin_bit_cast(bf16x8, w); }
#pragma unroll 1
        for (int kt = 0; kt < 4; ++kt) { const int k0 = kc * 64 + kt * 16;
            const float* wp = a.w_pq + ((size_t)l * D + k0 + fr) * NPQ + hp * 128 + fq * 8;
            f32x4 acc = {0.f, 0.f, 0.f, 0.f};
#pragma unroll
            for (int ks = 0; ks < 4; ++ks) { const f32x4 v0 = *(const f32x4*)(wp + ks * 32), v1 = *(const f32x4*)(wp + ks * 32 + 4);
                v4u w; w.x = pk2(v0[0], v0[1]); w.y = pk2(v0[2], v0[3]); w.z = pk2(v1[0], v1[1]); w.w = pk2(v1[2], v1[3]);
                acc = __builtin_amdgcn_mfma_f32_16x16x32_bf16(__builtin_bit_cast(bf16x8, w), bfr[ks], acc, 0, 0, 0); }
            const f32x4 g = *(const f32x4*)(a.ffn_g + l * D + k0 + 4 * fq); acc = acc * g;
            v2u o; o.x = pk2(acc[0], acc[1]); o.y = pk2(acc[2], acc[3]);
            *(v2u*)(a.WpqT + ((size_t)l * NPQ + hp * 128 + nt * 16 + fr) * D + k0 + 4 * fq) = o; } } }
    const size_t gt = (size_t)vcu * (NWAVES * 64) + tid, NGT = (size_t)G * NWAVES * 64;
    { constexpr size_t NB = (size_t)2 * NEXP * D / 2048;
      table_blocks(a.pu, a.pv, a.ffn_g, a.U8, a.V8, 0, NB / 2, (size_t)gw, (size_t)NGW, lane);
      table_blocks(a.pu, a.pv, a.ffn_g, a.U8, a.V8, NB, 2 * NB, (size_t)gw, (size_t)NGW, lane);
      if (G != 256) table_blocks(a.pu, a.pv, a.ffn_g, a.U8, a.V8, NB / 2, NB, (size_t)gw, (size_t)NGW, lane); }
    for (int m0 = 2 * gw; m0 < T; m0 += 2 * NGW) {
        f32x4 v[2][4]; float s2[2];
#pragma unroll
        for (int r = 0; r < 2; ++r)
#pragma unroll
            for (int j = 0; j < 4; ++j) v[r][j] = *((const f32x4*)(a.x + (size_t)(m0 + r) * D) + lane + 64 * j);
#pragma unroll
        for (int r = 0; r < 2; ++r) { float s = 0.f;
#pragma unroll
            for (int j = 0; j < 4; ++j) s += (v[r][j][0] * v[r][j][0] + v[r][j][1] * v[r][j][1]) + (v[r][j][2] * v[r][j][2] + v[r][j][3] * v[r][j][3]);
            s2[r] = wave_sum(s); }
#pragma unroll
        for (int r = 0; r < 2; ++r) { const int m = m0 + r;
            v2u* o8 = (v2u*)(a.XB + (size_t)m * D) + lane;
#pragma unroll
            for (int j = 0; j < 4; ++j) { v2u w; w.x = pk2(v[r][j][0], v[r][j][1]); w.y = pk2(v[r][j][2], v[r][j][3]); o8[64 * j] = w; }
            if (lane < 4) { f32x4 z = {0.f, 0.f, 0.f, 0.f}; ((f32x4*)(a.SS0 + (size_t)(2 * T + m) * 16))[lane] = z; ((f32x4*)(a.SS0 + (size_t)(4 * T + m) * 16))[lane] = z;
                if (lane == 0) z[0] = s2[r]; ((f32x4*)(a.SS0 + (size_t)m * 16))[lane] = z; } }
    }
}

DI void conv_gate_phase(const bf16* G1, const float* cw, bf16* Y, int vcu, int G, int tid) {
    const size_t gt = (size_t)vcu * (NWAVES * 64) + tid, NGT = (size_t)G * NWAVES * 64;
    for (size_t c = gt; c < (size_t)T * (D / 8); c += NGT) {
        const int t = (int)(c / (D / 8)), d0 = (int)(c % (D / 8)) * 8, ts = t % SEQ;
        const v4u gb = *(const v4u*)(G1 + (size_t)t * NIN + d0);
        float acc[8];
#pragma unroll
        for (int i = 0; i < 8; ++i) acc[i] = 0.f;
#pragma unroll
        for (int w = 0; w < 3; ++w) { const int tt = ts + w - 1;
            if (tt >= 0 && tt < SEQ) {
                const v4u gc = *(const v4u*)(G1 + (size_t)(t + w - 1) * NIN + D + d0), hh = *(const v4u*)(G1 + (size_t)(t + w - 1) * NIN + 2 * D + d0);
                const f32x4 w0 = *(const f32x4*)(cw + w * D + d0), w1 = *(const f32x4*)(cw + w * D + d0 + 4);
                acc[0] += w0[0] * (bf_lo(gc.x) * bf_lo(hh.x)); acc[1] += w0[1] * (bf_hi(gc.x) * bf_hi(hh.x));
                acc[2] += w0[2] * (bf_lo(gc.y) * bf_lo(hh.y)); acc[3] += w0[3] * (bf_hi(gc.y) * bf_hi(hh.y));
                acc[4] += w1[0] * (bf_lo(gc.z) * bf_lo(hh.z)); acc[5] += w1[1] * (bf_hi(gc.z) * bf_hi(hh.z));
                acc[6] += w1[2] * (bf_lo(gc.w) * bf_lo(hh.w)); acc[7] += w1[3] * (bf_hi(gc.w) * bf_hi(hh.w)); } }
        v4u o; o.x = pk2(acc[0] * bf_lo(gb.x), acc[1] * bf_hi(gb.x)); o.y = pk2(acc[2] * bf_lo(gb.y), acc[3] * bf_hi(gb.y));
        o.z = pk2(acc[4] * bf_lo(gb.z), acc[5] * bf_hi(gb.z)); o.w = pk2(acc[6] * bf_lo(gb.w), acc[7] * bf_hi(gb.w));
        *(v4u*)(Y + (size_t)t * D + d0) = o;
    }
}

template <int CTRL> DI unsigned dppu(unsigned v) { return (unsigned)__builtin_amdgcn_update_dpp(0, (int)v, CTRL, 0xf, 0xf, false); }
DI unsigned umax(unsigned a, unsigned b) { return a > b ? a : b; }
DI unsigned umin(unsigned a, unsigned b) { return a < b ? a : b; }
DI unsigned rowmax_u(unsigned v) { v = umax(v, dppu<0x128>(v)); v = umax(v, dppu<0x124>(v)); v = umax(v, dppu<0x122>(v)); v = umax(v, dppu<0x121>(v)); return v; }
DI float rowsum_f(float v) { v += __uint_as_float(dppu<0x128>(__float_as_uint(v))); v += __uint_as_float(dppu<0x124>(__float_as_uint(v))); v += __uint_as_float(dppu<0x122>(__float_as_uint(v))); v += __uint_as_float(dppu<0x121>(__float_as_uint(v))); return v; }
DI unsigned f2key(float f) { const unsigned u = __float_as_uint(f); return u ^ ((unsigned)((int)u >> 31) | 0x80000000u); }
DI float key2f(unsigned k) { const unsigned u = (k & 0x80000000u) ? (k ^ 0x80000000u) : ~k; return __uint_as_float(u); }
DI unsigned cand_ij(int c) {
    unsigned i, j;
    if (c < 16) { i = 0; j = c; } else if (c < 24) { i = 1; j = c - 16; } else if (c < 29) { i = 2; j = c - 24; } else if (c < 33) { i = 3; j = c - 29; }
    else if (c < 36) { i = 4; j = c - 33; } else if (c < 38) { i = 5; j = c - 36; } else if (c < 40) { i = 6; j = c - 38; } else if (c < 42) { i = 7; j = c - 40; }
    else { i = 8 + (c - 42); j = 0; }
    return (i & 15u) | (j << 4);
}
#define CE_DESC(a, b) do { const unsigned _hi = umax(a, b), _lo = umin(a, b); a = _hi; b = _lo; } while (0)
DI void topk_group(const LAS float* SC, int srow0, int t0, int h, unsigned short* IDX, float* GATE, const LAS unsigned char* TAB, int lane) {
    const int fr = lane & 15, fq = lane >> 4;
        unsigned res[2][4];
#pragma unroll
        for (int p = 0; p < 2; ++p) {
            f32x4 acc[8];
#pragma unroll
            for (int n = 0; n < 8; ++n)
#pragma unroll
                for (int r = 0; r < 4; ++r) acc[n][r] = SC[(srow0 + 4 * fq + r) * SC_STRIDE + p * 128 + 16 * n + fr];
            unsigned L[4][8];
#pragma unroll
            for (int r = 0; r < 4; ++r)
#pragma unroll
                for (int n = 0; n < 8; ++n) L[r][n] = (f2key(acc[n][r]) & ~127u) | (unsigned)(127 - (16 * n + fr));
#define CE4(i, j) do { _Pragma("unroll") for (int r = 0; r < 4; ++r) CE_DESC(L[r][i], L[r][j]); } while (0)
            CE4(0, 1); CE4(2, 3); CE4(4, 5); CE4(6, 7);
            CE4(0, 2); CE4(1, 3); CE4(4, 6); CE4(5, 7);
            CE4(1, 2); CE4(5, 6); CE4(0, 4); CE4(3, 7);
            CE4(1, 5); CE4(2, 6);
            CE4(1, 4); CE4(3, 6);
            CE4(2, 4); CE4(3, 5);
            CE4(3, 4);
#undef CE4
            unsigned rr[4] = {0u, 0u, 0u, 0u};
#pragma unroll
            for (int k = 0; k < 16; ++k) {
                unsigned gm[4];
#pragma unroll
                for (int r = 0; r < 4; ++r) gm[r] = umax(L[r][0], dppu<0x128>(L[r][0]));
#pragma unroll
                for (int r = 0; r < 4; ++r) gm[r] = umax(gm[r], dppu<0x124>(gm[r]));
#pragma unroll
                for (int r = 0; r < 4; ++r) gm[r] = umax(gm[r], dppu<0x122>(gm[r]));
#pragma unroll
                for (int r = 0; r < 4; ++r) gm[r] = umax(gm[r], dppu<0x121>(gm[r]));
#pragma unroll
                for (int r = 0; r < 4; ++r) { rr[r] = (fr == k) ? gm[r] : rr[r]; const bool pop = (L[r][0] == gm[r]);
#pragma unroll
                    for (int n = 0; n < 7; ++n) L[r][n] = pop ? L[r][n + 1] : L[r][n];
                    L[r][7] = pop ? 0u : L[r][7]; }
            }
#pragma unroll
            for (int r = 0; r < 4; ++r) res[p][r] = rr[r];
        }
        const int gbase = (lane & 48) * 4;
        unsigned ck[4][4];
#pragma unroll
        for (int r = 0; r < 4; ++r)
#pragma unroll
            for (int s = 0; s < 4; ++s) { const int c = fr + 16 * s; const unsigned tb = TAB[c & 63];
                const unsigned k0 = (unsigned)__builtin_amdgcn_ds_bpermute(gbase + (int)(tb & 15u) * 4, (int)res[0][r]);
                const unsigned k1 = (unsigned)__builtin_amdgcn_ds_bpermute(gbase + (int)((tb >> 4) & 15u) * 4, (int)res[1][r]);
                const float v = key2f((k0 & ~127u) | 64u) + key2f((k1 & ~127u) | 64u);
                ck[r][s] = (c < 50) ? ((f2key(v) & ~63u) | (unsigned)(63 - c)) : 0u; }
        unsigned sel[4] = {0u, 0u, 0u, 0u};
#pragma unroll
        for (int k = 0; k < 16; ++k) {
            unsigned gm[4];
#pragma unroll
            for (int r = 0; r < 4; ++r) { const unsigned lm = umax(umax(ck[r][0], ck[r][1]), umax(ck[r][2], ck[r][3])); gm[r] = umax(lm, dppu<0x128>(lm)); }
#pragma unroll
            for (int r = 0; r < 4; ++r) gm[r] = umax(gm[r], dppu<0x124>(gm[r]));
#pragma unroll
            for (int r = 0; r < 4; ++r) gm[r] = umax(gm[r], dppu<0x122>(gm[r]));
#pragma unroll
            for (int r = 0; r < 4; ++r) gm[r] = umax(gm[r], dppu<0x121>(gm[r]));
#pragma unroll
            for (int r = 0; r < 4; ++r) { sel[r] = (fr == k) ? gm[r] : sel[r];
#pragma unroll
                for (int s = 0; s < 4; ++s) ck[r][s] = (ck[r][s] == gm[r]) ? 0u : ck[r][s]; }
        }
#pragma unroll
        for (int r = 0; r < 4; ++r) {
            const int t = t0 + 4 * fq + r;
            const int cs = 63 - (int)(sel[r] & 63u); const unsigned tb = TAB[cs & 63];
            const unsigned k0 = (unsigned)__builtin_amdgcn_ds_bpermute(gbase + (int)(tb & 15u) * 4, (int)res[0][r]);
            const unsigned k1 = (unsigned)__builtin_amdgcn_ds_bpermute(gbase + (int)((tb >> 4) & 15u) * 4, (int)res[1][r]);
            const int e = (127 - (int)(k0 & 127u)) * 128 + (127 - (int)(k1 & 127u));
            const float val = key2f((sel[r] & ~63u) | 32u), top = key2f((rowmax_u(sel[r]) & ~63u) | 32u);
            const float ex = __builtin_amdgcn_exp2f((val - top) * LOG2E), sum = rowsum_f(ex);
            IDX[(size_t)t * 128 + h * 16 + fr] = (unsigned short)e; GATE[(size_t)t * 128 + h * 16 + fr] = ex / sum;
        }
}
struct EpiRoute {
    static constexpr bool PERM = true, AFTER_DRAIN = true;
    const float* ss; unsigned short* IDX; float* GATE;
    DI void fused(pg8::f32x4 (&acc)[2][2][4][2], const pg8::Unit& u, int wr, int wc, int fr, int fq, LAS unsigned char* lds, int wid, int lane) const {
        LAS float* SC = (LAS float*)lds; LAS unsigned char* TAB = lds + SC_TAB_OFF; LAS unsigned* gcnt = (LAS unsigned*)(lds + SC_TAB_OFF + 128);
        const int tid = wid * 64 + lane;
        if (tid < 64) TAB[tid] = (unsigned char)(tid < 50 ? cand_ij(tid) : 0xff);
#pragma unroll
        for (int ai = 0; ai < 2; ++ai) {
            __syncthreads();
#pragma unroll
            for (int m = 0; m < 4; ++m) { const int row = wr * 64 + m * 16 + fr; const float rs = pg8::row_rstd(ss, u.pm * 256 + ai * 128 + row);
#pragma unroll
                for (int bj = 0; bj < 2; ++bj)
#pragma unroll
                    for (int n = 0; n < 2; ++n) *(LAS f32x4*)(SC + row * SC_STRIDE + bj * 128 + wc * 32 + 8 * fq + 4 * n) = acc[ai][bj][m][n] * rs; }
            if (tid == 0) *gcnt = 0u;
            __syncthreads();
            for (;;) {
                unsigned grp = 0u; if (lane == 0) grp = __hip_atomic_fetch_add(gcnt, 1u, __ATOMIC_RELAXED, __HIP_MEMORY_SCOPE_WORKGROUP);
                grp = (unsigned)__builtin_amdgcn_readfirstlane((int)grp);
                if (grp >= 8u) break;
                topk_group(SC, (int)grp * 16, u.pm * 256 + ai * 128 + (int)grp * 16, u.pn, IDX, GATE, TAB, lane);
            }
        }
        __syncthreads();
    }
};
struct OneUnit { pg8::Unit u;
    DI bool next(int i, pg8::Unit& o) const { if (i != 0) return false; o = u; return true; }
    DI void a_ready(const pg8::Unit&) const {}
    DI void done(const pg8::Unit&) const {}
};

DI float dot8(v4u x, v4u u, float acc) {
    acc += bf_lo(x.x) * bf_lo(u.x); acc += bf_hi(x.x) * bf_hi(u.x); acc += bf_lo(x.y) * bf_lo(u.y); acc += bf_hi(x.y) * bf_hi(u.y);
    acc += bf_lo(x.z) * bf_lo(u.z); acc += bf_hi(x.z) * bf_hi(u.z); acc += bf_lo(x.w) * bf_lo(u.w); acc += bf_hi(x.w) * bf_hi(u.w);
    return acc;
}
DI void fma8(float* acc, float a, v4u v) {
    acc[0] += a * bf_lo(v.x); acc[1] += a * bf_hi(v.x); acc[2] += a * bf_lo(v.y); acc[3] += a * bf_hi(v.y);
    acc[4] += a * bf_lo(v.z); acc[5] += a * bf_hi(v.z); acc[6] += a * bf_lo(v.w); acc[7] += a * bf_hi(v.w);
}
DI f32x2 fp8lo(unsigned w) { return __builtin_amdgcn_cvt_pk_f32_fp8((int)w, false); }
DI f32x2 fp8hi(unsigned w) { return __builtin_amdgcn_cvt_pk_f32_fp8((int)w, true); }

template <int CTRL> DI float dppf(float v) { return __uint_as_float(dppu<CTRL>(__float_as_uint(v))); }
constexpr int XG = 8, XNG = T / XG;
DI unsigned wave_ticket(unsigned* head, int lane) {
    unsigned v = 0u; if (lane == 0) v = __hip_atomic_fetch_add(head, 1u, __ATOMIC_RELAXED, __HIP_MEMORY_SCOPE_AGENT);
    return (unsigned)__builtin_amdgcn_readfirstlane((int)v);
}
struct USmall { int i0, i1; v4u xa, xb; };
DI void u_small(USmall& S, const unsigned short* IDX, const bf16* XB, int t, int s, int lane) {
    S.i0 = IDX[(size_t)t * 128 + lane]; S.i1 = IDX[(size_t)t * 128 + 64 + lane];
    const v4u* xr = (const v4u*)(XB + (size_t)t * D + 128 * s + 16 * (lane & 7)); S.xa = xr[0]; S.xb = xr[1];
}
DI void u_token(USmall& SC, const v4u (&GC)[16], const USmall& SN, v4u (&GN)[16], const unsigned char* U8s, const unsigned short* IDX, const bf16* XB, float* HPs, int t, int t2, int s, int lane) {
    const int g = lane >> 3, k = lane & 7;
    const v4u xa = SC.xa, xb = SC.xb;
    float xv[16];
    xv[0] = bf_lo(xa.x); xv[1] = bf_hi(xa.x); xv[2] = bf_lo(xa.y); xv[3] = bf_hi(xa.y); xv[4] = bf_lo(xa.z); xv[5] = bf_hi(xa.z); xv[6] = bf_lo(xa.w); xv[7] = bf_hi(xa.w);
    xv[8] = bf_lo(xb.x); xv[9] = bf_hi(xb.x); xv[10] = bf_lo(xb.y); xv[11] = bf_hi(xb.y); xv[12] = bf_lo(xb.z); xv[13] = bf_hi(xb.z); xv[14] = bf_lo(xb.w); xv[15] = bf_hi(xb.w);
    float am = 0.f;
#pragma unroll
    for (int i = 0; i < 16; ++i) am = fmaxf(am, __builtin_fabsf(xv[i]));
    am = fmaxf(am, dppf<0xB1>(am)); am = fmaxf(am, dppf<0x4E>(am)); am = fmaxf(am, dppf<0x141>(am));
    am = fmaxf(am, 1e-20f);
    const float qs = 127.0f / am, dq = am * (1.0f / (127.0f * 512.0f));
    unsigned xq[4];
#pragma unroll
    for (int q = 0; q < 4; ++q) { unsigned w = 0u;
#pragma unroll
        for (int e = 0; e < 4; ++e) { const int qi = (int)__builtin_rintf(xv[4 * q + e] * qs); w |= ((unsigned)qi & 0xffu) << (8 * e); }
        xq[q] = w; }
    u_small(SC, IDX, XB, t2, s, lane);
    int p[16];
#pragma unroll
    for (int i = 0; i < 16; ++i) {
        const unsigned idx = (unsigned)__builtin_amdgcn_ds_bpermute((8 * g + (i & 7)) * 4, i < 8 ? SN.i0 : SN.i1);
        GN[i] = *(const v4u*)(U8s + (idx * 1024u + 16u * (unsigned)k));
        int a0 = __builtin_amdgcn_sdot4((int)xq[0], (int)GC[i][0], 0, false), a1 = __builtin_amdgcn_sdot4((int)xq[1], (int)GC[i][1], 0, false);
        a0 = __builtin_amdgcn_sdot4((int)xq[2], (int)GC[i][2], a0, false); a1 = __builtin_amdgcn_sdot4((int)xq[3], (int)GC[i][3], a1, false);
        p[i] = a0 + a1;
        __builtin_amdgcn_sched_barrier(0); }
    const bool h4 = k >= 4, h2 = k & 2, h1 = k & 1;
    int q8[8], q4[4], q2[2];
#pragma unroll
    for (int j = 0; j < 8; ++j) { const int keep = h4 ? p[8 + j] : p[j], send = h4 ? p[j] : p[8 + j]; q8[j] = keep + (int)dppu<0x141>((unsigned)send); }
#pragma unroll
    for (int j = 0; j < 4; ++j) { const int keep = h2 ? q8[4 + j] : q8[j], send = h2 ? q8[j] : q8[4 + j]; q4[j] = keep + (int)dppu<0x4E>((unsigned)send); }
#pragma unroll
    for (int j = 0; j < 2; ++j) { const int keep = h1 ? q4[2 + j] : q4[j], send = h1 ? q4[j] : q4[2 + j]; q2[j] = keep + (int)dppu<0xB1>((unsigned)send); }
    *(f32x2*)(HPs + (size_t)t * 128 + (h4 ? 64 : 0) + 8 * g + 2 * (k & 3)) = (f32x2){(float)q2[0] * dq, (float)q2[1] * dq};
}
DI float wave_sum_dpp63(float v) {
    v += dppf<0xB1>(v); v += dppf<0x4E>(v); v += dppf<0x141>(v); v += dppf<0x140>(v);
    v += __uint_as_float((unsigned)__builtin_amdgcn_update_dpp(0, (int)__float_as_uint(v), 0x142, 0xa, 0xf, false));
    v += __uint_as_float((unsigned)__builtin_amdgcn_update_dpp(0, (int)__float_as_uint(v), 0x143, 0xc, 0xf, false));
    return v;
}
struct VSmall { int i0, i1; float a0, a1; unsigned xo; };
DI void v_small(VSmall& S, const unsigned short* IDX, const float* A, const bf16* XB, int t, int s, int lane) {
    S.i0 = IDX[(size_t)t * 128 + lane]; S.i1 = IDX[(size_t)t * 128 + 64 + lane]; S.a0 = A[(size_t)t * 128 + lane]; S.a1 = A[(size_t)t * 128 + 64 + lane];
    S.xo = *(const unsigned*)(XB + (size_t)t * D + 128 * s + 2 * lane);
}
template <bool FINAL>
DI void v_token(VSmall& SC, const v4u (&GC)[16], const VSmall& SN, v4u (&GN)[16], const unsigned char* V8s, const unsigned short* IDX, const float* A, float* xf, bf16* XB, float* ss_out,
                int t, int t2, int s, int lane) {
    const int g = lane >> 3, k = lane & 7;
    const bool b3 = lane & 8, b4 = lane & 16, b5 = lane & 32;
    float av[16];
#pragma unroll
    for (int i = 0; i < 16; ++i) av[i] = __uint_as_float((unsigned)__builtin_amdgcn_ds_bpermute((8 * g + (i & 7)) * 4, (int)__float_as_uint(i < 8 ? SC.a0 : SC.a1)));
    f32x2 o = {bf_lo(SC.xo), bf_hi(SC.xo)};
    v_small(SC, IDX, A, XB, t2, s, lane);
    f32x2 acc[8];
#pragma unroll
    for (int i = 0; i < 8; ++i) acc[i] = (f32x2){0.f, 0.f};
#pragma unroll
    for (int i = 0; i < 16; ++i) {
        const unsigned idx = (unsigned)__builtin_amdgcn_ds_bpermute((8 * g + (i & 7)) * 4, i < 8 ? SN.i0 : SN.i1);
        GN[i] = *(const v4u*)(V8s + (idx * 1024u + 16u * (unsigned)k));
        const f32x2 a2 = {av[i], av[i]};
#pragma unroll
        for (int q = 0; q < 4; ++q) { acc[2 * q] = __builtin_elementwise_fma(a2, fp8lo(GC[i][q]), acc[2 * q]); acc[2 * q + 1] = __builtin_elementwise_fma(a2, fp8hi(GC[i][q]), acc[2 * q + 1]); }
        __builtin_amdgcn_sched_barrier(0); }
    float v[16];
#pragma unroll
    for (int i = 0; i < 8; ++i) { v[2 * i] = acc[i].x; v[2 * i + 1] = acc[i].y; }
    float v8[8], v4[4], v2[2];
#pragma unroll
    for (int j = 0; j < 8; ++j) { const float keep = b3 ? v[8 + j] : v[j], send = b3 ? v[j] : v[8 + j]; v8[j] = keep + dppf<0x128>(send); }
#pragma unroll
    for (int j = 0; j < 4; ++j) { const float keep = b4 ? v8[4 + j] : v8[j], send = b4 ? v8[j] : v8[4 + j]; v4[j] = keep + __shfl_xor(send, 16); }
#pragma unroll
    for (int j = 0; j < 2; ++j) { const float keep = b5 ? v4[2 + j] : v4[j], send = b5 ? v4[j] : v4[2 + j]; v2[j] = keep + __shfl_xor(send, 32); }
    const int tl = (8 * k + (b3 ? 4 : 0) + (b4 ? 2 : 0) + (b5 ? 1 : 0)) * 4;
    const float s0 = __uint_as_float((unsigned)__builtin_amdgcn_ds_permute(tl, (int)__float_as_uint(v2[0]))), s1 = __uint_as_float((unsigned)__builtin_amdgcn_ds_permute(tl, (int)__float_as_uint(v2[1])));
    const int col = 128 * s + 2 * lane;
    o.x += s0; o.y += s1;
    *(unsigned*)(XB + (size_t)t * D + col) = pk2(o.x, o.y);
    const float sq = wave_sum_dpp63(o.x * o.x + o.y * o.y);
    if (lane == 63) ss_out[(size_t)t * 16 + s] = sq;
}
template <int PASS, bool FINAL>
DI void sliced_pass(const unsigned char* TAB, const unsigned short* IDX, const bf16* XBc, bf16* XBw, float* HP, const float* A, float* xf, float* ss_out,
                    unsigned* heads, unsigned* census, volatile LAS unsigned* slot, int wave, int lane, int tid) {
    const int own = (int)(xb_xcc_id() & 7u);
    __syncthreads();
    if (tid == 0) { unsigned all = 1u;
#pragma unroll 1
        for (int q = 0; q < 8; ++q) { const unsigned n = xb_ld(census + XB_XCNT(q)) + xb_ld(census + XB_XCNT(q + 8)); all &= (n > 0u) ? 1u : 0u; }
        slot[1] = all; }
    __syncthreads();
    const int nds = slot[1] ? 1 : 8;
#pragma unroll 1
    for (int ds = 0; ds < nds; ++ds) { const int s = (own + ds) & 7;
        unsigned* head = heads + 64 * s; const unsigned char* Ts = TAB + 128 * s; float* HPs = HP + (size_t)s * T * 128;
        unsigned tk = wave_ticket(head, lane);
        if (tk >= (unsigned)XNG) continue;
        unsigned nxt = wave_ticket(head, lane);
#define TOK_AT(dj) ((j + (dj) < XG) ? (int)tk * XG + j + (dj) : (nxt < (unsigned)XNG ? (int)nxt * XG + j + (dj) - XG : (int)tk * XG + XG - 1))
        int j = 0;
        if (PASS == 0) {
            USmall S0, S1; v4u G0[16], G1[16];
            u_small(S0, IDX, XBc, (int)tk * XG, s, lane); u_small(S1, IDX, XBc, (int)tk * XG + 1, s, lane);
            { const int g = lane >> 3, k = lane & 7;
#pragma unroll
              for (int i = 0; i < 16; ++i) { const unsigned idx = (unsigned)__builtin_amdgcn_ds_bpermute((8 * g + (i & 7)) * 4, i < 8 ? S0.i0 : S0.i1); G0[i] = *(const v4u*)(Ts + (idx * 1024u + 16u * (unsigned)k)); } }
            for (;;) {
#pragma unroll 1
                for (j = 0; j < XG; j += 2) {
                    u_token(S0, G0, S1, G1, Ts, IDX, XBc, HPs, (int)tk * XG + j, TOK_AT(2), s, lane);
                    { const int jj = j; j = jj + 1; const int t3 = TOK_AT(2); j = jj; u_token(S1, G1, S0, G0, Ts, IDX, XBc, HPs, (int)tk * XG + j + 1, t3, s, lane); } }
                if (nxt >= (unsigned)XNG) break; tk = nxt; nxt = wave_ticket(head, lane); }
        } else {
            VSmall S0, S1; v4u G0[16], G1[16];
            v_small(S0, IDX, A, XBw, (int)tk * XG, s, lane); v_small(S1, IDX, A, XBw, (int)tk * XG + 1, s, lane);
            { const int g = lane >> 3, k = lane & 7;
#pragma unroll
              for (int i = 0; i < 16; ++i) { const unsigned idx = (unsigned)__builtin_amdgcn_ds_bpermute((8 * g + (i & 7)) * 4, i < 8 ? S0.i0 : S0.i1); G0[i] = *(const v4u*)(Ts + (idx * 1024u + 16u * (unsigned)k)); } }
            for (;;) {
#pragma unroll 1
                for (j = 0; j < XG; j += 2) {
                    v_token<FINAL>(S0, G0, S1, G1, Ts, IDX, A, xf, XBw, ss_out, (int)tk * XG + j, TOK_AT(2), s, lane);
                    { const int jj = j; j = jj + 1; const int t3 = TOK_AT(2); j = jj; v_token<FINAL>(S1, G1, S0, G0, Ts, IDX, A, xf, XBw, ss_out, (int)tk * XG + j + 1, t3, s, lane); } }
                if (nxt >= (unsigned)XNG) break; tk = nxt; nxt = wave_ticket(head, lane); }
        }
#undef TOK_AT
    }
}
DI void reduce_phase(const float* HP, const float* GATE, const float* ss_in, float* A, int vcu, int G, int tid) {
    const size_t gt = (size_t)vcu * (NWAVES * 64) + tid, NGT = (size_t)G * NWAVES * 64;
    for (size_t c = gt; c < (size_t)T * 128; c += NGT) { float h = 0.f;
#pragma unroll
        for (int s = 0; s < 8; ++s) h += HP[(size_t)s * T * 128 + c];
        h *= pg8::row_rstd(ss_in, (int)(c >> 7));
        A[c] = (1.0f / 1024.0f) * GATE[c] * (0.5f * h * (1.f + erff(h * 0.70710678118654752f))); }
}
DI void final_phase(const float* ss, const bf16* XB, float* outp, const float* fin_g, int vcu, int G, int wave, int lane) {
    for (int m0 = 2 * (vcu * NWAVES + wave); m0 < T; m0 += 2 * G * NWAVES) {
        v4u v[2][2]; float rf[2];
#pragma unroll
        for (int r = 0; r < 2; ++r) { rf[r] = pg8::row_rstd(ss, m0 + r);
#pragma unroll
            for (int j = 0; j < 2; ++j) v[r][j] = *((const v4u*)(XB + (size_t)(m0 + r) * D) + lane + 64 * j); }
#pragma unroll
        for (int r = 0; r < 2; ++r)
#pragma unroll
            for (int j = 0; j < 2; ++j) { const f32x4 g0 = *((const f32x4*)(fin_g + 512 * j) + 2 * lane), g1 = *((const f32x4*)(fin_g + 512 * j) + 2 * lane + 1); const v4u w = v[r][j];
                float* o = outp + (size_t)(m0 + r) * D + 512 * j + 8 * lane;
                *(f32x4*)o = (f32x4){bf_lo(w.x), bf_hi(w.x), bf_lo(w.y), bf_hi(w.y)} * rf[r] * g0; *(f32x4*)(o + 4) = (f32x4){bf_lo(w.z), bf_hi(w.z), bf_lo(w.w), bf_hi(w.w)} * rf[r] * g1; } }
}

DI int t5_bucket(int rel) {
    const int n = rel < 0 ? -rel : rel; int b;
    if (n < 8) b = n; else if (n < 12) b = 8; else if (n < 16) b = 9; else if (n < 23) b = 10; else if (n < 32) b = 11; else if (n < 46) b = 12; else if (n < 64) b = 13; else if (n < 91) b = 14; else b = 15;
    return b + (rel > 0 ? 16 : 0);
}
DI int crow(int reg, int h) { return (reg & 3) + 8 * (reg >> 2) + 4 * h; }
constexpr int AT_KL = 0, AT_KSTR = 144, AT_VT = 384 * AT_KSTR  , AT_VSTR = 776, AT_BT = AT_VT + 64 * AT_VSTR  , AT_END = AT_BT + 4 * 512 * 4;
static_assert(AT_END <= RING_BYTES, "attention LDS");
DI void attn_phase(const bf16* Qg, const bf16* Kg, const bf16* Vg, bf16* AO, const float* rel_bias, const float* sink, LAS unsigned char* lds, int vcu, int G, int wave, int lane, int tid) {
    const int r = lane & 31, h = lane >> 5;
    for (int unit = vcu; unit < BATCH * 4 * (SEQ / 128); unit += G) {
        const int b = unit / 256, kvh = (unit % 256) / 64, blk = unit % 64;
        __syncthreads();
        for (int c = tid; c < 384 * 8; c += NWAVES * 64) { const int row = c >> 3, c8 = c & 7, ts = blk * 128 - 128 + row;
            v4u kv = {0u, 0u, 0u, 0u}, vv = {0u, 0u, 0u, 0u};
            if (ts >= 0 && ts < SEQ) { const size_t g = (size_t)(b * SEQ + ts) * 256 + kvh * 64 + c8 * 8; kv = *(const v4u*)(Kg + g); vv = *(const v4u*)(Vg + g); }
            *(LAS v4u*)(lds + AT_KL + row * AT_KSTR + c8 * 16) = kv;
            LAS unsigned short* vt = (LAS unsigned short*)(lds + AT_VT) + (c8 * 8) * (AT_VSTR / 2) + row;
            vt[0 * (AT_VSTR / 2)] = (unsigned short)(vv.x & 0xffffu); vt[1 * (AT_VSTR / 2)] = (unsigned short)(vv.x >> 16);
            vt[2 * (AT_VSTR / 2)] = (unsigned short)(vv.y & 0xffffu); vt[3 * (AT_VSTR / 2)] = (unsigned short)(vv.y >> 16);
            vt[4 * (AT_VSTR / 2)] = (unsigned short)(vv.z & 0xffffu); vt[5 * (AT_VSTR / 2)] = (unsigned short)(vv.z >> 16);
            vt[6 * (AT_VSTR / 2)] = (unsigned short)(vv.w & 0xffffu); vt[7 * (AT_VSTR / 2)] = (unsigned short)(vv.w >> 16); }
        for (int c = tid; c < 4 * 512; c += NWAVES * 64) { const int g = c >> 9, i = c & 511, rel = i - 255;
            float v = NEGBIG; if (rel >= -128 && rel <= 128) v = rel_bias[t5_bucket(rel) * 16 + kvh * 4 + g] * LOG2E;
            *(LAS float*)(lds + AT_BT + c * 4) = v; }
        __syncthreads();
        const int g = wave >> 1, qh = wave & 1, head = kvh * 4 + g;
        const float sinkl = sink[head] * LOG2E;
        bf16x8 qf[2][4];
#pragma unroll
        for (int qt = 0; qt < 2; ++qt)
#pragma unroll
            for (int s = 0; s < 4; ++s) qf[qt][s] = *(const bf16x8*)(Qg + (size_t)(b * SEQ + blk * 128 + qh * 64 + qt * 32 + r) * D + head * 64 + s * 16 + h * 8);
        float m[2] = {sinkl, sinkl}, l[2] = {0.f, 0.f};
        f32x16 o[2][2];
#pragma unroll
        for (int qt = 0; qt < 2; ++qt)
#pragma unroll
            for (int dt = 0; dt < 2; ++dt)
#pragma unroll
                for (int i = 0; i < 16; ++i) o[qt][dt][i] = 0.f;
        int kt_lo = 2 * qh, kt_hi = 2 * qh + 9;
        if (blk == 0 && kt_lo < 4) kt_lo = 4;
        if (blk == SEQ / 128 - 1 && kt_hi > 7) kt_hi = 7;
#pragma unroll 1
        for (int kt = kt_lo; kt <= kt_hi; ++kt) {
            bf16x8 kf[4];
#pragma unroll
            for (int s = 0; s < 4; ++s) kf[s] = *(const LAS bf16x8*)(lds + AT_KL + (32 * kt + r) * AT_KSTR + s * 32 + h * 16);
            bf16x8 vf[2][2];
#pragma unroll
            for (int dt = 0; dt < 2; ++dt)
#pragma unroll
                for (int s2 = 0; s2 < 2; ++s2) { const LAS unsigned char* vp = lds + AT_VT + (32 * dt + r) * AT_VSTR + (32 * kt + 16 * s2 + 4 * h) * 2;
                    const v2u lo = *(const LAS v2u*)vp, hi2 = *(const LAS v2u*)(vp + 16); v4u w = {lo.x, lo.y, hi2.x, hi2.y}; vf[dt][s2] = __builtin_bit_cast(bf16x8, w); }
#pragma unroll
            for (int qt = 0; qt < 2; ++qt) {
                f32x16 s;
                const LAS float* bt = (const LAS float*)(lds + AT_BT) + g * 512 + 127 + 32 * kt + 4 * h - (64 * qh + 32 * qt + r);
#pragma unroll
                for (int i = 0; i < 16; ++i) s[i] = bt[(i & 3) + 8 * (i >> 2)];
#pragma unroll
                for (int k4 = 0; k4 < 4; ++k4) s = __builtin_amdgcn_mfma_f32_32x32x16_bf16(kf[k4], qf[qt][k4], s, 0, 0, 0);
                float mx = s[0];
#pragma unroll
                for (int i = 1; i < 16; ++i) mx = fmaxf(mx, s[i]);
                mx = fmaxf(mx, __shfl_xor(mx, 32));
                const float mn = fmaxf(m[qt], mx), al = __builtin_amdgcn_exp2f(m[qt] - mn); m[qt] = mn;
                float ps = 0.f;
#pragma unroll
                for (int i = 0; i < 16; ++i) { s[i] = __builtin_amdgcn_exp2f(s[i] - mn); ps += s[i]; }
                l[qt] = l[qt] * al + ps;
#pragma unroll
                for (int dt = 0; dt < 2; ++dt)
#pragma unroll
                    for (int i = 0; i < 16; ++i) o[qt][dt][i] *= al;
                bf16x8 pf[2];
#pragma unroll
                for (int s2 = 0; s2 < 2; ++s2) { v4u w; w.x = pk2(s[8 * s2 + 0], s[8 * s2 + 1]); w.y = pk2(s[8 * s2 + 2], s[8 * s2 + 3]); w.z = pk2(s[8 * s2 + 4], s[8 * s2 + 5]); w.w = pk2(s[8 * s2 + 6], s[8 * s2 + 7]); pf[s2] = __builtin_bit_cast(bf16x8, w); }
#pragma unroll
                for (int dt = 0; dt < 2; ++dt)
#pragma unroll
                    for (int s2 = 0; s2 < 2; ++s2) o[qt][dt] = __builtin_amdgcn_mfma_f32_32x32x16_bf16(vf[dt][s2], pf[s2], o[qt][dt], 0, 0, 0);
            }
        }
#pragma unroll
        for (int qt = 0; qt < 2; ++qt) {
            const float lt = l[qt] + __shfl_xor(l[qt], 32) + __builtin_amdgcn_exp2f(sinkl - m[qt]), inv = 1.0f / lt;
            bf16* op = AO + (size_t)(b * SEQ + blk * 128 + qh * 64 + qt * 32 + r) * D + head * 64 + 4 * h;
#pragma unroll
            for (int dt = 0; dt < 2; ++dt)
#pragma unroll
                for (int gq = 0; gq < 4; ++gq) { v2u w; w.x = pk2(o[qt][dt][4 * gq] * inv, o[qt][dt][4 * gq + 1] * inv); w.y = pk2(o[qt][dt][4 * gq + 2] * inv, o[qt][dt][4 * gq + 3] * inv);
                    *(v2u*)(op + 32 * dt + 8 * gq) = w; }
        }
    }
}

struct Args { const float* in[16]; float* out; unsigned char* ws; int ph_lo, ph_hi; };
__global__ void __launch_bounds__(NWAVES * 64, 2) fwd_kernel(Args args) {
    extern __shared__ __attribute__((aligned(16))) unsigned char lds_raw[];
    LAS unsigned char* lds = (LAS unsigned char*)lds_raw;
    volatile LAS unsigned* MISC = (volatile LAS unsigned*)(lds + MISC_OFF);
    const int tid = threadIdx.x, lane = tid & 63, wave = __builtin_amdgcn_readfirstlane(tid >> 6);
    const int G = gridDim.x; const int bx = blockIdx.x; const int vcu = (G % 8 == 0) ? (bx % 8) * (G / 8) + bx / 8 : bx;
    unsigned char* ws = args.ws;
    unsigned* ctl = (unsigned*)(ws + WS_CTL);
    const float* x = args.in[0]; const float* conv_g = args.in[1]; const float* w_in = args.in[2]; const float* conv_w = args.in[3]; const float* w_out = args.in[4];
    const float* attn_g = args.in[5]; const float* w_qkv = args.in[6]; const float* sink = args.in[7]; const float* w_o = args.in[8]; const float* rel_bias = args.in[9];
    const float* ffn_g = args.in[10]; const float* w_pq = args.in[11]; const float* subk = args.in[12]; const float* pu = args.in[13]; const float* pv = args.in[14]; const float* fin_g = args.in[15];
    float* out = args.out;
    bf16* WinT = (bf16*)(ws + WS_WIN); bf16* WoutT = (bf16*)(ws + WS_WOUT); bf16* WqkvT = (bf16*)(ws + WS_WQKV); bf16* WoT = (bf16*)(ws + WS_WO); bf16* WpqT = (bf16*)(ws + WS_WPQ); bf16* SKb = (bf16*)(ws + WS_SK);
    float* SS = (float*)(ws + WS_SS); unsigned short* IDX = (unsigned short*)(ws + WS_IDX); float* HP = (float*)(ws + WS_HP); float* AA = (float*)(ws + WS_A); float* GATE = (float*)(ws + WS_GATE);
    bf16* XB = (bf16*)(ws + WS_XB); bf16* Y = (bf16*)(ws + WS_Y); unsigned char* U8 = ws + WS_U; unsigned char* V8 = ws + WS_V;
    bf16* G1 = (bf16*)(ws + WS_G1); bf16* PQ = (bf16*)(ws + WS_PQ); bf16* Qb = (bf16*)(ws + WS_Q); bf16* Kb = (bf16*)(ws + WS_K); bf16* VVb = (bf16*)(ws + WS_VV); bf16* AO = (bf16*)(ws + WS_AO);
    float* SS0 = SS; float* SS1 = SS + (size_t)T * 16; float* SS2 = SS + (size_t)2 * T * 16; float* SS3 = SS + (size_t)3 * T * 16; float* SS4 = SS + (size_t)4 * T * 16;

    for (int u = tid; u < (LDS_BYTES - LDSCTL_OFF) / 4; u += NWAVES * 64) ((LAS unsigned*)(lds + LDSCTL_OFF))[u] = 0u;
    __syncthreads();
    XcdBarrier bar; bar.bar = ctl + CW_BAR; bar.x = 0; bar.st = nullptr;
    if (!MK_PER_PHASE) bar = xcd_barrier_post(ctl + CW_BAR, MISC + 8);
    const int lo = args.ph_lo, hi = args.ph_hi;
#define IN(k) (lo <= (k) && (k) < hi)
#define SEAM(k) do { if (IN(k) && IN((k) + 1)) xcd_barrier(bar); } while (0)

    if (IN(0)) REPS(0) {
        P0Args a{x, conv_g, w_in, w_out, attn_g, w_qkv, w_o, ffn_g, w_pq, subk, pu, pv, WinT, WoutT, WqkvT, WoT, WpqT, SKb, U8, V8, XB, SS0};
        p0_prologue(a, lds, vcu, G, wave, lane, tid);
    }
    SEAM(0);
    if (IN(1)) REPS(1) {
        pg8::Gemm g{XB, WinT, T, NIN, D}; pg8::StaticOrder S; S.init(T, NIN, G, bx);
        pg8::EpiBf16RS E{G1, NIN, NIN / 256, nullptr, nullptr, 0, SS0};
        pg8::gemm_phase<pg8::EpiBf16RS, pg8::StaticOrder, true, true>(lds, g, S, E);
    }
    SEAM(1);
    if (IN(2)) REPS(2) conv_gate_phase(G1, conv_w, Y, vcu, G, tid);
    SEAM(2);
    if (IN(3)) REPS(3) {
        pg8::Gemm g{Y, WoutT, T, D, D}; pg8::StaticOrder S; S.init(T, D, G, bx);
        pg8::EpiResid<true> E{x, XB, SS1};
        pg8::gemm_phase<pg8::EpiResid<true>, pg8::StaticOrder, true, true>(lds, g, S, E);
    }
    SEAM(3);
    if (IN(4)) {
        pg8::Gemm g{XB, WpqT, T, NPQ, D}; pg8::StaticOrder S; S.init(T, NPQ, G, bx); EpiRoute E{SS1, IDX, GATE}; pg8::Unit uu;
        for (int i = 0; S.next(i, uu); ++i) { OneUnit O{uu}; pg8::gemm_phase<EpiRoute, OneUnit, false, true>(lds, g, O, E); }
    }
    SEAM(4);
    if (IN(6)) sliced_pass<0, false>(U8, IDX, XB, XB, HP, AA, out, SS2, ctl + CW_WQ + 64 * 0, ctl + CW_BAR, MISC + 12, wave, lane, tid);
    SEAM(6);
    if (IN(7)) reduce_phase(HP, GATE, SS1, AA, vcu, G, tid);
    SEAM(7);
    if (IN(8)) sliced_pass<1, false>(V8, IDX, XB, XB, HP, AA, out, SS2, ctl + CW_WQ + 64 * 8, ctl + CW_BAR, MISC + 12, wave, lane, tid);
    SEAM(8);
    if (IN(9)) REPS(9) {
        pg8::Gemm g{XB, WqkvT, T, NQKV, D}; pg8::StaticOrder S; S.init(T, NQKV, G, bx);
        pg8::EpiBf16RS E{Qb, D, 4, Kb, VVb, 256, SS2};
        pg8::gemm_phase<pg8::EpiBf16RS, pg8::StaticOrder, true, true>(lds, g, S, E);
        if (G == 256 && bx >= 128) { constexpr size_t NB = (size_t)2 * NEXP * D / 2048; table_blocks(pu, pv, ffn_g, U8, V8, NB / 2, NB, (size_t)((bx - 128) * NWAVES + wave), (size_t)128 * NWAVES, lane); }
    }
    SEAM(9);
    if (IN(10)) REPS(10) attn_phase(Qb, Kb, VVb, AO, rel_bias, sink, lds, vcu, G, wave, lane, tid);
    SEAM(10);
    if (IN(11)) {
        pg8::Gemm g{AO, WoT, T, D, D}; pg8::StaticOrder S; S.init(T, D, G, bx);
        pg8::EpiResid<false> E{nullptr, XB, SS3};
        pg8::gemm_phase<pg8::EpiResid<false>, pg8::StaticOrder, true, true>(lds, g, S, E);
    }
    SEAM(11);
    if (IN(12)) {
        pg8::Gemm g{XB, WpqT + (size_t)NPQ * D, T, NPQ, D}; pg8::StaticOrder S; S.init(T, NPQ, G, bx); EpiRoute E{SS3, IDX, GATE}; pg8::Unit uu;
        for (int i = 0; S.next(i, uu); ++i) { OneUnit O{uu}; pg8::gemm_phase<EpiRoute, OneUnit, false, true>(lds, g, O, E); }
    }
    SEAM(12);
    if (IN(14)) sliced_pass<0, true>(U8 + (size_t)NEXP * D, IDX, XB, XB, HP, AA, out, SS4, ctl + CW_WQ + 64 * 16, ctl + CW_BAR, MISC + 12, wave, lane, tid);
    SEAM(14);
    if (IN(15)) reduce_phase(HP, GATE, SS3, AA, vcu, G, tid);
    SEAM(15);
    if (IN(16)) sliced_pass<1, true>(V8 + (size_t)NEXP * D, IDX, XB, XB, HP, AA, out, SS4, ctl + CW_WQ + 64 * 24, ctl + CW_BAR, MISC + 12, wave, lane, tid);
    SEAM(16);
    if (IN(17)) final_phase(SS4, XB, out, fin_g, vcu, G, wave, lane);
#undef IN
#undef SEAM
}

extern "C" void kernel_launch(void* const* d_in, const int* in_sizes, int n_in, void* d_out, int out_size, void* d_ws, size_t ws_size, hipStream_t stream) {
    static int grid = 0;
    if (grid == 0) {
        if (n_in != 16 || in_sizes[0] != T * D || out_size != T * D || ws_size < WS_END) { fprintf(stderr, "kernel_launch: unexpected shapes (n_in %d, in0 %d, out %d, ws %zu)\n", n_in, n_in > 0 ? in_sizes[0] : -1, out_size, ws_size); grid = -1; return; }
        int dev = 0, cus = 0, per_cu = 0;
        if (hipGetDevice(&dev) != hipSuccess || hipDeviceGetAttribute(&cus, hipDeviceAttributeMultiprocessorCount, dev) != hipSuccess) { grid = -1; return; }
        if (hipFuncSetAttribute((const void*)fwd_kernel, hipFuncAttributeMaxDynamicSharedMemorySize, LDS_BYTES) != hipSuccess) { fprintf(stderr, "kernel_launch: hipFuncSetAttribute failed\n"); grid = -1; return; }
        if (hipOccupancyMaxActiveBlocksPerMultiprocessor(&per_cu, (const void*)fwd_kernel, NWAVES * 64, LDS_BYTES) != hipSuccess || per_cu < 1) { fprintf(stderr, "kernel_launch: occupancy query says %d blocks per CU\n", per_cu); (void)hipGetLastError(); grid = -1; return; }
        grid = cus;
    }
    if (grid < 0) return;
    (void)hipMemsetAsync((char*)d_ws + WS_CTL, 0, CTL_ZERO_BYTES, stream);
    Args a{};
    for (int i = 0; i < 16; ++i) a.in[i] = (const float*)d_in[i];
    a.out = (float*)d_out; a.ws = (unsigned char*)d_ws;
#if MK_PER_PHASE
    for (int p = 0; p < NPH; ++p) { a.ph_lo = p; a.ph_hi = p + 1; hipLaunchKernelGGL(fwd_kernel, dim3(grid), dim3(NWAVES * 64), LDS_BYTES, stream, a); }
#else
    a.ph_lo = 0; a.ph_hi = NPH;
    hipLaunchKernelGGL(fwd_kernel, dim3(grid), dim3(NWAVES * 64), LDS_BYTES, stream, a);
#endif
}
```

```cpp
#include <hip/hip_runtime.h>
#include <cstdio>
#include <cstdint>
namespace pg8 {
#define PG8_LAS __attribute__((address_space(3)))
typedef unsigned short bf16_t;
typedef short bf16x8 __attribute__((ext_vector_type(8)));
typedef float f32x4 __attribute__((ext_vector_type(4)));
typedef unsigned u32x4 __attribute__((ext_vector_type(4)));
constexpr int BM = 256, BK = 64, HALF = 128, HTB = HALF * BK * 2  , STAGE_BYTES = 8 * HTB, NXCD = 8, WGM = 8;

__host__ __device__ __forceinline__ int lds_byte(int r, int c) { const int st = (r >> 4) * 2 + (c >> 5), rr = r & 15, cc = c & 31, ob = rr * 64 + cc * 2; return st * 1024 + (ob ^ (((ob >> 9) & 1) << 5)); }
__host__ __device__ __forceinline__ void stage_rc(int b, int& R, int& C) { const int st = b / 1024, sb = b % 1024, swz = sb ^ (((sb >> 9) & 1) << 5); R = (st >> 1) * 16 + swz / 64; C = (st & 1) * 32 + (swz % 64) / 2; }
__host__ __device__ __forceinline__ int perm32(int rho) { const int n = rho >> 4, i = rho & 15; return 8 * (i >> 2) + 4 * n + (i & 3); }

struct Unit { int pm, pn; };
struct Gemm { const bf16_t* A; const bf16_t* Bt; int M, N, K; };

struct StaticOrder {
    int nM, nN, nwg, G, c;
    __host__ __device__ void init(int M, int N, int G_, int c_) { nM = M / BM; nN = N / BM; nwg = nM * nN; G = G_; c = c_; }
    __host__ __device__ bool next(int i, Unit& u) const {
        const long L = (long)i * G + c; if (L >= nwg) return false;
        int wgid = (int)L; { const int q = nwg / NXCD, r = nwg % NXCD, xcd = wgid % NXCD, off = wgid / NXCD; wgid = (xcd < r ? xcd * (q + 1) : r * (q + 1) + (xcd - r) * q) + off; }
        const int nig = WGM * nN, gid = wgid / nig, fm = gid * WGM, gsz = (nM - fm) < WGM ? (nM - fm) : WGM;
        u.pm = fm + ((wgid % nig) % gsz); u.pn = (wgid % nig) / gsz; return true;
    }
    __device__ __forceinline__ void a_ready(const Unit&) const {}
    __device__ __forceinline__ void done(const Unit&) const {}
};

__device__ __forceinline__ unsigned cvt_pk_bf16(float lo, float hi) { unsigned r; asm volatile("v_cvt_pk_bf16_f32 %0, %1, %2" : "=v"(r) : "v"(lo), "v"(hi)); return r; }
typedef unsigned u32x2 __attribute__((ext_vector_type(2)));
__device__ __forceinline__ float row_rstd(const float* ss, int row) {
    const f32x4* p = (const f32x4*)(ss + (size_t)row * 16);
    const f32x4 a = p[0], b = p[1], c = p[2], d = p[3];
    const float s = (((a[0] + a[1]) + (a[2] + a[3])) + ((b[0] + b[1]) + (b[2] + b[3]))) + (((c[0] + c[1]) + (c[2] + c[3])) + ((d[0] + d[1]) + (d[2] + d[3])));
    return __builtin_amdgcn_rsqf(s * (1.0f / 1024.0f) + 1e-6f);
}
struct EpiBf16RS {
    static constexpr bool PERM = true, AFTER_DRAIN = false;
    bf16_t* O0; int ld0; int nt0; bf16_t* O1; bf16_t* O2; int ld1; const float* ss;
    __device__ __forceinline__ void operator()(const f32x4 (&acc)[2][2][4][2], const Unit& u, int wr, int wc, int fr, int fq) const {
        bf16_t* base; int ld, colt;
        if (u.pn < nt0) { base = O0; ld = ld0; colt = u.pn * BM; } else if (u.pn == nt0) { base = O1; ld = ld1; colt = 0; } else { base = O2; ld = ld1; colt = (u.pn - nt0 - 1) * BM; }
        const int row0 = u.pm * BM + wr * 64 + fr, col0 = colt + wc * 32 + 8 * fq;
#pragma unroll
        for (int ai = 0; ai < 2; ++ai)
#pragma unroll
            for (int m = 0; m < 4; ++m) { const int row = row0 + ai * HALF + m * 16; const float rs = row_rstd(ss, row); bf16_t* rowp = base + (size_t)row * ld + col0;
#pragma unroll
                for (int bj = 0; bj < 2; ++bj) { const f32x4 v0 = acc[ai][bj][m][0] * rs, v1 = acc[ai][bj][m][1] * rs;
                    u32x4 w; w.x = cvt_pk_bf16(v0[0], v0[1]); w.y = cvt_pk_bf16(v0[2], v0[3]); w.z = cvt_pk_bf16(v1[0], v1[1]); w.w = cvt_pk_bf16(v1[2], v1[3]);
                    *(u32x4*)(rowp + bj * HALF) = w; } }
    }
};
struct EpiConvIn {
    static constexpr bool PERM = true, AFTER_DRAIN = false;
    bf16_t* P; bf16_t* GB; const float* ss;
    __device__ __forceinline__ void operator()(const f32x4 (&acc)[2][2][4][2], const Unit& u, int wr, int wc, int fr, int fq) const {
        const int row0 = u.pm * BM + wr * 64 + fr;
#pragma unroll
        for (int ai = 0; ai < 2; ++ai)
#pragma unroll
            for (int m = 0; m < 4; ++m) { const int row = row0 + ai * HALF + m * 16; const float rs = row_rstd(ss, row);
                if (u.pn < 8) { const float r2 = rs * rs; const f32x4 v0 = acc[ai][0][m][0] * acc[ai][1][m][0] * r2, v1 = acc[ai][0][m][1] * acc[ai][1][m][1] * r2;
                    u32x4 w; w.x = cvt_pk_bf16(v0[0], v0[1]); w.y = cvt_pk_bf16(v0[2], v0[3]); w.z = cvt_pk_bf16(v1[0], v1[1]); w.w = cvt_pk_bf16(v1[2], v1[3]);
                    *(u32x4*)(P + (size_t)row * 1024 + u.pn * 128 + wc * 32 + 8 * fq) = w;
                } else {
#pragma unroll
                    for (int bj = 0; bj < 2; ++bj) { const f32x4 v0 = acc[ai][bj][m][0] * rs, v1 = acc[ai][bj][m][1] * rs;
                        u32x4 w; w.x = cvt_pk_bf16(v0[0], v0[1]); w.y = cvt_pk_bf16(v0[2], v0[3]); w.z = cvt_pk_bf16(v1[0], v1[1]); w.w = cvt_pk_bf16(v1[2], v1[3]);
                        *(u32x4*)(GB + (size_t)row * 1024 + (u.pn - 8) * BM + bj * HALF + wc * 32 + 8 * fq) = w; } } }
    }
};
template <bool BASEF32> struct EpiResid {
    static constexpr bool PERM = true, AFTER_DRAIN = false;
    const float* basef; bf16_t* xb; float* ss;
    __device__ __forceinline__ void operator()(const f32x4 (&acc)[2][2][4][2], const Unit& u, int wr, int wc, int fr, int fq) const {
        const int row0 = u.pm * BM + wr * 64 + fr, col0 = u.pn * BM + wc * 32 + 8 * fq;
#pragma unroll
        for (int ai = 0; ai < 2; ++ai)
#pragma unroll
            for (int m = 0; m < 4; ++m) { const int row = row0 + ai * HALF + m * 16; float sq = 0.f;
#pragma unroll
                for (int bj = 0; bj < 2; ++bj) { const size_t off = (size_t)row * 1024 + col0 + bj * HALF;
                    f32x4 b0, b1;
                    if (BASEF32) { b0 = *(const f32x4*)(basef + off); b1 = *(const f32x4*)(basef + off + 4); }
                    else { const u32x4 w = *(const u32x4*)(xb + off);
                        b0 = (f32x4){__uint_as_float(w.x << 16), __uint_as_float(w.x & 0xffff0000u), __uint_as_float(w.y << 16), __uint_as_float(w.y & 0xffff0000u)};
                        b1 = (f32x4){__uint_as_float(w.z << 16), __uint_as_float(w.z & 0xffff0000u), __uint_as_float(w.w << 16), __uint_as_float(w.w & 0xffff0000u)}; }
                    const f32x4 o0 = b0 + acc[ai][bj][m][0], o1 = b1 + acc[ai][bj][m][1];
                    sq += ((o0[0] * o0[0] + o0[1] * o0[1]) + (o0[2] * o0[2] + o0[3] * o0[3])) + ((o1[0] * o1[0] + o1[1] * o1[1]) + (o1[2] * o1[2] + o1[3] * o1[3]));
                    u32x4 w; w.x = cvt_pk_bf16(o0[0], o0[1]); w.y = cvt_pk_bf16(o0[2], o0[3]); w.z = cvt_pk_bf16(o1[0], o1[1]); w.w = cvt_pk_bf16(o1[2], o1[3]);
                    *(u32x4*)(xb + off) = w; }
                sq += __shfl_xor(sq, 16); sq += __shfl_xor(sq, 32);
                if (fq == 0) ss[(size_t)row * 16 + u.pn * 4 + wc] = sq; }
    }
};

template <class Epi, class Sched, bool ALIGN_EPI = false, bool SP2 = false>
__device__ __forceinline__ void gemm_phase(PG8_LAS unsigned char* lds, const Gemm g, const Sched& S, const Epi& E) {
    const int tid = threadIdx.x, wid = __builtin_amdgcn_readfirstlane(tid >> 6), lane = tid & 63, wr = wid >> 2, wc = wid & 3, fr = lane & 15, fq = lane >> 4;
    const int K = g.K, nt = K / BK;
    unsigned voffA[2], voffB[2];
#pragma unroll
    for (int i = 0; i < 2; ++i) { int R, C; stage_rc(tid * 16 + i * 8192, R, C); const int Rb = Epi::PERM ? ((R & ~31) + perm32(R & 31)) : R;
        voffA[i] = (unsigned)(R * K + C) * 2u; voffB[i] = (unsigned)(Rb * K + C) * 2u; }
    const size_t kstep = (size_t)(BK * 2);
    const size_t hstep = (size_t)HALF * K * 2;
    const size_t tstep = 2 * hstep;
    const unsigned ldsw = (unsigned)wid * 1024u;
    const int aoff = lds_byte(wr * 64 + fr, fq * 8), boff = lds_byte(wc * 32 + fr, fq * 8);
#define PG8_SA(b, h) (((b) * 2 + (h)) * HTB)
#define PG8_SB(b, h) ((4 + (b) * 2 + (h)) * HTB)
#define PG8_STAGE(bufoff, gbase, voff) do { _Pragma("unroll") for (int _i = 0; _i < 2; ++_i) \
        __builtin_amdgcn_global_load_lds((const unsigned*)((const char*)(gbase) + (voff)[_i]), (PG8_LAS unsigned*)(lds + (bufoff) + ldsw + _i * 8192), 16, 0, 0); } while (0)
#define PG8_LDA(dst, b, h) do { _Pragma("unroll") for (int m = 0; m < 4; ++m) _Pragma("unroll") for (int k = 0; k < 2; ++k) dst[m][k] = *(const PG8_LAS bf16x8*)(lds + PG8_SA(b, h) + aoff + m * 2048 + k * 1024); } while (0)
#define PG8_LDB(dst, b, h) do { _Pragma("unroll") for (int n = 0; n < 2; ++n) _Pragma("unroll") for (int k = 0; k < 2; ++k) dst[n][k] = *(const PG8_LAS bf16x8*)(lds + PG8_SB(b, h) + boff + n * 2048 + k * 1024); } while (0)
#define PG8_MMA(ai, bj, At, Bt) do { __builtin_amdgcn_s_setprio(1); _Pragma("unroll") for (int m = 0; m < 4; ++m) _Pragma("unroll") for (int n = 0; n < 2; ++n) _Pragma("unroll") for (int k = 0; k < 2; ++k) \
        acc[ai][bj][m][n] = __builtin_amdgcn_mfma_f32_16x16x32_bf16(Bt[n][k], At[m][k], acc[ai][bj][m][n], 0, 0, 0); __builtin_amdgcn_s_setprio(0); } while (0)
#define PG8_WAIT_V(n) asm volatile("s_waitcnt vmcnt(" #n ")" ::: "memory")
#define PG8_WAIT_L(n) asm volatile("s_waitcnt lgkmcnt(" #n ")" ::: "memory")
#define PG8_BAR __builtin_amdgcn_s_barrier()
#define PG8_SCHED __builtin_amdgcn_sched_barrier(0)
    Unit cur, nxt; int ui = 0;
    if (!S.next(0, cur)) return;
    f32x4 acc[2][2][4][2];
#pragma unroll
    for (int a = 0; a < 2; ++a)
#pragma unroll
        for (int b = 0; b < 2; ++b)
#pragma unroll
            for (int m = 0; m < 4; ++m)
#pragma unroll
                for (int n = 0; n < 2; ++n) acc[a][b][m][n] = (f32x4){0.f, 0.f, 0.f, 0.f};
    bf16x8 At[4][2], B0[2][2], B1[2][2];
    const char* cA = (const char*)g.A + (size_t)cur.pm * tstep; const char* cB = (const char*)g.Bt + (size_t)cur.pn * tstep;
    S.a_ready(cur);
    if constexpr (SP2) {
        PG8_STAGE(PG8_SB(0, 0), cB, voffB); PG8_STAGE(PG8_SB(0, 1), cB + hstep, voffB); PG8_STAGE(PG8_SA(0, 0), cA, voffA); PG8_STAGE(PG8_SA(0, 1), cA + hstep, voffA);
        if (wr == 1) PG8_BAR;
        PG8_WAIT_V(2); PG8_BAR;
        PG8_STAGE(PG8_SB(1, 0), cB + kstep, voffB); PG8_STAGE(PG8_SA(1, 0), cA + kstep, voffA); PG8_STAGE(PG8_SB(1, 1), cB + hstep + kstep, voffB);
        PG8_WAIT_V(6); PG8_BAR;
    } else {
        PG8_STAGE(PG8_SB(0, 0), cB, voffB); PG8_STAGE(PG8_SA(0, 0), cA, voffA); PG8_STAGE(PG8_SB(0, 1), cB + hstep, voffB); PG8_STAGE(PG8_SA(0, 1), cA + hstep, voffA);
        if (wr == 1) PG8_BAR;
        PG8_WAIT_V(4); PG8_BAR;
        PG8_STAGE(PG8_SB(1, 0), cB + kstep, voffB); PG8_STAGE(PG8_SA(1, 0), cA + kstep, voffA); PG8_STAGE(PG8_SB(1, 1), cB + hstep + kstep, voffB);
        PG8_WAIT_V(6); PG8_BAR;
    }
    for (;;) {
        const bool has_next = S.next(ui + 1, nxt);
        const char* nA = has_next ? (const char*)g.A + (size_t)nxt.pm * tstep : cA; const char* nB = has_next ? (const char*)g.Bt + (size_t)nxt.pn * tstep : cB;
        for (int t = 0; t < nt; t += 2) {
            const bool last = (t == nt - 2);
            const char* a1 = cA + (size_t)(t + 1) * kstep;
            const char* a2 = last ? nA : cA + (size_t)(t + 2) * kstep; const char* b2 = last ? nB : cB + (size_t)(t + 2) * kstep;
            const char* a3 = a2 + kstep; const char* b3 = b2 + kstep;
            if (last && has_next) S.a_ready(nxt);
            if constexpr (SP2) {
            PG8_LDB(B0, 0, 0); PG8_LDB(B1, 0, 1); PG8_SCHED; PG8_LDA(At, 0, 0); PG8_STAGE(PG8_SA(1, 1), a1 + hstep, voffA);
            PG8_WAIT_V(8); PG8_WAIT_L(0); PG8_BAR; PG8_MMA(0, 0, At, B0); PG8_MMA(0, 1, At, B1); PG8_BAR; PG8_SCHED;
            PG8_LDA(At, 0, 1); PG8_STAGE(PG8_SB(0, 0), b2, voffB); PG8_STAGE(PG8_SB(0, 1), b2 + hstep, voffB); PG8_STAGE(PG8_SA(0, 0), a2, voffA);
            PG8_WAIT_V(8); PG8_WAIT_L(0); PG8_BAR; PG8_MMA(1, 0, At, B0); PG8_MMA(1, 1, At, B1); PG8_BAR; PG8_SCHED;
            PG8_LDB(B0, 1, 0); PG8_LDB(B1, 1, 1); PG8_SCHED; PG8_LDA(At, 1, 0); PG8_STAGE(PG8_SA(0, 1), a2 + hstep, voffA);
            PG8_WAIT_V(8); PG8_WAIT_L(0); PG8_BAR; PG8_MMA(0, 0, At, B0); PG8_MMA(0, 1, At, B1); PG8_BAR; PG8_SCHED;
            PG8_LDA(At, 1, 1); PG8_STAGE(PG8_SB(1, 0), b3, voffB); PG8_STAGE(PG8_SB(1, 1), b3 + hstep, voffB); PG8_STAGE(PG8_SA(1, 0), a3, voffA);
            PG8_WAIT_V(8); PG8_WAIT_L(0); PG8_BAR; PG8_MMA(1, 0, At, B0); PG8_MMA(1, 1, At, B1); PG8_BAR; PG8_SCHED;
            } else {
            PG8_LDB(B0, 0, 0); PG8_SCHED; PG8_LDA(At, 0, 0); PG8_STAGE(PG8_SA(1, 1), a1 + hstep, voffA);
            PG8_WAIT_L(8); PG8_BAR; PG8_WAIT_L(0); PG8_MMA(0, 0, At, B0); PG8_BAR; PG8_SCHED;
            PG8_LDB(B1, 0, 1); PG8_STAGE(PG8_SB(0, 0), b2, voffB);
            PG8_BAR; PG8_WAIT_L(0); PG8_MMA(0, 1, At, B1); PG8_BAR;
            PG8_LDA(At, 0, 1); PG8_STAGE(PG8_SA(0, 0), a2, voffA);
            PG8_BAR; PG8_WAIT_L(0); PG8_MMA(1, 0, At, B0); PG8_BAR; PG8_SCHED;
            PG8_STAGE(PG8_SB(0, 1), b2 + hstep, voffB);
            PG8_WAIT_V(6); PG8_BAR; PG8_MMA(1, 1, At, B1); PG8_BAR;
            PG8_LDB(B0, 1, 0); PG8_SCHED; PG8_LDA(At, 1, 0); PG8_STAGE(PG8_SA(0, 1), a2 + hstep, voffA);
            PG8_WAIT_L(8); PG8_BAR; PG8_WAIT_L(0); PG8_MMA(0, 0, At, B0); PG8_BAR; PG8_SCHED;
            PG8_LDB(B1, 1, 1); PG8_STAGE(PG8_SB(1, 0), b3, voffB);
            PG8_BAR; PG8_WAIT_L(0); PG8_MMA(0, 1, At, B1); PG8_BAR;
            PG8_LDA(At, 1, 1); PG8_STAGE(PG8_SA(1, 0), a3, voffA);
            PG8_BAR; PG8_WAIT_L(0); PG8_MMA(1, 0, At, B0); PG8_BAR; PG8_SCHED;
            PG8_STAGE(PG8_SB(1, 1), b3 + hstep, voffB);
            PG8_WAIT_V(6); PG8_BAR; PG8_MMA(1, 1, At, B1); PG8_BAR;
            }
        }
        if constexpr (ALIGN_EPI) { if (wr == 0) PG8_BAR; }
        if constexpr (!Epi::AFTER_DRAIN) { E(acc, cur, wr, wc, fr, fq); S.done(cur); }
        if (!has_next) break;
#pragma unroll
        for (int a = 0; a < 2; ++a)
#pragma unroll
            for (int b = 0; b < 2; ++b)
#pragma unroll
                for (int m = 0; m < 4; ++m)
#pragma unroll
                    for (int n = 0; n < 2; ++n) acc[a][b][m][n] = (f32x4){0.f, 0.f, 0.f, 0.f};
        cur = nxt; cA = nA; cB = nB; ++ui;
        if constexpr (ALIGN_EPI) { if (wr == 1) PG8_BAR; }
    }
    PG8_WAIT_V(0);
    if constexpr (!ALIGN_EPI) { if (wr == 0) PG8_BAR; }
    PG8_BAR;
    if constexpr (Epi::AFTER_DRAIN) { E.fused(acc, cur, wr, wc, fr, fq, lds, wid, lane); S.done(cur); }
#undef PG8_SA
#undef PG8_SB
#undef PG8_STAGE
#undef PG8_LDA
#undef PG8_LDB
#undef PG8_MMA
#undef PG8_WAIT_V
#undef PG8_WAIT_L
#undef PG8_BAR
#undef PG8_SCHED
}
}

constexpr int NWAVES = 8;
constexpr int BATCH = 2, SEQ = 8192, D = 1024, T = BATCH * SEQ;
constexpr int NIN = 3072, NQKV = 1536, NPQ = 2048, NEXP = 16384;
constexpr float LOG2E = 1.4426950408889634f;
constexpr float QSCALE = 0.125f * LOG2E;
constexpr float NEGBIG = -1e30f;
#ifndef MK_PER_PHASE
#define MK_PER_PHASE 0
#endif
constexpr int NPH = 18;
#ifndef REP_MASK
#define REP_MASK 0
#endif
#define REPS(k) for (int rep_ = 0; rep_ < (((REP_MASK) >> (k)) & 1) + 1; ++rep_)

constexpr size_t MiB = 1u << 20;
constexpr size_t WS_CTL = 0, CTL_ZERO_BYTES = 65536;
constexpr size_t WS_WIN = 1 * MiB, WS_WOUT = 7 * MiB, WS_WQKV = 9 * MiB, WS_WO = 12 * MiB, WS_WPQ = 14 * MiB, WS_SK = 22 * MiB;
constexpr size_t WS_SS = 23 * MiB;
constexpr size_t WS_IDX = 28 * MiB, WS_GATE = 36 * MiB, WS_XB = 44 * MiB, WS_Y = 76 * MiB, WS_U = 108 * MiB, WS_V = 172 * MiB;
constexpr size_t WS_G1 = 236 * MiB, WS_PQ = 332 * MiB, WS_Q = 396 * MiB, WS_K = 428 * MiB, WS_VV = 436 * MiB, WS_AO = 444 * MiB, WS_END = 476 * MiB;
constexpr size_t WS_HP = WS_G1, WS_A = WS_G1 + 64 * MiB;
constexpr int CW_BAR = 4096;
constexpr int CW_WQ = 8192;

constexpr int RING_BYTES = 131072;
constexpr int LDSCTL_OFF = 143360, MISC_OFF = LDSCTL_OFF + 320;
constexpr int SC_STRIDE = 260, SC_TAB_OFF = 135168;
constexpr int LDS_BYTES = 147456;

#define LAS __attribute__((address_space(3)))
typedef unsigned short bf16;
typedef unsigned v4u __attribute__((ext_vector_type(4)));
typedef unsigned v2u __attribute__((ext_vector_type(2)));
typedef float f32x4 __attribute__((ext_vector_type(4)));
typedef float f32x2 __attribute__((ext_vector_type(2)));
typedef float f32x16 __attribute__((ext_vector_type(16)));
typedef short bf16x8 __attribute__((ext_vector_type(8)));
typedef __bf16 bf16x2_t __attribute__((ext_vector_type(2)));
#define LDS_WAIT() asm volatile("s_waitcnt lgkmcnt(0)" ::: "memory")
#define DI __device__ __forceinline__

DI unsigned pk2(float lo, float hi) { f32x2 v = {lo, hi}; bf16x2_t b = __builtin_convertvector(v, bf16x2_t); return __builtin_bit_cast(unsigned, b); }
DI float bf_lo(unsigned u) { return __uint_as_float(u << 16); }
DI float bf_hi(unsigned u) { return __uint_as_float(u & 0xffff0000u); }
DI float wave_sum(float v) {
#pragma unroll
    for (int o = 1; o < 64; o <<= 1) v += __shfl_xor(v, o);
    return v;
}
#define XB_TMO      128
#define XB_XCNT(j)  (256  + 64 * (j))
#define XB_XSUB(j)  (1280 + 64 * (j))
#define XB_XGEN(j)  (2304 + 64 * (j))
#define XB_TOP      3328
#define XB_TOPGEN   3392
#define XCD_BAR_WORDS 3456
#define XB_SPIN_CAP (1u << 18)

__device__ __forceinline__ unsigned xb_ld(unsigned* p)              { return __hip_atomic_load(p, __ATOMIC_RELAXED, __HIP_MEMORY_SCOPE_AGENT); }
__device__ __forceinline__ unsigned xb_add(unsigned* p, unsigned v) { return __hip_atomic_fetch_add(p, v, __ATOMIC_RELAXED, __HIP_MEMORY_SCOPE_AGENT); }
__device__ __forceinline__ unsigned xb_xcc_id() { return (unsigned)__builtin_amdgcn_s_getreg((3 << 11) | 20) & 0xFu; }
#define XB_SPIN(cond, bar) do { unsigned _sp = 0; while (cond) { __builtin_amdgcn_s_sleep(1); \
    if ((++_sp & 255u) == 0u) { if (xb_ld(&(bar)[XB_TMO])) break; if (_sp > XB_SPIN_CAP) { atomicAdd(&(bar)[XB_TMO], 1u); break; } } } } while (0)

struct XcdBarrier {
    unsigned* bar; unsigned x;
    volatile LAS unsigned* st;
};

__device__ __forceinline__ XcdBarrier xcd_barrier_post(unsigned* bar, volatile LAS unsigned* st) {
    XcdBarrier b; b.bar = bar; b.x = xb_xcc_id(); b.st = st;
    if (threadIdx.x == 0) (void)xb_add(&bar[XB_XCNT(b.x)], 1u);
    return b;
}
__device__ __forceinline__ void xcd_barrier_complete(unsigned* bar, unsigned x, unsigned& nloc, unsigned& nx) {
    const unsigned G = gridDim.x * gridDim.y * gridDim.z;
    unsigned sum, cnt, mine, sp = 0u;
    for (;;) {
        sum = 0u; cnt = 0u; mine = 0u;
#pragma unroll
        for (unsigned j = 0; j < 16; ++j) { const unsigned c = xb_ld(&bar[XB_XCNT(j)]); sum += c; cnt += (c > 0u) ? 1u : 0u; mine = (j == x) ? c : mine; }
        if (sum == G) break;
        __builtin_amdgcn_s_sleep(1);
        if ((++sp & 255u) == 0u) { if (xb_ld(&bar[XB_TMO])) break; if (sp > XB_SPIN_CAP) { atomicAdd(&bar[XB_TMO], 1u); break; } }
    }
    nloc = mine > 0u ? mine : 1u; nx = cnt > 0u ? cnt : 1u;
}

__device__ __forceinline__ void xcd_barrier(const XcdBarrier& b) {
    asm volatile("s_waitcnt vmcnt(0)" ::: "memory");
    __syncthreads();
    if (threadIdx.x == 0) {
        unsigned* bar = b.bar;
        __builtin_amdgcn_s_waitcnt(0);
        unsigned nloc = b.st[0], nx = b.st[1];
        if (nloc == 0u) { xcd_barrier_complete(bar, b.x, nloc, nx); b.st[0] = nloc; b.st[1] = nx; }
        const unsigned old = xb_add(&bar[XB_XSUB(b.x)], 1u);
        const unsigned gen = old / nloc;
        if (old + 1u == (gen + 1u) * nloc) {
            __builtin_amdgcn_fence(__ATOMIC_RELEASE, "agent");
            asm volatile("s_waitcnt vmcnt(0)" ::: "memory");
            const unsigned og = xb_add(&bar[XB_TOP], 1u);
            const unsigned tg = og / nx;
            if (og + 1u == (tg + 1u) * nx) xb_add(&bar[XB_TOPGEN], 1u);
            else XB_SPIN(xb_ld(&bar[XB_TOPGEN]) == tg, bar);
            __builtin_amdgcn_fence(__ATOMIC_ACQUIRE, "agent");
            xb_add(&bar[XB_XGEN(b.x)], 1u);
            asm volatile("s_waitcnt vmcnt(0)" ::: "memory");
        } else {
            XB_SPIN(xb_ld(&bar[XB_XGEN(b.x)]) == gen, bar);
            __builtin_amdgcn_fence(__ATOMIC_ACQUIRE, "agent");
            asm volatile("s_waitcnt vmcnt(0)" ::: "memory");
        }
    }
    __syncthreads();
}

template <bool REMAP = false>
DI void p0_transpose_item(const float* W, int K, int N, bf16* WT, LAS float* scr, int item, int lane, const float* gain, int nscaled, float cscale) {
    const int nblk = N / 32, kb = item / nblk, nb = item % nblk, k0 = 64 * kb, n0 = 32 * nb;
    float tv[32];
#pragma unroll
    for (int i = 0; i < 32; ++i) tv[i] = W[(size_t)(k0 + 2 * i + (lane >> 5)) * N + n0 + (lane & 31)];
#pragma unroll
    for (int i = 0; i < 32; ++i) { const int kk = 2 * i + (lane >> 5); float v = tv[i]; if (gain) v *= gain[k0 + kk]; scr[kk * 33 + (lane & 31)] = v; }
    LDS_WAIT();
    const int c = lane & 7;
#pragma unroll
    for (int j = 0; j < 4; ++j) { const int n = (lane >> 3) + 8 * j; const LAS float* s = scr + (8 * c) * 33 + n; const float cs = (n0 + n < nscaled) ? cscale : 1.f;
        v4u o; o.x = pk2(s[0 * 33] * cs, s[1 * 33] * cs); o.y = pk2(s[2 * 33] * cs, s[3 * 33] * cs); o.z = pk2(s[4 * 33] * cs, s[5 * 33] * cs); o.w = pk2(s[6 * 33] * cs, s[7 * 33] * cs);
        int drow = n0 + n; if (REMAP) { const int part = drow >> 10, d = drow & 1023; drow = part == 0 ? 2048 + d : 256 * (d >> 7) + (d & 127) + (part == 2 ? 128 : 0); }
        *(v4u*)(WT + (size_t)drow * K + k0 + 8 * c) = o; }
    LDS_WAIT();
}
DI void table_blocks(const float* pu, const float* pv, const float* ffn_g, unsigned char* U8, unsigned char* V8, size_t b0, size_t b1, size_t w, size_t nw, int lane) {
    constexpr size_t NB = (size_t)2 * NEXP * D / 2048;
    for (size_t blk = b0 + w; blk < b1; blk += nw) { const bool isv = blk >= NB; const size_t bb = isv ? blk - NB : blk; const int layer = (int)(bb / (NB / 2));
        const float* src = (isv ? pv : pu) + bb * 2048; unsigned char* dst = (isv ? V8 : U8) + bb * 2048;
        f32x4 v[8];
#pragma unroll
        for (int j = 0; j < 8; ++j) v[j] = __builtin_nontemporal_load((const f32x4*)(src + 256 * j) + lane);
#pragma unroll
        for (int j = 0; j < 8; ++j) { unsigned wd;
            if (isv) { const f32x4 t = v[j] * 1024.0f; int wi = __builtin_amdgcn_cvt_pk_fp8_f32(t[0], t[1], 0, false); wi = __builtin_amdgcn_cvt_pk_fp8_f32(t[2], t[3], wi, true); wd = (unsigned)wi; }
            else { const f32x4 g = *((const f32x4*)(ffn_g + layer * D + 256 * (j & 3)) + lane); const f32x4 t = v[j] * g * 512.0f; wd = 0u;
#pragma unroll
                for (int e = 0; e < 4; ++e) { const int qi = (int)__builtin_rintf(fminf(fmaxf(t[e], -127.f), 127.f)); wd |= ((unsigned)qi & 0xffu) << (8 * e); } }
            *((unsigned*)(dst + 256 * j) + lane) = wd; } }
}
struct P0Args { const float *x, *conv_g, *w_in, *w_out, *attn_g, *w_qkv, *w_o, *ffn_g, *w_pq, *subk, *pu, *pv;
                bf16 *WinT, *WoutT, *WqkvT, *WoT, *WpqT, *SKb; unsigned char *U8, *V8; bf16* XB; float* SS0; };
DI void p0_prologue(const P0Args& a, LAS unsigned char* lds, int vcu, int G, int wave, int lane, int tid) {
    LAS float* scr = (LAS float*)(lds + wave * 16384);
    const int gw = vcu * NWAVES + wave, NGW = G * NWAVES;
    constexpr int I_IN = 16 * (NIN / 32), I_OUT = 16 * (D / 32), I_QKV = 16 * (NQKV / 32), I_O = I_OUT;
    constexpr int NITEMS = I_IN + I_OUT + I_QKV + I_O;
    for (int it = gw; it < NITEMS; it += NGW) {
        int r = it;
        if (r < I_IN) { p0_transpose_item<true>(a.w_in, D, NIN, a.WinT, scr, r, lane, a.conv_g, 0, 1.f); continue; } r -= I_IN;
        if (r < I_OUT) { p0_transpose_item(a.w_out, D, D, a.WoutT, scr, r, lane, nullptr, 0, 1.f); continue; } r -= I_OUT;
        if (r < I_QKV) { p0_transpose_item(a.w_qkv, D, NQKV, a.WqkvT, scr, r, lane, a.attn_g, 1024, QSCALE); continue; } r -= I_QKV;
        p0_transpose_item(a.w_o, D, D, a.WoT, scr, r, lane, nullptr, 0, 1.f);
    }
    { const int fr = lane & 15, fq = lane >> 4;
      for (int task = gw; task < 2 * 16 * 8 * 16; task += NGW) { const int kc = task & 15, nt = (task >> 4) & 7, hp = (task >> 7) & 15, l = task >> 11;
        const float* skp = a.subk + ((size_t)(l * 16 + hp) * 128 + nt * 16 + fr) * 128 + fq * 8;
        bf16x8 bfr[4];
#pragma unroll
        for (int ks = 0; ks < 4; ++ks) { const f32x4 v0 = *(const f32x4*)(skp + ks * 32), v1 = *(const f32x4*)(skp + ks * 32 + 4);
            v4u w; w.x = pk2(v0[0], v0[1]); w.y = pk2(v0[2], v0[3]); w.z = pk2(v1[0], v1[1]); w.w = pk2(v1[2], v1[3]); bfr[ks] = __builtin_bit_cast(bf16x8, w); }
#pragma unroll 1
        for (int kt = 0; kt < 4; ++kt) { const int k0 = kc * 64 + kt * 16;
            const float* wp = a.w_pq + ((size_t)l * D + k0 + fr) * NPQ + hp * 128 + fq * 8;
            f32x4 acc = {0.f, 0.f, 0.f, 0.f};
#pragma unroll
            for (int ks = 0; ks < 4; ++ks) { const f32x4 v0 = *(const f32x4*)(wp + ks * 32), v1 = *(const f32x4*)(wp + ks * 32 + 4);
                v4u w; w.x = pk2(v0[0], v0[1]); w.y = pk2(v0[2], v0[3]); w.z = pk2(v1[0], v1[1]); w.w = pk2(v1[2], v1[3]);
                acc = __builtin_amdgcn_mfma_f32_16x16x32_bf16(__builtin_bit_cast(bf16x8, w), bfr[ks], acc, 0, 0, 0); }
            const f32x4 g = *(const f32x4*)(a.ffn_g + l * D + k0 + 4 * fq); acc = acc * g;
            v2u o; o.x = pk2(acc[0], acc[1]); o.y = pk2(acc[2], acc[3]);
            *(v2u*)(a.WpqT + ((size_t)l * NPQ + hp * 128 + nt * 16 + fr) * D + k0 + 4 * fq) = o; } } }
    const size_t gt = (size_t)vcu * (NWAVES * 64) + tid, NGT = (size_t)G * NWAVES * 64;
    { constexpr size_t NB = (size_t)2 * NEXP * D / 2048;
      table_blocks(a.pu, a.pv, a.ffn_g, a.U8, a.V8, 0, NB / 2, (size_t)gw, (size_t)NGW, lane);
      table_blocks(a.pu, a.pv, a.ffn_g, a.U8, a.V8, NB, 2 * NB, (size_t)gw, (size_t)NGW, lane);
      if (G != 256) table_blocks(a.pu, a.pv, a.ffn_g, a.U8, a.V8, NB / 2, NB, (size_t)gw, (size_t)NGW, lane); }
    for (int m0 = 2 * gw; m0 < T; m0 += 2 * NGW) {
        f32x4 v[2][4]; float s2[2];
#pragma unroll
        for (int r = 0; r < 2; ++r)
#pragma unroll
            for (int j = 0; j < 4; ++j) v[r][j] = *((const f32x4*)(a.x + (size_t)(m0 + r) * D) + lane + 64 * j);
#pragma unroll
        for (int r = 0; r < 2; ++r) { float s = 0.f;
#pragma unroll
            for (int j = 0; j < 4; ++j) s += (v[r][j][0] * v[r][j][0] + v[r][j][1] * v[r][j][1]) + (v[r][j][2] * v[r][j][2] + v[r][j][3] * v[r][j][3]);
            s2[r] = wave_sum(s); }
#pragma unroll
        for (int r = 0; r < 2; ++r) { const int m = m0 + r;
            v2u* o8 = (v2u*)(a.XB + (size_t)m * D) + lane;
#pragma unroll
            for (int j = 0; j < 4; ++j) { v2u w; w.x = pk2(v[r][j][0], v[r][j][1]); w.y = pk2(v[r][j][2], v[r][j][3]); o8[64 * j] = w; }
            if (lane < 4) { f32x4 z = {0.f, 0.f, 0.f, 0.f}; ((f32x4*)(a.SS0 + (size_t)(2 * T + m) * 16))[lane] = z; ((f32x4*)(a.SS0 + (size_t)(4 * T + m) * 16))[lane] = z;
                if (lane == 0) z[0] = s2[r]; ((f32x4*)(a.SS0 + (size_t)m * 16))[lane] = z; } }
    }
}

DI void conv_gate_phase(const bf16* GB, const bf16* P, const float* cw, bf16* Y, int vcu, int G, int tid) {
    const size_t gt = (size_t)vcu * (NWAVES * 64) + tid, NGT = (size_t)G * NWAVES * 64;
    for (size_t c = gt; c < (size_t)T * (D / 8); c += NGT) {
        const int t = (int)(c / (D / 8)), d0 = (int)(c % (D / 8)) * 8, ts = t % SEQ;
        const v4u gb = *(const v4u*)(GB + (size_t)t * D + d0);
        float acc[8];
#pragma unroll
        for (int i = 0; i < 8; ++i) acc[i] = 0.f;
#pragma unroll
        for (int w = 0; w < 3; ++w) { const int tt = ts + w - 1;
            if (tt >= 0 && tt < SEQ) {
                const v4u pp = *(const v4u*)(P + (size_t)(t + w - 1) * D + d0);
                const f32x4 w0 = *(const f32x4*)(cw + w * D + d0), w1 = *(const f32x4*)(cw + w * D + d0 + 4);
                acc[0] += w0[0] * bf_lo(pp.x); acc[1] += w0[1] * bf_hi(pp.x); acc[2] += w0[2] * bf_lo(pp.y); acc[3] += w0[3] * bf_hi(pp.y);
                acc[4] += w1[0] * bf_lo(pp.z); acc[5] += w1[1] * bf_hi(pp.z); acc[6] += w1[2] * bf_lo(pp.w); acc[7] += w1[3] * bf_hi(pp.w); } }
        v4u o; o.x = pk2(acc[0] * bf_lo(gb.x), acc[1] * bf_hi(gb.x)); o.y = pk2(acc[2] * bf_lo(gb.y), acc[3] * bf_hi(gb.y));
        o.z = pk2(acc[4] * bf_lo(gb.z), acc[5] * bf_hi(gb.z)); o.w = pk2(acc[6] * bf_lo(gb.w), acc[7] * bf_hi(gb.w));
        *(v4u*)(Y + (size_t)t * D + d0) = o;
    }
}

template <int CTRL> DI unsigned dppu(unsigned v) { return (unsigned)__builtin_amdgcn_update_dpp(0, (int)v, CTRL, 0xf, 0xf, false); }
DI unsigned umax(unsigned a, unsigned b) { return a > b ? a : b; }
DI unsigned umin(unsigned a, unsigned b) { return a < b ? a : b; }
DI unsigned rowmax_u(unsigned v) { v = umax(v, dppu<0x128>(v)); v = umax(v, dppu<0x124>(v)); v = umax(v, dppu<0x122>(v)); v = umax(v, dppu<0x121>(v)); return v; }
DI float rowsum_f(float v) { v += __uint_as_float(dppu<0x128>(__float_as_uint(v))); v += __uint_as_float(dppu<0x124>(__float_as_uint(v))); v += __uint_as_float(dppu<0x122>(__float_as_uint(v))); v += __uint_as_float(dppu<0x121>(__float_as_uint(v))); return v; }
DI unsigned f2key(float f) { const unsigned u = __float_as_uint(f); return u ^ ((unsigned)((int)u >> 31) | 0x80000000u); }
DI float key2f(unsigned k) { const unsigned u = (k & 0x80000000u) ? (k ^ 0x80000000u) : ~k; return __uint_as_float(u); }
DI unsigned cand_ij(int c) {
    unsigned i, j;
    if (c < 16) { i = 0; j = c; } else if (c < 24) { i = 1; j = c - 16; } else if (c < 29) { i = 2; j = c - 24; } else if (c < 33) { i = 3; j = c - 29; }
    else if (c < 36) { i = 4; j = c - 33; } else if (c < 38) { i = 5; j = c - 36; } else if (c < 40) { i = 6; j = c - 38; } else if (c < 42) { i = 7; j = c - 40; }
    else { i = 8 + (c - 42); j = 0; }
    return (i & 15u) | (j << 4);
}
#define CE_DESC(a, b) do { const unsigned _hi = umax(a, b), _lo = umin(a, b); a = _hi; b = _lo; } while (0)
DI void topk_group(const LAS float* SC, int srow0, int t0, int h, unsigned short* IDX, float* GATE, const LAS unsigned char* TAB, int lane) {
    const int fr = lane & 15, fq = lane >> 4;
        unsigned res[2][4];
#pragma unroll
        for (int p = 0; p < 2; ++p) {
            f32x4 acc[8];
#pragma unroll
            for (int n = 0; n < 8; ++n)
#pragma unroll
                for (int r = 0; r < 4; ++r) acc[n][r] = SC[(srow0 + 4 * fq + r) * SC_STRIDE + p * 128 + 16 * n + fr];
            unsigned L[4][8];
#pragma unroll
            for (int r = 0; r < 4; ++r)
#pragma unroll
                for (int n = 0; n < 8; ++n) L[r][n] = (f2key(acc[n][r]) & ~127u) | (unsigned)(127 - (16 * n + fr));
#define CE4(i, j) do { _Pragma("unroll") for (int r = 0; r < 4; ++r) CE_DESC(L[r][i], L[r][j]); } while (0)
            CE4(0, 1); CE4(2, 3); CE4(4, 5); CE4(6, 7);
            CE4(0, 2); CE4(1, 3); CE4(4, 6); CE4(5, 7);
            CE4(1, 2); CE4(5, 6); CE4(0, 4); CE4(3, 7);
            CE4(1, 5); CE4(2, 6);
            CE4(1, 4); CE4(3, 6);
            CE4(2, 4); CE4(3, 5);
            CE4(3, 4);
#undef CE4
            unsigned rr[4] = {0u, 0u, 0u, 0u};
#pragma unroll
            for (int k = 0; k < 16; ++k) {
                unsigned gm[4];
#pragma unroll
                for (int r = 0; r < 4; ++r) gm[r] = umax(L[r][0], dppu<0x128>(L[r][0]));
#pragma unroll
                for (int r = 0; r < 4; ++r) gm[r] = umax(gm[r], dppu<0x124>(gm[r]));
#pragma unroll
                for (int r = 0; r < 4; ++r) gm[r] = umax(gm[r], dppu<0x122>(gm[r]));
#pragma unroll
                for (int r = 0; r < 4; ++r) gm[r] = umax(gm[r], dppu<0x121>(gm[r]));
#pragma unroll
                for (int r = 0; r < 4; ++r) { rr[r] = (fr == k) ? gm[r] : rr[r]; const bool pop = (L[r][0] == gm[r]);
#pragma unroll
                    for (int n = 0; n < 7; ++n) L[r][n] = pop ? L[r][n + 1] : L[r][n];
                    L[r][7] = pop ? 0u : L[r][7]; }
            }
#pragma unroll
            for (int r = 0; r < 4; ++r) res[p][r] = rr[r];
        }
        const int gbase = (lane & 48) * 4;
        unsigned ck[4][4];
#pragma unroll
        for (int r = 0; r < 4; ++r)
#pragma unroll
            for (int s = 0; s < 4; ++s) { const int c = fr + 16 * s; const unsigned tb = TAB[c & 63];
                const unsigned k0 = (unsigned)__builtin_amdgcn_ds_bpermute(gbase + (int)(tb & 15u) * 4, (int)res[0][r]);
                const unsigned k1 = (unsigned)__builtin_amdgcn_ds_bpermute(gbase + (int)((tb >> 4) & 15u) * 4, (int)res[1][r]);
                const float v = key2f((k0 & ~127u) | 64u) + key2f((k1 & ~127u) | 64u);
                ck[r][s] = (c < 50) ? ((f2key(v) & ~63u) | (unsigned)(63 - c)) : 0u; }
        unsigned sel[4] = {0u, 0u, 0u, 0u};
#pragma unroll
        for (int k = 0; k < 16; ++k) {
            unsigned gm[4];
#pragma unroll
            for (int r = 0; r < 4; ++r) { const unsigned lm = umax(umax(ck[r][0], ck[r][1]), umax(ck[r][2], ck[r][3])); gm[r] = umax(lm, dppu<0x128>(lm)); }
#pragma unroll
            for (int r = 0; r < 4; ++r) gm[r] = umax(gm[r], dppu<0x124>(gm[r]));
#pragma unroll
            for (int r = 0; r < 4; ++r) gm[r] = umax(gm[r], dppu<0x122>(gm[r]));
#pragma unroll
            for (int r = 0; r < 4; ++r) gm[r] = umax(gm[r], dppu<0x121>(gm[r]));
#pragma unroll
            for (int r = 0; r < 4; ++r) { sel[r] = (fr == k) ? gm[r] : sel[r];
#pragma unroll
                for (int s = 0; s < 4; ++s) ck[r][s] = (ck[r][s] == gm[r]) ? 0u : ck[r][s]; }
        }
#pragma unroll
        for (int r = 0; r < 4; ++r) {
            const int t = t0 + 4 * fq + r;
            const int cs = 63 - (int)(sel[r] & 63u); const unsigned tb = TAB[cs & 63];
            const unsigned k0 = (unsigned)__builtin_amdgcn_ds_bpermute(gbase + (int)(tb & 15u) * 4, (int)res[0][r]);
            const unsigned k1 = (unsigned)__builtin_amdgcn_ds_bpermute(gbase + (int)((tb >> 4) & 15u) * 4, (int)res[1][r]);
            const int e = (127 - (int)(k0 & 127u)) * 128 + (127 - (int)(k1 & 127u));
            const float val = key2f((sel[r] & ~63u) | 32u), top = key2f((rowmax_u(sel[r]) & ~63u) | 32u);
            const float ex = __builtin_amdgcn_exp2f((val - top) * LOG2E), sum = rowsum_f(ex);
            IDX[(size_t)t * 128 + h * 16 + fr] = (unsigned short)e; GATE[(size_t)t * 128 + h * 16 + fr] = ex / sum;
        }
}
struct EpiRoute {
    static constexpr bool PERM = true, AFTER_DRAIN = true;
    const float* ss; unsigned short* IDX; float* GATE;
    DI void fused(pg8::f32x4 (&acc)[2][2][4][2], const pg8::Unit& u, int wr, int wc, int fr, int fq, LAS unsigned char* lds, int wid, int lane) const {
        LAS float* SC = (LAS float*)lds; LAS unsigned char* TAB = lds + SC_TAB_OFF; LAS unsigned* gcnt = (LAS unsigned*)(lds + SC_TAB_OFF + 128);
        const int tid = wid * 64 + lane;
        if (tid < 64) TAB[tid] = (unsigned char)(tid < 50 ? cand_ij(tid) : 0xff);
#pragma unroll
        for (int ai = 0; ai < 2; ++ai) {
            __syncthreads();
#pragma unroll
            for (int m = 0; m < 4; ++m) { const int row = wr * 64 + m * 16 + fr; const float rs = pg8::row_rstd(ss, u.pm * 256 + ai * 128 + row);
#pragma unroll
                for (int bj = 0; bj < 2; ++bj)
#pragma unroll
                    for (int n = 0; n < 2; ++n) *(LAS f32x4*)(SC + row * SC_STRIDE + bj * 128 + wc * 32 + 8 * fq + 4 * n) = acc[ai][bj][m][n] * rs; }
            if (tid == 0) *gcnt = 0u;
            __syncthreads();
            for (;;) {
                unsigned grp = 0u; if (lane == 0) grp = __hip_atomic_fetch_add(gcnt, 1u, __ATOMIC_RELAXED, __HIP_MEMORY_SCOPE_WORKGROUP);
                grp = (unsigned)__builtin_amdgcn_readfirstlane((int)grp);
                if (grp >= 8u) break;
                topk_group(SC, (int)grp * 16, u.pm * 256 + ai * 128 + (int)grp * 16, u.pn, IDX, GATE, TAB, lane);
            }
        }
        __syncthreads();
    }
};
struct OneUnit { pg8::Unit u;
    DI bool next(int i, pg8::Unit& o) const { if (i != 0) return false; o = u; return true; }
    DI void a_ready(const pg8::Unit&) const {}
    DI void done(const pg8::Unit&) const {}
};

DI float dot8(v4u x, v4u u, float acc) {
    acc += bf_lo(x.x) * bf_lo(u.x); acc += bf_hi(x.x) * bf_hi(u.x); acc += bf_lo(x.y) * bf_lo(u.y); acc += bf_hi(x.y) * bf_hi(u.y);
    acc += bf_lo(x.z) * bf_lo(u.z); acc += bf_hi(x.z) * bf_hi(u.z); acc += bf_lo(x.w) * bf_lo(u.w); acc += bf_hi(x.w) * bf_hi(u.w);
    return acc;
}
DI void fma8(float* acc, float a, v4u v) {
    acc[0] += a * bf_lo(v.x); acc[1] += a * bf_hi(v.x); acc[2] += a * bf_lo(v.y); acc[3] += a * bf_hi(v.y);
    acc[4] += a * bf_lo(v.z); acc[5] += a * bf_hi(v.z); acc[6] += a * bf_lo(v.w); acc[7] += a * bf_hi(v.w);
}
DI f32x2 fp8lo(unsigned w) { return __builtin_amdgcn_cvt_pk_f32_fp8((int)w, false); }
DI f32x2 fp8hi(unsigned w) { return __builtin_amdgcn_cvt_pk_f32_fp8((int)w, true); }

template <int CTRL> DI float dppf(float v) { return __uint_as_float(dppu<CTRL>(__float_as_uint(v))); }
constexpr int XG = 8, XNG = T / XG;
DI unsigned wave_ticket(unsigned* head, int lane) {
    unsigned v = 0u; if (lane == 0) v = __hip_atomic_fetch_add(head, 1u, __ATOMIC_RELAXED, __HIP_MEMORY_SCOPE_AGENT);
    return (unsigned)__builtin_amdgcn_readfirstlane((int)v);
}
struct USmall { int i0, i1; v4u xa, xb; };
DI void u_small(USmall& S, const unsigned short* IDX, const bf16* XB, int t, int s, int lane) {
    S.i0 = IDX[(size_t)t * 128 + lane]; S.i1 = IDX[(size_t)t * 128 + 64 + lane];
    const v4u* xr = (const v4u*)(XB + (size_t)t * D + 128 * s + 16 * (lane & 7)); S.xa = xr[0]; S.xb = xr[1];
}
DI void u_token(USmall& SC, const v4u (&GC)[16], const USmall& SN, v4u (&GN)[16], const unsigned char* U8s, const unsigned short* IDX, const bf16* XB, bf16* HPs, int t, int t2, int s, int lane) {
    const int g = lane >> 3, k = lane & 7;
    const v4u xa = SC.xa, xb = SC.xb;
    float xv[16];
    xv[0] = bf_lo(xa.x); xv[1] = bf_hi(xa.x); xv[2] = bf_lo(xa.y); xv[3] = bf_hi(xa.y); xv[4] = bf_lo(xa.z); xv[5] = bf_hi(xa.z); xv[6] = bf_lo(xa.w); xv[7] = bf_hi(xa.w);
    xv[8] = bf_lo(xb.x); xv[9] = bf_hi(xb.x); xv[10] = bf_lo(xb.y); xv[11] = bf_hi(xb.y); xv[12] = bf_lo(xb.z); xv[13] = bf_hi(xb.z); xv[14] = bf_lo(xb.w); xv[15] = bf_hi(xb.w);
    float am = 0.f;
#pragma unroll
    for (int i = 0; i < 16; ++i) am = fmaxf(am, __builtin_fabsf(xv[i]));
    am = fmaxf(am, dppf<0xB1>(am)); am = fmaxf(am, dppf<0x4E>(am)); am = fmaxf(am, dppf<0x141>(am));
    am = fmaxf(am, 1e-20f);
    const float qs = 127.0f / am, dq = am * (1.0f / (127.0f * 512.0f));
    unsigned xq[4];
#pragma unroll
    for (int q = 0; q < 4; ++q) { unsigned w = 0u;
#pragma unroll
        for (int e = 0; e < 4; ++e) { const int qi = (int)__builtin_rintf(xv[4 * q + e] * qs); w |= ((unsigned)qi & 0xffu) << (8 * e); }
        xq[q] = w; }
    u_small(SC, IDX, XB, t2, s, lane);
    int p[16];
#pragma unroll
    for (int i = 0; i < 16; ++i) {
        const unsigned idx = (unsigned)__builtin_amdgcn_ds_bpermute((8 * g + (i & 7)) * 4, i < 8 ? SN.i0 : SN.i1);
        GN[i] = *(const v4u*)(U8s + (idx * 1024u + 16u * (unsigned)k));
        int a0 = __builtin_amdgcn_sdot4((int)xq[0], (int)GC[i][0], 0, false), a1 = __builtin_amdgcn_sdot4((int)xq[1], (int)GC[i][1], 0, false);
        a0 = __builtin_amdgcn_sdot4((int)xq[2], (int)GC[i][2], a0, false); a1 = __builtin_amdgcn_sdot4((int)xq[3], (int)GC[i][3], a1, false);
        p[i] = a0 + a1;
        __builtin_amdgcn_sched_barrier(0); }
    const bool h4 = k >= 4, h2 = k & 2, h1 = k & 1;
    int q8[8], q4[4], q2[2];
#pragma unroll
    for (int j = 0; j < 8; ++j) { const int keep = h4 ? p[8 + j] : p[j], send = h4 ? p[j] : p[8 + j]; q8[j] = keep + (int)dppu<0x141>((unsigned)send); }
#pragma unroll
    for (int j = 0; j < 4; ++j) { const int keep = h2 ? q8[4 + j] : q8[j], send = h2 ? q8[j] : q8[4 + j]; q4[j] = keep + (int)dppu<0x4E>((unsigned)send); }
#pragma unroll
    for (int j = 0; j < 2; ++j) { const int keep = h1 ? q4[2 + j] : q4[j], send = h1 ? q4[j] : q4[2 + j]; q2[j] = keep + (int)dppu<0xB1>((unsigned)send); }
    *(unsigned*)(HPs + (size_t)t * 128 + (h4 ? 64 : 0) + 8 * g + 2 * (k & 3)) = pk2((float)q2[0] * dq, (float)q2[1] * dq);
}
DI float wave_sum_dpp63(float v) {
    v += dppf<0xB1>(v); v += dppf<0x4E>(v); v += dppf<0x141>(v); v += dppf<0x140>(v);
    v += __uint_as_float((unsigned)__builtin_amdgcn_update_dpp(0, (int)__float_as_uint(v), 0x142, 0xa, 0xf, false));
    v += __uint_as_float((unsigned)__builtin_amdgcn_update_dpp(0, (int)__float_as_uint(v), 0x143, 0xc, 0xf, false));
    return v;
}
struct VSmall { int i0, i1; float a0, a1; unsigned xo; };
DI void v_small(VSmall& S, const unsigned short* IDX, const bf16* A, const bf16* XB, int t, int s, int lane) {
    S.i0 = IDX[(size_t)t * 128 + lane]; S.i1 = IDX[(size_t)t * 128 + 64 + lane]; S.a0 = __uint_as_float((unsigned)A[(size_t)t * 128 + lane] << 16); S.a1 = __uint_as_float((unsigned)A[(size_t)t * 128 + 64 + lane] << 16);
    S.xo = *(const unsigned*)(XB + (size_t)t * D + 128 * s + 2 * lane);
}
template <bool FINAL>
DI void v_token(VSmall& SC, const v4u (&GC)[16], const VSmall& SN, v4u (&GN)[16], const unsigned char* V8s, const unsigned short* IDX, const bf16* A, float* xf, bf16* XB, float* ss_out,
                int t, int t2, int s, int lane) {
    const int g = lane >> 3, k = lane & 7;
    const bool b3 = lane & 8, b4 = lane & 16, b5 = lane & 32;
    float av[16];
#pragma unroll
    for (int i = 0; i < 16; ++i) av[i] = __uint_as_float((unsigned)__builtin_amdgcn_ds_bpermute((8 * g + (i & 7)) * 4, (int)__float_as_uint(i < 8 ? SC.a0 : SC.a1)));
    f32x2 o = {bf_lo(SC.xo), bf_hi(SC.xo)};
    v_small(SC, IDX, A, XB, t2, s, lane);
    f32x2 acc[8];
#pragma unroll
    for (int i = 0; i < 8; ++i) acc[i] = (f32x2){0.f, 0.f};
#pragma unroll
    for (int i = 0; i < 16; ++i) {
        const unsigned idx = (unsigned)__builtin_amdgcn_ds_bpermute((8 * g + (i & 7)) * 4, i < 8 ? SN.i0 : SN.i1);
        GN[i] = *(const v4u*)(V8s + (idx * 1024u + 16u * (unsigned)k));
        const f32x2 a2 = {av[i], av[i]};
#pragma unroll
        for (int q = 0; q < 4; ++q) { acc[2 * q] = __builtin_elementwise_fma(a2, fp8lo(GC[i][q]), acc[2 * q]); acc[2 * q + 1] = __builtin_elementwise_fma(a2, fp8hi(GC[i][q]), acc[2 * q + 1]); }
        __builtin_amdgcn_sched_barrier(0); }
    float v[16];
#pragma unroll
    for (int i = 0; i < 8; ++i) { v[2 * i] = acc[i].x; v[2 * i + 1] = acc[i].y; }
    float v8[8], v4[4], v2[2];
#pragma unroll
    for (int j = 0; j < 8; ++j) { const float keep = b3 ? v[8 + j] : v[j], send = b3 ? v[j] : v[8 + j]; v8[j] = keep + dppf<0x128>(send); }
#pragma unroll
    for (int j = 0; j < 4; ++j) { const float keep = b4 ? v8[4 + j] : v8[j], send = b4 ? v8[j] : v8[4 + j]; v4[j] = keep + __shfl_xor(send, 16); }
#pragma unroll
    for (int j = 0; j < 2; ++j) { const float keep = b5 ? v4[2 + j] : v4[j], send = b5 ? v4[j] : v4[2 + j]; v2[j] = keep + __shfl_xor(send, 32); }
    const int tl = (8 * k + (b3 ? 4 : 0) + (b4 ? 2 : 0) + (b5 ? 1 : 0)) * 4;
    const float s0 = __uint_as_float((unsigned)__builtin_amdgcn_ds_permute(tl, (int)__float_as_uint(v2[0]))), s1 = __uint_as_float((unsigned)__builtin_amdgcn_ds_permute(tl, (int)__float_as_uint(v2[1])));
    const int col = 128 * s + 2 * lane;
    o.x += s0; o.y += s1;
    *(unsigned*)(XB + (size_t)t * D + col) = pk2(o.x, o.y);
    const float sq = wave_sum_dpp63(o.x * o.x + o.y * o.y);
    if (lane == 63) ss_out[(size_t)t * 16 + s] = sq;
}
template <int PASS, bool FINAL>
DI void sliced_pass(const unsigned char* TAB, const unsigned short* IDX, const bf16* XBc, bf16* XBw, bf16* HP, const bf16* A, float* xf, float* ss_out,
                    unsigned* heads, unsigned* census, volatile LAS unsigned* slot, int wave, int lane, int tid) {
    const int own = (int)(xb_xcc_id() & 7u);
    __syncthreads();
    if (tid == 0) { unsigned all = 1u;
#pragma unroll 1
        for (int q = 0; q < 8; ++q) { const unsigned n = xb_ld(census + XB_XCNT(q)) + xb_ld(census + XB_XCNT(q + 8)); all &= (n > 0u) ? 1u : 0u; }
        slot[1] = all; }
    __syncthreads();
    const int nds = slot[1] ? 1 : 8;
#pragma unroll 1
    for (int ds = 0; ds < nds; ++ds) { const int s = (own + ds) & 7;
        unsigned* head = heads + 64 * s; const unsigned char* Ts = TAB + 128 * s; bf16* HPs = HP + (size_t)s * T * 128;
        unsigned tk = wave_ticket(head, lane);
        if (tk >= (unsigned)XNG) continue;
        unsigned nxt = wave_ticket(head, lane);
#define TOK_AT(dj) ((j + (dj) < XG) ? (int)tk * XG + j + (dj) : (nxt < (unsigned)XNG ? (int)nxt * XG + j + (dj) - XG : (int)tk * XG + XG - 1))
        int j = 0;
        if (PASS == 0) {
            USmall S0, S1; v4u G0[16], G1[16];
            u_small(S0, IDX, XBc, (int)tk * XG, s, lane); u_small(S1, IDX, XBc, (int)tk * XG + 1, s, lane);
            { const int g = lane >> 3, k = lane & 7;
#pragma unroll
              for (int i = 0; i < 16; ++i) { const unsigned idx = (unsigned)__builtin_amdgcn_ds_bpermute((8 * g + (i & 7)) * 4, i < 8 ? S0.i0 : S0.i1); G0[i] = *(const v4u*)(Ts + (idx * 1024u + 16u * (unsigned)k)); } }
            for (;;) {
#pragma unroll 1
                for (j = 0; j < XG; j += 2) {
                    u_token(S0, G0, S1, G1, Ts, IDX, XBc, HPs, (int)tk * XG + j, TOK_AT(2), s, lane);
                    { const int jj = j; j = jj + 1; const int t3 = TOK_AT(2); j = jj; u_token(S1, G1, S0, G0, Ts, IDX, XBc, HPs, (int)tk * XG + j + 1, t3, s, lane); } }
                if (nxt >= (unsigned)XNG) break; tk = nxt; nxt = wave_ticket(head, lane); }
        } else {
            VSmall S0, S1; v4u G0[16], G1[16];
            v_small(S0, IDX, A, XBw, (int)tk * XG, s, lane); v_small(S1, IDX, A, XBw, (int)tk * XG + 1, s, lane);
            { const int g = lane >> 3, k = lane & 7;
#pragma unroll
              for (int i = 0; i < 16; ++i) { const unsigned idx = (unsigned)__builtin_amdgcn_ds_bpermute((8 * g + (i & 7)) * 4, i < 8 ? S0.i0 : S0.i1); G0[i] = *(const v4u*)(Ts + (idx * 1024u + 16u * (unsigned)k)); } }
            for (;;) {
#pragma unroll 1
                for (j = 0; j < XG; j += 2) {
                    v_token<FINAL>(S0, G0, S1, G1, Ts, IDX, A, xf, XBw, ss_out, (int)tk * XG + j, TOK_AT(2), s, lane);
                    { const int jj = j; j = jj + 1; const int t3 = TOK_AT(2); j = jj; v_token<FINAL>(S1, G1, S0, G0, Ts, IDX, A, xf, XBw, ss_out, (int)tk * XG + j + 1, t3, s, lane); } }
                if (nxt >= (unsigned)XNG) break; tk = nxt; nxt = wave_ticket(head, lane); }
        }
#undef TOK_AT
    }
}
DI void reduce_phase(const bf16* HP, const float* GATE, const float* ss_in, bf16* A, int vcu, int G, int tid) {
    const size_t gt = (size_t)vcu * (NWAVES * 64) + tid, NGT = (size_t)G * NWAVES * 64;
    for (size_t c = gt; c < (size_t)T * 64; c += NGT) { float h0 = 0.f, h1 = 0.f;
#pragma unroll
        for (int s = 0; s < 8; ++s) { const unsigned w = *(const unsigned*)(HP + (size_t)s * T * 128 + 2 * c); h0 += bf_lo(w); h1 += bf_hi(w); }
        const float rs = pg8::row_rstd(ss_in, (int)(c >> 6)); h0 *= rs; h1 *= rs;
        const f32x2 g = *(const f32x2*)(GATE + 2 * c);
        *(unsigned*)(A + 2 * c) = pk2((1.0f / 1024.0f) * g.x * (0.5f * h0 * (1.f + erff(h0 * 0.70710678118654752f))), (1.0f / 1024.0f) * g.y * (0.5f * h1 * (1.f + erff(h1 * 0.70710678118654752f)))); }
}
DI void final_phase(const float* ss, const bf16* XB, float* outp, const float* fin_g, int vcu, int G, int wave, int lane) {
    for (int m0 = 2 * (vcu * NWAVES + wave); m0 < T; m0 += 2 * G * NWAVES) {
        v4u v[2][2]; float rf[2];
#pragma unroll
        for (int r = 0; r < 2; ++r) { rf[r] = pg8::row_rstd(ss, m0 + r);
#pragma unroll
            for (int j = 0; j < 2; ++j) v[r][j] = *((const v4u*)(XB + (size_t)(m0 + r) * D) + lane + 64 * j); }
#pragma unroll
        for (int r = 0; r < 2; ++r)
#pragma unroll
            for (int j = 0; j < 2; ++j) { const f32x4 g0 = *((const f32x4*)(fin_g + 512 * j) + 2 * lane), g1 = *((const f32x4*)(fin_g + 512 * j) + 2 * lane + 1); const v4u w = v[r][j];
                float* o = outp + (size_t)(m0 + r) * D + 512 * j + 8 * lane;
                *(f32x4*)o = (f32x4){bf_lo(w.x), bf_hi(w.x), bf_lo(w.y), bf_hi(w.y)} * rf[r] * g0; *(f32x4*)(o + 4) = (f32x4){bf_lo(w.z), bf_hi(w.z), bf_lo(w.w), bf_hi(w.w)} * rf[r] * g1; } }
}

DI int t5_bucket(int rel) {
    const int n = rel < 0 ? -rel : rel; int b;
    if (n < 8) b = n; else if (n < 12) b = 8; else if (n < 16) b = 9; else if (n < 23) b = 10; else if (n < 32) b = 11; else if (n < 46) b = 12; else if (n < 64) b = 13; else if (n < 91) b = 14; else b = 15;
    return b + (rel > 0 ? 16 : 0);
}
DI int crow(int reg, int h) { return (reg & 3) + 8 * (reg >> 2) + 4 * h; }
constexpr int AT_KL = 0, AT_KSTR = 144, AT_VT = 384 * AT_KSTR  , AT_VSTR = 776, AT_BT = AT_VT + 64 * AT_VSTR  , AT_END = AT_BT + 4 * 512 * 4;
static_assert(AT_END <= RING_BYTES, "attention LDS");
DI void attn_phase(const bf16* Qg, const bf16* Kg, const bf16* Vg, bf16* AO, const float* rel_bias, const float* sink, LAS unsigned char* lds, int vcu, int G, int wave, int lane, int tid) {
    const int r = lane & 31, h = lane >> 5;
    for (int unit = vcu; unit < BATCH * 4 * (SEQ / 128); unit += G) {
        const int b = unit / 256, kvh = (unit % 256) / 64, blk = unit % 64;
        __syncthreads();
        for (int c = tid; c < 384 * 8; c += NWAVES * 64) { const int row = c >> 3, c8 = c & 7, ts = blk * 128 - 128 + row;
            v4u kv = {0u, 0u, 0u, 0u}, vv = {0u, 0u, 0u, 0u};
            if (ts >= 0 && ts < SEQ) { const size_t g = (size_t)(b * SEQ + ts) * 256 + kvh * 64 + c8 * 8; kv = *(const v4u*)(Kg + g); vv = *(const v4u*)(Vg + g); }
            *(LAS v4u*)(lds + AT_KL + row * AT_KSTR + c8 * 16) = kv;
            LAS unsigned short* vt = (LAS unsigned short*)(lds + AT_VT) + (c8 * 8) * (AT_VSTR / 2) + row;
            vt[0 * (AT_VSTR / 2)] = (unsigned short)(vv.x & 0xffffu); vt[1 * (AT_VSTR / 2)] = (unsigned short)(vv.x >> 16);
            vt[2 * (AT_VSTR / 2)] = (unsigned short)(vv.y & 0xffffu); vt[3 * (AT_VSTR / 2)] = (unsigned short)(vv.y >> 16);
            vt[4 * (AT_VSTR / 2)] = (unsigned short)(vv.z & 0xffffu); vt[5 * (AT_VSTR / 2)] = (unsigned short)(vv.z >> 16);
            vt[6 * (AT_VSTR / 2)] = (unsigned short)(vv.w & 0xffffu); vt[7 * (AT_VSTR / 2)] = (unsigned short)(vv.w >> 16); }
        for (int c = tid; c < 4 * 512; c += NWAVES * 64) { const int g = c >> 9, i = c & 511, rel = i - 255;
            float v = NEGBIG; if (rel >= -128 && rel <= 128) v = rel_bias[t5_bucket(rel) * 16 + kvh * 4 + g] * LOG2E;
            *(LAS float*)(lds + AT_BT + c * 4) = v; }
        __syncthreads();
        const int g = wave >> 1, qh = wave & 1, head = kvh * 4 + g;
        const float sinkl = sink[head] * LOG2E;
        bf16x8 qf[2][4];
#pragma unroll
        for (int qt = 0; qt < 2; ++qt)
#pragma unroll
            for (int s = 0; s < 4; ++s) qf[qt][s] = *(const bf16x8*)(Qg + (size_t)(b * SEQ + blk * 128 + qh * 64 + qt * 32 + r) * D + head * 64 + s * 16 + h * 8);
        float m[2] = {sinkl, sinkl}, l[2] = {0.f, 0.f};
        f32x16 o[2][2];
#pragma unroll
        for (int qt = 0; qt < 2; ++qt)
#pragma unroll
            for (int dt = 0; dt < 2; ++dt)
#pragma unroll
                for (int i = 0; i < 16; ++i) o[qt][dt][i] = 0.f;
        int kt_lo = 2 * qh, kt_hi = 2 * qh + 9;
        if (blk == 0 && kt_lo < 4) kt_lo = 4;
        if (blk == SEQ / 128 - 1 && kt_hi > 7) kt_hi = 7;
#pragma unroll 1
        for (int kt = kt_lo; kt <= kt_hi; ++kt) {
            bf16x8 kf[4];
#pragma unroll
            for (int s = 0; s < 4; ++s) kf[s] = *(const LAS bf16x8*)(lds + AT_KL + (32 * kt + r) * AT_KSTR + s * 32 + h * 16);
            bf16x8 vf[2][2];
#pragma unroll
            for (int dt = 0; dt < 2; ++dt)
#pragma unroll
                for (int s2 = 0; s2 < 2; ++s2) { const LAS unsigned char* vp = lds + AT_VT + (32 * dt + r) * AT_VSTR + (32 * kt + 16 * s2 + 4 * h) * 2;
                    const v2u lo = *(const LAS v2u*)vp, hi2 = *(const LAS v2u*)(vp + 16); v4u w = {lo.x, lo.y, hi2.x, hi2.y}; vf[dt][s2] = __builtin_bit_cast(bf16x8, w); }
#pragma unroll
            for (int qt = 0; qt < 2; ++qt) {
                f32x16 s;
                const LAS float* bt = (const LAS float*)(lds + AT_BT) + g * 512 + 127 + 32 * kt + 4 * h - (64 * qh + 32 * qt + r);
#pragma unroll
                for (int i = 0; i < 16; ++i) s[i] = bt[(i & 3) + 8 * (i >> 2)];
#pragma unroll
                for (int k4 = 0; k4 < 4; ++k4) s = __builtin_amdgcn_mfma_f32_32x32x16_bf16(kf[k4], qf[qt][k4], s, 0, 0, 0);
                float mx = s[0];
#pragma unroll
                for (int i = 1; i < 16; ++i) mx = fmaxf(mx, s[i]);
                mx = fmaxf(mx, __shfl_xor(mx, 32));
                const float mn = fmaxf(m[qt], mx), al = __builtin_amdgcn_exp2f(m[qt] - mn); m[qt] = mn;
                float ps = 0.f;
#pragma unroll
                for (int i = 0; i < 16; ++i) { s[i] = __builtin_amdgcn_exp2f(s[i] - mn); ps += s[i]; }
                l[qt] = l[qt] * al + ps;
#pragma unroll
                for (int dt = 0; dt < 2; ++dt)
#pragma unroll
                    for (int i = 0; i < 16; ++i) o[qt][dt][i] *= al;
                bf16x8 pf[2];
#pragma unroll
                for (int s2 = 0; s2 < 2; ++s2) { v4u w; w.x = pk2(s[8 * s2 + 0], s[8 * s2 + 1]); w.y = pk2(s[8 * s2 + 2], s[8 * s2 + 3]); w.z = pk2(s[8 * s2 + 4], s[8 * s2 + 5]); w.w = pk2(s[8 * s2 + 6], s[8 * s2 + 7]); pf[s2] = __builtin_bit_cast(bf16x8, w); }
#pragma unroll
                for (int dt = 0; dt < 2; ++dt)
#pragma unroll
                    for (int s2 = 0; s2 < 2; ++s2) o[qt][dt] = __builtin_amdgcn_mfma_f32_32x32x16_bf16(vf[dt][s2], pf[s2], o[qt][dt], 0, 0, 0);
            }
        }
#pragma unroll
        for (int qt = 0; qt < 2; ++qt) {
            const float lt = l[qt] + __shfl_xor(l[qt], 32) + __builtin_amdgcn_exp2f(sinkl - m[qt]), inv = 1.0f / lt;
            bf16* op = AO + (size_t)(b * SEQ + blk * 128 + qh * 64 + qt * 32 + r) * D + head * 64 + 4 * h;
#pragma unroll
            for (int dt = 0; dt < 2; ++dt)
#pragma unroll
                for (int gq = 0; gq < 4; ++gq) { v2u w; w.x = pk2(o[qt][dt][4 * gq] * inv, o[qt][dt][4 * gq + 1] * inv); w.y = pk2(o[qt][dt][4 * gq + 2] * inv, o[qt][dt][4 * gq + 3] * inv);
                    *(v2u*)(op + 32 * dt + 8 * gq) = w; }
        }
    }
}

struct Args { const float* in[16]; float* out; unsigned char* ws; int ph_lo, ph_hi; };
__global__ void __launch_bounds__(NWAVES * 64, 2) fwd_kernel(Args args) {
    extern __shared__ __attribute__((aligned(16))) unsigned char lds_raw[];
    LAS unsigned char* lds = (LAS unsigned char*)lds_raw;
    volatile LAS unsigned* MISC = (volatile LAS unsigned*)(lds + MISC_OFF);
    const int tid = threadIdx.x, lane = tid & 63, wave = __builtin_amdgcn_readfirstlane(tid >> 6);
    const int G = gridDim.x; const int bx = blockIdx.x; const int vcu = (G % 8 == 0) ? (bx % 8) * (G / 8) + bx / 8 : bx;
    unsigned char* ws = args.ws;
    unsigned* ctl = (unsigned*)(ws + WS_CTL);
    const float* x = args.in[0]; const float* conv_g = args.in[1]; const float* w_in = args.in[2]; const float* conv_w = args.in[3]; const float* w_out = args.in[4];
    const float* attn_g = args.in[5]; const float* w_qkv = args.in[6]; const float* sink = args.in[7]; const float* w_o = args.in[8]; const float* rel_bias = args.in[9];
    const float* ffn_g = args.in[10]; const float* w_pq = args.in[11]; const float* subk = args.in[12]; const float* pu = args.in[13]; const float* pv = args.in[14]; const float* fin_g = args.in[15];
    float* out = args.out;
    bf16* WinT = (bf16*)(ws + WS_WIN); bf16* WoutT = (bf16*)(ws + WS_WOUT); bf16* WqkvT = (bf16*)(ws + WS_WQKV); bf16* WoT = (bf16*)(ws + WS_WO); bf16* WpqT = (bf16*)(ws + WS_WPQ); bf16* SKb = (bf16*)(ws + WS_SK);
    float* SS = (float*)(ws + WS_SS); unsigned short* IDX = (unsigned short*)(ws + WS_IDX); bf16* HP = (bf16*)(ws + WS_HP); bf16* AA = (bf16*)(ws + WS_A); float* GATE = (float*)(ws + WS_GATE);
    bf16* XB = (bf16*)(ws + WS_XB); bf16* Y = (bf16*)(ws + WS_Y); unsigned char* U8 = ws + WS_U; unsigned char* V8 = ws + WS_V;
    bf16* G1 = (bf16*)(ws + WS_G1); bf16* PQ = (bf16*)(ws + WS_PQ); bf16* Qb = (bf16*)(ws + WS_Q); bf16* Kb = (bf16*)(ws + WS_K); bf16* VVb = (bf16*)(ws + WS_VV); bf16* AO = (bf16*)(ws + WS_AO);
    float* SS0 = SS; float* SS1 = SS + (size_t)T * 16; float* SS2 = SS + (size_t)2 * T * 16; float* SS3 = SS + (size_t)3 * T * 16; float* SS4 = SS + (size_t)4 * T * 16;

    for (int u = tid; u < (LDS_BYTES - LDSCTL_OFF) / 4; u += NWAVES * 64) ((LAS unsigned*)(lds + LDSCTL_OFF))[u] = 0u;
    __syncthreads();
    XcdBarrier bar; bar.bar = ctl + CW_BAR; bar.x = 0; bar.st = nullptr;
    if (!MK_PER_PHASE) bar = xcd_barrier_post(ctl + CW_BAR, MISC + 8);
    const int lo = args.ph_lo, hi = args.ph_hi;
#define IN(k) (lo <= (k) && (k) < hi)
#define SEAM(k) do { if (IN(k) && IN((k) + 1)) xcd_barrier(bar); } while (0)

    if (IN(0)) REPS(0) {
        P0Args a{x, conv_g, w_in, w_out, attn_g, w_qkv, w_o, ffn_g, w_pq, subk, pu, pv, WinT, WoutT, WqkvT, WoT, WpqT, SKb, U8, V8, XB, SS0};
        p0_prologue(a, lds, vcu, G, wave, lane, tid);
    }
    SEAM(0);
    if (IN(1)) REPS(1) {
        pg8::Gemm g{XB, WinT, T, NIN, D}; pg8::StaticOrder S; S.init(T, NIN, G, bx);
        pg8::EpiConvIn E{G1 + (size_t)T * D, G1, SS0};
        pg8::gemm_phase<pg8::EpiConvIn, pg8::StaticOrder, true, true>(lds, g, S, E);
    }
    SEAM(1);
    if (IN(2)) REPS(2) conv_gate_phase(G1, G1 + (size_t)T * D, conv_w, Y, vcu, G, tid);
    SEAM(2);
    if (IN(3)) REPS(3) {
        pg8::Gemm g{Y, WoutT, T, D, D}; pg8::StaticOrder S; S.init(T, D, G, bx);
        pg8::EpiResid<true> E{x, XB, SS1};
        pg8::gemm_phase<pg8::EpiResid<true>, pg8::StaticOrder, true, true>(lds, g, S, E);
    }
    SEAM(3);
    if (IN(4)) {
        pg8::Gemm g{XB, WpqT, T, NPQ, D}; pg8::StaticOrder S; S.init(T, NPQ, G, bx); EpiRoute E{SS1, IDX, GATE}; pg8::Unit uu;
        for (int i = 0; S.next(i, uu); ++i) { OneUnit O{uu}; pg8::gemm_phase<EpiRoute, OneUnit, false, true>(lds, g, O, E); }
    }
    SEAM(4);
    if (IN(6)) sliced_pass<0, false>(U8, IDX, XB, XB, HP, AA, out, SS2, ctl + CW_WQ + 64 * 0, ctl + CW_BAR, MISC + 12, wave, lane, tid);
    SEAM(6);
    if (IN(7)) reduce_phase(HP, GATE, SS1, AA, vcu, G, tid);
    SEAM(7);
    if (IN(8)) sliced_pass<1, false>(V8, IDX, XB, XB, HP, AA, out, SS2, ctl + CW_WQ + 64 * 8, ctl + CW_BAR, MISC + 12, wave, lane, tid);
    SEAM(8);
    if (IN(9)) REPS(9) {
        pg8::Gemm g{XB, WqkvT, T, NQKV, D}; pg8::StaticOrder S; S.init(T, NQKV, G, bx);
        pg8::EpiBf16RS E{Qb, D, 4, Kb, VVb, 256, SS2};
        pg8::gemm_phase<pg8::EpiBf16RS, pg8::StaticOrder, true, true>(lds, g, S, E);
        if (G == 256 && bx >= 128) { constexpr size_t NB = (size_t)2 * NEXP * D / 2048; table_blocks(pu, pv, ffn_g, U8, V8, NB / 2, NB, (size_t)((bx - 128) * NWAVES + wave), (size_t)128 * NWAVES, lane); }
    }
    SEAM(9);
    if (IN(10)) REPS(10) attn_phase(Qb, Kb, VVb, AO, rel_bias, sink, lds, vcu, G, wave, lane, tid);
    SEAM(10);
    if (IN(11)) {
        pg8::Gemm g{AO, WoT, T, D, D}; pg8::StaticOrder S; S.init(T, D, G, bx);
        pg8::EpiResid<false> E{nullptr, XB, SS3};
        pg8::gemm_phase<pg8::EpiResid<false>, pg8::StaticOrder, true, true>(lds, g, S, E);
    }
    SEAM(11);
    if (IN(12)) {
        pg8::Gemm g{XB, WpqT + (size_t)NPQ * D, T, NPQ, D}; pg8::StaticOrder S; S.init(T, NPQ, G, bx); EpiRoute E{SS3, IDX, GATE}; pg8::Unit uu;
        for (int i = 0; S.next(i, uu); ++i) { OneUnit O{uu}; pg8::gemm_phase<EpiRoute, OneUnit, false, true>(lds, g, O, E); }
    }
    SEAM(12);
    if (IN(14)) sliced_pass<0, true>(U8 + (size_t)NEXP * D, IDX, XB, XB, HP, AA, out, SS4, ctl + CW_WQ + 64 * 16, ctl + CW_BAR, MISC + 12, wave, lane, tid);
    SEAM(14);
    if (IN(15)) reduce_phase(HP, GATE, SS3, AA, vcu, G, tid);
    SEAM(15);
    if (IN(16)) sliced_pass<1, true>(V8 + (size_t)NEXP * D, IDX, XB, XB, HP, AA, out, SS4, ctl + CW_WQ + 64 * 24, ctl + CW_BAR, MISC + 12, wave, lane, tid);
    SEAM(16);
    if (IN(17)) final_phase(SS4, XB, out, fin_g, vcu, G, wave, lane);
#undef IN
#undef SEAM
}

extern "C" void kernel_launch(void* const* d_in, const int* in_sizes, int n_in, void* d_out, int out_size, void* d_ws, size_t ws_size, hipStream_t stream) {
    static int grid = 0;
    if (grid == 0) {
        if (n_in != 16 || in_sizes[0] != T * D || out_size != T * D || ws_size < WS_END) { fprintf(stderr, "kernel_launch: unexpected shapes (n_in %d, in0 %d, out %d, ws %zu)\n", n_in, n_in > 0 ? in_sizes[0] : -1, out_size, ws_size); grid = -1; return; }
        int dev = 0, cus = 0, per_cu = 0;
        if (hipGetDevice(&dev) != hipSuccess || hipDeviceGetAttribute(&cus, hipDeviceAttributeMultiprocessorCount, dev) != hipSuccess) { grid = -1; return; }
        if (hipFuncSetAttribute((const void*)fwd_kernel, hipFuncAttributeMaxDynamicSharedMemorySize, LDS_BYTES) != hipSuccess) { fprintf(stderr, "kernel_launch: hipFuncSetAttribute failed\n"); grid = -1; return; }
        if (hipOccupancyMaxActiveBlocksPerMultiprocessor(&per_cu, (const void*)fwd_kernel, NWAVES * 64, LDS_BYTES) != hipSuccess || per_cu < 1) { fprintf(stderr, "kernel_launch: occupancy query says %d blocks per CU\n", per_cu); (void)hipGetLastError(); grid = -1; return; }
        grid = cus;
    }
    if (grid < 0) return;
    (void)hipMemsetAsync((char*)d_ws + WS_CTL, 0, CTL_ZERO_BYTES, stream);
    Args a{};
    for (int i = 0; i < 16; ++i) a.in[i] = (const float*)d_in[i];
    a.out = (float*)d_out; a.ws = (unsigned char*)d_ws;
#if MK_PER_PHASE
    for (int p = 0; p < NPH; ++p) { a.ph_lo = p; a.ph_hi = p + 1; hipLaunchKernelGGL(fwd_kernel, dim3(grid), dim3(NWAVES * 64), LDS_BYTES, stream, a); }
#else
    a.ph_lo = 0; a.ph_hi = NPH;
    hipLaunchKernelGGL(fwd_kernel, dim3(grid), dim3(NWAVES * 64), LDS_BYTES, stream, a);
#endif
}
```

```cpp
#include <hip/hip_runtime.h>
#include <cstdio>
#include <cstdint>
namespace pg8 {
#define PG8_LAS __attribute__((address_space(3)))
typedef unsigned short bf16_t;
typedef short bf16x8 __attribute__((ext_vector_type(8)));
typedef float f32x4 __attribute__((ext_vector_type(4)));
typedef unsigned u32x4 __attribute__((ext_vector_type(4)));
constexpr int BM = 256, BK = 64, HALF = 128, HTB = HALF * BK * 2  , STAGE_BYTES = 8 * HTB, NXCD = 8, WGM = 8;

__host__ __device__ __forceinline__ int lds_byte(int r, int c) { const int st = (r >> 4) * 2 + (c >> 5), rr = r & 15, cc = c & 31, ob = rr * 64 + cc * 2; return st * 1024 + (ob ^ (((ob >> 9) & 1) << 5)); }
__host__ __device__ __forceinline__ void stage_rc(int b, int& R, int& C) { const int st = b / 1024, sb = b % 1024, swz = sb ^ (((sb >> 9) & 1) << 5); R = (st >> 1) * 16 + swz / 64; C = (st & 1) * 32 + (swz % 64) / 2; }
__host__ __device__ __forceinline__ int perm32(int rho) { const int n = rho >> 4, i = rho & 15; return 8 * (i >> 2) + 4 * n + (i & 3); }

struct Unit { int pm, pn; };
struct Gemm { const bf16_t* A; const bf16_t* Bt; int M, N, K; };

struct StaticOrder {
    int nM, nN, nwg, G, c;
    __host__ __device__ void init(int M, int N, int G_, int c_) { nM = M / BM; nN = N / BM; nwg = nM * nN; G = G_; c = c_; }
    __host__ __device__ bool next(int i, Unit& u) const {
        const long L = (long)i * G + c; if (L >= nwg) return false;
        int wgid = (int)L; { const int q = nwg / NXCD, r = nwg % NXCD, xcd = wgid % NXCD, off = wgid / NXCD; wgid = (xcd < r ? xcd * (q + 1) : r * (q + 1) + (xcd - r) * q) + off; }
        const int nig = WGM * nN, gid = wgid / nig, fm = gid * WGM, gsz = (nM - fm) < WGM ? (nM - fm) : WGM;
        u.pm = fm + ((wgid % nig) % gsz); u.pn = (wgid % nig) / gsz; return true;
    }
    __device__ __forceinline__ void a_ready(const Unit&) const {}
    __device__ __forceinline__ void done(const Unit&) const {}
};

__device__ __forceinline__ unsigned cvt_pk_bf16(float lo, float hi) { unsigned r; asm volatile("v_cvt_pk_bf16_f32 %0, %1, %2" : "=v"(r) : "v"(lo), "v"(hi)); return r; }
typedef unsigned u32x2 __attribute__((ext_vector_type(2)));
__device__ __forceinline__ float row_rstd(const float* ss, int row) {
    const f32x4* p = (const f32x4*)(ss + (size_t)row * 16);
    const f32x4 a = p[0], b = p[1], c = p[2], d = p[3];
    const float s = (((a[0] + a[1]) + (a[2] + a[3])) + ((b[0] + b[1]) + (b[2] + b[3]))) + (((c[0] + c[1]) + (c[2] + c[3])) + ((d[0] + d[1]) + (d[2] + d[3])));
    return __builtin_amdgcn_rsqf(s * (1.0f / 1024.0f) + 1e-6f);
}
struct EpiBf16RS {
    static constexpr bool PERM = true, AFTER_DRAIN = false;
    bf16_t* O0; int ld0; int nt0; bf16_t* O1; bf16_t* O2; int ld1; const float* ss;
    __device__ __forceinline__ void operator()(const f32x4 (&acc)[2][2][4][2], const Unit& u, int wr, int wc, int fr, int fq) const {
        bf16_t* base; int ld, colt;
        if (u.pn < nt0) { base = O0; ld = ld0; colt = u.pn * BM; } else if (u.pn == nt0) { base = O1; ld = ld1; colt = 0; } else { base = O2; ld = ld1; colt = (u.pn - nt0 - 1) * BM; }
        const int row0 = u.pm * BM + wr * 64 + fr, col0 = colt + wc * 32 + 8 * fq;
#pragma unroll
        for (int ai = 0; ai < 2; ++ai)
#pragma unroll
            for (int m = 0; m < 4; ++m) { const int row = row0 + ai * HALF + m * 16; const float rs = row_rstd(ss, row); bf16_t* rowp = base + (size_t)row * ld + col0;
#pragma unroll
                for (int bj = 0; bj < 2; ++bj) { const f32x4 v0 = acc[ai][bj][m][0] * rs, v1 = acc[ai][bj][m][1] * rs;
                    u32x4 w; w.x = cvt_pk_bf16(v0[0], v0[1]); w.y = cvt_pk_bf16(v0[2], v0[3]); w.z = cvt_pk_bf16(v1[0], v1[1]); w.w = cvt_pk_bf16(v1[2], v1[3]);
                    *(u32x4*)(rowp + bj * HALF) = w; } }
    }
};
struct EpiConvIn {
    static constexpr bool PERM = true, AFTER_DRAIN = false;
    bf16_t* P; bf16_t* GB; const float* ss;
    __device__ __forceinline__ void operator()(const f32x4 (&acc)[2][2][4][2], const Unit& u, int wr, int wc, int fr, int fq) const {
        const int row0 = u.pm * BM + wr * 64 + fr;
#pragma unroll
        for (int ai = 0; ai < 2; ++ai)
#pragma unroll
            for (int m = 0; m < 4; ++m) { const int row = row0 + ai * HALF + m * 16; const float rs = row_rstd(ss, row);
                if (u.pn < 8) { const float r2 = rs * rs; const f32x4 v0 = acc[ai][0][m][0] * acc[ai][1][m][0] * r2, v1 = acc[ai][0][m][1] * acc[ai][1][m][1] * r2;
                    u32x4 w; w.x = cvt_pk_bf16(v0[0], v0[1]); w.y = cvt_pk_bf16(v0[2], v0[3]); w.z = cvt_pk_bf16(v1[0], v1[1]); w.w = cvt_pk_bf16(v1[2], v1[3]);
                    *(u32x4*)(P + (size_t)row * 1024 + u.pn * 128 + wc * 32 + 8 * fq) = w;
                } else {
#pragma unroll
                    for (int bj = 0; bj < 2; ++bj) { const f32x4 v0 = acc[ai][bj][m][0] * rs, v1 = acc[ai][bj][m][1] * rs;
                        u32x4 w; w.x = cvt_pk_bf16(v0[0], v0[1]); w.y = cvt_pk_bf16(v0[2], v0[3]); w.z = cvt_pk_bf16(v1[0], v1[1]); w.w = cvt_pk_bf16(v1[2], v1[3]);
                        *(u32x4*)(GB + (size_t)row * 1024 + (u.pn - 8) * BM + bj * HALF + wc * 32 + 8 * fq) = w; } } }
    }
};
template <bool BASEF32> struct EpiResid {
    static constexpr bool PERM = true, AFTER_DRAIN = false;
    const float* basef; bf16_t* xb; float* ss;
    __device__ __forceinline__ void operator()(const f32x4 (&acc)[2][2][4][2], const Unit& u, int wr, int wc, int fr, int fq) const {
        const int row0 = u.pm * BM + wr * 64 + fr, col0 = u.pn * BM + wc * 32 + 8 * fq;
#pragma unroll
        for (int ai = 0; ai < 2; ++ai)
#pragma unroll
            for (int m = 0; m < 4; ++m) { const int row = row0 + ai * HALF + m * 16; float sq = 0.f;
#pragma unroll
                for (int bj = 0; bj < 2; ++bj) { const size_t off = (size_t)row * 1024 + col0 + bj * HALF;
                    f32x4 b0, b1;
                    if (BASEF32) { b0 = *(const f32x4*)(basef + off); b1 = *(const f32x4*)(basef + off + 4); }
                    else { const u32x4 w = *(const u32x4*)(xb + off);
                        b0 = (f32x4){__uint_as_float(w.x << 16), __uint_as_float(w.x & 0xffff0000u), __uint_as_float(w.y << 16), __uint_as_float(w.y & 0xffff0000u)};
                        b1 = (f32x4){__uint_as_float(w.z << 16), __uint_as_float(w.z & 0xffff0000u), __uint_as_float(w.w << 16), __uint_as_float(w.w & 0xffff0000u)}; }
                    const f32x4 o0 = b0 + acc[ai][bj][m][0], o1 = b1 + acc[ai][bj][m][1];
                    sq += ((o0[0] * o0[0] + o0[1] * o0[1]) + (o0[2] * o0[2] + o0[3] * o0[3])) + ((o1[0] * o1[0] + o1[1] * o1[1]) + (o1[2] * o1[2] + o1[3] * o1[3]));
                    u32x4 w; w.x = cvt_pk_bf16(o0[0], o0[1]); w.y = cvt_pk_bf16(o0[2], o0[3]); w.z = cvt_pk_bf16(o1[0], o1[1]); w.w = cvt_pk_bf16(o1[2], o1[3]);
                    *(u32x4*)(xb + off) = w; }
                sq += __shfl_xor(sq, 16); sq += __shfl_xor(sq, 32);
                if (fq == 0) ss[(size_t)row * 16 + u.pn * 4 + wc] = sq; }
    }
};

template <class Epi, class Sched, bool ALIGN_EPI = false, bool SP2 = false>
__device__ __forceinline__ void gemm_phase(PG8_LAS unsigned char* lds, const Gemm g, const Sched& S, const Epi& E) {
    const int tid = threadIdx.x, wid = __builtin_amdgcn_readfirstlane(tid >> 6), lane = tid & 63, wr = wid >> 2, wc = wid & 3, fr = lane & 15, fq = lane >> 4;
    const int K = g.K, nt = K / BK;
    unsigned voffA[2], voffB[2];
#pragma unroll
    for (int i = 0; i < 2; ++i) { int R, C; stage_rc(tid * 16 + i * 8192, R, C); const int Rb = Epi::PERM ? ((R & ~31) + perm32(R & 31)) : R;
        voffA[i] = (unsigned)(R * K + C) * 2u; voffB[i] = (unsigned)(Rb * K + C) * 2u; }
    const size_t kstep = (size_t)(BK * 2);
    const size_t hstep = (size_t)HALF * K * 2;
    const size_t tstep = 2 * hstep;
    const unsigned ldsw = (unsigned)wid * 1024u;
    const int aoff = lds_byte(wr * 64 + fr, fq * 8), boff = lds_byte(wc * 32 + fr, fq * 8);
#define PG8_SA(b, h) (((b) * 2 + (h)) * HTB)
#define PG8_SB(b, h) ((4 + (b) * 2 + (h)) * HTB)
#define PG8_STAGE(bufoff, gbase, voff) do { _Pragma("unroll") for (int _i = 0; _i < 2; ++_i) \
        __builtin_amdgcn_global_load_lds((const unsigned*)((const char*)(gbase) + (voff)[_i]), (PG8_LAS unsigned*)(lds + (bufoff) + ldsw + _i * 8192), 16, 0, 0); } while (0)
#define PG8_LDA(dst, b, h) do { _Pragma("unroll") for (int m = 0; m < 4; ++m) _Pragma("unroll") for (int k = 0; k < 2; ++k) dst[m][k] = *(const PG8_LAS bf16x8*)(lds + PG8_SA(b, h) + aoff + m * 2048 + k * 1024); } while (0)
#define PG8_LDB(dst, b, h) do { _Pragma("unroll") for (int n = 0; n < 2; ++n) _Pragma("unroll") for (int k = 0; k < 2; ++k) dst[n][k] = *(const PG8_LAS bf16x8*)(lds + PG8_SB(b, h) + boff + n * 2048 + k * 1024); } while (0)
#define PG8_MMA(ai, bj, At, Bt) do { __builtin_amdgcn_s_setprio(1); _Pragma("unroll") for (int m = 0; m < 4; ++m) _Pragma("unroll") for (int n = 0; n < 2; ++n) _Pragma("unroll") for (int k = 0; k < 2; ++k) \
        acc[ai][bj][m][n] = __builtin_amdgcn_mfma_f32_16x16x32_bf16(Bt[n][k], At[m][k], acc[ai][bj][m][n], 0, 0, 0); __builtin_amdgcn_s_setprio(0); } while (0)
#define PG8_WAIT_V(n) asm volatile("s_waitcnt vmcnt(" #n ")" ::: "memory")
#define PG8_WAIT_L(n) asm volatile("s_waitcnt lgkmcnt(" #n ")" ::: "memory")
#define PG8_BAR __builtin_amdgcn_s_barrier()
#define PG8_SCHED __builtin_amdgcn_sched_barrier(0)
    Unit cur, nxt; int ui = 0;
    if (!S.next(0, cur)) return;
    f32x4 acc[2][2][4][2];
#pragma unroll
    for (int a = 0; a < 2; ++a)
#pragma unroll
        for (int b = 0; b < 2; ++b)
#pragma unroll
            for (int m = 0; m < 4; ++m)
#pragma unroll
                for (int n = 0; n < 2; ++n) acc[a][b][m][n] = (f32x4){0.f, 0.f, 0.f, 0.f};
    bf16x8 At[4][2], B0[2][2], B1[2][2];
    const char* cA = (const char*)g.A + (size_t)cur.pm * tstep; const char* cB = (const char*)g.Bt + (size_t)cur.pn * tstep;
    S.a_ready(cur);
    if constexpr (SP2) {
        PG8_STAGE(PG8_SB(0, 0), cB, voffB); PG8_STAGE(PG8_SB(0, 1), cB + hstep, voffB); PG8_STAGE(PG8_SA(0, 0), cA, voffA); PG8_STAGE(PG8_SA(0, 1), cA + hstep, voffA);
        if (wr == 1) PG8_BAR;
        PG8_WAIT_V(2); PG8_BAR;
        PG8_STAGE(PG8_SB(1, 0), cB + kstep, voffB); PG8_STAGE(PG8_SA(1, 0), cA + kstep, voffA); PG8_STAGE(PG8_SB(1, 1), cB + hstep + kstep, voffB);
        PG8_WAIT_V(6); PG8_BAR;
    } else {
        PG8_STAGE(PG8_SB(0, 0), cB, voffB); PG8_STAGE(PG8_SA(0, 0), cA, voffA); PG8_STAGE(PG8_SB(0, 1), cB + hstep, voffB); PG8_STAGE(PG8_SA(0, 1), cA + hstep, voffA);
        if (wr == 1) PG8_BAR;
        PG8_WAIT_V(4); PG8_BAR;
        PG8_STAGE(PG8_SB(1, 0), cB + kstep, voffB); PG8_STAGE(PG8_SA(1, 0), cA + kstep, voffA); PG8_STAGE(PG8_SB(1, 1), cB + hstep + kstep, voffB);
        PG8_WAIT_V(6); PG8_BAR;
    }
    for (;;) {
        const bool has_next = S.next(ui + 1, nxt);
        const char* nA = has_next ? (const char*)g.A + (size_t)nxt.pm * tstep : cA; const char* nB = has_next ? (const char*)g.Bt + (size_t)nxt.pn * tstep : cB;
        for (int t = 0; t < nt; t += 2) {
            const bool last = (t == nt - 2);
            const char* a1 = cA + (size_t)(t + 1) * kstep;
            const char* a2 = last ? nA : cA + (size_t)(t + 2) * kstep; const char* b2 = last ? nB : cB + (size_t)(t + 2) * kstep;
            const char* a3 = a2 + kstep; const char* b3 = b2 + kstep;
            if (last && has_next) S.a_ready(nxt);
            if constexpr (SP2) {
            PG8_LDB(B0, 0, 0); PG8_LDB(B1, 0, 1); PG8_SCHED; PG8_LDA(At, 0, 0); PG8_STAGE(PG8_SA(1, 1), a1 + hstep, voffA);
            PG8_WAIT_V(8); PG8_WAIT_L(0); PG8_BAR; PG8_MMA(0, 0, At, B0); PG8_MMA(0, 1, At, B1); PG8_BAR; PG8_SCHED;
            PG8_LDA(At, 0, 1); PG8_STAGE(PG8_SB(0, 0), b2, voffB); PG8_STAGE(PG8_SB(0, 1), b2 + hstep, voffB); PG8_STAGE(PG8_SA(0, 0), a2, voffA);
            PG8_WAIT_V(8); PG8_WAIT_L(0); PG8_BAR; PG8_MMA(1, 0, At, B0); PG8_MMA(1, 1, At, B1); PG8_BAR; PG8_SCHED;
            PG8_LDB(B0, 1, 0); PG8_LDB(B1, 1, 1); PG8_SCHED; PG8_LDA(At, 1, 0); PG8_STAGE(PG8_SA(0, 1), a2 + hstep, voffA);
            PG8_WAIT_V(8); PG8_WAIT_L(0); PG8_BAR; PG8_MMA(0, 0, At, B0); PG8_MMA(0, 1, At, B1); PG8_BAR; PG8_SCHED;
            PG8_LDA(At, 1, 1); PG8_STAGE(PG8_SB(1, 0), b3, voffB); PG8_STAGE(PG8_SB(1, 1), b3 + hstep, voffB); PG8_STAGE(PG8_SA(1, 0), a3, voffA);
            PG8_WAIT_V(8); PG8_WAIT_L(0); PG8_BAR; PG8_MMA(1, 0, At, B0); PG8_MMA(1, 1, At, B1); PG8_BAR; PG8_SCHED;
            } else {
            PG8_LDB(B0, 0, 0); PG8_SCHED; PG8_LDA(At, 0, 0); PG8_STAGE(PG8_SA(1, 1), a1 + hstep, voffA);
            PG8_WAIT_L(8); PG8_BAR; PG8_WAIT_L(0); PG8_MMA(0, 0, At, B0); PG8_BAR; PG8_SCHED;
            PG8_LDB(B1, 0, 1); PG8_STAGE(PG8_SB(0, 0), b2, voffB);
            PG8_BAR; PG8_WAIT_L(0); PG8_MMA(0, 1, At, B1); PG8_BAR;
            PG8_LDA(At, 0, 1); PG8_STAGE(PG8_SA(0, 0), a2, voffA);
            PG8_BAR; PG8_WAIT_L(0); PG8_MMA(1, 0, At, B0); PG8_BAR; PG8_SCHED;
            PG8_STAGE(PG8_SB(0, 1), b2 + hstep, voffB);
            PG8_WAIT_V(6); PG8_BAR; PG8_MMA(1, 1, At, B1); PG8_BAR;
            PG8_LDB(B0, 1, 0); PG8_SCHED; PG8_LDA(At, 1, 0); PG8_STAGE(PG8_SA(0, 1), a2 + hstep, voffA);
            PG8_WAIT_L(8); PG8_BAR; PG8_WAIT_L(0); PG8_MMA(0, 0, At, B0); PG8_BAR; PG8_SCHED;
            PG8_LDB(B1, 1, 1); PG8_STAGE(PG8_SB(1, 0), b3, voffB);
            PG8_BAR; PG8_WAIT_L(0); PG8_MMA(0, 1, At, B1); PG8_BAR;
            PG8_LDA(At, 1, 1); PG8_STAGE(PG8_SA(1, 0), a3, voffA);
            PG8_BAR; PG8_WAIT_L(0); PG8_MMA(1, 0, At, B0); PG8_BAR; PG8_SCHED;
            PG8_STAGE(PG8_SB(1, 1), b3 + hstep, voffB);
            PG8_WAIT_V(6); PG8_BAR; PG8_MMA(1, 1, At, B1); PG8_BAR;
            }
        }
        if constexpr (ALIGN_EPI) { if (wr == 0) PG8_BAR; }
        if constexpr (!Epi::AFTER_DRAIN) { E(acc, cur, wr, wc, fr, fq); S.done(cur); }
        if (!has_next) break;
#pragma unroll
        for (int a = 0; a < 2; ++a)
#pragma unroll
            for (int b = 0; b < 2; ++b)
#pragma unroll
                for (int m = 0; m < 4; ++m)
#pragma unroll
                    for (int n = 0; n < 2; ++n) acc[a][b][m][n] = (f32x4){0.f, 0.f, 0.f, 0.f};
        cur = nxt; cA = nA; cB = nB; ++ui;
        if constexpr (ALIGN_EPI) { if (wr == 1) PG8_BAR; }
    }
    PG8_WAIT_V(0);
    if constexpr (!ALIGN_EPI) { if (wr == 0) PG8_BAR; }
    PG8_BAR;
    if constexpr (Epi::AFTER_DRAIN) { E.fused(acc, cur, wr, wc, fr, fq, lds, wid, lane); S.done(cur); }
#undef PG8_SA
#undef PG8_SB
#undef PG8_STAGE
#undef PG8_LDA
#undef PG8_LDB
#undef PG8_MMA
#undef PG8_WAIT_V
#undef PG8_WAIT_L
#undef PG8_BAR
#undef PG8_SCHED
}
}

constexpr int NWAVES = 8;
constexpr int BATCH = 2, SEQ = 8192, D = 1024, T = BATCH * SEQ;
constexpr int NIN = 3072, NQKV = 1536, NPQ = 2048, NEXP = 16384;
constexpr int TROW = 2048;
#define CPOS(c) (2 * (c))
constexpr float LOG2E = 1.4426950408889634f;
constexpr float QSCALE = 0.125f * LOG2E;
constexpr float NEGBIG = -1e30f;
#ifndef MK_PER_PHASE
#define MK_PER_PHASE 0
#endif
constexpr int NPH = 18;
#ifndef REP_MASK
#define REP_MASK 0
#endif
#define REPS(k) for (int rep_ = 0; rep_ < (((REP_MASK) >> (k)) & 1) + 1; ++rep_)

constexpr size_t MiB = 1u << 20;
constexpr size_t WS_CTL = 0, CTL_ZERO_BYTES = 65536;
constexpr size_t WS_WIN = 1 * MiB, WS_WOUT = 7 * MiB, WS_WQKV = 9 * MiB, WS_WO = 12 * MiB, WS_WPQ = 14 * MiB, WS_SK = 22 * MiB;
constexpr size_t WS_SS = 23 * MiB;
constexpr size_t WS_IDX = 28 * MiB, WS_GATE = 36 * MiB, WS_XB = 44 * MiB, WS_Y = 76 * MiB, WS_U = 108 * MiB, WS_V = 172 * MiB;
constexpr size_t WS_G1 = 236 * MiB, WS_PQ = 332 * MiB, WS_Q = 396 * MiB, WS_K = 428 * MiB, WS_VV = 436 * MiB, WS_AO = 444 * MiB, WS_END = 476 * MiB;
constexpr size_t WS_HP = WS_G1, WS_A = WS_G1 + 64 * MiB;
constexpr int CW_BAR = 4096;
constexpr int CW_WQ = 8192;

constexpr int RING_BYTES = 131072;
constexpr int LDSCTL_OFF = 143360, MISC_OFF = LDSCTL_OFF + 320;
constexpr int SC_STRIDE = 260, SC_TAB_OFF = 135168;
constexpr int LDS_BYTES = 147456;

#define LAS __attribute__((address_space(3)))
typedef unsigned short bf16;
typedef unsigned v4u __attribute__((ext_vector_type(4)));
typedef unsigned v2u __attribute__((ext_vector_type(2)));
typedef float f32x4 __attribute__((ext_vector_type(4)));
typedef float f32x2 __attribute__((ext_vector_type(2)));
typedef float f32x16 __attribute__((ext_vector_type(16)));
typedef short bf16x8 __attribute__((ext_vector_type(8)));
typedef __bf16 bf16x2_t __attribute__((ext_vector_type(2)));
#define LDS_WAIT() asm volatile("s_waitcnt lgkmcnt(0)" ::: "memory")
#define DI __device__ __forceinline__

DI unsigned pk2(float lo, float hi) { f32x2 v = {lo, hi}; bf16x2_t b = __builtin_convertvector(v, bf16x2_t); return __builtin_bit_cast(unsigned, b); }
DI float bf_lo(unsigned u) { return __uint_as_float(u << 16); }
DI float bf_hi(unsigned u) { return __uint_as_float(u & 0xffff0000u); }
DI float wave_sum(float v) {
#pragma unroll
    for (int o = 1; o < 64; o <<= 1) v += __shfl_xor(v, o);
    return v;
}
#define XB_TMO      128
#define XB_XCNT(j)  (256  + 64 * (j))
#define XB_XSUB(j)  (1280 + 64 * (j))
#define XB_XGEN(j)  (2304 + 64 * (j))
#define XB_TOP      3328
#define XB_TOPGEN   3392
#define XCD_BAR_WORDS 3456
#define XB_SPIN_CAP (1u << 18)

__device__ __forceinline__ unsigned xb_ld(unsigned* p)              { return __hip_atomic_load(p, __ATOMIC_RELAXED, __HIP_MEMORY_SCOPE_AGENT); }
__device__ __forceinline__ unsigned xb_add(unsigned* p, unsigned v) { return __hip_atomic_fetch_add(p, v, __ATOMIC_RELAXED, __HIP_MEMORY_SCOPE_AGENT); }
__device__ __forceinline__ unsigned xb_xcc_id() { return (unsigned)__builtin_amdgcn_s_getreg((3 << 11) | 20) & 0xFu; }
#define XB_SPIN(cond, bar) do { unsigned _sp = 0; while (cond) { __builtin_amdgcn_s_sleep(1); \
    if ((++_sp & 255u) == 0u) { if (xb_ld(&(bar)[XB_TMO])) break; if (_sp > XB_SPIN_CAP) { atomicAdd(&(bar)[XB_TMO], 1u); break; } } } } while (0)

struct XcdBarrier {
    unsigned* bar; unsigned x;
    volatile LAS unsigned* st;
};

__device__ __forceinline__ XcdBarrier xcd_barrier_post(unsigned* bar, volatile LAS unsigned* st) {
    XcdBarrier b; b.bar = bar; b.x = xb_xcc_id(); b.st = st;
    if (threadIdx.x == 0) (void)xb_add(&bar[XB_XCNT(b.x)], 1u);
    return b;
}
__device__ __forceinline__ void xcd_barrier_complete(unsigned* bar, unsigned x, unsigned& nloc, unsigned& nx) {
    const unsigned G = gridDim.x * gridDim.y * gridDim.z;
    unsigned sum, cnt, mine, sp = 0u;
    for (;;) {
        sum = 0u; cnt = 0u; mine = 0u;
#pragma unroll
        for (unsigned j = 0; j < 16; ++j) { const unsigned c = xb_ld(&bar[XB_XCNT(j)]); sum += c; cnt += (c > 0u) ? 1u : 0u; mine = (j == x) ? c : mine; }
        if (sum == G) break;
        __builtin_amdgcn_s_sleep(1);
        if ((++sp & 255u) == 0u) { if (xb_ld(&bar[XB_TMO])) break; if (sp > XB_SPIN_CAP) { atomicAdd(&bar[XB_TMO], 1u); break; } }
    }
    nloc = mine > 0u ? mine : 1u; nx = cnt > 0u ? cnt : 1u;
}

__device__ __forceinline__ void xcd_barrier(const XcdBarrier& b) {
    asm volatile("s_waitcnt vmcnt(0)" ::: "memory");
    __syncthreads();
    if (threadIdx.x == 0) {
        unsigned* bar = b.bar;
        __builtin_amdgcn_s_waitcnt(0);
        unsigned nloc = b.st[0], nx = b.st[1];
        if (nloc == 0u) { xcd_barrier_complete(bar, b.x, nloc, nx); b.st[0] = nloc; b.st[1] = nx; }
        const unsigned old = xb_add(&bar[XB_XSUB(b.x)], 1u);
        const unsigned gen = old / nloc;
        if (old + 1u == (gen + 1u) * nloc) {
            __builtin_amdgcn_fence(__ATOMIC_RELEASE, "agent");
            asm volatile("s_waitcnt vmcnt(0)" ::: "memory");
            const unsigned og = xb_add(&bar[XB_TOP], 1u);
            const unsigned tg = og / nx;
            if (og + 1u == (tg + 1u) * nx) xb_add(&bar[XB_TOPGEN], 1u);
            else XB_SPIN(xb_ld(&bar[XB_TOPGEN]) == tg, bar);
            __builtin_amdgcn_fence(__ATOMIC_ACQUIRE, "agent");
            xb_add(&bar[XB_XGEN(b.x)], 1u);
            asm volatile("s_waitcnt vmcnt(0)" ::: "memory");
        } else {
            XB_SPIN(xb_ld(&bar[XB_XGEN(b.x)]) == gen, bar);
            __builtin_amdgcn_fence(__ATOMIC_ACQUIRE, "agent");
            asm volatile("s_waitcnt vmcnt(0)" ::: "memory");
        }
    }
    __syncthreads();
}

template <bool REMAP = false>
DI void p0_transpose_item(const float* W, int K, int N, bf16* WT, LAS float* scr, int item, int lane, const float* gain, int nscaled, float cscale) {
    const int nblk = N / 32, kb = item / nblk, nb = item % nblk, k0 = 64 * kb, n0 = 32 * nb;
    float tv[32];
#pragma unroll
    for (int i = 0; i < 32; ++i) tv[i] = W[(size_t)(k0 + 2 * i + (lane >> 5)) * N + n0 + (lane & 31)];
#pragma unroll
    for (int i = 0; i < 32; ++i) { const int kk = 2 * i + (lane >> 5); float v = tv[i]; if (gain) v *= gain[k0 + kk]; scr[kk * 33 + (lane & 31)] = v; }
    LDS_WAIT();
    const int c = lane & 7;
#pragma unroll
    for (int j = 0; j < 4; ++j) { const int n = (lane >> 3) + 8 * j; const LAS float* s = scr + (8 * c) * 33 + n; const float cs = (n0 + n < nscaled) ? cscale : 1.f;
        v4u o; o.x = pk2(s[0 * 33] * cs, s[1 * 33] * cs); o.y = pk2(s[2 * 33] * cs, s[3 * 33] * cs); o.z = pk2(s[4 * 33] * cs, s[5 * 33] * cs); o.w = pk2(s[6 * 33] * cs, s[7 * 33] * cs);
        int drow = n0 + n; if (REMAP) { const int part = drow >> 10, d = drow & 1023; drow = part == 0 ? 2048 + d : 256 * (d >> 7) + (d & 127) + (part == 2 ? 128 : 0); }
        *(v4u*)(WT + (size_t)drow * K + k0 + 8 * c) = o; }
    LDS_WAIT();
}
DI void table_blocks(const float* pu, const float* pv, const float* ffn_g, unsigned char* U8, unsigned char* V8, size_t b0, size_t b1, size_t w, size_t nw, int lane) {
    constexpr size_t NB = (size_t)2 * NEXP * D / 2048;
    for (size_t blk = b0 + w; blk < b1; blk += nw) { const bool isv = blk >= NB; const size_t bb = isv ? blk - NB : blk; const int layer = (int)(bb / (NB / 2));
        const float* src = (isv ? pv : pu) + bb * 2048; unsigned char* dst = (isv ? V8 : U8) + bb * 2 * TROW;
        f32x4 v[8];
#pragma unroll
        for (int j = 0; j < 8; ++j) v[j] = __builtin_nontemporal_load((const f32x4*)(src + 256 * j) + lane);
#pragma unroll
        for (int j = 0; j < 8; ++j) { unsigned wd;
            if (isv) { const f32x4 t = v[j] * 1024.0f; int wi = __builtin_amdgcn_cvt_pk_fp8_f32(t[0], t[1], 0, false); wi = __builtin_amdgcn_cvt_pk_fp8_f32(t[2], t[3], wi, true); wd = (unsigned)wi; }
            else { const f32x4 g = *((const f32x4*)(ffn_g + layer * D + 256 * (j & 3)) + lane); const f32x4 t = v[j] * g * 512.0f; wd = 0u;
#pragma unroll
                for (int e = 0; e < 4; ++e) { const int qi = (int)__builtin_rintf(fminf(fmaxf(t[e], -127.f), 127.f)); wd |= ((unsigned)qi & 0xffu) << (8 * e); } }
            { const int cc = 2 * (j & 3) + (lane >> 5); *(unsigned*)(dst + TROW * (j >> 2) + 128 * CPOS(cc) + 4 * (lane & 31)) = wd; } } }
}
struct P0Args { const float *x, *conv_g, *w_in, *w_out, *attn_g, *w_qkv, *w_o, *ffn_g, *w_pq, *subk, *pu, *pv;
                bf16 *WinT, *WoutT, *WqkvT, *WoT, *WpqT, *SKb; unsigned char *U8, *V8; bf16* XB; float* SS0; };
DI void p0_prologue(const P0Args& a, LAS unsigned char* lds, int vcu, int G, int wave, int lane, int tid) {
    LAS float* scr = (LAS float*)(lds + wave * 16384);
    const int gw = vcu * NWAVES + wave, NGW = G * NWAVES;
    constexpr int I_IN = 16 * (NIN / 32), I_OUT = 16 * (D / 32), I_QKV = 16 * (NQKV / 32), I_O = I_OUT;
    constexpr int NITEMS = I_IN + I_OUT + I_QKV + I_O;
    for (int it = gw; it < NITEMS; it += NGW) {
        int r = it;
        if (r < I_IN) { p0_transpose_item<true>(a.w_in, D, NIN, a.WinT, scr, r, lane, a.conv_g, 0, 1.f); continue; } r -= I_IN;
        if (r < I_OUT) { p0_transpose_item(a.w_out, D, D, a.WoutT, scr, r, lane, nullptr, 0, 1.f); continue; } r -= I_OUT;
        if (r < I_QKV) { p0_transpose_item(a.w_qkv, D, NQKV, a.WqkvT, scr, r, lane, a.attn_g, 1024, QSCALE); continue; } r -= I_QKV;
        p0_transpose_item(a.w_o, D, D, a.WoT, scr, r, lane, nullptr, 0, 1.f);
    }
    { const int fr = lane & 15, fq = lane >> 4;
      for (int task = gw; task < 2 * 16 * 8 * 16; task += NGW) { const int kc = task & 15, nt = (task >> 4) & 7, hp = (task >> 7) & 15, l = task >> 11;
        const float* skp = a.subk + ((size_t)(l * 16 + hp) * 128 + nt * 16 + fr) * 128 + fq * 8;
        bf16x8 bfr[4];
#pragma unroll
        for (int ks = 0; ks < 4; ++ks) { const f32x4 v0 = *(const f32x4*)(skp + ks * 32), v1 = *(const f32x4*)(skp + ks * 32 + 4);
            v4u w; w.x = pk2(v0[0], v0[1]); w.y = pk2(v0[2], v0[3]); w.z = pk2(v1[0], v1[1]); w.w = pk2(v1[2], v1[3]); bfr[ks] = __builtin_bit_cast(bf16x8, w); }
#pragma unroll 1
        for (int kt = 0; kt < 4; ++kt) { const int k0 = kc * 64 + kt * 16;
            const float* wp = a.w_pq + ((size_t)l * D + k0 + fr) * NPQ + hp * 128 + fq * 8;
            f32x4 acc = {0.f, 0.f, 0.f, 0.f};
#pragma unroll
            for (int ks = 0; ks < 4; ++ks) { const f32x4 v0 = *(const f32x4*)(wp + ks * 32), v1 = *(const f32x4*)(wp + ks * 32 + 4);
                v4u w; w.x = pk2(v0[0], v0[1]); w.y = pk2(v0[2], v0[3]); w.z = pk2(v1[0], v1[1]); w.w = pk2(v1[2], v1[3]);
                acc = __builtin_amdgcn_mfma_f32_16x16x32_bf16(__builtin_bit_cast(bf16x8, w), bfr[ks], acc, 0, 0, 0); }
            const f32x4 g = *(const f32x4*)(a.ffn_g + l * D + k0 + 4 * fq); acc = acc * g;
            v2u o; o.x = pk2(acc[0], acc[1]); o.y = pk2(acc[2], acc[3]);
            *(v2u*)(a.WpqT + ((size_t)l * NPQ + hp * 128 + nt * 16 + fr) * D + k0 + 4 * fq) = o; } } }
    const size_t gt = (size_t)vcu * (NWAVES * 64) + tid, NGT = (size_t)G * NWAVES * 64;
    { constexpr size_t NB = (size_t)2 * NEXP * D / 2048;
      table_blocks(a.pu, a.pv, a.ffn_g, a.U8, a.V8, 0, NB / 2, (size_t)gw, (size_t)NGW, lane);
      table_blocks(a.pu, a.pv, a.ffn_g, a.U8, a.V8, NB, 2 * NB, (size_t)gw, (size_t)NGW, lane);
      if (G != 256) table_blocks(a.pu, a.pv, a.ffn_g, a.U8, a.V8, NB / 2, NB, (size_t)gw, (size_t)NGW, lane); }
    for (int m0 = 2 * gw; m0 < T; m0 += 2 * NGW) {
        f32x4 v[2][4]; float s2[2];
#pragma unroll
        for (int r = 0; r < 2; ++r)
#pragma unroll
            for (int j = 0; j < 4; ++j) v[r][j] = *((const f32x4*)(a.x + (size_t)(m0 + r) * D) + lane + 64 * j);
#pragma unroll
        for (int r = 0; r < 2; ++r) { float s = 0.f;
#pragma unroll
            for (int j = 0; j < 4; ++j) s += (v[r][j][0] * v[r][j][0] + v[r][j][1] * v[r][j][1]) + (v[r][j][2] * v[r][j][2] + v[r][j][3] * v[r][j][3]);
            s2[r] = wave_sum(s); }
#pragma unroll
        for (int r = 0; r < 2; ++r) { const int m = m0 + r;
            v2u* o8 = (v2u*)(a.XB + (size_t)m * D) + lane;
#pragma unroll
            for (int j = 0; j < 4; ++j) { v2u w; w.x = pk2(v[r][j][0], v[r][j][1]); w.y = pk2(v[r][j][2], v[r][j][3]); o8[64 * j] = w; }
            if (lane < 4) { f32x4 z = {0.f, 0.f, 0.f, 0.f}; ((f32x4*)(a.SS0 + (size_t)(2 * T + m) * 16))[lane] = z; ((f32x4*)(a.SS0 + (size_t)(4 * T + m) * 16))[lane] = z;
                if (lane == 0) z[0] = s2[r]; ((f32x4*)(a.SS0 + (size_t)m * 16))[lane] = z; } }
    }
}

DI void conv_gate_phase(const bf16* GB, const bf16* P, const float* cw, bf16* Y, int vcu, int G, int tid) {
    const size_t gt = (size_t)vcu * (NWAVES * 64) + tid, NGT = (size_t)G * NWAVES * 64;
    for (size_t c = gt; c < (size_t)T * (D / 8); c += NGT) {
        const int t = (int)(c / (D / 8)), d0 = (int)(c % (D / 8)) * 8, ts = t % SEQ;
        const v4u gb = *(const v4u*)(GB + (size_t)t * D + d0);
        float acc[8];
#pragma unroll
        for (int i = 0; i < 8; ++i) acc[i] = 0.f;
#pragma unroll
        for (int w = 0; w < 3; ++w) { const int tt = ts + w - 1;
            if (tt >= 0 && tt < SEQ) {
                const v4u pp = *(const v4u*)(P + (size_t)(t + w - 1) * D + d0);
                const f32x4 w0 = *(const f32x4*)(cw + w * D + d0), w1 = *(const f32x4*)(cw + w * D + d0 + 4);
                acc[0] += w0[0] * bf_lo(pp.x); acc[1] += w0[1] * bf_hi(pp.x); acc[2] += w0[2] * bf_lo(pp.y); acc[3] += w0[3] * bf_hi(pp.y);
                acc[4] += w1[0] * bf_lo(pp.z); acc[5] += w1[1] * bf_hi(pp.z); acc[6] += w1[2] * bf_lo(pp.w); acc[7] += w1[3] * bf_hi(pp.w); } }
        v4u o; o.x = pk2(acc[0] * bf_lo(gb.x), acc[1] * bf_hi(gb.x)); o.y = pk2(acc[2] * bf_lo(gb.y), acc[3] * bf_hi(gb.y));
        o.z = pk2(acc[4] * bf_lo(gb.z), acc[5] * bf_hi(gb.z)); o.w = pk2(acc[6] * bf_lo(gb.w), acc[7] * bf_hi(gb.w));
        *(v4u*)(Y + (size_t)t * D + d0) = o;
    }
}

template <int CTRL> DI unsigned dppu(unsigned v) { return (unsigned)__builtin_amdgcn_update_dpp(0, (int)v, CTRL, 0xf, 0xf, false); }
DI unsigned umax(unsigned a, unsigned b) { return a > b ? a : b; }
DI unsigned umin(unsigned a, unsigned b) { return a < b ? a : b; }
DI unsigned rowmax_u(unsigned v) { v = umax(v, dppu<0x128>(v)); v = umax(v, dppu<0x124>(v)); v = umax(v, dppu<0x122>(v)); v = umax(v, dppu<0x121>(v)); return v; }
DI float rowsum_f(float v) { v += __uint_as_float(dppu<0x128>(__float_as_uint(v))); v += __uint_as_float(dppu<0x124>(__float_as_uint(v))); v += __uint_as_float(dppu<0x122>(__float_as_uint(v))); v += __uint_as_float(dppu<0x121>(__float_as_uint(v))); return v; }
DI unsigned f2key(float f) { const unsigned u = __float_as_uint(f); return u ^ ((unsigned)((int)u >> 31) | 0x80000000u); }
DI float key2f(unsigned k) { const unsigned u = (k & 0x80000000u) ? (k ^ 0x80000000u) : ~k; return __uint_as_float(u); }
DI unsigned cand_ij(int c) {
    unsigned i, j;
    if (c < 16) { i = 0; j = c; } else if (c < 24) { i = 1; j = c - 16; } else if (c < 29) { i = 2; j = c - 24; } else if (c < 33) { i = 3; j = c - 29; }
    else if (c < 36) { i = 4; j = c - 33; } else if (c < 38) { i = 5; j = c - 36; } else if (c < 40) { i = 6; j = c - 38; } else if (c < 42) { i = 7; j = c - 40; }
    else { i = 8 + (c - 42); j = 0; }
    return (i & 15u) | (j << 4);
}
#define CE_DESC(a, b) do { const unsigned _hi = umax(a, b), _lo = umin(a, b); a = _hi; b = _lo; } while (0)
DI void topk_group(const LAS float* SC, int srow0, int t0, int h, unsigned short* IDX, float* GATE, const LAS unsigned char* TAB, int lane) {
    const int fr = lane & 15, fq = lane >> 4;
        unsigned res[2][4];
#pragma unroll
        for (int p = 0; p < 2; ++p) {
            f32x4 acc[8];
#pragma unroll
            for (int n = 0; n < 8; ++n)
#pragma unroll
                for (int r = 0; r < 4; ++r) acc[n][r] = SC[(srow0 + 4 * fq + r) * SC_STRIDE + p * 128 + 16 * n + fr];
            unsigned L[4][8];
#pragma unroll
            for (int r = 0; r < 4; ++r)
#pragma unroll
                for (int n = 0; n < 8; ++n) L[r][n] = (f2key(acc[n][r]) & ~127u) | (unsigned)(127 - (16 * n + fr));
#define CE4(i, j) do { _Pragma("unroll") for (int r = 0; r < 4; ++r) CE_DESC(L[r][i], L[r][j]); } while (0)
            CE4(0, 1); CE4(2, 3); CE4(4, 5); CE4(6, 7);
            CE4(0, 2); CE4(1, 3); CE4(4, 6); CE4(5, 7);
            CE4(1, 2); CE4(5, 6); CE4(0, 4); CE4(3, 7);
            CE4(1, 5); CE4(2, 6);
            CE4(1, 4); CE4(3, 6);
            CE4(2, 4); CE4(3, 5);
            CE4(3, 4);
#undef CE4
            unsigned rr[4] = {0u, 0u, 0u, 0u};
#pragma unroll
            for (int k = 0; k < 16; ++k) {
                unsigned gm[4];
#pragma unroll
                for (int r = 0; r < 4; ++r) gm[r] = umax(L[r][0], dppu<0x128>(L[r][0]));
#pragma unroll
                for (int r = 0; r < 4; ++r) gm[r] = umax(gm[r], dppu<0x124>(gm[r]));
#pragma unroll
                for (int r = 0; r < 4; ++r) gm[r] = umax(gm[r], dppu<0x122>(gm[r]));
#pragma unroll
                for (int r = 0; r < 4; ++r) gm[r] = umax(gm[r], dppu<0x121>(gm[r]));
#pragma unroll
                for (int r = 0; r < 4; ++r) { rr[r] = (fr == k) ? gm[r] : rr[r]; const bool pop = (L[r][0] == gm[r]);
#pragma unroll
                    for (int n = 0; n < 7; ++n) L[r][n] = pop ? L[r][n + 1] : L[r][n];
                    L[r][7] = pop ? 0u : L[r][7]; }
            }
#pragma unroll
            for (int r = 0; r < 4; ++r) res[p][r] = rr[r];
        }
        const int gbase = (lane & 48) * 4;
        unsigned ck[4][4];
#pragma unroll
        for (int r = 0; r < 4; ++r)
#pragma unroll
            for (int s = 0; s < 4; ++s) { const int c = fr + 16 * s; const unsigned tb = TAB[c & 63];
                const unsigned k0 = (unsigned)__builtin_amdgcn_ds_bpermute(gbase + (int)(tb & 15u) * 4, (int)res[0][r]);
                const unsigned k1 = (unsigned)__builtin_amdgcn_ds_bpermute(gbase + (int)((tb >> 4) & 15u) * 4, (int)res[1][r]);
                const float v = key2f((k0 & ~127u) | 64u) + key2f((k1 & ~127u) | 64u);
                ck[r][s] = (c < 50) ? ((f2key(v) & ~63u) | (unsigned)(63 - c)) : 0u; }
        unsigned sel[4] = {0u, 0u, 0u, 0u};
#pragma unroll
        for (int k = 0; k < 16; ++k) {
            unsigned gm[4];
#pragma unroll
            for (int r = 0; r < 4; ++r) { const unsigned lm = umax(umax(ck[r][0], ck[r][1]), umax(ck[r][2], ck[r][3])); gm[r] = umax(lm, dppu<0x128>(lm)); }
#pragma unroll
            for (int r = 0; r < 4; ++r) gm[r] = umax(gm[r], dppu<0x124>(gm[r]));
#pragma unroll
            for (int r = 0; r < 4; ++r) gm[r] = umax(gm[r], dppu<0x122>(gm[r]));
#pragma unroll
            for (int r = 0; r < 4; ++r) gm[r] = umax(gm[r], dppu<0x121>(gm[r]));
#pragma unroll
            for (int r = 0; r < 4; ++r) { sel[r] = (fr == k) ? gm[r] : sel[r];
#pragma unroll
                for (int s = 0; s < 4; ++s) ck[r][s] = (ck[r][s] == gm[r]) ? 0u : ck[r][s]; }
        }
#pragma unroll
        for (int r = 0; r < 4; ++r) {
            const int t = t0 + 4 * fq + r;
            const int cs = 63 - (int)(sel[r] & 63u); const unsigned tb = TAB[cs & 63];
            const unsigned k0 = (unsigned)__builtin_amdgcn_ds_bpermute(gbase + (int)(tb & 15u) * 4, (int)res[0][r]);
            const unsigned k1 = (unsigned)__builtin_amdgcn_ds_bpermute(gbase + (int)((tb >> 4) & 15u) * 4, (int)res[1][r]);
            const int e = (127 - (int)(k0 & 127u)) * 128 + (127 - (int)(k1 & 127u));
            const float val = key2f((sel[r] & ~63u) | 32u), top = key2f((rowmax_u(sel[r]) & ~63u) | 32u);
            const float ex = __builtin_amdgcn_exp2f((val - top) * LOG2E), sum = rowsum_f(ex);
            IDX[(size_t)t * 128 + h * 16 + fr] = (unsigned short)e; GATE[(size_t)t * 128 + h * 16 + fr] = ex / sum;
        }
}
struct EpiRoute {
    static constexpr bool PERM = true, AFTER_DRAIN = true;
    const float* ss; unsigned short* IDX; float* GATE;
    DI void fused(pg8::f32x4 (&acc)[2][2][4][2], const pg8::Unit& u, int wr, int wc, int fr, int fq, LAS unsigned char* lds, int wid, int lane) const {
        LAS float* SC = (LAS float*)lds; LAS unsigned char* TAB = lds + SC_TAB_OFF; LAS unsigned* gcnt = (LAS unsigned*)(lds + SC_TAB_OFF + 128);
        const int tid = wid * 64 + lane;
        if (tid < 64) TAB[tid] = (unsigned char)(tid < 50 ? cand_ij(tid) : 0xff);
#pragma unroll
        for (int ai = 0; ai < 2; ++ai) {
            __syncthreads();
#pragma unroll
            for (int m = 0; m < 4; ++m) { const int row = wr * 64 + m * 16 + fr; const float rs = pg8::row_rstd(ss, u.pm * 256 + ai * 128 + row);
#pragma unroll
                for (int bj = 0; bj < 2; ++bj)
#pragma unroll
                    for (int n = 0; n < 2; ++n) *(LAS f32x4*)(SC + row * SC_STRIDE + bj * 128 + wc * 32 + 8 * fq + 4 * n) = acc[ai][bj][m][n] * rs; }
            if (tid == 0) *gcnt = 0u;
            __syncthreads();
            for (;;) {
                unsigned grp = 0u; if (lane == 0) grp = __hip_atomic_fetch_add(gcnt, 1u, __ATOMIC_RELAXED, __HIP_MEMORY_SCOPE_WORKGROUP);
                grp = (unsigned)__builtin_amdgcn_readfirstlane((int)grp);
                if (grp >= 8u) break;
                topk_group(SC, (int)grp * 16, u.pm * 256 + ai * 128 + (int)grp * 16, u.pn, IDX, GATE, TAB, lane);
            }
        }
        __syncthreads();
    }
};
struct OneUnit { pg8::Unit u;
    DI bool next(int i, pg8::Unit& o) const { if (i != 0) return false; o = u; return true; }
    DI void a_ready(const pg8::Unit&) const {}
    DI void done(const pg8::Unit&) const {}
};

DI float dot8(v4u x, v4u u, float acc) {
    acc += bf_lo(x.x) * bf_lo(u.x); acc += bf_hi(x.x) * bf_hi(u.x); acc += bf_lo(x.y) * bf_lo(u.y); acc += bf_hi(x.y) * bf_hi(u.y);
    acc += bf_lo(x.z) * bf_lo(u.z); acc += bf_hi(x.z) * bf_hi(u.z); acc += bf_lo(x.w) * bf_lo(u.w); acc += bf_hi(x.w) * bf_hi(u.w);
    return acc;
}
DI void fma8(float* acc, float a, v4u v) {
    acc[0] += a * bf_lo(v.x); acc[1] += a * bf_hi(v.x); acc[2] += a * bf_lo(v.y); acc[3] += a * bf_hi(v.y);
    acc[4] += a * bf_lo(v.z); acc[5] += a * bf_hi(v.z); acc[6] += a * bf_lo(v.w); acc[7] += a * bf_hi(v.w);
}
DI f32x2 fp8lo(unsigned w) { return __builtin_amdgcn_cvt_pk_f32_fp8((int)w, false); }
DI f32x2 fp8hi(unsigned w) { return __builtin_amdgcn_cvt_pk_f32_fp8((int)w, true); }

template <int CTRL> DI float dppf(float v) { return __uint_as_float(dppu<CTRL>(__float_as_uint(v))); }
constexpr int XG = 8, XNG = T / XG;
DI unsigned wave_ticket(unsigned* head, int lane) {
    unsigned v = 0u; if (lane == 0) v = __hip_atomic_fetch_add(head, 1u, __ATOMIC_RELAXED, __HIP_MEMORY_SCOPE_AGENT);
    return (unsigned)__builtin_amdgcn_readfirstlane((int)v);
}
struct USmall { int i0, i1; v4u xa, xb; };
DI void u_small(USmall& S, const unsigned short* IDX, const bf16* XB, int t, int s, int lane) {
    S.i0 = IDX[(size_t)t * 128 + lane]; S.i1 = IDX[(size_t)t * 128 + 64 + lane];
    const v4u* xr = (const v4u*)(XB + (size_t)t * D + 128 * s + 16 * (lane & 7)); S.xa = xr[0]; S.xb = xr[1];
}
DI void u_token(USmall& SC, const v4u (&GC)[16], const USmall& SN, v4u (&GN)[16], const unsigned char* U8s, const unsigned short* IDX, const bf16* XB, bf16* HPs, int t, int t2, int s, int lane) {
    const int g = lane >> 3, k = lane & 7;
    const v4u xa = SC.xa, xb = SC.xb;
    float xv[16];
    xv[0] = bf_lo(xa.x); xv[1] = bf_hi(xa.x); xv[2] = bf_lo(xa.y); xv[3] = bf_hi(xa.y); xv[4] = bf_lo(xa.z); xv[5] = bf_hi(xa.z); xv[6] = bf_lo(xa.w); xv[7] = bf_hi(xa.w);
    xv[8] = bf_lo(xb.x); xv[9] = bf_hi(xb.x); xv[10] = bf_lo(xb.y); xv[11] = bf_hi(xb.y); xv[12] = bf_lo(xb.z); xv[13] = bf_hi(xb.z); xv[14] = bf_lo(xb.w); xv[15] = bf_hi(xb.w);
    float am = 0.f;
#pragma unroll
    for (int i = 0; i < 16; ++i) am = fmaxf(am, __builtin_fabsf(xv[i]));
    am = fmaxf(am, dppf<0xB1>(am)); am = fmaxf(am, dppf<0x4E>(am)); am = fmaxf(am, dppf<0x141>(am));
    am = fmaxf(am, 1e-20f);
    const float qs = 127.0f / am, dq = am * (1.0f / (127.0f * 512.0f));
    unsigned xq[4];
#pragma unroll
    for (int q = 0; q < 4; ++q) { unsigned w = 0u;
#pragma unroll
        for (int e = 0; e < 4; ++e) { const int qi = (int)__builtin_rintf(xv[4 * q + e] * qs); w |= ((unsigned)qi & 0xffu) << (8 * e); }
        xq[q] = w; }
    u_small(SC, IDX, XB, t2, s, lane);
    int p[16];
#pragma unroll
    for (int i = 0; i < 16; ++i) {
        const unsigned idx = (unsigned)__builtin_amdgcn_ds_bpermute((8 * g + (i & 7)) * 4, i < 8 ? SN.i0 : SN.i1);
        GN[i] = *(const v4u*)(U8s + (idx * (unsigned)TROW + 16u * (unsigned)k));
        int a0 = __builtin_amdgcn_sdot4((int)xq[0], (int)GC[i][0], 0, false), a1 = __builtin_amdgcn_sdot4((int)xq[1], (int)GC[i][1], 0, false);
        a0 = __builtin_amdgcn_sdot4((int)xq[2], (int)GC[i][2], a0, false); a1 = __builtin_amdgcn_sdot4((int)xq[3], (int)GC[i][3], a1, false);
        p[i] = a0 + a1;
        __builtin_amdgcn_sched_barrier(0); }
    const bool h4 = k >= 4, h2 = k & 2, h1 = k & 1;
    int q8[8], q4[4], q2[2];
#pragma unroll
    for (int j = 0; j < 8; ++j) { const int keep = h4 ? p[8 + j] : p[j], send = h4 ? p[j] : p[8 + j]; q8[j] = keep + (int)dppu<0x141>((unsigned)send); }
#pragma unroll
    for (int j = 0; j < 4; ++j) { const int keep = h2 ? q8[4 + j] : q8[j], send = h2 ? q8[j] : q8[4 + j]; q4[j] = keep + (int)dppu<0x4E>((unsigned)send); }
#pragma unroll
    for (int j = 0; j < 2; ++j) { const int keep = h1 ? q4[2 + j] : q4[j], send = h1 ? q4[j] : q4[2 + j]; q2[j] = keep + (int)dppu<0xB1>((unsigned)send); }
    *(unsigned*)(HPs + (size_t)t * 128 + (h4 ? 64 : 0) + 8 * g + 2 * (k & 3)) = pk2((float)q2[0] * dq, (float)q2[1] * dq);
}
DI float wave_sum_dpp63(float v) {
    v += dppf<0xB1>(v); v += dppf<0x4E>(v); v += dppf<0x141>(v); v += dppf<0x140>(v);
    v += __uint_as_float((unsigned)__builtin_amdgcn_update_dpp(0, (int)__float_as_uint(v), 0x142, 0xa, 0xf, false));
    v += __uint_as_float((unsigned)__builtin_amdgcn_update_dpp(0, (int)__float_as_uint(v), 0x143, 0xc, 0xf, false));
    return v;
}
struct VSmall { int i0, i1; float a0, a1; unsigned xo; };
DI void v_small(VSmall& S, const unsigned short* IDX, const bf16* A, const bf16* XB, int t, int s, int lane) {
    S.i0 = IDX[(size_t)t * 128 + lane]; S.i1 = IDX[(size_t)t * 128 + 64 + lane]; S.a0 = __uint_as_float((unsigned)A[(size_t)t * 128 + lane] << 16); S.a1 = __uint_as_float((unsigned)A[(size_t)t * 128 + 64 + lane] << 16);
    S.xo = *(const unsigned*)(XB + (size_t)t * D + 128 * s + 2 * lane);
}
template <bool FINAL>
DI void v_token(VSmall& SC, const v4u (&GC)[16], const VSmall& SN, v4u (&GN)[16], const unsigned char* V8s, const unsigned short* IDX, const bf16* A, float* xf, bf16* XB, float* ss_out,
                int t, int t2, int s, int lane) {
    const int g = lane >> 3, k = lane & 7;
    const bool b3 = lane & 8, b4 = lane & 16, b5 = lane & 32;
    float av[16];
#pragma unroll
    for (int i = 0; i < 16; ++i) av[i] = __uint_as_float((unsigned)__builtin_amdgcn_ds_bpermute((8 * g + (i & 7)) * 4, (int)__float_as_uint(i < 8 ? SC.a0 : SC.a1)));
    f32x2 o = {bf_lo(SC.xo), bf_hi(SC.xo)};
    v_small(SC, IDX, A, XB, t2, s, lane);
    f32x2 acc[8];
#pragma unroll
    for (int i = 0; i < 8; ++i) acc[i] = (f32x2){0.f, 0.f};
#pragma unroll
    for (int i = 0; i < 16; ++i) {
        const unsigned idx = (unsigned)__builtin_amdgcn_ds_bpermute((8 * g + (i & 7)) * 4, i < 8 ? SN.i0 : SN.i1);
        GN[i] = *(const v4u*)(V8s + (idx * (unsigned)TROW + 16u * (unsigned)k));
        const f32x2 a2 = {av[i], av[i]};
#pragma unroll
        for (int q = 0; q < 4; ++q) { acc[2 * q] = __builtin_elementwise_fma(a2, fp8lo(GC[i][q]), acc[2 * q]); acc[2 * q + 1] = __builtin_elementwise_fma(a2, fp8hi(GC[i][q]), acc[2 * q + 1]); }
        __builtin_amdgcn_sched_barrier(0); }
    float v[16];
#pragma unroll
    for (int i = 0; i < 8; ++i) { v[2 * i] = acc[i].x; v[2 * i + 1] = acc[i].y; }
    float v8[8], v4[4], v2[2];
#pragma unroll
    for (int j = 0; j < 8; ++j) { const float keep = b3 ? v[8 + j] : v[j], send = b3 ? v[j] : v[8 + j]; v8[j] = keep + dppf<0x128>(send); }
#pragma unroll
    for (int j = 0; j < 4; ++j) { const float keep = b4 ? v8[4 + j] : v8[j], send = b4 ? v8[j] : v8[4 + j]; v4[j] = keep + __shfl_xor(send, 16); }
#pragma unroll
    for (int j = 0; j < 2; ++j) { const float keep = b5 ? v4[2 + j] : v4[j], send = b5 ? v4[j] : v4[2 + j]; v2[j] = keep + __shfl_xor(send, 32); }
    const int tl = (8 * k + (b3 ? 4 : 0) + (b4 ? 2 : 0) + (b5 ? 1 : 0)) * 4;
    const float s0 = __uint_as_float((unsigned)__builtin_amdgcn_ds_permute(tl, (int)__float_as_uint(v2[0]))), s1 = __uint_as_float((unsigned)__builtin_amdgcn_ds_permute(tl, (int)__float_as_uint(v2[1])));
    const int col = 128 * s + 2 * lane;
    o.x += s0; o.y += s1;
    *(unsigned*)(XB + (size_t)t * D + col) = pk2(o.x, o.y);
    const float sq = wave_sum_dpp63(o.x * o.x + o.y * o.y);
    if (lane == 63) ss_out[(size_t)t * 16 + s] = sq;
}
template <int PASS, bool FINAL>
DI void sliced_pass(const unsigned char* TAB, const unsigned short* IDX, const bf16* XBc, bf16* XBw, bf16* HP, const bf16* A, float* xf, float* ss_out,
                    unsigned* heads, unsigned* census, volatile LAS unsigned* slot, int wave, int lane, int tid) {
    const int own = (int)(xb_xcc_id() & 7u);
    __syncthreads();
    if (tid == 0) { unsigned all = 1u;
#pragma unroll 1
        for (int q = 0; q < 8; ++q) { const unsigned n = xb_ld(census + XB_XCNT(q)) + xb_ld(census + XB_XCNT(q + 8)); all &= (n > 0u) ? 1u : 0u; }
        slot[1] = all; }
    __syncthreads();
    const int nds = slot[1] ? 1 : 8;
#pragma unroll 1
    for (int ds = 0; ds < nds; ++ds) { const int s = (own + ds) & 7;
        unsigned* head = heads + 64 * s; const unsigned char* Ts = TAB + 128 * CPOS(s); bf16* HPs = HP + (size_t)s * T * 128;
        unsigned tk = wave_ticket(head, lane);
        if (tk >= (unsigned)XNG) continue;
        unsigned nxt = wave_ticket(head, lane);
#define TOK_AT(dj) ((j + (dj) < XG) ? (int)tk * XG + j + (dj) : (nxt < (unsigned)XNG ? (int)nxt * XG + j + (dj) - XG : (int)tk * XG + XG - 1))
        int j = 0;
        if (PASS == 0) {
            USmall S0, S1; v4u G0[16], G1[16];
            u_small(S0, IDX, XBc, (int)tk * XG, s, lane); u_small(S1, IDX, XBc, (int)tk * XG + 1, s, lane);
            { const int g = lane >> 3, k = lane & 7;
#pragma unroll
              for (int i = 0; i < 16; ++i) { const unsigned idx = (unsigned)__builtin_amdgcn_ds_bpermute((8 * g + (i & 7)) * 4, i < 8 ? S0.i0 : S0.i1); G0[i] = *(const v4u*)(Ts + (idx * (unsigned)TROW + 16u * (unsigned)k)); } }
            for (;;) {
#pragma unroll 1
                for (j = 0; j < XG; j += 2) {
                    u_token(S0, G0, S1, G1, Ts, IDX, XBc, HPs, (int)tk * XG + j, TOK_AT(2), s, lane);
                    { const int jj = j; j = jj + 1; const int t3 = TOK_AT(2); j = jj; u_token(S1, G1, S0, G0, Ts, IDX, XBc, HPs, (int)tk * XG + j + 1, t3, s, lane); } }
                if (nxt >= (unsigned)XNG) break; tk = nxt; nxt = wave_ticket(head, lane); }
        } else {
            VSmall S0, S1; v4u G0[16], G1[16];
            v_small(S0, IDX, A, XBw, (int)tk * XG, s, lane); v_small(S1, IDX, A, XBw, (int)tk * XG + 1, s, lane);
            { const int g = lane >> 3, k = lane & 7;
#pragma unroll
              for (int i = 0; i < 16; ++i) { const unsigned idx = (unsigned)__builtin_amdgcn_ds_bpermute((8 * g + (i & 7)) * 4, i < 8 ? S0.i0 : S0.i1); G0[i] = *(const v4u*)(Ts + (idx * (unsigned)TROW + 16u * (unsigned)k)); } }
            for (;;) {
#pragma unroll 1
                for (j = 0; j < XG; j += 2) {
                    v_token<FINAL>(S0, G0, S1, G1, Ts, IDX, A, xf, XBw, ss_out, (int)tk * XG + j, TOK_AT(2), s, lane);
                    { const int jj = j; j = jj + 1; const int t3 = TOK_AT(2); j = jj; v_token<FINAL>(S1, G1, S0, G0, Ts, IDX, A, xf, XBw, ss_out, (int)tk * XG + j + 1, t3, s, lane); } }
                if (nxt >= (unsigned)XNG) break; tk = nxt; nxt = wave_ticket(head, lane); }
        }
#undef TOK_AT
    }
}
DI void reduce_phase(const bf16* HP, const float* GATE, const float* ss_in, bf16* A, int vcu, int G, int tid) {
    const size_t gt = (size_t)vcu * (NWAVES * 64) + tid, NGT = (size_t)G * NWAVES * 64;
    for (size_t c = gt; c < (size_t)T * 64; c += NGT) { float h0 = 0.f, h1 = 0.f;
#pragma unroll
        for (int s = 0; s < 8; ++s) { const unsigned w = *(const unsigned*)(HP + (size_t)s * T * 128 + 2 * c); h0 += bf_lo(w); h1 += bf_hi(w); }
        const float rs = pg8::row_rstd(ss_in, (int)(c >> 6)); h0 *= rs; h1 *= rs;
        const f32x2 g = *(const f32x2*)(GATE + 2 * c);
        *(unsigned*)(A + 2 * c) = pk2((1.0f / 1024.0f) * g.x * (0.5f * h0 * (1.f + erff(h0 * 0.70710678118654752f))), (1.0f / 1024.0f) * g.y * (0.5f * h1 * (1.f + erff(h1 * 0.70710678118654752f)))); }
}
DI void final_phase(const float* ss, const bf16* XB, float* outp, const float* fin_g, int vcu, int G, int wave, int lane) {
    for (int m0 = 2 * (vcu * NWAVES + wave); m0 < T; m0 += 2 * G * NWAVES) {
        v4u v[2][2]; float rf[2];
#pragma unroll
        for (int r = 0; r < 2; ++r) { rf[r] = pg8::row_rstd(ss, m0 + r);
#pragma unroll
            for (int j = 0; j < 2; ++j) v[r][j] = *((const v4u*)(XB + (size_t)(m0 + r) * D) + lane + 64 * j); }
#pragma unroll
        for (int r = 0; r < 2; ++r)
#pragma unroll
            for (int j = 0; j < 2; ++j) { const f32x4 g0 = *((const f32x4*)(fin_g + 512 * j) + 2 * lane), g1 = *((const f32x4*)(fin_g + 512 * j) + 2 * lane + 1); const v4u w = v[r][j];
                float* o = outp + (size_t)(m0 + r) * D + 512 * j + 8 * lane;
                *(f32x4*)o = (f32x4){bf_lo(w.x), bf_hi(w.x), bf_lo(w.y), bf_hi(w.y)} * rf[r] * g0; *(f32x4*)(o + 4) = (f32x4){bf_lo(w.z), bf_hi(w.z), bf_lo(w.w), bf_hi(w.w)} * rf[r] * g1; } }
}

DI int t5_bucket(int rel) {
    const int n = rel < 0 ? -rel : rel; int b;
    if (n < 8) b = n; else if (n < 12) b = 8; else if (n < 16) b = 9; else if (n < 23) b = 10; else if (n < 32) b = 11; else if (n < 46) b = 12; else if (n < 64) b = 13; else if (n < 91) b = 14; else b = 15;
    return b + (rel > 0 ? 16 : 0);
}
DI int crow(int reg, int h) { return (reg & 3) + 8 * (reg >> 2) + 4 * h; }
constexpr int AT_KL = 0, AT_KSTR = 144, AT_VT = 384 * AT_KSTR  , AT_VSTR = 776, AT_BT = AT_VT + 64 * AT_VSTR  , AT_END = AT_BT + 4 * 512 * 4;
static_assert(AT_END <= RING_BYTES, "attention LDS");
DI void attn_phase(const bf16* Qg, const bf16* Kg, const bf16* Vg, bf16* AO, const float* rel_bias, const float* sink, LAS unsigned char* lds, int vcu, int G, int wave, int lane, int tid) {
    const int r = lane & 31, h = lane >> 5;
    for (int unit = vcu; unit < BATCH * 4 * (SEQ / 128); unit += G) {
        const int b = unit / 256, kvh = (unit % 256) / 64, blk = unit % 64;
        __syncthreads();
        for (int c = tid; c < 384 * 8; c += NWAVES * 64) { const int row = c >> 3, c8 = c & 7, ts = blk * 128 - 128 + row;
            v4u kv = {0u, 0u, 0u, 0u}, vv = {0u, 0u, 0u, 0u};
            if (ts >= 0 && ts < SEQ) { const size_t g = (size_t)(b * SEQ + ts) * 256 + kvh * 64 + c8 * 8; kv = *(const v4u*)(Kg + g); vv = *(const v4u*)(Vg + g); }
            *(LAS v4u*)(lds + AT_KL + row * AT_KSTR + c8 * 16) = kv;
            LAS unsigned short* vt = (LAS unsigned short*)(lds + AT_VT) + (c8 * 8) * (AT_VSTR / 2) + row;
            vt[0 * (AT_VSTR / 2)] = (unsigned short)(vv.x & 0xffffu); vt[1 * (AT_VSTR / 2)] = (unsigned short)(vv.x >> 16);
            vt[2 * (AT_VSTR / 2)] = (unsigned short)(vv.y & 0xffffu); vt[3 * (AT_VSTR / 2)] = (unsigned short)(vv.y >> 16);
            vt[4 * (AT_VSTR / 2)] = (unsigned short)(vv.z & 0xffffu); vt[5 * (AT_VSTR / 2)] = (unsigned short)(vv.z >> 16);
            vt[6 * (AT_VSTR / 2)] = (unsigned short)(vv.w & 0xffffu); vt[7 * (AT_VSTR / 2)] = (unsigned short)(vv.w >> 16); }
        for (int c = tid; c < 4 * 512; c += NWAVES * 64) { const int g = c >> 9, i = c & 511, rel = i - 255;
            float v = NEGBIG; if (rel >= -128 && rel <= 128) v = rel_bias[t5_bucket(rel) * 16 + kvh * 4 + g] * LOG2E;
            *(LAS float*)(lds + AT_BT + c * 4) = v; }
        __syncthreads();
        const int g = wave >> 1, qh = wave & 1, head = kvh * 4 + g;
        const float sinkl = sink[head] * LOG2E;
        bf16x8 qf[2][4];
#pragma unroll
        for (int qt = 0; qt < 2; ++qt)
#pragma unroll
            for (int s = 0; s < 4; ++s) qf[qt][s] = *(const bf16x8*)(Qg + (size_t)(b * SEQ + blk * 128 + qh * 64 + qt * 32 + r) * D + head * 64 + s * 16 + h * 8);
        float m[2] = {sinkl, sinkl}, l[2] = {0.f, 0.f};
        f32x16 o[2][2];
#pragma unroll
        for (int qt = 0; qt < 2; ++qt)
#pragma unroll
            for (int dt = 0; dt < 2; ++dt)
#pragma unroll
                for (int i = 0; i < 16; ++i) o[qt][dt][i] = 0.f;
        int kt_lo = 2 * qh, kt_hi = 2 * qh + 9;
        if (blk == 0 && kt_lo < 4) kt_lo = 4;
        if (blk == SEQ / 128 - 1 && kt_hi > 7) kt_hi = 7;
#pragma unroll 1
        for (int kt = kt_lo; kt <= kt_hi; ++kt) {
            bf16x8 kf[4];
#pragma unroll
            for (int s = 0; s < 4; ++s) kf[s] = *(const LAS bf16x8*)(lds + AT_KL + (32 * kt + r) * AT_KSTR + s * 32 + h * 16);
            bf16x8 vf[2][2];
#pragma unroll
            for (int dt = 0; dt < 2; ++dt)
#pragma unroll
                for (int s2 = 0; s2 < 2; ++s2) { const LAS unsigned char* vp = lds + AT_VT + (32 * dt + r) * AT_VSTR + (32 * kt + 16 * s2 + 4 * h) * 2;
                    const v2u lo = *(const LAS v2u*)vp, hi2 = *(const LAS v2u*)(vp + 16); v4u w = {lo.x, lo.y, hi2.x, hi2.y}; vf[dt][s2] = __builtin_bit_cast(bf16x8, w); }
#pragma unroll
            for (int qt = 0; qt < 2; ++qt) {
                f32x16 s;
                const LAS float* bt = (const LAS float*)(lds + AT_BT) + g * 512 + 127 + 32 * kt + 4 * h - (64 * qh + 32 * qt + r);
#pragma unroll
                for (int i = 0; i < 16; ++i) s[i] = bt[(i & 3) + 8 * (i >> 2)];
#pragma unroll
                for (int k4 = 0; k4 < 4; ++k4) s = __builtin_amdgcn_mfma_f32_32x32x16_bf16(kf[k4], qf[qt][k4], s, 0, 0, 0);
                float mx = s[0];
#pragma unroll
                for (int i = 1; i < 16; ++i) mx = fmaxf(mx, s[i]);
                mx = fmaxf(mx, __shfl_xor(mx, 32));
                const float mn = fmaxf(m[qt], mx), al = __builtin_amdgcn_exp2f(m[qt] - mn); m[qt] = mn;
                float ps = 0.f;
#pragma unroll
                for (int i = 0; i < 16; ++i) { s[i] = __builtin_amdgcn_exp2f(s[i] - mn); ps += s[i]; }
                l[qt] = l[qt] * al + ps;
#pragma unroll
                for (int dt = 0; dt < 2; ++dt)
#pragma unroll
                    for (int i = 0; i < 16; ++i) o[qt][dt][i] *= al;
                bf16x8 pf[2];
#pragma unroll
                for (int s2 = 0; s2 < 2; ++s2) { v4u w; w.x = pk2(s[8 * s2 + 0], s[8 * s2 + 1]); w.y = pk2(s[8 * s2 + 2], s[8 * s2 + 3]); w.z = pk2(s[8 * s2 + 4], s[8 * s2 + 5]); w.w = pk2(s[8 * s2 + 6], s[8 * s2 + 7]); pf[s2] = __builtin_bit_cast(bf16x8, w); }
#pragma unroll
                for (int dt = 0; dt < 2; ++dt)
#pragma unroll
                    for (int s2 = 0; s2 < 2; ++s2) o[qt][dt] = __builtin_amdgcn_mfma_f32_32x32x16_bf16(vf[dt][s2], pf[s2], o[qt][dt], 0, 0, 0);
            }
        }
#pragma unroll
        for (int qt = 0; qt < 2; ++qt) {
            const float lt = l[qt] + __shfl_xor(l[qt], 32) + __builtin_amdgcn_exp2f(sinkl - m[qt]), inv = 1.0f / lt;
            bf16* op = AO + (size_t)(b * SEQ + blk * 128 + qh * 64 + qt * 32 + r) * D + head * 64 + 4 * h;
#pragma unroll
            for (int dt = 0; dt < 2; ++dt)
#pragma unroll
                for (int gq = 0; gq < 4; ++gq) { v2u w; w.x = pk2(o[qt][dt][4 * gq] * inv, o[qt][dt][4 * gq + 1] * inv); w.y = pk2(o[qt][dt][4 * gq + 2] * inv, o[qt][dt][4 * gq + 3] * inv);
                    *(v2u*)(op + 32 * dt + 8 * gq) = w; }
        }
    }
}

struct Args { const float* in[16]; float* out; unsigned char* ws; int ph_lo, ph_hi; };
__global__ void __launch_bounds__(NWAVES * 64, 2) fwd_kernel(Args args) {
    extern __shared__ __attribute__((aligned(16))) unsigned char lds_raw[];
    LAS unsigned char* lds = (LAS unsigned char*)lds_raw;
    volatile LAS unsigned* MISC = (volatile LAS unsigned*)(lds + MISC_OFF);
    const int tid = threadIdx.x, lane = tid & 63, wave = __builtin_amdgcn_readfirstlane(tid >> 6);
    const int G = gridDim.x; const int bx = blockIdx.x; const int vcu = (G % 8 == 0) ? (bx % 8) * (G / 8) + bx / 8 : bx;
    unsigned char* ws = args.ws;
    unsigned* ctl = (unsigned*)(ws + WS_CTL);
    const float* x = args.in[0]; const float* conv_g = args.in[1]; const float* w_in = args.in[2]; const float* conv_w = args.in[3]; const float* w_out = args.in[4];
    const float* attn_g = args.in[5]; const float* w_qkv = args.in[6]; const float* sink = args.in[7]; const float* w_o = args.in[8]; const float* rel_bias = args.in[9];
    const float* ffn_g = args.in[10]; const float* w_pq = args.in[11]; const float* subk = args.in[12]; const float* pu = args.in[13]; const float* pv = args.in[14]; const float* fin_g = args.in[15];
    float* out = args.out;
    bf16* WinT = (bf16*)(ws + WS_WIN); bf16* WoutT = (bf16*)(ws + WS_WOUT); bf16* WqkvT = (bf16*)(ws + WS_WQKV); bf16* WoT = (bf16*)(ws + WS_WO); bf16* WpqT = (bf16*)(ws + WS_WPQ); bf16* SKb = (bf16*)(ws + WS_SK);
    float* SS = (float*)(ws + WS_SS); unsigned short* IDX = (unsigned short*)(ws + WS_IDX); bf16* HP = (bf16*)(ws + WS_HP); bf16* AA = (bf16*)(ws + WS_A); float* GATE = (float*)(ws + WS_GATE);
    bf16* XB = (bf16*)(ws + WS_XB); bf16* Y = (bf16*)(ws + WS_Y); unsigned char* U8 = ws + WS_U; unsigned char* V8 = ws + WS_V;
    bf16* G1 = (bf16*)(ws + WS_G1); bf16* PQ = (bf16*)(ws + WS_PQ); bf16* Qb = (bf16*)(ws + WS_Q); bf16* Kb = (bf16*)(ws + WS_K); bf16* VVb = (bf16*)(ws + WS_VV); bf16* AO = (bf16*)(ws + WS_AO);
    float* SS0 = SS; float* SS1 = SS + (size_t)T * 16; float* SS2 = SS + (size_t)2 * T * 16; float* SS3 = SS + (size_t)3 * T * 16; float* SS4 = SS + (size_t)4 * T * 16;

    for (int u = tid; u < (LDS_BYTES - LDSCTL_OFF) / 4; u += NWAVES * 64) ((LAS unsigned*)(lds + LDSCTL_OFF))[u] = 0u;
    __syncthreads();
    XcdBarrier bar; bar.bar = ctl + CW_BAR; bar.x = 0; bar.st = nullptr;
    if (!MK_PER_PHASE) bar = xcd_barrier_post(ctl + CW_BAR, MISC + 8);
    const int lo = args.ph_lo, hi = args.ph_hi;
#define IN(k) (lo <= (k) && (k) < hi)
#define SEAM(k) do { if (IN(k) && IN((k) + 1)) xcd_barrier(bar); } while (0)

    if (IN(0)) REPS(0) {
        P0Args a{x, conv_g, w_in, w_out, attn_g, w_qkv, w_o, ffn_g, w_pq, subk, pu, pv, WinT, WoutT, WqkvT, WoT, WpqT, SKb, U8, V8, XB, SS0};
        p0_prologue(a, lds, vcu, G, wave, lane, tid);
    }
    SEAM(0);
    if (IN(1)) REPS(1) {
        pg8::Gemm g{XB, WinT, T, NIN, D}; pg8::StaticOrder S; S.init(T, NIN, G, bx);
        pg8::EpiConvIn E{G1 + (size_t)T * D, G1, SS0};
        pg8::gemm_phase<pg8::EpiConvIn, pg8::StaticOrder, true, true>(lds, g, S, E);
    }
    SEAM(1);
    if (IN(2)) REPS(2) conv_gate_phase(G1, G1 + (size_t)T * D, conv_w, Y, vcu, G, tid);
    SEAM(2);
    if (IN(3)) REPS(3) {
        pg8::Gemm g{Y, WoutT, T, D, D}; pg8::StaticOrder S; S.init(T, D, G, bx);
        pg8::EpiResid<true> E{x, XB, SS1};
        pg8::gemm_phase<pg8::EpiResid<true>, pg8::StaticOrder, true, true>(lds, g, S, E);
    }
    SEAM(3);
    if (IN(4)) {
        pg8::Gemm g{XB, WpqT, T, NPQ, D}; pg8::StaticOrder S; S.init(T, NPQ, G, bx); EpiRoute E{SS1, IDX, GATE}; pg8::Unit uu;
        for (int i = 0; S.next(i, uu); ++i) { OneUnit O{uu}; pg8::gemm_phase<EpiRoute, OneUnit, false, true>(lds, g, O, E); }
    }
    SEAM(4);
    if (IN(6)) sliced_pass<0, false>(U8, IDX, XB, XB, HP, AA, out, SS2, ctl + CW_WQ + 64 * 0, ctl + CW_BAR, MISC + 12, wave, lane, tid);
    SEAM(6);
    if (IN(7)) reduce_phase(HP, GATE, SS1, AA, vcu, G, tid);
    SEAM(7);
    if (IN(8)) sliced_pass<1, false>(V8, IDX, XB, XB, HP, AA, out, SS2, ctl + CW_WQ + 64 * 8, ctl + CW_BAR, MISC + 12, wave, lane, tid);
    SEAM(8);
    if (IN(9)) REPS(9) {
        pg8::Gemm g{XB, WqkvT, T, NQKV, D}; pg8::StaticOrder S; S.init(T, NQKV, G, bx);
        pg8::EpiBf16RS E{Qb, D, 4, Kb, VVb, 256, SS2};
        pg8::gemm_phase<pg8::EpiBf16RS, pg8::StaticOrder, true, true>(lds, g, S, E);
        if (G == 256 && bx >= 128) { constexpr size_t NB = (size_t)2 * NEXP * D / 2048; table_blocks(pu, pv, ffn_g, U8, V8, NB / 2, NB, (size_t)((bx - 128) * NWAVES + wave), (size_t)128 * NWAVES, lane); }
    }
    SEAM(9);
    if (IN(10)) REPS(10) attn_phase(Qb, Kb, VVb, AO, rel_bias, sink, lds, vcu, G, wave, lane, tid);
    SEAM(10);
    if (IN(11)) {
        pg8::Gemm g{AO, WoT, T, D, D}; pg8::StaticOrder S; S.init(T, D, G, bx);
        pg8::EpiResid<false> E{nullptr, XB, SS3};
        pg8::gemm_phase<pg8::EpiResid<false>, pg8::StaticOrder, true, true>(lds, g, S, E);
    }
    SEAM(11);
    if (IN(12)) {
        pg8::Gemm g{XB, WpqT + (size_t)NPQ * D, T, NPQ, D}; pg8::StaticOrder S; S.init(T, NPQ, G, bx); EpiRoute E{SS3, IDX, GATE}; pg8::Unit uu;
        for (int i = 0; S.next(i, uu); ++i) { OneUnit O{uu}; pg8::gemm_phase<EpiRoute, OneUnit, false, true>(lds, g, O, E); }
    }
    SEAM(12);
    if (IN(14)) sliced_pass<0, true>(U8 + (size_t)NEXP * TROW, IDX, XB, XB, HP, AA, out, SS4, ctl + CW_WQ + 64 * 16, ctl + CW_BAR, MISC + 12, wave, lane, tid);
    SEAM(14);
    if (IN(15)) reduce_phase(HP, GATE, SS3, AA, vcu, G, tid);
    SEAM(15);
    if (IN(16)) sliced_pass<1, true>(V8 + (size_t)NEXP * TROW, IDX, XB, XB, HP, AA, out, SS4, ctl + CW_WQ + 64 * 24, ctl + CW_BAR, MISC + 12, wave, lane, tid);
    SEAM(16);
    if (IN(17)) final_phase(SS4, XB, out, fin_g, vcu, G, wave, lane);
#undef IN
#undef SEAM
}

extern "C" void kernel_launch(void* const* d_in, const int* in_sizes, int n_in, void* d_out, int out_size, void* d_ws, size_t ws_size, hipStream_t stream) {
    static int grid = 0;
    if (grid == 0) {
        if (n_in != 16 || in_sizes[0] != T * D || out_size != T * D || ws_size < WS_END) { fprintf(stderr, "kernel_launch: unexpected shapes (n_in %d, in0 %d, out %d, ws %zu)\n", n_in, n_in > 0 ? in_sizes[0] : -1, out_size, ws_size); grid = -1; return; }
        int dev = 0, cus = 0, per_cu = 0;
        if (hipGetDevice(&dev) != hipSuccess || hipDeviceGetAttribute(&cus, hipDeviceAttributeMultiprocessorCount, dev) != hipSuccess) { grid = -1; return; }
        if (hipFuncSetAttribute((const void*)fwd_kernel, hipFuncAttributeMaxDynamicSharedMemorySize, LDS_BYTES) != hipSuccess) { fprintf(stderr, "kernel_launch: hipFuncSetAttribute failed\n"); grid = -1; return; }
        if (hipOccupancyMaxActiveBlocksPerMultiprocessor(&per_cu, (const void*)fwd_kernel, NWAVES * 64, LDS_BYTES) != hipSuccess || per_cu < 1) { fprintf(stderr, "kernel_launch: occupancy query says %d blocks per CU\n", per_cu); (void)hipGetLastError(); grid = -1; return; }
        grid = cus;
    }
    if (grid < 0) return;
    (void)hipMemsetAsync((char*)d_ws + WS_CTL, 0, CTL_ZERO_BYTES, stream);
    Args a{};
    for (int i = 0; i < 16; ++i) a.in[i] = (const float*)d_in[i];
    a.out = (float*)d_out; a.ws = (unsigned char*)d_ws;
#if MK_PER_PHASE
    for (int p = 0; p < NPH; ++p) { a.ph_lo = p; a.ph_hi = p + 1; hipLaunchKernelGGL(fwd_kernel, dim3(grid), dim3(NWAVES * 64), LDS_BYTES, stream, a); }
#else
    a.ph_lo = 0; a.ph_hi = NPH;
    hipLaunchKernelGGL(fwd_kernel, dim3(grid), dim3(NWAVES * 64), LDS_BYTES, stream, a);
#endif
}
```
